# Optimizing an MI355X kernel written in HIP

```python
import math
import jax
import jax.numpy as jnp
from jax import lax
import numpy as np

D_MODEL = 2048
BATCH = 2
SEQ = 4096
DEPTH = 4
DEC_BATCH = 32
DEC_SEQ = 8
PAST_LEN = 16384
PAGE_SIZE = 128

MIX_W = D_MODEL // 2
N_BRANCH = 3
GLA_HEADS = 4
GLA_DK = MIX_W // 2 // GLA_HEADS
GLA_DV = MIX_W // GLA_HEADS
GLA_RANK = 16
GLA_TAU = 16.0
GLA_CHUNK = 64
SWA_HEADS = 16
SWA_KV = 2
SWA_HD = MIX_W // SWA_HEADS
SWA_GROUP = SWA_HEADS // SWA_KV
WINDOW = 128
SWA_BLOCK = 128
N_BUCKETS = 32
MAX_DIST = 128
CONV_W = 3
N_MEM = 256
X_HEADS = 4
X_HD = 128
D_FF = ((8 * D_MODEL // 3 + 127) // 128) * 128
EPS = 1e-6
SPLIT_SIZES = (GLA_HEADS * GLA_DK, GLA_HEADS * GLA_DK, MIX_W, MIX_W, GLA_RANK,
               SWA_HEADS * SWA_HD, SWA_KV * SWA_HD, SWA_KV * SWA_HD,
               MIX_W, MIX_W, MIX_W, N_BRANCH * D_MODEL)
N_IN = sum(SPLIT_SIZES)

kernel_name = 'hybrid_gla_swa_shortconv_decoder_step'


def rmsnorm(x, g):
    xf = x.astype(jnp.float32)
    y = xf * lax.rsqrt(jnp.mean(xf * xf, axis=-1, keepdims=True) + EPS)
    return (y * g.astype(jnp.float32)).astype(x.dtype)


def split_columns(z):
    idx, acc = [], 0
    for s in SPLIT_SIZES[:-1]:
        acc += s
        idx.append(acc)
    return jnp.split(z, idx, axis=-1)


def causal_dwconv(u, prev, w):
    T = u.shape[1]
    up = jnp.concatenate([prev.astype(u.dtype), u], axis=1)
    out = up[:, 0:T] * w[0]
    for j in range(1, CONV_W):
        out = out + up[:, j:j + T] * w[j]
    return out, up[:, T:]


def t5_bucket(dist):
    n = jnp.maximum(dist, 0)
    max_exact = N_BUCKETS // 2
    nf = jnp.maximum(n, 1).astype(jnp.float32)
    large = max_exact + (jnp.log(nf / max_exact) / math.log(MAX_DIST / max_exact)
                         * (N_BUCKETS - max_exact)).astype(jnp.int32)
    large = jnp.minimum(large, N_BUCKETS - 1)
    return jnp.where(n < max_exact, n, large)


def gla_chunked(q, k, v, lg, s0):
    B, T, H, _ = q.shape
    L = min(GLA_CHUNK, T)
    nc = -(-T // L)
    pad = nc * L - T

    def chunks(a):
        a = a.astype(jnp.float32)
        if pad:
            a = jnp.pad(a, ((0, 0), (0, pad), (0, 0), (0, 0)))
        return a.reshape(B, nc, L, H, a.shape[-1]).transpose(1, 0, 3, 2, 4)

    causal = jnp.tril(jnp.ones((L, L), dtype=bool))[:, :, None]

    def step(S, inp):
        qc, kc, vc, gc = inp
        b = jnp.cumsum(gc, axis=2)
        o = jnp.einsum('bhtd,bhdv->bhtv', qc * jnp.exp(b), S)
        decay = jnp.exp(jnp.where(causal, b[:, :, :, None, :] - b[:, :, None, :, :], -jnp.inf))
        a = jnp.einsum('bhtd,bhsd,bhtsd->bhts', qc, kc, decay)
        o = o + jnp.einsum('bhts,bhsv->bhtv', a, vc)
        b_end = b[:, :, -1:, :]
        S = (jnp.exp(b_end[:, :, 0, :, None]) * S
             + jnp.einsum('bhsd,bhsv->bhdv', kc * jnp.exp(b_end - b), vc))
        return S, o

    S, o = lax.scan(step, s0.astype(jnp.float32), (chunks(q), chunks(k), chunks(v), chunks(lg)))
    o = o.transpose(1, 0, 3, 2, 4).reshape(B, nc * L, H, -1)[:, :T]
    return o.astype(v.dtype), S.astype(s0.dtype)


def sink_attention(q, k, v, dist, valid, sinks, rel_bias):
    s = jnp.einsum('bnqkgd,bnskd->bnkgqs', q, k).astype(jnp.float32) * (SWA_HD ** -0.5)
    bias = rel_bias[t5_bucket(dist)].astype(jnp.float32)
    bias = bias.reshape(dist.shape + (SWA_KV, SWA_GROUP)).transpose(2, 3, 0, 1)
    s = jnp.where(valid[None, :, None, None], s + bias, -jnp.inf)
    sink = sinks.astype(jnp.float32).reshape(SWA_KV, SWA_GROUP)[:, :, None, None]
    m = jnp.maximum(jnp.max(s, axis=-1, keepdims=True), sink)
    p = jnp.exp(s - m)
    p = p / (jnp.sum(p, axis=-1, keepdims=True) + jnp.exp(sink - m))
    return jnp.einsum('bnkgqs,bnskd->bnqkgd', p.astype(v.dtype), v)


def swa_prompt(q, k, v, sinks, rel_bias):
    B, T = q.shape[:2]
    nb = T // SWA_BLOCK
    qb = q.reshape(B, nb, SWA_BLOCK, SWA_KV, SWA_GROUP, SWA_HD)

    def band(a):
        prev = jnp.concatenate([jnp.zeros_like(a[:, :SWA_BLOCK]), a[:, :T - SWA_BLOCK]], axis=1)
        return jnp.concatenate([prev.reshape(B, nb, SWA_BLOCK, SWA_KV, SWA_HD),
                                a.reshape(B, nb, SWA_BLOCK, SWA_KV, SWA_HD)], axis=2)

    i = jnp.arange(SWA_BLOCK)[:, None]
    j = jnp.arange(2 * SWA_BLOCK)[None, :]
    dist = SWA_BLOCK + i - j
    kpos = (jnp.arange(nb)[:, None, None] - 1) * SWA_BLOCK + j[None]
    valid = ((dist >= 0) & (dist <= WINDOW))[None] & (kpos >= 0)
    o = sink_attention(qb, band(k), band(v), dist, valid, sinks, rel_bias)
    return o.reshape(B, T, MIX_W), k[:, T - WINDOW:], v[:, T - WINDOW:]


def swa_sample(q, k, v, k_buf, v_buf, sinks, rel_bias):
    B, T = q.shape[:2]
    W = k_buf.shape[1]
    kc = jnp.concatenate([k_buf.astype(k.dtype), k], axis=1)
    vc = jnp.concatenate([v_buf.astype(v.dtype), v], axis=1)
    dist = W + jnp.arange(T)[:, None] - jnp.arange(W + T)[None, :]
    valid = ((dist >= 0) & (dist <= WINDOW))[None]
    o = sink_attention(q.reshape(B, 1, T, SWA_KV, SWA_GROUP, SWA_HD), kc[:, None], vc[:, None],
                       dist, valid, sinks, rel_bias)
    return o.reshape(B, T, MIX_W), kc[:, T:], vc[:, T:]


def parallel_mixers(h, w, rel_bias, gla_s0, swa_buf, conv_prev):
    B, T, _ = h.shape
    gq, gk, gv, gr, glr, sq, sk, sv, cb, cc, ch, gates = split_columns(h @ w['w_in'])
    lg = jax.nn.log_sigmoid((glr @ w['gla_gate_up'] + w['gla_gate_b']).astype(jnp.float32)) / GLA_TAU
    o, gla_S = gla_chunked(gq.reshape(B, T, GLA_HEADS, GLA_DK) * (GLA_DK ** -0.5),
                           gk.reshape(B, T, GLA_HEADS, GLA_DK),
                           gv.reshape(B, T, GLA_HEADS, GLA_DV),
                           lg.reshape(B, T, GLA_HEADS, GLA_DK), gla_s0)
    br_a = rmsnorm(o, w['gla_norm']).reshape(B, T, MIX_W) * jax.nn.silu(gr)
    sq = sq.reshape(B, T, SWA_KV, SWA_GROUP, SWA_HD)
    sk = sk.reshape(B, T, SWA_KV, SWA_HD)
    sv = sv.reshape(B, T, SWA_KV, SWA_HD)
    if swa_buf is None:
        br_b, kb, vb = swa_prompt(sq, sk, sv, w['swa_sinks'], rel_bias)
    else:
        br_b, kb, vb = swa_sample(sq, sk, sv, swa_buf[0], swa_buf[1], w['swa_sinks'], rel_bias)
    u, conv_buf = causal_dwconv(cc * ch, conv_prev, w['conv_w'])
    br_c = cb * u
    g = jax.nn.sigmoid(gates).reshape(B, T, N_BRANCH, D_MODEL)
    wb = w['w_branch']
    merged = (g[:, :, 0] * (br_a @ wb[0]) + g[:, :, 1] * (br_b @ wb[1]) + g[:, :, 2] * (br_c @ wb[2]))
    return merged @ w['w_out'], (gla_S, kb, vb, conv_buf)


def cross_attention(h, mem_k, mem_v, wq, wo):
    B, T, _ = h.shape
    q = (h @ wq).reshape(B, T, X_HEADS, X_HD)
    s = jnp.einsum('bthd,bmhd->bhtm', q, mem_k.astype(q.dtype)).astype(jnp.float32) * (X_HD ** -0.5)
    p = jax.nn.softmax(s, axis=-1).astype(h.dtype)
    o = jnp.einsum('bhtm,bmhd->bthd', p, mem_v.astype(h.dtype)).reshape(B, T, X_HEADS * X_HD)
    return o @ wo


def conv_ffn(h, w_up, cw, cbias, w_down, prev):
    u, g = jnp.split(h @ w_up, 2, axis=-1)
    gc, buf = causal_dwconv(g, prev, cw)
    return (jax.nn.silu(gc + cbias) * u) @ w_down, buf


def trunk_layer(x, w, rel_bias, gla_s0, swa_buf, conv_prev, ffn_prev, mem_k, mem_v):
    mix, (gla_S, kb, vb, conv_buf) = parallel_mixers(rmsnorm(x, w['norm_mix']), w, rel_bias,
                                                      gla_s0, swa_buf, conv_prev)
    x = x + mix
    x = x + cross_attention(rmsnorm(x, w['norm_x']), mem_k, mem_v, w['wx_q'], w['wx_o'])
    f, ffn_buf = conv_ffn(rmsnorm(x, w['norm_ffn']), w['ffn_up'], w['ffn_conv_w'], w['ffn_conv_b'],
                          w['ffn_down'], ffn_prev)
    return x + f, (gla_S, kb, vb, conv_buf, ffn_buf)


def setup_inputs(seed: int = 0) -> dict:
    key = jax.random.key(seed)
    ks = jax.random.split(key, 40)
    f32 = jnp.float32

    def nrm(k, shape, scale):
        return jax.random.normal(k, shape, f32) * scale

    def gain(k, shape):
        return 1.0 + 0.01 * jax.random.normal(k, shape, f32)

    W = min(WINDOW, PAST_LEN)
    return {
        'x_prompt': nrm(ks[0], (BATCH, SEQ, D_MODEL), 1.0),
        'x_sample': nrm(ks[1], (DEC_BATCH, DEC_SEQ, D_MODEL), 1.0),
        'state_gla': nrm(ks[2], (DEPTH, DEC_BATCH, GLA_HEADS, GLA_DK, GLA_DV), 1.0),
        'cache_swa_k': nrm(ks[3], (DEPTH, DEC_BATCH, W, SWA_KV, SWA_HD), 1.0),
        'cache_swa_v': nrm(ks[4], (DEPTH, DEC_BATCH, W, SWA_KV, SWA_HD), 1.0),
        'state_conv': nrm(ks[5], (DEPTH, DEC_BATCH, CONV_W - 1, MIX_W), 1.0),
        'state_ffn': nrm(ks[6], (DEPTH, DEC_BATCH, CONV_W - 1, D_FF), 1.0),
        'cache_mem_k': nrm(ks[7], (DEPTH, DEC_BATCH, N_MEM, X_HEADS, X_HD), 1.0),
        'cache_mem_v': nrm(ks[8], (DEPTH, DEC_BATCH, N_MEM, X_HEADS, X_HD), 1.0),
        'mem_prompt': nrm(ks[9], (BATCH, N_MEM, D_MODEL), 1.0),
        'norm_mix': gain(ks[10], (DEPTH, D_MODEL)),
        'w_in': nrm(ks[11], (DEPTH, D_MODEL, N_IN), D_MODEL ** -0.5),
        'gla_gate_up': nrm(ks[12], (DEPTH, GLA_RANK, GLA_HEADS * GLA_DK), GLA_RANK ** -0.5),
        'gla_gate_b': nrm(ks[13], (DEPTH, GLA_HEADS * GLA_DK), 0.1),
        'gla_norm': gain(ks[14], (DEPTH, GLA_DV)),
        'swa_sinks': nrm(ks[15], (DEPTH, SWA_HEADS), 0.5),
        'rel_bias': nrm(ks[16], (N_BUCKETS, SWA_HEADS), 0.5),
        'conv_w': nrm(ks[17], (DEPTH, CONV_W, MIX_W), CONV_W ** -0.5),
        'w_branch': nrm(ks[18], (DEPTH, N_BRANCH, MIX_W, D_MODEL), MIX_W ** -0.5),
        'w_out': nrm(ks[19], (DEPTH, D_MODEL, D_MODEL), D_MODEL ** -0.5),
        'norm_x': gain(ks[20], (DEPTH, D_MODEL)),
        'wx_q': nrm(ks[21], (DEPTH, D_MODEL, X_HEADS * X_HD), D_MODEL ** -0.5),
        'wx_k': nrm(ks[22], (DEPTH, D_MODEL, X_HEADS * X_HD), D_MODEL ** -0.5),
        'wx_v': nrm(ks[23], (DEPTH, D_MODEL, X_HEADS * X_HD), D_MODEL ** -0.5),
        'wx_o': nrm(ks[24], (DEPTH, X_HEADS * X_HD, D_MODEL), (X_HEADS * X_HD) ** -0.5),
        'norm_ffn': gain(ks[25], (DEPTH, D_MODEL)),
        'ffn_up': nrm(ks[26], (DEPTH, D_MODEL, 2 * D_FF), D_MODEL ** -0.5),
        'ffn_conv_w': nrm(ks[27], (DEPTH, CONV_W, D_FF), CONV_W ** -0.5),
        'ffn_conv_b': nrm(ks[28], (DEPTH, D_FF), 0.01),
        'ffn_down': nrm(ks[29], (DEPTH, D_FF, D_MODEL), D_FF ** -0.5),
        'norm_final': gain(ks[30], (D_MODEL,)),
    }


def reference(x_prompt, x_sample, state_gla, cache_swa_k, cache_swa_v, state_conv, state_ffn,
              cache_mem_k, cache_mem_v, mem_prompt, norm_mix, w_in, gla_gate_up, gla_gate_b,
              gla_norm, swa_sinks, rel_bias, conv_w, w_branch, w_out, norm_x, wx_q, wx_k, wx_v,
              wx_o, norm_ffn, ffn_up, ffn_conv_w, ffn_conv_b, ffn_down, norm_final):
    Bp = x_prompt.shape[0]
    yp, ys = x_prompt, x_sample
    st_p, st_s = [], []
    for i in range(DEPTH):
        w = {'norm_mix': norm_mix[i], 'w_in': w_in[i], 'gla_gate_up': gla_gate_up[i],
             'gla_gate_b': gla_gate_b[i], 'gla_norm': gla_norm[i], 'swa_sinks': swa_sinks[i],
             'conv_w': conv_w[i], 'w_branch': w_branch[i], 'w_out': w_out[i], 'norm_x': norm_x[i],
             'wx_q': wx_q[i], 'wx_o': wx_o[i], 'norm_ffn': norm_ffn[i], 'ffn_up': ffn_up[i],
             'ffn_conv_w': ffn_conv_w[i], 'ffn_conv_b': ffn_conv_b[i], 'ffn_down': ffn_down[i]}
        mem_k = (mem_prompt @ wx_k[i]).reshape(Bp, -1, X_HEADS, X_HD)
        mem_v = (mem_prompt @ wx_v[i]).reshape(Bp, -1, X_HEADS, X_HD)
        zero_gla = jnp.zeros((Bp, GLA_HEADS, GLA_DK, GLA_DV), jnp.float32)
        zero_conv = jnp.zeros((Bp, CONV_W - 1, MIX_W), yp.dtype)
        zero_ffn = jnp.zeros((Bp, CONV_W - 1, D_FF), yp.dtype)
        yp, sp = trunk_layer(yp, w, rel_bias, zero_gla, None, zero_conv, zero_ffn, mem_k, mem_v)
        ys, ss = trunk_layer(ys, w, rel_bias, state_gla[i], (cache_swa_k[i], cache_swa_v[i]),
                             state_conv[i], state_ffn[i], cache_mem_k[i], cache_mem_v[i])
        st_p.append(sp + (mem_k, mem_v))
        st_s.append(ss)
    y_prompt = rmsnorm(yp, norm_final)
    y_sample = rmsnorm(ys, norm_final)

    def stack(lst, j):
        return jnp.stack([s[j] for s in lst])

    return (y_prompt, y_sample, stack(st_p, 0), stack(st_s, 0), stack(st_p, 1), stack(st_p, 2),
            stack(st_s, 1), stack(st_s, 2), stack(st_p, 3), stack(st_s, 3), stack(st_p, 4),
            stack(st_s, 4), stack(st_p, 5), stack(st_p, 6))
```

```cpp
#include <hip/hip_runtime.h>
#include <cstdio>
#include <cstdint>
#include <cmath>
#define MK_PER_PHASE 1
namespace pg8 {
#define PG8_LAS __attribute__((address_space(3)))
typedef unsigned short bf16_t;
typedef short bf16x8 __attribute__((ext_vector_type(8)));
typedef float f32x4 __attribute__((ext_vector_type(4)));
typedef unsigned u32x4 __attribute__((ext_vector_type(4)));
constexpr int BM = 256, BK = 64, HALF = 128, HTB = HALF * BK * 2  , STAGE_BYTES = 8 * HTB, NXCD = 8, WGM = 8;

__host__ __device__ __forceinline__ int lds_byte(int r, int c) { const int st = (r >> 4) * 2 + (c >> 5), rr = r & 15, cc = c & 31, ob = rr * 64 + cc * 2; return st * 1024 + (ob ^ (((ob >> 9) & 1) << 5)); }
__host__ __device__ __forceinline__ void stage_rc(int b, int& R, int& C) { const int st = b / 1024, sb = b % 1024, swz = sb ^ (((sb >> 9) & 1) << 5); R = (st >> 1) * 16 + swz / 64; C = (st & 1) * 32 + (swz % 64) / 2; }
__host__ __device__ __forceinline__ int perm32(int rho) { const int n = rho >> 4, i = rho & 15; return 8 * (i >> 2) + 4 * n + (i & 3); }

struct Unit { int pm, pn; };
struct Gemm { const bf16_t* A; const bf16_t* Bt; int M, N, K; };

struct StaticOrder {
    int nM, nN, nwg, G, c;
    __host__ __device__ void init(int M, int N, int G_, int c_) { nM = M / BM; nN = N / BM; nwg = nM * nN; G = G_; c = c_; }
    __host__ __device__ bool next(int i, Unit& u) const {
        const long L = (long)i * G + c; if (L >= nwg) return false;
        int wgid = (int)L; { const int q = nwg / NXCD, r = nwg % NXCD, xcd = wgid % NXCD, off = wgid / NXCD; wgid = (xcd < r ? xcd * (q + 1) : r * (q + 1) + (xcd - r) * q) + off; }
        const int nig = WGM * nN, gid = wgid / nig, fm = gid * WGM, gsz = (nM - fm) < WGM ? (nM - fm) : WGM;
        u.pm = fm + ((wgid % nig) % gsz); u.pn = (wgid % nig) / gsz; return true;
    }
    __device__ __forceinline__ void a_ready(const Unit&) const {}
    __device__ __forceinline__ void done(const Unit&) const {}
};

__device__ __forceinline__ unsigned cvt_pk_bf16(float lo, float hi) { unsigned r; asm volatile("v_cvt_pk_bf16_f32 %0, %1, %2" : "=v"(r) : "v"(lo), "v"(hi)); return r; }
typedef float f32x2 __attribute__((ext_vector_type(2)));
typedef unsigned u32x2 __attribute__((ext_vector_type(2)));
__device__ __forceinline__ float bf_lo(unsigned w) { return __uint_as_float(w << 16); }
__device__ __forceinline__ float bf_hi(unsigned w) { return __uint_as_float(w & 0xffff0000u); }
__device__ __forceinline__ float sigmoidf_(float v) { return 1.0f / (1.0f + __expf(-v)); }

struct EpiScaleBf16 {
    static constexpr bool PERM = true, AFTER_DRAIN = false;
    bf16_t* O; int ldc; const float* ssq; int sig_lo, sig_hi;
    __device__ __forceinline__ void operator()(const f32x4 (&acc)[2][2][4][2], const Unit& u, int wr, int wc, int fr, int fq) const {
        const int row0 = u.pm * BM + wr * 64 + fr, col0 = u.pn * BM + wc * 32 + 8 * fq;
        const bool sig = (u.pn >= sig_lo) && (u.pn < sig_hi);
#pragma unroll
        for (int ai = 0; ai < 2; ++ai)
#pragma unroll
            for (int m = 0; m < 4; ++m) {
                const int row = row0 + ai * HALF + m * 16;
                float rs = 1.0f;
                if (ssq) { const f32x4* p = (const f32x4*)(ssq + (size_t)row * 32); f32x4 s = p[0];
#pragma unroll
                    for (int i = 1; i < 8; ++i) s += p[i];
                    rs = rsqrtf(((s[0] + s[1]) + (s[2] + s[3])) * (1.0f / 2048.0f) + 1e-6f); }
                bf16_t* rowp = O + (size_t)row * ldc + col0;
#pragma unroll
                for (int bj = 0; bj < 2; ++bj) { f32x4 v0 = acc[ai][bj][m][0] * rs, v1 = acc[ai][bj][m][1] * rs;
                    if (sig) { v0 = (f32x4){sigmoidf_(v0[0]), sigmoidf_(v0[1]), sigmoidf_(v0[2]), sigmoidf_(v0[3])}; v1 = (f32x4){sigmoidf_(v1[0]), sigmoidf_(v1[1]), sigmoidf_(v1[2]), sigmoidf_(v1[3])}; }
                    u32x4 w; w.x = cvt_pk_bf16(v0[0], v0[1]); w.y = cvt_pk_bf16(v0[2], v0[3]); w.z = cvt_pk_bf16(v1[0], v1[1]); w.w = cvt_pk_bf16(v1[2], v1[3]);
                    *(u32x4*)(rowp + bj * HALF) = w; }
            }
    }
};

struct EpiResidual {
    static constexpr bool PERM = false, AFTER_DRAIN = false;
    float* X; bf16_t* XB; float* ssq;
    __device__ __forceinline__ void operator()(const f32x4 (&acc)[2][2][4][2], const Unit& u, int wr, int wc, int fr, int fq) const {
        const int row0 = u.pm * BM + wr * 64 + fr, col0 = u.pn * BM + wc * 32 + 4 * fq;
#pragma unroll
        for (int ai = 0; ai < 2; ++ai)
#pragma unroll
            for (int m = 0; m < 4; ++m) {
                const int row = row0 + ai * HALF + m * 16; float ss = 0.f;
#pragma unroll
                for (int bj = 0; bj < 2; ++bj)
#pragma unroll
                    for (int n = 0; n < 2; ++n) { const size_t off = (size_t)row * 2048 + col0 + bj * HALF + n * 16;
                        const f32x4 x = *(const f32x4*)(X + off) + acc[ai][bj][m][n];
                        *(f32x4*)(X + off) = x;
                        u32x2 w; w.x = cvt_pk_bf16(x[0], x[1]); w.y = cvt_pk_bf16(x[2], x[3]); *(u32x2*)(XB + off) = w;
                        ss += (x[0] * x[0] + x[1] * x[1]) + (x[2] * x[2] + x[3] * x[3]); }
                ss += __shfl_xor(ss, 16); ss += __shfl_xor(ss, 32);
                if (fq == 0) ssq[(size_t)row * 32 + u.pn * 4 + wc] = ss;
            }
    }
};

struct EpiBranch {
    static constexpr bool PERM = true, AFTER_DRAIN = false;
    bf16_t* MG; const bf16_t* G; int ldg; int first;
    __device__ __forceinline__ void operator()(const f32x4 (&acc)[2][2][4][2], const Unit& u, int wr, int wc, int fr, int fq) const {
        const int row0 = u.pm * BM + wr * 64 + fr, col0 = u.pn * BM + wc * 32 + 8 * fq;
#pragma unroll
        for (int ai = 0; ai < 2; ++ai)
#pragma unroll
            for (int m = 0; m < 4; ++m) {
                const int row = row0 + ai * HALF + m * 16;
#pragma unroll
                for (int bj = 0; bj < 2; ++bj) { const int col = col0 + bj * HALF;
                    const u32x4 g = *(const u32x4*)(G + (size_t)row * ldg + col);
                    f32x4 v0 = acc[ai][bj][m][0], v1 = acc[ai][bj][m][1];
                    v0 = v0 * (f32x4){bf_lo(g.x), bf_hi(g.x), bf_lo(g.y), bf_hi(g.y)}; v1 = v1 * (f32x4){bf_lo(g.z), bf_hi(g.z), bf_lo(g.w), bf_hi(g.w)};
                    bf16_t* dst = MG + (size_t)row * 2048 + col;
                    if (!first) { const u32x4 o = *(const u32x4*)dst; v0 += (f32x4){bf_lo(o.x), bf_hi(o.x), bf_lo(o.y), bf_hi(o.y)}; v1 += (f32x4){bf_lo(o.z), bf_hi(o.z), bf_lo(o.w), bf_hi(o.w)}; }
                    u32x4 w; w.x = cvt_pk_bf16(v0[0], v0[1]); w.y = cvt_pk_bf16(v0[2], v0[3]); w.z = cvt_pk_bf16(v1[0], v1[1]); w.w = cvt_pk_bf16(v1[2], v1[3]);
                    *(u32x4*)dst = w; }
            }
    }
};

struct EpiMemKV {
    static constexpr bool PERM = false, AFTER_DRAIN = false;
    float* outk; float* outv; bf16_t* KV;
    __device__ __forceinline__ void operator()(const f32x4 (&acc)[2][2][4][2], const Unit& u, int wr, int wc, int fr, int fq) const {
        const int row0 = u.pm * BM + wr * 64 + fr, col0 = u.pn * BM + wc * 32 + 4 * fq;
#pragma unroll
        for (int ai = 0; ai < 2; ++ai)
#pragma unroll
            for (int m = 0; m < 4; ++m) {
                const int row = row0 + ai * HALF + m * 16;
#pragma unroll
                for (int bj = 0; bj < 2; ++bj)
#pragma unroll
                    for (int n = 0; n < 2; ++n) { const int col = col0 + bj * HALF + n * 16; const f32x4 a = acc[ai][bj][m][n];
                        float* dst = (col < 512) ? (outk + (size_t)row * 512 + col) : (outv + (size_t)row * 512 + (col - 512));
                        *(f32x4*)dst = a;
                        u32x2 w; w.x = cvt_pk_bf16(a[0], a[1]); w.y = cvt_pk_bf16(a[2], a[3]); *(u32x2*)(KV + (size_t)row * 1024 + col) = w; }
            }
    }
};
template <class Epi, class Sched, bool ALIGN_EPI = false, bool SP2 = false>
__device__ __forceinline__ void gemm_phase(PG8_LAS unsigned char* lds, const Gemm g, const Sched& S, const Epi& E) {
    int tid_ = threadIdx.x; asm volatile("" : "+v"(tid_));
    const int tid = tid_, wid = __builtin_amdgcn_readfirstlane(tid >> 6), lane = tid & 63, wr = wid >> 2, wc = wid & 3, fr = lane & 15, fq = lane >> 4;
    const int K = g.K, nt = K / BK;
    unsigned voffA[2], voffB[2];
#pragma unroll
    for (int i = 0; i < 2; ++i) { int R, C; stage_rc(tid * 16 + i * 8192, R, C); const int Rb = Epi::PERM ? ((R & ~31) + perm32(R & 31)) : R;
        voffA[i] = (unsigned)(R * K + C) * 2u; voffB[i] = (unsigned)(Rb * K + C) * 2u; }
    const size_t kstep = (size_t)(BK * 2);
    const size_t hstep = (size_t)HALF * K * 2;
    const size_t tstep = 2 * hstep;
    const unsigned ldsw = (unsigned)wid * 1024u;
    const int aoff = lds_byte(wr * 64 + fr, fq * 8), boff = lds_byte(wc * 32 + fr, fq * 8);
#define PG8_SA(b, h) (((b) * 2 + (h)) * HTB)
#define PG8_SB(b, h) ((4 + (b) * 2 + (h)) * HTB)
#define PG8_STAGE(bufoff, gbase, voff) do { _Pragma("unroll") for (int _i = 0; _i < 2; ++_i) \
        __builtin_amdgcn_global_load_lds((const unsigned*)((const char*)(gbase) + (voff)[_i]), (PG8_LAS unsigned*)(lds + (bufoff) + ldsw + _i * 8192), 16, 0, 0); } while (0)
#define PG8_LDA(dst, b, h) do { _Pragma("unroll") for (int m = 0; m < 4; ++m) _Pragma("unroll") for (int k = 0; k < 2; ++k) dst[m][k] = *(const PG8_LAS bf16x8*)(lds + PG8_SA(b, h) + aoff + m * 2048 + k * 1024); } while (0)
#define PG8_LDB(dst, b, h) do { _Pragma("unroll") for (int n = 0; n < 2; ++n) _Pragma("unroll") for (int k = 0; k < 2; ++k) dst[n][k] = *(const PG8_LAS bf16x8*)(lds + PG8_SB(b, h) + boff + n * 2048 + k * 1024); } while (0)
#define PG8_MMA(ai, bj, At, Bt) do { __builtin_amdgcn_s_setprio(1); _Pragma("unroll") for (int m = 0; m < 4; ++m) _Pragma("unroll") for (int n = 0; n < 2; ++n) _Pragma("unroll") for (int k = 0; k < 2; ++k) \
        acc[ai][bj][m][n] = __builtin_amdgcn_mfma_f32_16x16x32_bf16(Bt[n][k], At[m][k], acc[ai][bj][m][n], 0, 0, 0); __builtin_amdgcn_s_setprio(0); } while (0)
#define PG8_WAIT_V(n) asm volatile("s_waitcnt vmcnt(" #n ")" ::: "memory")
#define PG8_WAIT_L(n) asm volatile("s_waitcnt lgkmcnt(" #n ")" ::: "memory")
#define PG8_BAR __builtin_amdgcn_s_barrier()
#define PG8_SCHED __builtin_amdgcn_sched_barrier(0)
    Unit cur, nxt; int ui = 0;
    if (!S.next(0, cur)) return;
    f32x4 acc[2][2][4][2];
#pragma unroll
    for (int a = 0; a < 2; ++a)
#pragma unroll
        for (int b = 0; b < 2; ++b)
#pragma unroll
            for (int m = 0; m < 4; ++m)
#pragma unroll
                for (int n = 0; n < 2; ++n) acc[a][b][m][n] = (f32x4){0.f, 0.f, 0.f, 0.f};
    bf16x8 At[4][2], B0[2][2], B1[2][2];
    const char* cA = (const char*)g.A + (size_t)cur.pm * tstep; const char* cB = (const char*)g.Bt + (size_t)cur.pn * tstep;
    S.a_ready(cur);
    if constexpr (SP2) {
        PG8_STAGE(PG8_SB(0, 0), cB, voffB); PG8_STAGE(PG8_SB(0, 1), cB + hstep, voffB); PG8_STAGE(PG8_SA(0, 0), cA, voffA); PG8_STAGE(PG8_SA(0, 1), cA + hstep, voffA);
        if (wr == 1) PG8_BAR;
        PG8_WAIT_V(2); PG8_BAR;
        PG8_STAGE(PG8_SB(1, 0), cB + kstep, voffB); PG8_STAGE(PG8_SA(1, 0), cA + kstep, voffA); PG8_STAGE(PG8_SB(1, 1), cB + hstep + kstep, voffB);
        PG8_WAIT_V(6); PG8_BAR;
    } else {
        PG8_STAGE(PG8_SB(0, 0), cB, voffB); PG8_STAGE(PG8_SA(0, 0), cA, voffA); PG8_STAGE(PG8_SB(0, 1), cB + hstep, voffB); PG8_STAGE(PG8_SA(0, 1), cA + hstep, voffA);
        if (wr == 1) PG8_BAR;
        PG8_WAIT_V(4); PG8_BAR;
        PG8_STAGE(PG8_SB(1, 0), cB + kstep, voffB); PG8_STAGE(PG8_SA(1, 0), cA + kstep, voffA); PG8_STAGE(PG8_SB(1, 1), cB + hstep + kstep, voffB);
        PG8_WAIT_V(6); PG8_BAR;
    }
    for (;;) {
        const bool has_next = S.next(ui + 1, nxt);
        const char* nA = has_next ? (const char*)g.A + (size_t)nxt.pm * tstep : cA; const char* nB = has_next ? (const char*)g.Bt + (size_t)nxt.pn * tstep : cB;
        for (int t = 0; t < nt; t += 2) {
            const bool last = (t == nt - 2);
            const char* a1 = cA + (size_t)(t + 1) * kstep;
            const char* a2 = last ? nA : cA + (size_t)(t + 2) * kstep; const char* b2 = last ? nB : cB + (size_t)(t + 2) * kstep;
            const char* a3 = a2 + kstep; const char* b3 = b2 + kstep;
            if (last && has_next) S.a_ready(nxt);
            if constexpr (SP2) {
            PG8_LDB(B0, 0, 0); PG8_LDB(B1, 0, 1); PG8_SCHED; PG8_LDA(At, 0, 0); PG8_STAGE(PG8_SA(1, 1), a1 + hstep, voffA);
            PG8_WAIT_V(8); PG8_WAIT_L(0); PG8_BAR; PG8_MMA(0, 0, At, B0); PG8_MMA(0, 1, At, B1); PG8_BAR; PG8_SCHED;
            PG8_LDA(At, 0, 1); PG8_STAGE(PG8_SB(0, 0), b2, voffB); PG8_STAGE(PG8_SB(0, 1), b2 + hstep, voffB); PG8_STAGE(PG8_SA(0, 0), a2, voffA);
            PG8_WAIT_V(8); PG8_WAIT_L(0); PG8_BAR; PG8_MMA(1, 0, At, B0); PG8_MMA(1, 1, At, B1); PG8_BAR; PG8_SCHED;
            PG8_LDB(B0, 1, 0); PG8_LDB(B1, 1, 1); PG8_SCHED; PG8_LDA(At, 1, 0); PG8_STAGE(PG8_SA(0, 1), a2 + hstep, voffA);
            PG8_WAIT_V(8); PG8_WAIT_L(0); PG8_BAR; PG8_MMA(0, 0, At, B0); PG8_MMA(0, 1, At, B1); PG8_BAR; PG8_SCHED;
            PG8_LDA(At, 1, 1); PG8_STAGE(PG8_SB(1, 0), b3, voffB); PG8_STAGE(PG8_SB(1, 1), b3 + hstep, voffB); PG8_STAGE(PG8_SA(1, 0), a3, voffA);
            PG8_WAIT_V(8); PG8_WAIT_L(0); PG8_BAR; PG8_MMA(1, 0, At, B0); PG8_MMA(1, 1, At, B1); PG8_BAR; PG8_SCHED;
            } else {
            PG8_LDB(B0, 0, 0); PG8_SCHED; PG8_LDA(At, 0, 0); PG8_STAGE(PG8_SA(1, 1), a1 + hstep, voffA);
            PG8_WAIT_L(8); PG8_BAR; PG8_WAIT_L(0); PG8_MMA(0, 0, At, B0); PG8_BAR; PG8_SCHED;
            PG8_LDB(B1, 0, 1); PG8_STAGE(PG8_SB(0, 0), b2, voffB);
            PG8_BAR; PG8_WAIT_L(0); PG8_MMA(0, 1, At, B1); PG8_BAR;
            PG8_LDA(At, 0, 1); PG8_STAGE(PG8_SA(0, 0), a2, voffA);
            PG8_BAR; PG8_WAIT_L(0); PG8_MMA(1, 0, At, B0); PG8_BAR; PG8_SCHED;
            PG8_STAGE(PG8_SB(0, 1), b2 + hstep, voffB);
            PG8_WAIT_V(6); PG8_BAR; PG8_MMA(1, 1, At, B1); PG8_BAR;
            PG8_LDB(B0, 1, 0); PG8_SCHED; PG8_LDA(At, 1, 0); PG8_STAGE(PG8_SA(0, 1), a2 + hstep, voffA);
            PG8_WAIT_L(8); PG8_BAR; PG8_WAIT_L(0); PG8_MMA(0, 0, At, B0); PG8_BAR; PG8_SCHED;
            PG8_LDB(B1, 1, 1); PG8_STAGE(PG8_SB(1, 0), b3, voffB);
            PG8_BAR; PG8_WAIT_L(0); PG8_MMA(0, 1, At, B1); PG8_BAR;
            PG8_LDA(At, 1, 1); PG8_STAGE(PG8_SA(1, 0), a3, voffA);
            PG8_BAR; PG8_WAIT_L(0); PG8_MMA(1, 0, At, B0); PG8_BAR; PG8_SCHED;
            PG8_STAGE(PG8_SB(1, 1), b3 + hstep, voffB);
            PG8_WAIT_V(6); PG8_BAR; PG8_MMA(1, 1, At, B1); PG8_BAR;
            }
        }
        if constexpr (ALIGN_EPI) { if (wr == 0) PG8_BAR; }
        if constexpr (!Epi::AFTER_DRAIN) { E(acc, cur, wr, wc, fr, fq); S.done(cur); }
        if (!has_next) break;
#pragma unroll
        for (int a = 0; a < 2; ++a)
#pragma unroll
            for (int b = 0; b < 2; ++b)
#pragma unroll
                for (int m = 0; m < 4; ++m)
#pragma unroll
                    for (int n = 0; n < 2; ++n) acc[a][b][m][n] = (f32x4){0.f, 0.f, 0.f, 0.f};
        cur = nxt; cA = nA; cB = nB; ++ui;
        if constexpr (ALIGN_EPI) { if (wr == 1) PG8_BAR; }
    }
    PG8_WAIT_V(0);
    if constexpr (!ALIGN_EPI) { if (wr == 0) PG8_BAR; }
    PG8_BAR;
    if constexpr (Epi::AFTER_DRAIN) { E.fused(acc, cur, wr, wc, fr, fq, lds, wid, lane); S.done(cur); }
#undef PG8_SA
#undef PG8_SB
#undef PG8_STAGE
#undef PG8_LDA
#undef PG8_LDB
#undef PG8_MMA
#undef PG8_WAIT_V
#undef PG8_WAIT_L
#undef PG8_BAR
#undef PG8_SCHED
}
}

constexpr int NWAVES = 8, NTHR = 512;
constexpr int DM = 2048, SEQ = 4096, NBP = 2, DEPTH = 4, NBS = 32, TS = 8;
constexpr int MP = NBP * SEQ, MS = NBS * TS, M = MP + MS;
constexpr int MIXW = 1024, GH = 4, GDK = 128, GDV = 256, GRANK = 16;
constexpr int SH = 16, SKV = 2, SHD = 64, WIN = 128;
constexpr int NMEM = 256, XH = 4, XHD = 128, XW = XH * XHD;
constexpr int DFF = 5504, NIN = 13584, NINP = 13824;
constexpr float EPS = 1e-6f;
constexpr int ZC_GQ = 0, ZC_GK = 512, ZC_GV = 1024, ZC_GR = 2048, ZC_SQ = 3072, ZC_SK = 4096, ZC_SV = 4224, ZC_CB = 4352, ZC_CC = 5376, ZC_CH = 6400, ZC_GATE = 7424, ZC_GLR = 13568;
static_assert(ZC_GATE % 256 == 0 && ZC_GLR % 256 == 0 && ZC_GLR + 16 == NIN && NINP % 256 == 0, "z layout");
constexpr size_t O_YP = 0, O_YS = O_YP + (size_t)MP * DM, O_GLAP = O_YS + (size_t)MS * DM, O_GLAS = O_GLAP + (size_t)DEPTH * NBP * GH * GDK * GDV,
                 O_SKP = O_GLAS + (size_t)DEPTH * NBS * GH * GDK * GDV, O_SVP = O_SKP + (size_t)DEPTH * NBP * WIN * SKV * SHD, O_SKS = O_SVP + (size_t)DEPTH * NBP * WIN * SKV * SHD,
                 O_SVS = O_SKS + (size_t)DEPTH * NBS * WIN * SKV * SHD, O_CONVP = O_SVS + (size_t)DEPTH * NBS * WIN * SKV * SHD, O_CONVS = O_CONVP + (size_t)DEPTH * NBP * 2 * MIXW,
                 O_FFNP = O_CONVS + (size_t)DEPTH * NBS * 2 * MIXW, O_FFNS = O_FFNP + (size_t)DEPTH * NBP * 2 * DFF, O_MKP = O_FFNS + (size_t)DEPTH * NBS * 2 * DFF,
                 O_MVP = O_MKP + (size_t)DEPTH * NBP * NMEM * XW, O_END = O_MVP + (size_t)DEPTH * NBP * NMEM * XW;
static_assert(O_END == 43456512, "output size");
enum { I_XP = 0, I_XS, I_SGLA, I_CSK, I_CSV, I_SCONV, I_SFFN, I_CMK, I_CMV, I_MEMP, I_NMIX, I_WIN, I_GUP, I_GB, I_GNORM, I_SINK, I_RELB, I_CONVW, I_WBR, I_WOUT, I_NX, I_WXQ, I_WXK, I_WXV, I_WXO,
       I_NFFN, I_FUP, I_FCW, I_FCB, I_FDN, I_NFIN, N_INPUTS };
static_assert(N_INPUTS == 31, "inputs");

constexpr size_t MiB = 1u << 20;
constexpr size_t al1m(size_t x) { return (x + MiB - 1) / MiB * MiB; }
constexpr size_t WS_CTL = 0, CTL_ZERO_BYTES = 1 * MiB;
constexpr size_t SZ_WIN = (size_t)NINP * DM * 2, SZ_WBR = (size_t)3 * DM * MIXW * 2, SZ_WOUT = (size_t)DM * DM * 2, SZ_WXQ = (size_t)XW * DM * 2, SZ_WXKV = (size_t)2 * XW * DM * 2,
                 SZ_WXO = (size_t)DM * XW * 2, SZ_WUP = (size_t)2 * DFF * DM * 2, SZ_WDN = (size_t)DM * DFF * 2;
constexpr size_t WS_WIN = 2 * MiB, WS_WBR = al1m(WS_WIN + DEPTH * SZ_WIN), WS_WOUT = al1m(WS_WBR + DEPTH * SZ_WBR), WS_WXQ = al1m(WS_WOUT + DEPTH * SZ_WOUT),
                 WS_WXKV = al1m(WS_WXQ + DEPTH * SZ_WXQ), WS_WXO = al1m(WS_WXKV + DEPTH * SZ_WXKV), WS_WUP = al1m(WS_WXO + DEPTH * SZ_WXO), WS_WDN = al1m(WS_WUP + DEPTH * SZ_WUP);
constexpr size_t WS_X = al1m(WS_WDN + DEPTH * SZ_WDN), WS_XB = al1m(WS_X + (size_t)M * DM * 4), WS_SSQ = al1m(WS_XB + (size_t)M * DM * 2), WS_Z = al1m(WS_SSQ + (size_t)M * 32 * 4),
                 WS_BR = al1m(WS_Z + (size_t)M * NINP * 2), WS_MG = al1m(WS_BR + (size_t)3 * M * MIXW * 2), WS_XQ = al1m(WS_MG + (size_t)M * DM * 2), WS_XO = al1m(WS_XQ + (size_t)M * XW * 2),
                 WS_UG = al1m(WS_XO + (size_t)M * XW * 2), WS_ACT = al1m(WS_UG + (size_t)M * 2 * DFF * 2), WS_MEMB = al1m(WS_ACT + (size_t)M * DFF * 2), WS_MEMKV = al1m(WS_MEMB + (size_t)NBP * NMEM * DM * 2),
                 WS_GLAU = al1m(WS_MEMKV + (size_t)DEPTH * NBP * NMEM * 2 * XW * 2), WS_GLAD = al1m(WS_GLAU + (size_t)512 * GDK * GDV * 4), WS_END = al1m(WS_GLAD + (size_t)512 * GDK * 4);
constexpr int CW_TMO = 0, CW_CODE = 1, CW_BAR = 4096;

constexpr int RING_OFF = 0, RING_BYTES = 131072;
constexpr int LDSCTL_OFF = RING_BYTES, MISC_OFF = LDSCTL_OFF + 320;
constexpr int LDS_BYTES = 147456;
static_assert(MISC_OFF + 128 <= LDS_BYTES, "LDS map");

#define GAS __attribute__((address_space(1)))
#define LAS __attribute__((address_space(3)))
typedef unsigned short bf16;
typedef unsigned v4u __attribute__((ext_vector_type(4)));
typedef unsigned v2u __attribute__((ext_vector_type(2)));
typedef float f32x4 __attribute__((ext_vector_type(4)));
typedef float f32x2 __attribute__((ext_vector_type(2)));
typedef GAS unsigned gu32;
#define RLX_AGENT __ATOMIC_RELAXED, __HIP_MEMORY_SCOPE_AGENT
#define LDS_WAIT() asm volatile("s_waitcnt lgkmcnt(0)" ::: "memory")
#define VM_WAIT() asm volatile("s_waitcnt vmcnt(0)" ::: "memory")
__device__ __forceinline__ float bflo(unsigned w) { return __uint_as_float(w << 16); }
__device__ __forceinline__ float bfhi(unsigned w) { return __uint_as_float(w & 0xffff0000u); }
__device__ __forceinline__ float bf1(bf16 h) { return __uint_as_float(((unsigned)h) << 16); }
__device__ __forceinline__ unsigned pk2(float lo, float hi) { return pg8::cvt_pk_bf16(lo, hi); }
__device__ __forceinline__ void unpack8(const v4u w, float (&f)[8]) { f[0] = bflo(w.x); f[1] = bfhi(w.x); f[2] = bflo(w.y); f[3] = bfhi(w.y); f[4] = bflo(w.z); f[5] = bfhi(w.z); f[6] = bflo(w.w); f[7] = bfhi(w.w); }
__device__ __forceinline__ v4u pack8(const float (&f)[8]) { v4u w; w.x = pk2(f[0], f[1]); w.y = pk2(f[2], f[3]); w.z = pk2(f[4], f[5]); w.w = pk2(f[6], f[7]); return w; }
__device__ __forceinline__ float sigm(float v) { return 1.0f / (1.0f + __expf(-v)); }
__device__ __forceinline__ float wave_sum(float v) {
#pragma unroll
    for (int o = 1; o < 64; o <<= 1) v += __shfl_xor(v, o);
    return v;
}
#define XB_TMO      128
#define XB_XCNT(j)  (256  + 64 * (j))
#define XB_XSUB(j)  (1280 + 64 * (j))
#define XB_XGEN(j)  (2304 + 64 * (j))
#define XB_TOP      3328
#define XB_TOPGEN   3392
#define XCD_BAR_WORDS 3456
#define XB_SPIN_CAP (1u << 18)

__device__ __forceinline__ unsigned xb_ld(unsigned* p)              { return __hip_atomic_load(p, __ATOMIC_RELAXED, __HIP_MEMORY_SCOPE_AGENT); }
__device__ __forceinline__ unsigned xb_add(unsigned* p, unsigned v) { return __hip_atomic_fetch_add(p, v, __ATOMIC_RELAXED, __HIP_MEMORY_SCOPE_AGENT); }
__device__ __forceinline__ unsigned xb_xcc_id() { return (unsigned)__builtin_amdgcn_s_getreg((3 << 11) | 20) & 0xFu; }
#define XB_SPIN(cond, bar) do { unsigned _sp = 0; while (cond) { __builtin_amdgcn_s_sleep(1); \
    if ((++_sp & 255u) == 0u) { if (xb_ld(&(bar)[XB_TMO])) break; if (_sp > XB_SPIN_CAP) { atomicAdd(&(bar)[XB_TMO], 1u); break; } } } } while (0)

struct XcdBarrier {
    unsigned* bar; unsigned x;
    volatile LAS unsigned* st;
};

__device__ __forceinline__ XcdBarrier xcd_barrier_post(unsigned* bar, volatile LAS unsigned* st) {
    XcdBarrier b; b.bar = bar; b.x = xb_xcc_id(); b.st = st;
    if (threadIdx.x == 0) (void)xb_add(&bar[XB_XCNT(b.x)], 1u);
    return b;
}
__device__ __forceinline__ void xcd_barrier_complete(unsigned* bar, unsigned x, unsigned& nloc, unsigned& nx) {
    const unsigned G = gridDim.x * gridDim.y * gridDim.z;
    unsigned sum, cnt, mine, sp = 0u;
    for (;;) {
        sum = 0u; cnt = 0u; mine = 0u;
#pragma unroll
        for (unsigned j = 0; j < 16; ++j) { const unsigned c = xb_ld(&bar[XB_XCNT(j)]); sum += c; cnt += (c > 0u) ? 1u : 0u; mine = (j == x) ? c : mine; }
        if (sum == G) break;
        __builtin_amdgcn_s_sleep(1);
        if ((++sp & 255u) == 0u) { if (xb_ld(&bar[XB_TMO])) break; if (sp > XB_SPIN_CAP) { atomicAdd(&bar[XB_TMO], 1u); break; } }
    }
    nloc = mine > 0u ? mine : 1u; nx = cnt > 0u ? cnt : 1u;
}

__device__ __forceinline__ void xcd_barrier(const XcdBarrier& b) {
    asm volatile("s_waitcnt vmcnt(0)" ::: "memory");
    __syncthreads();
    if (threadIdx.x == 0) {
        unsigned* bar = b.bar;
        __builtin_amdgcn_s_waitcnt(0);
        unsigned nloc = b.st[0], nx = b.st[1];
        if (nloc == 0u) { xcd_barrier_complete(bar, b.x, nloc, nx); b.st[0] = nloc; b.st[1] = nx; }
        const unsigned old = xb_add(&bar[XB_XSUB(b.x)], 1u);
        const unsigned gen = old / nloc;
        if (old + 1u == (gen + 1u) * nloc) {
            __builtin_amdgcn_fence(__ATOMIC_RELEASE, "agent");
            asm volatile("s_waitcnt vmcnt(0)" ::: "memory");
            const unsigned og = xb_add(&bar[XB_TOP], 1u);
            const unsigned tg = og / nx;
            if (og + 1u == (tg + 1u) * nx) xb_add(&bar[XB_TOPGEN], 1u);
            else XB_SPIN(xb_ld(&bar[XB_TOPGEN]) == tg, bar);
            __builtin_amdgcn_fence(__ATOMIC_ACQUIRE, "agent");
            xb_add(&bar[XB_XGEN(b.x)], 1u);
            asm volatile("s_waitcnt vmcnt(0)" ::: "memory");
        } else {
            XB_SPIN(xb_ld(&bar[XB_XGEN(b.x)]) == gen, bar);
            __builtin_amdgcn_fence(__ATOMIC_ACQUIRE, "agent");
            asm volatile("s_waitcnt vmcnt(0)" ::: "memory");
        }
    }
    __syncthreads();
}

struct Args { const float* in[N_INPUTS]; float* out; unsigned char* ws; int ph_lo, ph_hi; };
static_assert(sizeof(Args) == N_INPUTS * 8 + 8 + 8 + 8, "Args has no padding");

struct Frame {
    LAS unsigned char* lds;
    volatile LAS unsigned* MISC;
    gu32* ctl;
    int tid, lane, wave, vcu, G;
};

#define LAUNDER(F) do { asm volatile("" : "+v"((F).tid), "+v"((F).lane)); asm volatile("" : "+s"((F).wave), "+s"((F).vcu), "+s"((F).G)); } while (0)
__device__ __forceinline__ void tr_item(const float* W, int K, int Nsrc, bf16* WT, int dstrow0, int k0, int srccol, float cscale, const float* gain, LAS float* scr, int lane) {
#pragma unroll 8
    for (int i = 0; i < 32; ++i) { const int kk = 2 * i + (lane >> 5); float v = 0.f; if (srccol >= 0) v = W[(size_t)(k0 + kk) * Nsrc + srccol]; if (gain) v *= gain[k0 + kk]; scr[kk * 33 + (lane & 31)] = v * cscale; }
    LDS_WAIT(); asm volatile("" ::: "memory");
    const int c = lane & 7;
#pragma unroll
    for (int j = 0; j < 4; ++j) { const int n = (lane >> 3) + 8 * j; const LAS float* s = scr + (8 * c) * 33 + n;
        v4u o; o.x = pk2(s[0 * 33], s[1 * 33]); o.y = pk2(s[2 * 33], s[3 * 33]); o.z = pk2(s[4 * 33], s[5 * 33]); o.w = pk2(s[6 * 33], s[7 * 33]);
        *(v4u*)(WT + (size_t)(dstrow0 + n) * K + k0 + 8 * c) = o; }
    LDS_WAIT(); asm volatile("" ::: "memory");
}
__device__ __forceinline__ void tr_plain(const float* W, int K, int N, bf16* WT, int dst_off, int r, float cscale, const float* gain, LAS float* scr, int lane) {
    const int nblk = N / 32, kb = r / nblk, nb = r % nblk;
    tr_item(W, K, N, WT, dst_off + 32 * nb, 64 * kb, 32 * nb + (lane & 31), cscale, gain, scr, lane);
}
constexpr int IT_IN = (DM / 64) * (NINP / 32), IT_BR = (MIXW / 64) * (DM / 32), IT_OUT = (DM / 64) * (DM / 32), IT_XQ = (DM / 64) * (XW / 32), IT_XO = (XW / 64) * (DM / 32),
              IT_UP = (DM / 64) * (2 * DFF / 32), IT_DN = (DFF / 64) * (DM / 32), IT_LAYER = IT_IN + 3 * IT_BR + IT_OUT + 3 * IT_XQ + IT_XO + IT_UP + IT_DN;
__device__ __forceinline__ void p0_convert(const Args& A, Frame& F0) {
    Frame F = F0; LAUNDER(F);
    LAS float* scr = (LAS float*)(F.lds + RING_OFF + F.wave * 16384);
    const int gw = F.vcu * NWAVES + F.wave, NGW = F.G * NWAVES, lane = F.lane;
    for (int it = gw; it < DEPTH * IT_LAYER; it += NGW) {
        const int l = it / IT_LAYER; int r = it % IT_LAYER;
        if (r < IT_IN) {
            const int nblk = NINP / 32, kb = r / nblk, nb = r % nblk, n = 32 * nb + (lane & 31);
            int src; if (n < 3072) src = n; else if (n < ZC_GLR) src = n + 16; else if (n < NIN) src = 3072 + (n - ZC_GLR); else src = -1;
            const float cs = (n < 512) ? 0.08838834764831845f : ((n >= ZC_SQ && n < ZC_SK) ? 0.125f : 1.0f);
            tr_item(A.in[I_WIN] + (size_t)l * DM * NIN, DM, NIN, ((bf16*)(A.ws + WS_WIN)) + (size_t)l * NINP * DM, 32 * nb, 64 * kb, src, cs, A.in[I_NMIX] + l * DM, scr, lane); continue; }
        r -= IT_IN;
        if (r < 3 * IT_BR) { const int i = r / IT_BR; r %= IT_BR;
            tr_plain(A.in[I_WBR] + ((size_t)l * 3 + i) * MIXW * DM, MIXW, DM, ((bf16*)(A.ws + WS_WBR)) + ((size_t)l * 3 + i) * DM * MIXW, 0, r, 1.0f, nullptr, scr, lane); continue; }
        r -= 3 * IT_BR;
        if (r < IT_OUT) { tr_plain(A.in[I_WOUT] + (size_t)l * DM * DM, DM, DM, ((bf16*)(A.ws + WS_WOUT)) + (size_t)l * DM * DM, 0, r, 1.0f, nullptr, scr, lane); continue; }
        r -= IT_OUT;
        if (r < IT_XQ) { tr_plain(A.in[I_WXQ] + (size_t)l * DM * XW, DM, XW, ((bf16*)(A.ws + WS_WXQ)) + (size_t)l * XW * DM, 0, r, 0.08838834764831845f, A.in[I_NX] + l * DM, scr, lane); continue; }
        r -= IT_XQ;
        if (r < IT_XQ) { tr_plain(A.in[I_WXK] + (size_t)l * DM * XW, DM, XW, ((bf16*)(A.ws + WS_WXKV)) + (size_t)l * 2 * XW * DM, 0, r, 1.0f, nullptr, scr, lane); continue; }
        r -= IT_XQ;
        if (r < IT_XQ) { tr_plain(A.in[I_WXV] + (size_t)l * DM * XW, DM, XW, ((bf16*)(A.ws + WS_WXKV)) + (size_t)l * 2 * XW * DM, XW, r, 1.0f, nullptr, scr, lane); continue; }
        r -= IT_XQ;
        if (r < IT_XO) { tr_plain(A.in[I_WXO] + (size_t)l * XW * DM, XW, DM, ((bf16*)(A.ws + WS_WXO)) + (size_t)l * DM * XW, 0, r, 1.0f, nullptr, scr, lane); continue; }
        r -= IT_XO;
        if (r < IT_UP) { tr_plain(A.in[I_FUP] + (size_t)l * DM * 2 * DFF, DM, 2 * DFF, ((bf16*)(A.ws + WS_WUP)) + (size_t)l * 2 * DFF * DM, 0, r, 1.0f, A.in[I_NFFN] + l * DM, scr, lane); continue; }
        r -= IT_UP;
        tr_plain(A.in[I_FDN] + (size_t)l * DFF * DM, DFF, DM, ((bf16*)(A.ws + WS_WDN)) + (size_t)l * DM * DFF, 0, r, 1.0f, nullptr, scr, lane);
    }
    for (int m = gw; m < M + NBP * NMEM; m += NGW) {
        if (m < M) {
            const float* src = (m < MP) ? A.in[I_XP] + (size_t)m * DM : A.in[I_XS] + (size_t)(m - MP) * DM;
            float ss = 0.f;
#pragma unroll
            for (int j = 0; j < 8; ++j) { const f32x4 v = *((const f32x4*)src + lane + 64 * j); *((f32x4*)(((float*)(A.ws + WS_X)) + (size_t)m * DM) + lane + 64 * j) = v;
                v2u w; w.x = pk2(v[0], v[1]); w.y = pk2(v[2], v[3]); *((v2u*)(((bf16*)(A.ws + WS_XB)) + (size_t)m * DM) + lane + 64 * j) = w; ss += (v[0] * v[0] + v[1] * v[1]) + (v[2] * v[2] + v[3] * v[3]); }
            ss = wave_sum(ss);
            if (lane < 32) ((float*)(A.ws + WS_SSQ))[(size_t)m * 32 + lane] = (lane == 0) ? ss : 0.f;
        } else {
            const int r = m - M; const float* src = A.in[I_MEMP] + (size_t)r * DM;
#pragma unroll
            for (int j = 0; j < 8; ++j) { const f32x4 v = *((const f32x4*)src + lane + 64 * j); v2u w; w.x = pk2(v[0], v[1]); w.y = pk2(v[2], v[3]); *((v2u*)(((bf16*)(A.ws + WS_MEMB)) + (size_t)r * DM) + lane + 64 * j) = w; }
        }
    }
}

__device__ __forceinline__ int t5_bucket(int n) {
    if (n < 16) return n;
    const float v = logf((float)n / 16.0f) / logf(8.0f) * 16.0f; const int lg = 16 + (int)v; return lg < 31 ? lg : 31;
}
template <int STRIDE, bool PAIR, bool BIAS>
__device__ __forceinline__ void attn_core(const float (&q)[64], LAS const unsigned char* kp, LAS const unsigned char* vp, int nsteps, int jmin, LAS const float* bp, float& m, float& lsum, float (&o)[64]) {
    for (int j = 0; j < nsteps; ++j) {
        LAS const v4u* kr = (LAS const v4u*)(kp + j * STRIDE);
        float s0 = 0.f, s1 = 0.f;
#pragma unroll
        for (int c = 0; c < 8; ++c) { const v4u kk = kr[c];
            s0 += q[8 * c + 0] * bflo(kk.x) + q[8 * c + 2] * bflo(kk.y) + q[8 * c + 4] * bflo(kk.z) + q[8 * c + 6] * bflo(kk.w);
            s1 += q[8 * c + 1] * bfhi(kk.x) + q[8 * c + 3] * bfhi(kk.y) + q[8 * c + 5] * bfhi(kk.z) + q[8 * c + 7] * bfhi(kk.w); }
        float s = s0 + s1;
        if (PAIR) s += __shfl_xor(s, 1);
        if (BIAS) s += bp[-j];
        s = (j >= jmin) ? s : -INFINITY;
        const float mn = fmaxf(m, s), sc = __expf(m - mn), p = __expf(s - mn);
        lsum = lsum * sc + p; m = mn;
        LAS const v4u* vr = (LAS const v4u*)(vp + j * STRIDE);
#pragma unroll
        for (int c = 0; c < 8; ++c) { const v4u vv = vr[c];
            o[8 * c + 0] = o[8 * c + 0] * sc + p * bflo(vv.x); o[8 * c + 1] = o[8 * c + 1] * sc + p * bfhi(vv.x);
            o[8 * c + 2] = o[8 * c + 2] * sc + p * bflo(vv.y); o[8 * c + 3] = o[8 * c + 3] * sc + p * bfhi(vv.y);
            o[8 * c + 4] = o[8 * c + 4] * sc + p * bflo(vv.z); o[8 * c + 5] = o[8 * c + 5] * sc + p * bfhi(vv.z);
            o[8 * c + 6] = o[8 * c + 6] * sc + p * bflo(vv.w); o[8 * c + 7] = o[8 * c + 7] * sc + p * bfhi(vv.w); }
    }
}
__device__ __forceinline__ void load_q64(const bf16* p, float (&q)[64]) {
#pragma unroll
    for (int c = 0; c < 8; ++c) { const v4u w = *((const v4u*)p + c); float f[8]; unpack8(w, f);
#pragma unroll
        for (int i = 0; i < 8; ++i) q[8 * c + i] = f[i]; }
}
__device__ __forceinline__ void store_o64(bf16* p, const float (&o)[64], float inv) {
#pragma unroll
    for (int c = 0; c < 8; ++c) { float f[8];
#pragma unroll
        for (int i = 0; i < 8; ++i) f[i] = o[8 * c + i] * inv;
        *((v4u*)p + c) = pack8(f); }
}

constexpr int SWA_STR = 144, SWA_K = 0, SWA_V = 192 * SWA_STR, SWA_BT = 2 * 192 * SWA_STR, SWA_BTS = 132;
__device__ __forceinline__ void swa_phase(const Args& A, Frame& F0, int l) {
    Frame F = F0; LAUNDER(F);
    LAS unsigned char* Ks = F.lds + SWA_K; LAS unsigned char* Vs = F.lds + SWA_V; LAS float* BT = (LAS float*)(F.lds + SWA_BT);
    for (int i = F.tid; i < SH * 129; i += NTHR) { const int h = i / 129, d = i % 129; BT[h * SWA_BTS + d] = A.in[I_RELB][t5_bucket(d) * SH + h]; }
    const float* sinks = A.in[I_SINK] + l * SH;
    for (int u = F.vcu; u < 256 + 64; u += F.G) {
        __syncthreads();
        if (u < 256) {
            const int b = u >> 7, kvh = (u >> 6) & 1, qb = u & 63, q0 = qb * 64;
            for (int i = F.tid; i < 192 * 8; i += NTHR) { const int r = i >> 3, c8 = i & 7, pos = q0 - 128 + r; v4u kv = (v4u){0u, 0u, 0u, 0u}, vv = kv;
                if (pos >= 0) { const bf16* zr = ((bf16*)(A.ws + WS_Z)) + (size_t)(b * SEQ + pos) * NINP + kvh * 64 + c8 * 8; kv = *(const v4u*)(zr + ZC_SK); vv = *(const v4u*)(zr + ZC_SV); }
                *(LAS v4u*)(Ks + r * SWA_STR + c8 * 16) = kv; *(LAS v4u*)(Vs + r * SWA_STR + c8 * 16) = vv;
                if (qb == 63 && r >= 64) { float fk[8], fv[8]; unpack8(kv, fk); unpack8(vv, fv); const size_t o = ((((size_t)l * NBP + b) * WIN + (r - 64)) * SKV + kvh) * SHD + c8 * 8;
                    *(f32x4*)(A.out + O_SKP + o) = (f32x4){fk[0], fk[1], fk[2], fk[3]}; *(f32x4*)(A.out + O_SKP + o + 4) = (f32x4){fk[4], fk[5], fk[6], fk[7]};
                    *(f32x4*)(A.out + O_SVP + o) = (f32x4){fv[0], fv[1], fv[2], fv[3]}; *(f32x4*)(A.out + O_SVP + o + 4) = (f32x4){fv[4], fv[5], fv[6], fv[7]}; }
            }
            __syncthreads();
            const int head = kvh * 8 + F.wave, t = q0 + F.lane, row = b * SEQ + t;
            float q[64], o[64]; load_q64(((bf16*)(A.ws + WS_Z)) + (size_t)row * NINP + ZC_SQ + head * 64, q);
#pragma unroll
            for (int i = 0; i < 64; ++i) o[i] = 0.f;
            float m = sinks[head], ls = 1.0f;
            attn_core<SWA_STR, false, true>(q, Ks + F.lane * SWA_STR, Vs + F.lane * SWA_STR, 129, 128 - t, BT + head * SWA_BTS + 128, m, ls, o);
            store_o64(((bf16*)(A.ws + WS_BR)) + (size_t)1 * M * MIXW + (size_t)row * MIXW + head * 64, o, 1.0f / ls);
        } else {
            const int su = u - 256, b = su >> 1, kvh = su & 1;
            for (int i = F.tid; i < 136 * 8; i += NTHR) { const int r = i >> 3, c8 = i & 7; float fk[8], fv[8];
                if (r < 128) { const size_t o = ((((size_t)l * NBS + b) * WIN + r) * SKV + kvh) * SHD + c8 * 8; const f32x4 a0 = *(const f32x4*)(A.in[I_CSK] + o), a1 = *(const f32x4*)(A.in[I_CSK] + o + 4), b0 = *(const f32x4*)(A.in[I_CSV] + o), b1 = *(const f32x4*)(A.in[I_CSV] + o + 4);
#pragma unroll
                    for (int k = 0; k < 4; ++k) { fk[k] = a0[k]; fk[4 + k] = a1[k]; fv[k] = b0[k]; fv[4 + k] = b1[k]; } }
                else { const bf16* zr = ((bf16*)(A.ws + WS_Z)) + (size_t)(MP + b * TS + (r - 128)) * NINP + kvh * 64 + c8 * 8; unpack8(*(const v4u*)(zr + ZC_SK), fk); unpack8(*(const v4u*)(zr + ZC_SV), fv); }
                *(LAS v4u*)(Ks + r * SWA_STR + c8 * 16) = pack8(fk); *(LAS v4u*)(Vs + r * SWA_STR + c8 * 16) = pack8(fv);
                if (r >= 8) { const size_t o = ((((size_t)l * NBS + b) * WIN + (r - 8)) * SKV + kvh) * SHD + c8 * 8;
                    *(f32x4*)(A.out + O_SKS + o) = (f32x4){fk[0], fk[1], fk[2], fk[3]}; *(f32x4*)(A.out + O_SKS + o + 4) = (f32x4){fk[4], fk[5], fk[6], fk[7]};
                    *(f32x4*)(A.out + O_SVS + o) = (f32x4){fv[0], fv[1], fv[2], fv[3]}; *(f32x4*)(A.out + O_SVS + o + 4) = (f32x4){fv[4], fv[5], fv[6], fv[7]}; }
            }
            __syncthreads();
            if (F.wave == 0) {
                const int t = F.lane & 7, head = kvh * 8 + (F.lane >> 3), row = MP + b * TS + t;
                float q[64], o[64]; load_q64(((bf16*)(A.ws + WS_Z)) + (size_t)row * NINP + ZC_SQ + head * 64, q);
#pragma unroll
                for (int i = 0; i < 64; ++i) o[i] = 0.f;
                float m = sinks[head], ls = 1.0f;
                attn_core<SWA_STR, false, true>(q, Ks + t * SWA_STR, Vs + t * SWA_STR, 129, 0, BT + head * SWA_BTS + 128, m, ls, o);
                store_o64(((bf16*)(A.ws + WS_BR)) + (size_t)1 * M * MIXW + (size_t)row * MIXW + head * 64, o, 1.0f / ls);
            }
        }
    }
    __syncthreads();
}

__device__ __forceinline__ void conv_phase(const Args& A, Frame& F0, int l) {
    Frame F = F0; LAUNDER(F);
    const float* cw = A.in[I_CONVW] + (size_t)l * 3 * MIXW;
    for (int idx = F.vcu * NTHR + F.tid; idx < M * (MIXW / 8); idx += F.G * NTHR) {
        const int row = idx >> 7, c = (idx & 127) * 8; int b, t, T; const bool smp = row >= MP;
        if (!smp) { b = row >> 12; t = row & (SEQ - 1); T = SEQ; } else { b = (row - MP) >> 3; t = (row - MP) & 7; T = TS; }
        float u[3][8];
#pragma unroll
        for (int k = 0; k < 3; ++k) {
            if (t - k >= 0) { const bf16* zr = ((bf16*)(A.ws + WS_Z)) + (size_t)(row - k) * NINP + c; float a[8], d[8]; unpack8(*(const v4u*)(zr + ZC_CC), a); unpack8(*(const v4u*)(zr + ZC_CH), d);
#pragma unroll
                for (int i = 0; i < 8; ++i) u[k][i] = a[i] * d[i]; }
            else if (smp) { const float* sp = A.in[I_SCONV] + (((size_t)l * NBS + b) * 2 + (2 + t - k)) * MIXW + c; const f32x4 a0 = *(const f32x4*)sp, a1 = *(const f32x4*)(sp + 4);
#pragma unroll
                for (int i = 0; i < 4; ++i) { u[k][i] = a0[i]; u[k][4 + i] = a1[i]; } }
            else {
#pragma unroll
                for (int i = 0; i < 8; ++i) u[k][i] = 0.f; }
        }
        float cb[8], o[8]; unpack8(*(const v4u*)(((bf16*)(A.ws + WS_Z)) + (size_t)row * NINP + ZC_CB + c), cb);
#pragma unroll
        for (int i = 0; i < 8; ++i) o[i] = cb[i] * (cw[c + i] * u[2][i] + cw[MIXW + c + i] * u[1][i] + cw[2 * MIXW + c + i] * u[0][i]);
        *(v4u*)(((bf16*)(A.ws + WS_BR)) + (size_t)2 * M * MIXW + (size_t)row * MIXW + c) = pack8(o);
        if (t >= T - 2) { float* dst = A.out + (smp ? O_CONVS + (((size_t)l * NBS + b) * 2 + (t - (T - 2))) * MIXW : O_CONVP + (((size_t)l * NBP + b) * 2 + (t - (T - 2))) * MIXW) + c;
            *(f32x4*)dst = (f32x4){u[0][0], u[0][1], u[0][2], u[0][3]}; *(f32x4*)(dst + 4) = (f32x4){u[0][4], u[0][5], u[0][6], u[0][7]}; }
    }
}

__device__ __forceinline__ void gla_stage_wg(const Args& A, Frame& F, int l, int h, LAS float* wgs) {
    for (int i = F.tid; i < 16 * 128; i += NTHR) wgs[i] = A.in[I_GUP][(size_t)l * GRANK * 512 + (i >> 7) * 512 + h * 128 + (i & 127)];
    if (F.tid < 128) wgs[2048 + F.tid] = A.in[I_GB][l * 512 + h * 128 + F.tid];
}
__device__ __forceinline__ float gla_lg(const float (&gl)[16], LAS const float* wgs, int d) {
    float zg = wgs[2048 + d];
#pragma unroll
    for (int r = 0; r < 16; ++r) zg += gl[r] * wgs[r * 128 + d];
    return (fminf(zg, 0.f) - log1pf(__expf(-fabsf(zg)))) * (1.0f / 16.0f);
}
__device__ __forceinline__ void load_glr(const bf16* zr, float (&gl)[16]) {
    float a[8], b[8]; unpack8(*(const v4u*)zr, a); unpack8(*(const v4u*)(zr + 8), b);
#pragma unroll
    for (int i = 0; i < 8; ++i) { gl[i] = a[i]; gl[8 + i] = b[i]; }
}
__device__ __forceinline__ void gla_chunk_b(const Args& A, Frame& F, int l, int row0, int h, LAS float* bl, LAS float* wgs) {
    gla_stage_wg(A, F, l, h, wgs);
    __syncthreads();
    { const int t = F.tid >> 3, dg = F.tid & 7; float gl[16]; load_glr(((bf16*)(A.ws + WS_Z)) + (size_t)(row0 + t) * NINP + ZC_GLR, gl);
#pragma unroll 4
      for (int dd = 0; dd < 16; ++dd) { const int d = dg * 16 + dd; bl[t * 128 + d] = gla_lg(gl, wgs, d); } }
    __syncthreads();
    if (F.tid < 128) { float a = 0.f; for (int t = 0; t < 64; ++t) { a += bl[t * 128 + F.tid]; bl[t * 128 + F.tid] = a; } }
    __syncthreads();
}
__device__ __forceinline__ void gla_pass1(const Args& A, Frame& F0, int l) {
    Frame F = F0; LAUNDER(F);
    LAS float* bl = (LAS float*)(F.lds); LAS float* kt = (LAS float*)(F.lds + 32768); LAS float* wgs = (LAS float*)(F.lds + 65536);
    for (int u = F.vcu; u < 512 + 128; u += F.G) {
        __syncthreads();
        if (u < 512) {
            const int bh = u >> 6, c = u & 63, b = bh >> 2, h = bh & 3, row0 = b * SEQ + c * 64;
            gla_chunk_b(A, F, l, row0, h, bl, wgs);
            for (int i8 = F.tid; i8 < 64 * 16; i8 += NTHR) { const int t = i8 >> 4, d0 = (i8 & 15) * 8; float k[8]; unpack8(*(const v4u*)(((bf16*)(A.ws + WS_Z)) + (size_t)(row0 + t) * NINP + ZC_GK + h * 128 + d0), k);
#pragma unroll
                for (int i = 0; i < 8; ++i) kt[t * 128 + d0 + i] = k[i] * __expf(bl[63 * 128 + d0 + i] - bl[t * 128 + d0 + i]); }
            __syncthreads();
            const int d0 = (F.tid >> 5) * 8, v0 = (F.tid & 31) * 8;
            float acc[8][8];
#pragma unroll
            for (int i = 0; i < 8; ++i)
#pragma unroll
                for (int j = 0; j < 8; ++j) acc[i][j] = 0.f;
            for (int t = 0; t < 64; ++t) { const f32x4 k0 = *(LAS const f32x4*)(kt + t * 128 + d0), k1 = *(LAS const f32x4*)(kt + t * 128 + d0 + 4); float vv[8]; unpack8(*(const v4u*)(((bf16*)(A.ws + WS_Z)) + (size_t)(row0 + t) * NINP + ZC_GV + h * 256 + v0), vv);
#pragma unroll
                for (int i = 0; i < 4; ++i)
#pragma unroll
                    for (int j = 0; j < 8; ++j) { acc[i][j] += k0[i] * vv[j]; acc[4 + i][j] += k1[i] * vv[j]; } }
            float* U = ((float*)(A.ws + WS_GLAU)) + (size_t)u * GDK * GDV;
#pragma unroll
            for (int i = 0; i < 8; ++i) { *(f32x4*)(U + (d0 + i) * 256 + v0) = (f32x4){acc[i][0], acc[i][1], acc[i][2], acc[i][3]}; *(f32x4*)(U + (d0 + i) * 256 + v0 + 4) = (f32x4){acc[i][4], acc[i][5], acc[i][6], acc[i][7]}; }
            if (F.tid < 128) ((float*)(A.ws + WS_GLAD))[(size_t)u * 128 + F.tid] = __expf(bl[63 * 128 + F.tid]);
        } else {
            const int su = u - 512, b = su >> 2, h = su & 3, row0 = MP + b * TS;
            LAS float* qs = (LAS float*)(F.lds); LAS float* ks = qs + 1024; LAS float* es = qs + 2048; LAS float* vs = qs + 3072; LAS float* red = qs + 5120;
            gla_stage_wg(A, F, l, h, wgs);
            __syncthreads();
            { const int t = F.tid >> 6, dp = F.tid & 63; float gl[16]; load_glr(((bf16*)(A.ws + WS_Z)) + (size_t)(row0 + t) * NINP + ZC_GLR, gl);
              es[t * 128 + 2 * dp] = __expf(gla_lg(gl, wgs, 2 * dp)); es[t * 128 + 2 * dp + 1] = __expf(gla_lg(gl, wgs, 2 * dp + 1)); }
            for (int i = F.tid; i < 8 * 128; i += NTHR) { const int t = i >> 7, d = i & 127; const bf16* zr = ((bf16*)(A.ws + WS_Z)) + (size_t)(row0 + t) * NINP + h * 128 + d; qs[i] = bf1(zr[ZC_GQ]); ks[i] = bf1(zr[ZC_GK]); }
            for (int i = F.tid; i < 8 * 256; i += NTHR) { const int t = i >> 8, v = i & 255; vs[i] = bf1(((bf16*)(A.ws + WS_Z))[(size_t)(row0 + t) * NINP + ZC_GV + h * 256 + v]); }
            __syncthreads();
            const int v = F.tid & 255, half = F.tid >> 8; const size_t sidx = (((size_t)l * NBS + b) * GH + h) * GDK * GDV;
            const float* S0 = A.in[I_SGLA] + sidx + (size_t)(64 * half) * 256 + v;
            float S[64];
#pragma unroll
            for (int i = 0; i < 64; ++i) S[i] = S0[i * 256];
            for (int t = 0; t < 8; ++t) { const float vv = vs[t * 256 + v]; float part = 0.f;
#pragma unroll
                for (int i = 0; i < 64; ++i) { const int d = 64 * half + i; S[i] = es[t * 128 + d] * S[i] + ks[t * 128 + d] * vv; part += qs[t * 128 + d] * S[i]; }
                red[(t * 2 + half) * 256 + v] = part; }
            float* So = A.out + O_GLAS + sidx + (size_t)(64 * half) * 256 + v;
#pragma unroll
            for (int i = 0; i < 64; ++i) So[i * 256] = S[i];
            __syncthreads();
            { const int t = F.wave, row = row0 + t; float o[4]; float ss = 0.f;
#pragma unroll
              for (int k = 0; k < 4; ++k) { const int vv = F.lane + 64 * k; o[k] = red[(t * 2) * 256 + vv] + red[(t * 2 + 1) * 256 + vv]; ss += o[k] * o[k]; }
              ss = wave_sum(ss); const float rs = rsqrtf(ss * (1.0f / 256.0f) + EPS);
#pragma unroll
              for (int k = 0; k < 4; ++k) { const int vv = F.lane + 64 * k; const float g = bf1(((bf16*)(A.ws + WS_Z))[(size_t)row * NINP + ZC_GR + h * 256 + vv]);
                  ((bf16*)(A.ws + WS_BR))[(size_t)row * MIXW + h * 256 + vv] = (bf16)(pk2(o[k] * rs * A.in[I_GNORM][l * GDV + vv] * g * sigm(g), 0.f) & 0xffffu); } }
        }
    }
    __syncthreads();
}
__device__ __forceinline__ void gla_pass2(const Args& A, Frame& F0, int l) {
    Frame F = F0; LAUNDER(F);
    for (int e = F.vcu * NTHR + F.tid; e < 8 * GDK * GDV; e += F.G * NTHR) {
        const int bh = e >> 15, dv = e & 32767, d = dv >> 8;
        float* U = ((float*)(A.ws + WS_GLAU)) + (size_t)bh * 64 * GDK * GDV + dv; const float* D = ((float*)(A.ws + WS_GLAD)) + (size_t)bh * 64 * 128 + d;
        float S = 0.f;
        for (int c0 = 0; c0 < 64; c0 += 8) { float uu[8], dd[8];
#pragma unroll
            for (int k = 0; k < 8; ++k) { uu[k] = U[(size_t)(c0 + k) * GDK * GDV]; dd[k] = D[(c0 + k) * 128]; }
#pragma unroll
            for (int k = 0; k < 8; ++k) { U[(size_t)(c0 + k) * GDK * GDV] = S; S = dd[k] * S + uu[k]; } }
        A.out[O_GLAP + ((size_t)l * 8 + bh) * GDK * GDV + dv] = S;
    }
}
__device__ __forceinline__ void gla_pass3(const Args& A, Frame& F0, int l) {
    Frame F = F0; LAUNDER(F);
    LAS float* bl = (LAS float*)(F.lds); LAS float* qdT = (LAS float*)(F.lds + 32768); LAS float* kdT = (LAS float*)(F.lds + 67584); LAS float* Am = (LAS float*)(F.lds + 102400); LAS float* wgs = (LAS float*)(F.lds + 119808);
    for (int u = F.vcu; u < 512; u += F.G) {
        __syncthreads();
        const int bh = u >> 6, c = u & 63, b = bh >> 2, h = bh & 3, row0 = b * SEQ + c * 64;
        gla_chunk_b(A, F, l, row0, h, bl, wgs);
        { const int t = F.tid & 63, dg = F.tid >> 6; const bf16* zr = ((bf16*)(A.ws + WS_Z)) + (size_t)(row0 + t) * NINP + h * 128 + dg * 16; float q[16], k[16];
          { float a[8], bb[8]; unpack8(*(const v4u*)(zr + ZC_GQ), a); unpack8(*(const v4u*)(zr + ZC_GQ + 8), bb);
#pragma unroll
            for (int i = 0; i < 8; ++i) { q[i] = a[i]; q[8 + i] = bb[i]; }
            unpack8(*(const v4u*)(zr + ZC_GK), a); unpack8(*(const v4u*)(zr + ZC_GK + 8), bb);
#pragma unroll
            for (int i = 0; i < 8; ++i) { k[i] = a[i]; k[8 + i] = bb[i]; } }
#pragma unroll
          for (int i = 0; i < 16; ++i) { const int d = dg * 16 + i; const float bb = bl[t * 128 + d]; qdT[d * 68 + t] = q[i] * __expf(bb); kdT[d * 68 + t] = k[i] * __expf(-bb); } }
        __syncthreads();
        const int tb = F.tid >> 5, vb = F.tid & 31;
        {
            float a[4][2];
#pragma unroll
            for (int i = 0; i < 4; ++i) { a[i][0] = 0.f; a[i][1] = 0.f; }
            for (int d = 0; d < 128; ++d) { const f32x4 qq = *(LAS const f32x4*)(qdT + d * 68 + 4 * tb); const f32x2 kk = *(LAS const f32x2*)(kdT + d * 68 + 2 * vb);
#pragma unroll
                for (int i = 0; i < 4; ++i) { a[i][0] += qq[i] * kk[0]; a[i][1] += qq[i] * kk[1]; } }
#pragma unroll
            for (int i = 0; i < 4; ++i)
#pragma unroll
                for (int j = 0; j < 2; ++j) { const int t = 4 * tb + i, s = 2 * vb + j; Am[s * 68 + t] = (s <= t) ? a[i][j] : 0.f; }
        }
        float o[4][8];
#pragma unroll
        for (int i = 0; i < 4; ++i)
#pragma unroll
            for (int j = 0; j < 8; ++j) o[i][j] = 0.f;
        { const float* S = ((float*)(A.ws + WS_GLAU)) + (size_t)u * GDK * GDV + 8 * vb;
          for (int d = 0; d < 128; ++d) { const f32x4 qq = *(LAS const f32x4*)(qdT + d * 68 + 4 * tb); const f32x4 s0 = *(const f32x4*)(S + d * 256), s1 = *(const f32x4*)(S + d * 256 + 4);
#pragma unroll
              for (int i = 0; i < 4; ++i)
#pragma unroll
                  for (int j = 0; j < 4; ++j) { o[i][j] += qq[i] * s0[j]; o[i][4 + j] += qq[i] * s1[j]; } } }
        __syncthreads();
        for (int s = 0; s < 64; ++s) { const f32x4 aa = *(LAS const f32x4*)(Am + s * 68 + 4 * tb); float vv[8]; unpack8(*(const v4u*)(((bf16*)(A.ws + WS_Z)) + (size_t)(row0 + s) * NINP + ZC_GV + h * 256 + 8 * vb), vv);
#pragma unroll
            for (int i = 0; i < 4; ++i)
#pragma unroll
                for (int j = 0; j < 8; ++j) o[i][j] += aa[i] * vv[j]; }
        float gn[8];
#pragma unroll
        for (int j = 0; j < 8; ++j) gn[j] = A.in[I_GNORM][l * GDV + 8 * vb + j];
#pragma unroll
        for (int i = 0; i < 4; ++i) { float ss = 0.f;
#pragma unroll
            for (int j = 0; j < 8; ++j) ss += o[i][j] * o[i][j];
#pragma unroll
            for (int x = 1; x < 32; x <<= 1) ss += __shfl_xor(ss, x);
            const float rs = rsqrtf(ss * (1.0f / 256.0f) + EPS); const int row = row0 + 4 * tb + i; float g[8], r[8]; unpack8(*(const v4u*)(((bf16*)(A.ws + WS_Z)) + (size_t)row * NINP + ZC_GR + h * 256 + 8 * vb), g);
#pragma unroll
            for (int j = 0; j < 8; ++j) r[j] = o[i][j] * rs * gn[j] * g[j] * sigm(g[j]);
            *(v4u*)(((bf16*)(A.ws + WS_BR)) + (size_t)row * MIXW + h * 256 + 8 * vb) = pack8(r); }
    }
    __syncthreads();
}

__device__ __forceinline__ void xattn_phase(const Args& A, Frame& F0, int l) {
    Frame F = F0; LAUNDER(F);
    LAS unsigned char* Ks = F.lds; LAS unsigned char* Vs = F.lds + 65536;
    for (int u = F.vcu; u < 128 + 128; u += F.G) {
        __syncthreads();
        if (u < 128) {
            const int b = u >> 6, h = (u >> 4) & 3, q0 = (u & 15) * 256;
            for (int i = F.tid; i < 256 * 16; i += NTHR) { const int mrow = i >> 4, c8 = i & 15; const bf16* src = ((bf16*)(A.ws + WS_MEMKV)) + ((size_t)l * 512 + b * 256 + mrow) * 1024 + h * 128 + c8 * 8;
                *(LAS v4u*)(Ks + mrow * 256 + c8 * 16) = *(const v4u*)src; *(LAS v4u*)(Vs + mrow * 256 + c8 * 16) = *(const v4u*)(src + 512); }
            __syncthreads();
            const int qi = F.tid >> 1, half = F.tid & 1, row = b * SEQ + q0 + qi;
            float q[64], o[64]; load_q64(((bf16*)(A.ws + WS_XQ)) + (size_t)row * XW + h * 128 + 64 * half, q);
#pragma unroll
            for (int i = 0; i < 64; ++i) o[i] = 0.f;
            float m = -INFINITY, ls = 0.f;
            attn_core<256, true, false>(q, Ks + half * 128, Vs + half * 128, 256, 0, nullptr, m, ls, o);
            store_o64(((bf16*)(A.ws + WS_XO)) + (size_t)row * XW + h * 128 + 64 * half, o, 1.0f / ls);
        } else {
            const int su = u - 128, b = su >> 2, h = su & 3;
            for (int i = F.tid; i < 256 * 16; i += NTHR) { const int mrow = i >> 4, c8 = i & 15; const size_t o = (((size_t)l * NBS + b) * NMEM + mrow) * XW + h * 128 + c8 * 8; float fk[8], fv[8];
                const f32x4 a0 = *(const f32x4*)(A.in[I_CMK] + o), a1 = *(const f32x4*)(A.in[I_CMK] + o + 4), b0 = *(const f32x4*)(A.in[I_CMV] + o), b1 = *(const f32x4*)(A.in[I_CMV] + o + 4);
#pragma unroll
                for (int k = 0; k < 4; ++k) { fk[k] = a0[k]; fk[4 + k] = a1[k]; fv[k] = b0[k]; fv[4 + k] = b1[k]; }
                *(LAS v4u*)(Ks + mrow * 256 + c8 * 16) = pack8(fk); *(LAS v4u*)(Vs + mrow * 256 + c8 * 16) = pack8(fv); }
            __syncthreads();
            if (F.tid < 16) {
                const int qi = F.tid >> 1, half = F.tid & 1, row = MP + b * TS + qi;
                float q[64], o[64]; load_q64(((bf16*)(A.ws + WS_XQ)) + (size_t)row * XW + h * 128 + 64 * half, q);
#pragma unroll
                for (int i = 0; i < 64; ++i) o[i] = 0.f;
                float m = -INFINITY, ls = 0.f;
                attn_core<256, true, false>(q, Ks + half * 128, Vs + half * 128, 256, 0, nullptr, m, ls, o);
                store_o64(((bf16*)(A.ws + WS_XO)) + (size_t)row * XW + h * 128 + 64 * half, o, 1.0f / ls);
            }
        }
    }
    __syncthreads();
}

__device__ __forceinline__ void ffnact_phase(const Args& A, Frame& F0, int l) {
    Frame F = F0; LAUNDER(F);
    const float* cw = A.in[I_FCW] + (size_t)l * 3 * DFF; const float* cbv = A.in[I_FCB] + (size_t)l * DFF;
    constexpr int NG = DFF / 8;
    for (int idx = F.vcu * NTHR + F.tid; idx < M * NG; idx += F.G * NTHR) {
        const int row = idx / NG, c = (idx % NG) * 8; int b, t, T; const bool smp = row >= MP;
        if (!smp) { b = row >> 12; t = row & (SEQ - 1); T = SEQ; } else { b = (row - MP) >> 3; t = (row - MP) & 7; T = TS; }
        float g[3][8];
#pragma unroll
        for (int k = 0; k < 3; ++k) {
            if (t - k >= 0) unpack8(*(const v4u*)(((bf16*)(A.ws + WS_UG)) + (size_t)(row - k) * 2 * DFF + DFF + c), g[k]);
            else if (smp) { const float* sp = A.in[I_SFFN] + (((size_t)l * NBS + b) * 2 + (2 + t - k)) * DFF + c; const f32x4 a0 = *(const f32x4*)sp, a1 = *(const f32x4*)(sp + 4);
#pragma unroll
                for (int i = 0; i < 4; ++i) { g[k][i] = a0[i]; g[k][4 + i] = a1[i]; } }
            else {
#pragma unroll
                for (int i = 0; i < 8; ++i) g[k][i] = 0.f; }
        }
        float uu[8], o[8]; unpack8(*(const v4u*)(((bf16*)(A.ws + WS_UG)) + (size_t)row * 2 * DFF + c), uu);
#pragma unroll
        for (int i = 0; i < 8; ++i) { const float gc = cw[c + i] * g[2][i] + cw[DFF + c + i] * g[1][i] + cw[2 * DFF + c + i] * g[0][i] + cbv[c + i]; o[i] = gc * sigm(gc) * uu[i]; }
        *(v4u*)(((bf16*)(A.ws + WS_ACT)) + (size_t)row * DFF + c) = pack8(o);
        if (t >= T - 2) { float* dst = A.out + (smp ? O_FFNS + (((size_t)l * NBS + b) * 2 + (t - (T - 2))) * DFF : O_FFNP + (((size_t)l * NBP + b) * 2 + (t - (T - 2))) * DFF) + c;
            *(f32x4*)dst = (f32x4){g[0][0], g[0][1], g[0][2], g[0][3]}; *(f32x4*)(dst + 4) = (f32x4){g[0][4], g[0][5], g[0][6], g[0][7]}; }
    }
}

__device__ __forceinline__ void final_phase(const Args& A, Frame& F0) {
    Frame F = F0; LAUNDER(F);
    const int gw = F.vcu * NWAVES + F.wave, NGW = F.G * NWAVES, lane = F.lane; const float* g = A.in[I_NFIN];
    for (int m = gw; m < M; m += NGW) {
        float s = (lane < 32) ? ((float*)(A.ws + WS_SSQ))[(size_t)m * 32 + lane] : 0.f; s = wave_sum(s);
        const float rs = rsqrtf(s * (1.0f / DM) + EPS);
        float* dst = A.out + ((m < MP) ? O_YP + (size_t)m * DM : O_YS + (size_t)(m - MP) * DM);
#pragma unroll
        for (int j = 0; j < 8; ++j) { const f32x4 v = *((const f32x4*)(((float*)(A.ws + WS_X)) + (size_t)m * DM) + lane + 64 * j); const f32x4 gg = *((const f32x4*)g + lane + 64 * j); *((f32x4*)dst + lane + 64 * j) = v * rs * gg; }
    }
}

#ifndef PH_MASK
#define PH_MASK 0xffffffffu
#endif
#define PON(i) constexpr ((PH_MASK >> (i)) & 1u)
#ifndef MK_PER_PHASE
#define MK_PER_PHASE 0
#endif
constexpr int PH_PER_LAYER = 12, N_PHASES = 2 + DEPTH * PH_PER_LAYER + 1;

__global__ void __launch_bounds__(NTHR, 2) fwd(const Args A) {
    extern __shared__ __attribute__((aligned(16))) unsigned char lds[];
    Frame F;
    F.lds = (LAS unsigned char*)lds;
    F.MISC = (volatile LAS unsigned*)(F.lds + MISC_OFF);
    F.tid = threadIdx.x; F.lane = F.tid & 63; F.wave = __builtin_amdgcn_readfirstlane(F.tid >> 6);
    F.G = gridDim.x; { const int bx = blockIdx.x; F.vcu = (F.G % 8 == 0) ? (bx % 8) * (F.G / 8) + bx / 8 : bx; }
    F.ctl = (gu32*)(A.ws + WS_CTL);
    for (int u = F.tid; u < (LDS_BYTES - LDSCTL_OFF) / 4; u += NTHR) ((LAS unsigned*)(F.lds + LDSCTL_OFF))[u] = 0u;
    __syncthreads();
    XcdBarrier bar; bar.bar = (unsigned*)(F.ctl + CW_BAR); bar.x = 0; bar.st = nullptr;
    if (!MK_PER_PHASE) bar = xcd_barrier_post((unsigned*)(F.ctl + CW_BAR), F.MISC + 8);
    const int lo = A.ph_lo, hi = A.ph_hi;
#define IN(k) (lo <= (k) && (k) < hi)
#define SEAM(k) do { if (IN(k) && IN((k) + 1)) xcd_barrier(bar); } while (0)
    typedef pg8::StaticOrder SO;
    LAS unsigned char* ring = F.lds + RING_OFF;

    if (IN(0)) { if PON(0) p0_convert(A, F); }
    SEAM(0);
    if (IN(1)) { if PON(1)
        for (int l = 0; l < DEPTH; ++l) {
            pg8::Gemm g{((bf16*)(A.ws + WS_MEMB)), ((bf16*)(A.ws + WS_WXKV)) + (size_t)l * 2 * XW * DM, NBP * NMEM, 2 * XW, DM}; SO S; S.init(NBP * NMEM, 2 * XW, F.G, (int)((blockIdx.x + F.G - 8 * l) % F.G));
            pg8::EpiMemKV E{A.out + O_MKP + (size_t)l * NBP * NMEM * XW, A.out + O_MVP + (size_t)l * NBP * NMEM * XW, ((bf16*)(A.ws + WS_MEMKV)) + (size_t)l * NBP * NMEM * 2 * XW};
            pg8::gemm_phase<pg8::EpiMemKV, SO, true, true>(ring, g, S, E);
        }
    }
    SEAM(1);
    for (int l = 0; l < DEPTH; ++l) {
        const int pb = 2 + l * PH_PER_LAYER;
        if (IN(pb + 0)) { if PON(2) {
            pg8::Gemm g{((bf16*)(A.ws + WS_XB)), ((bf16*)(A.ws + WS_WIN)) + (size_t)l * NINP * DM, M, NINP, DM}; SO S; S.init(M, NINP, F.G, (int)blockIdx.x);
            pg8::EpiScaleBf16 E{((bf16*)(A.ws + WS_Z)), NINP, ((float*)(A.ws + WS_SSQ)), ZC_GATE / 256, ZC_GLR / 256};
            pg8::gemm_phase<pg8::EpiScaleBf16, SO, true, true>(ring, g, S, E);
        } }
        SEAM(pb + 0);
        if (IN(pb + 1)) { if PON(3) conv_phase(A, F, l); if PON(4) swa_phase(A, F, l); if PON(5) gla_pass1(A, F, l); }
        SEAM(pb + 1);
        if (IN(pb + 2)) { if PON(6) gla_pass2(A, F, l); }
        SEAM(pb + 2);
        if (IN(pb + 3)) { if PON(7) gla_pass3(A, F, l); }
        SEAM(pb + 3);
        if (IN(pb + 4)) { if PON(8) {
            for (int i = 0; i < 3; ++i) {
                pg8::Gemm g{((bf16*)(A.ws + WS_BR)) + (size_t)i * M * MIXW, ((bf16*)(A.ws + WS_WBR)) + ((size_t)l * 3 + i) * DM * MIXW, M, DM, MIXW}; SO S; S.init(M, DM, F.G, (int)blockIdx.x);
                pg8::EpiBranch E{((bf16*)(A.ws + WS_MG)), ((bf16*)(A.ws + WS_Z)) + ZC_GATE + i * DM, NINP, i == 0 ? 1 : 0};
                pg8::gemm_phase<pg8::EpiBranch, SO, true, true>(ring, g, S, E);
            }
        } }
        SEAM(pb + 4);
        if (IN(pb + 5)) { if PON(9) {
            pg8::Gemm g{((bf16*)(A.ws + WS_MG)), ((bf16*)(A.ws + WS_WOUT)) + (size_t)l * DM * DM, M, DM, DM}; SO S; S.init(M, DM, F.G, (int)blockIdx.x);
            pg8::EpiResidual E{((float*)(A.ws + WS_X)), ((bf16*)(A.ws + WS_XB)), ((float*)(A.ws + WS_SSQ))};
            pg8::gemm_phase<pg8::EpiResidual, SO, true, true>(ring, g, S, E);
        } }
        SEAM(pb + 5);
        if (IN(pb + 6)) { if PON(10) {
            pg8::Gemm g{((bf16*)(A.ws + WS_XB)), ((bf16*)(A.ws + WS_WXQ)) + (size_t)l * XW * DM, M, XW, DM}; SO S; S.init(M, XW, F.G, (int)blockIdx.x);
            pg8::EpiScaleBf16 E{((bf16*)(A.ws + WS_XQ)), XW, ((float*)(A.ws + WS_SSQ)), 0, 0};
            pg8::gemm_phase<pg8::EpiScaleBf16, SO, true, true>(ring, g, S, E);
        } }
        SEAM(pb + 6);
        if (IN(pb + 7)) { if PON(11) xattn_phase(A, F, l); }
        SEAM(pb + 7);
        if (IN(pb + 8)) { if PON(12) {
            pg8::Gemm g{((bf16*)(A.ws + WS_XO)), ((bf16*)(A.ws + WS_WXO)) + (size_t)l * DM * XW, M, DM, XW}; SO S; S.init(M, DM, F.G, (int)blockIdx.x);
            pg8::EpiResidual E{((float*)(A.ws + WS_X)), ((bf16*)(A.ws + WS_XB)), ((float*)(A.ws + WS_SSQ))};
            pg8::gemm_phase<pg8::EpiResidual, SO, true, true>(ring, g, S, E);
        } }
        SEAM(pb + 8);
        if (IN(pb + 9)) { if PON(13) {
            pg8::Gemm g{((bf16*)(A.ws + WS_XB)), ((bf16*)(A.ws + WS_WUP)) + (size_t)l * 2 * DFF * DM, M, 2 * DFF, DM}; SO S; S.init(M, 2 * DFF, F.G, (int)blockIdx.x);
            pg8::EpiScaleBf16 E{((bf16*)(A.ws + WS_UG)), 2 * DFF, ((float*)(A.ws + WS_SSQ)), 0, 0};
            pg8::gemm_phase<pg8::EpiScaleBf16, SO, true, true>(ring, g, S, E);
        } }
        SEAM(pb + 9);
        if (IN(pb + 10)) { if PON(14) ffnact_phase(A, F, l); }
        SEAM(pb + 10);
        if (IN(pb + 11)) { if PON(15) {
            pg8::Gemm g{((bf16*)(A.ws + WS_ACT)), ((bf16*)(A.ws + WS_WDN)) + (size_t)l * DM * DFF, M, DM, DFF}; SO S; S.init(M, DM, F.G, (int)blockIdx.x);
            pg8::EpiResidual E{((float*)(A.ws + WS_X)), ((bf16*)(A.ws + WS_XB)), ((float*)(A.ws + WS_SSQ))};
            pg8::gemm_phase<pg8::EpiResidual, SO, true, true>(ring, g, S, E);
        } }
        SEAM(pb + 11);
    }
    if (IN(N_PHASES - 1)) { if PON(16) final_phase(A, F); }
#undef IN
#undef SEAM
}

extern "C" void kernel_launch(void* const* d_in, const int* in_sizes, int n_in, void* d_out, int out_size, void* d_ws, size_t ws_size, hipStream_t stream) {
    static int grid = 0;
    if (grid == 0) {
        if (n_in != N_INPUTS || (size_t)out_size != O_END || ws_size < WS_END) { fprintf(stderr, "kernel_launch: built for %d inputs, %zu outputs, >= %zu bytes of workspace; got n_in %d, out %d, ws %zu; nothing launched\n", N_INPUTS, (size_t)O_END, (size_t)WS_END, n_in, out_size, ws_size); grid = -1; return; }
        int dev = 0, cus = 0, per_cu = 0;
        if (hipGetDevice(&dev) != hipSuccess || hipDeviceGetAttribute(&cus, hipDeviceAttributeMultiprocessorCount, dev) != hipSuccess) { fprintf(stderr, "kernel_launch: device query failed\n"); grid = -1; return; }
        if (hipFuncSetAttribute((const void*)fwd, hipFuncAttributeMaxDynamicSharedMemorySize, LDS_BYTES) != hipSuccess) { fprintf(stderr, "kernel_launch: hipFuncSetAttribute failed\n"); grid = -1; return; }
        if (hipOccupancyMaxActiveBlocksPerMultiprocessor(&per_cu, (const void*)fwd, NTHR, LDS_BYTES) != hipSuccess || per_cu < 1) { fprintf(stderr, "kernel_launch: occupancy query reports %d workgroups per CU\n", per_cu); }
        (void)hipGetLastError();
        grid = cus;
    }
    if (grid < 0) return;
    if (hipMemsetAsync((char*)d_ws + WS_CTL, 0, CTL_ZERO_BYTES, stream) != hipSuccess) { fprintf(stderr, "kernel_launch: memset failed\n"); return; }
    Args a{};
    for (int i = 0; i < N_INPUTS; ++i) a.in[i] = (const float*)d_in[i];
    a.out = (float*)d_out; a.ws = (unsigned char*)d_ws;
#if MK_PER_PHASE
    for (int p = 0; p < N_PHASES; ++p) {
        a.ph_lo = p; a.ph_hi = p + 1;
        hipLaunchKernelGGL(fwd, dim3(grid), dim3(NTHR), LDS_BYTES, stream, a);
    }
#else
    a.ph_lo = 0; a.ph_hi = N_PHASES;
    hipLaunchKernelGGL(fwd, dim3(grid), dim3(NTHR), LDS_BYTES, stream, a);
#endif
    const hipError_t le = hipPeekAtLastError();
    if (le != hipSuccess) fprintf(stderr, "kernel_launch: launch failed: %s\n", hipGetErrorName(le));
}
```

```cpp
#include <hip/hip_runtime.h>
#include <cstdio>
#include <cstdint>
#include <cmath>
#define MK_PER_PHASE 0
namespace pg8 {
#define PG8_LAS __attribute__((address_space(3)))
typedef unsigned short bf16_t;
typedef short bf16x8 __attribute__((ext_vector_type(8)));
typedef float f32x4 __attribute__((ext_vector_type(4)));
typedef unsigned u32x4 __attribute__((ext_vector_type(4)));
constexpr int BM = 256, BK = 64, HALF = 128, HTB = HALF * BK * 2  , STAGE_BYTES = 8 * HTB, NXCD = 8, WGM = 8;

__host__ __device__ __forceinline__ int lds_byte(int r, int c) { const int st = (r >> 4) * 2 + (c >> 5), rr = r & 15, cc = c & 31, ob = rr * 64 + cc * 2; return st * 1024 + (ob ^ (((ob >> 9) & 1) << 5)); }
__host__ __device__ __forceinline__ void stage_rc(int b, int& R, int& C) { const int st = b / 1024, sb = b % 1024, swz = sb ^ (((sb >> 9) & 1) << 5); R = (st >> 1) * 16 + swz / 64; C = (st & 1) * 32 + (swz % 64) / 2; }
__host__ __device__ __forceinline__ int perm32(int rho) { const int n = rho >> 4, i = rho & 15; return 8 * (i >> 2) + 4 * n + (i & 3); }

struct Unit { int pm, pn; };
struct Gemm { const bf16_t* A; const bf16_t* Bt; int M, N, K; };

struct StaticOrder {
    int nM, nN, nwg, G, c;
    __host__ __device__ void init(int M, int N, int G_, int c_) { nM = M / BM; nN = N / BM; nwg = nM * nN; G = G_; c = c_; }
    __host__ __device__ bool next(int i, Unit& u) const {
        const long L = (long)i * G + c; if (L >= nwg) return false;
        int wgid = (int)L; { const int q = nwg / NXCD, r = nwg % NXCD, xcd = wgid % NXCD, off = wgid / NXCD; wgid = (xcd < r ? xcd * (q + 1) : r * (q + 1) + (xcd - r) * q) + off; }
        const int nig = WGM * nN, gid = wgid / nig, fm = gid * WGM, gsz = (nM - fm) < WGM ? (nM - fm) : WGM;
        u.pm = fm + ((wgid % nig) % gsz); u.pn = (wgid % nig) / gsz; return true;
    }
    __device__ __forceinline__ void a_ready(const Unit&) const {}
    __device__ __forceinline__ void done(const Unit&) const {}
};

__device__ __forceinline__ unsigned cvt_pk_bf16(float lo, float hi) { unsigned r; asm volatile("v_cvt_pk_bf16_f32 %0, %1, %2" : "=v"(r) : "v"(lo), "v"(hi)); return r; }
typedef float f32x2 __attribute__((ext_vector_type(2)));
typedef unsigned u32x2 __attribute__((ext_vector_type(2)));
__device__ __forceinline__ float bf_lo(unsigned w) { return __uint_as_float(w << 16); }
__device__ __forceinline__ float bf_hi(unsigned w) { return __uint_as_float(w & 0xffff0000u); }
__device__ __forceinline__ float sigmoidf_(float v) { return 1.0f / (1.0f + __expf(-v)); }

struct EpiScaleBf16 {
    static constexpr bool PERM = true, AFTER_DRAIN = false;
    bf16_t* O; int ldc; const float* ssq; int sig_lo, sig_hi;
    __device__ __forceinline__ void operator()(const f32x4 (&acc)[2][2][4][2], const Unit& u, int wr, int wc, int fr, int fq) const {
        const int row0 = u.pm * BM + wr * 64 + fr, col0 = u.pn * BM + wc * 32 + 8 * fq;
        const bool sig = (u.pn >= sig_lo) && (u.pn < sig_hi);
#pragma unroll
        for (int ai = 0; ai < 2; ++ai)
#pragma unroll
            for (int m = 0; m < 4; ++m) {
                const int row = row0 + ai * HALF + m * 16;
                float rs = 1.0f;
                if (ssq) { const f32x4* p = (const f32x4*)(ssq + (size_t)row * 32); f32x4 s = p[0];
#pragma unroll
                    for (int i = 1; i < 8; ++i) s += p[i];
                    rs = rsqrtf(((s[0] + s[1]) + (s[2] + s[3])) * (1.0f / 2048.0f) + 1e-6f); }
                bf16_t* rowp = O + (size_t)row * ldc + col0;
#pragma unroll
                for (int bj = 0; bj < 2; ++bj) { f32x4 v0 = acc[ai][bj][m][0] * rs, v1 = acc[ai][bj][m][1] * rs;
                    if (sig) { v0 = (f32x4){sigmoidf_(v0[0]), sigmoidf_(v0[1]), sigmoidf_(v0[2]), sigmoidf_(v0[3])}; v1 = (f32x4){sigmoidf_(v1[0]), sigmoidf_(v1[1]), sigmoidf_(v1[2]), sigmoidf_(v1[3])}; }
                    u32x4 w; w.x = cvt_pk_bf16(v0[0], v0[1]); w.y = cvt_pk_bf16(v0[2], v0[3]); w.z = cvt_pk_bf16(v1[0], v1[1]); w.w = cvt_pk_bf16(v1[2], v1[3]);
                    *(u32x4*)(rowp + bj * HALF) = w; }
            }
    }
};

struct EpiResidual {
    static constexpr bool PERM = false, AFTER_DRAIN = false;
    float* X; bf16_t* XB; float* ssq;
    __device__ __forceinline__ void operator()(const f32x4 (&acc)[2][2][4][2], const Unit& u, int wr, int wc, int fr, int fq) const {
        const int row0 = u.pm * BM + wr * 64 + fr, col0 = u.pn * BM + wc * 32 + 4 * fq;
#pragma unroll
        for (int ai = 0; ai < 2; ++ai)
#pragma unroll
            for (int m = 0; m < 4; ++m) {
                const int row = row0 + ai * HALF + m * 16; float ss = 0.f;
#pragma unroll
                for (int bj = 0; bj < 2; ++bj)
#pragma unroll
                    for (int n = 0; n < 2; ++n) { const size_t off = (size_t)row * 2048 + col0 + bj * HALF + n * 16;
                        const f32x4 x = *(const f32x4*)(X + off) + acc[ai][bj][m][n];
                        *(f32x4*)(X + off) = x;
                        u32x2 w; w.x = cvt_pk_bf16(x[0], x[1]); w.y = cvt_pk_bf16(x[2], x[3]); *(u32x2*)(XB + off) = w;
                        ss += (x[0] * x[0] + x[1] * x[1]) + (x[2] * x[2] + x[3] * x[3]); }
                ss += __shfl_xor(ss, 16); ss += __shfl_xor(ss, 32);
                if (fq == 0) ssq[(size_t)row * 32 + u.pn * 4 + wc] = ss;
            }
    }
};

struct EpiBranch {
    static constexpr bool PERM = true, AFTER_DRAIN = false;
    bf16_t* MG; const bf16_t* G; int ldg; int first;
    __device__ __forceinline__ void operator()(const f32x4 (&acc)[2][2][4][2], const Unit& u, int wr, int wc, int fr, int fq) const {
        const int row0 = u.pm * BM + wr * 64 + fr, col0 = u.pn * BM + wc * 32 + 8 * fq;
#pragma unroll
        for (int ai = 0; ai < 2; ++ai)
#pragma unroll
            for (int m = 0; m < 4; ++m) {
                const int row = row0 + ai * HALF + m * 16;
#pragma unroll
                for (int bj = 0; bj < 2; ++bj) { const int col = col0 + bj * HALF;
                    const u32x4 g = *(const u32x4*)(G + (size_t)row * ldg + col);
                    f32x4 v0 = acc[ai][bj][m][0], v1 = acc[ai][bj][m][1];
                    v0 = v0 * (f32x4){bf_lo(g.x), bf_hi(g.x), bf_lo(g.y), bf_hi(g.y)}; v1 = v1 * (f32x4){bf_lo(g.z), bf_hi(g.z), bf_lo(g.w), bf_hi(g.w)};
                    bf16_t* dst = MG + (size_t)row * 2048 + col;
                    if (!first) { const u32x4 o = *(const u32x4*)dst; v0 += (f32x4){bf_lo(o.x), bf_hi(o.x), bf_lo(o.y), bf_hi(o.y)}; v1 += (f32x4){bf_lo(o.z), bf_hi(o.z), bf_lo(o.w), bf_hi(o.w)}; }
                    u32x4 w; w.x = cvt_pk_bf16(v0[0], v0[1]); w.y = cvt_pk_bf16(v0[2], v0[3]); w.z = cvt_pk_bf16(v1[0], v1[1]); w.w = cvt_pk_bf16(v1[2], v1[3]);
                    *(u32x4*)dst = w; }
            }
    }
};

struct EpiMemKV {
    static constexpr bool PERM = false, AFTER_DRAIN = false;
    float* outk; float* outv; bf16_t* KV;
    __device__ __forceinline__ void operator()(const f32x4 (&acc)[2][2][4][2], const Unit& u, int wr, int wc, int fr, int fq) const {
        const int row0 = u.pm * BM + wr * 64 + fr, col0 = u.pn * BM + wc * 32 + 4 * fq;
#pragma unroll
        for (int ai = 0; ai < 2; ++ai)
#pragma unroll
            for (int m = 0; m < 4; ++m) {
                const int row = row0 + ai * HALF + m * 16;
#pragma unroll
                for (int bj = 0; bj < 2; ++bj)
#pragma unroll
                    for (int n = 0; n < 2; ++n) { const int col = col0 + bj * HALF + n * 16; const f32x4 a = acc[ai][bj][m][n];
                        float* dst = (col < 512) ? (outk + (size_t)row * 512 + col) : (outv + (size_t)row * 512 + (col - 512));
                        *(f32x4*)dst = a;
                        u32x2 w; w.x = cvt_pk_bf16(a[0], a[1]); w.y = cvt_pk_bf16(a[2], a[3]); *(u32x2*)(KV + (size_t)row * 1024 + col) = w; }
            }
    }
};
template <class Epi, class Sched, bool ALIGN_EPI = false, bool SP2 = false>
__device__ __forceinline__ void gemm_phase(PG8_LAS unsigned char* lds, const Gemm g, const Sched& S, const Epi& E) {
    int tid_ = threadIdx.x; asm volatile("" : "+v"(tid_));
    const int tid = tid_, wid = __builtin_amdgcn_readfirstlane(tid >> 6), lane = tid & 63, wr = wid >> 2, wc = wid & 3, fr = lane & 15, fq = lane >> 4;
    const int K = g.K, nt = K / BK;
    unsigned voffA[2], voffB[2];
#pragma unroll
    for (int i = 0; i < 2; ++i) { int R, C; stage_rc(tid * 16 + i * 8192, R, C); const int Rb = Epi::PERM ? ((R & ~31) + perm32(R & 31)) : R;
        voffA[i] = (unsigned)(R * K + C) * 2u; voffB[i] = (unsigned)(Rb * K + C) * 2u; }
    const size_t kstep = (size_t)(BK * 2);
    const size_t hstep = (size_t)HALF * K * 2;
    const size_t tstep = 2 * hstep;
    const unsigned ldsw = (unsigned)wid * 1024u;
    const int aoff = lds_byte(wr * 64 + fr, fq * 8), boff = lds_byte(wc * 32 + fr, fq * 8);
#define PG8_SA(b, h) (((b) * 2 + (h)) * HTB)
#define PG8_SB(b, h) ((4 + (b) * 2 + (h)) * HTB)
#define PG8_STAGE(bufoff, gbase, voff) do { _Pragma("unroll") for (int _i = 0; _i < 2; ++_i) \
        __builtin_amdgcn_global_load_lds((const unsigned*)((const char*)(gbase) + (voff)[_i]), (PG8_LAS unsigned*)(lds + (bufoff) + ldsw + _i * 8192), 16, 0, 0); } while (0)
#define PG8_LDA(dst, b, h) do { _Pragma("unroll") for (int m = 0; m < 4; ++m) _Pragma("unroll") for (int k = 0; k < 2; ++k) dst[m][k] = *(const PG8_LAS bf16x8*)(lds + PG8_SA(b, h) + aoff + m * 2048 + k * 1024); } while (0)
#define PG8_LDB(dst, b, h) do { _Pragma("unroll") for (int n = 0; n < 2; ++n) _Pragma("unroll") for (int k = 0; k < 2; ++k) dst[n][k] = *(const PG8_LAS bf16x8*)(lds + PG8_SB(b, h) + boff + n * 2048 + k * 1024); } while (0)
#define PG8_MMA(ai, bj, At, Bt) do { __builtin_amdgcn_s_setprio(1); _Pragma("unroll") for (int m = 0; m < 4; ++m) _Pragma("unroll") for (int n = 0; n < 2; ++n) _Pragma("unroll") for (int k = 0; k < 2; ++k) \
        acc[ai][bj][m][n] = __builtin_amdgcn_mfma_f32_16x16x32_bf16(Bt[n][k], At[m][k], acc[ai][bj][m][n], 0, 0, 0); __builtin_amdgcn_s_setprio(0); } while (0)
#define PG8_WAIT_V(n) asm volatile("s_waitcnt vmcnt(" #n ")" ::: "memory")
#define PG8_WAIT_L(n) asm volatile("s_waitcnt lgkmcnt(" #n ")" ::: "memory")
#define PG8_BAR __builtin_amdgcn_s_barrier()
#define PG8_SCHED __builtin_amdgcn_sched_barrier(0)
    Unit cur, nxt; int ui = 0;
    if (!S.next(0, cur)) return;
    f32x4 acc[2][2][4][2];
#pragma unroll
    for (int a = 0; a < 2; ++a)
#pragma unroll
        for (int b = 0; b < 2; ++b)
#pragma unroll
            for (int m = 0; m < 4; ++m)
#pragma unroll
                for (int n = 0; n < 2; ++n) acc[a][b][m][n] = (f32x4){0.f, 0.f, 0.f, 0.f};
    bf16x8 At[4][2], B0[2][2], B1[2][2];
    const char* cA = (const char*)g.A + (size_t)cur.pm * tstep; const char* cB = (const char*)g.Bt + (size_t)cur.pn * tstep;
    S.a_ready(cur);
    if constexpr (SP2) {
        PG8_STAGE(PG8_SB(0, 0), cB, voffB); PG8_STAGE(PG8_SB(0, 1), cB + hstep, voffB); PG8_STAGE(PG8_SA(0, 0), cA, voffA); PG8_STAGE(PG8_SA(0, 1), cA + hstep, voffA);
        if (wr == 1) PG8_BAR;
        PG8_WAIT_V(2); PG8_BAR;
        PG8_STAGE(PG8_SB(1, 0), cB + kstep, voffB); PG8_STAGE(PG8_SA(1, 0), cA + kstep, voffA); PG8_STAGE(PG8_SB(1, 1), cB + hstep + kstep, voffB);
        PG8_WAIT_V(6); PG8_BAR;
    } else {
        PG8_STAGE(PG8_SB(0, 0), cB, voffB); PG8_STAGE(PG8_SA(0, 0), cA, voffA); PG8_STAGE(PG8_SB(0, 1), cB + hstep, voffB); PG8_STAGE(PG8_SA(0, 1), cA + hstep, voffA);
        if (wr == 1) PG8_BAR;
        PG8_WAIT_V(4); PG8_BAR;
        PG8_STAGE(PG8_SB(1, 0), cB + kstep, voffB); PG8_STAGE(PG8_SA(1, 0), cA + kstep, voffA); PG8_STAGE(PG8_SB(1, 1), cB + hstep + kstep, voffB);
        PG8_WAIT_V(6); PG8_BAR;
    }
    for (;;) {
        const bool has_next = S.next(ui + 1, nxt);
        const char* nA = has_next ? (const char*)g.A + (size_t)nxt.pm * tstep : cA; const char* nB = has_next ? (const char*)g.Bt + (size_t)nxt.pn * tstep : cB;
        for (int t = 0; t < nt; t += 2) {
            const bool last = (t == nt - 2);
            const char* a1 = cA + (size_t)(t + 1) * kstep;
            const char* a2 = last ? nA : cA + (size_t)(t + 2) * kstep; const char* b2 = last ? nB : cB + (size_t)(t + 2) * kstep;
            const char* a3 = a2 + kstep; const char* b3 = b2 + kstep;
            if (last && has_next) S.a_ready(nxt);
            if constexpr (SP2) {
            PG8_LDB(B0, 0, 0); PG8_LDB(B1, 0, 1); PG8_SCHED; PG8_LDA(At, 0, 0); PG8_STAGE(PG8_SA(1, 1), a1 + hstep, voffA);
            PG8_WAIT_V(8); PG8_WAIT_L(0); PG8_BAR; PG8_MMA(0, 0, At, B0); PG8_MMA(0, 1, At, B1); PG8_BAR; PG8_SCHED;
            PG8_LDA(At, 0, 1); PG8_STAGE(PG8_SB(0, 0), b2, voffB); PG8_STAGE(PG8_SB(0, 1), b2 + hstep, voffB); PG8_STAGE(PG8_SA(0, 0), a2, voffA);
            PG8_WAIT_V(8); PG8_WAIT_L(0); PG8_BAR; PG8_MMA(1, 0, At, B0); PG8_MMA(1, 1, At, B1); PG8_BAR; PG8_SCHED;
            PG8_LDB(B0, 1, 0); PG8_LDB(B1, 1, 1); PG8_SCHED; PG8_LDA(At, 1, 0); PG8_STAGE(PG8_SA(0, 1), a2 + hstep, voffA);
            PG8_WAIT_V(8); PG8_WAIT_L(0); PG8_BAR; PG8_MMA(0, 0, At, B0); PG8_MMA(0, 1, At, B1); PG8_BAR; PG8_SCHED;
            PG8_LDA(At, 1, 1); PG8_STAGE(PG8_SB(1, 0), b3, voffB); PG8_STAGE(PG8_SB(1, 1), b3 + hstep, voffB); PG8_STAGE(PG8_SA(1, 0), a3, voffA);
            PG8_WAIT_V(8); PG8_WAIT_L(0); PG8_BAR; PG8_MMA(1, 0, At, B0); PG8_MMA(1, 1, At, B1); PG8_BAR; PG8_SCHED;
            } else {
            PG8_LDB(B0, 0, 0); PG8_SCHED; PG8_LDA(At, 0, 0); PG8_STAGE(PG8_SA(1, 1), a1 + hstep, voffA);
            PG8_WAIT_L(8); PG8_BAR; PG8_WAIT_L(0); PG8_MMA(0, 0, At, B0); PG8_BAR; PG8_SCHED;
            PG8_LDB(B1, 0, 1); PG8_STAGE(PG8_SB(0, 0), b2, voffB);
            PG8_BAR; PG8_WAIT_L(0); PG8_MMA(0, 1, At, B1); PG8_BAR;
            PG8_LDA(At, 0, 1); PG8_STAGE(PG8_SA(0, 0), a2, voffA);
            PG8_BAR; PG8_WAIT_L(0); PG8_MMA(1, 0, At, B0); PG8_BAR; PG8_SCHED;
            PG8_STAGE(PG8_SB(0, 1), b2 + hstep, voffB);
            PG8_WAIT_V(6); PG8_BAR; PG8_MMA(1, 1, At, B1); PG8_BAR;
            PG8_LDB(B0, 1, 0); PG8_SCHED; PG8_LDA(At, 1, 0); PG8_STAGE(PG8_SA(0, 1), a2 + hstep, voffA);
            PG8_WAIT_L(8); PG8_BAR; PG8_WAIT_L(0); PG8_MMA(0, 0, At, B0); PG8_BAR; PG8_SCHED;
            PG8_LDB(B1, 1, 1); PG8_STAGE(PG8_SB(1, 0), b3, voffB);
            PG8_BAR; PG8_WAIT_L(0); PG8_MMA(0, 1, At, B1); PG8_BAR;
            PG8_LDA(At, 1, 1); PG8_STAGE(PG8_SA(1, 0), a3, voffA);
            PG8_BAR; PG8_WAIT_L(0); PG8_MMA(1, 0, At, B0); PG8_BAR; PG8_SCHED;
            PG8_STAGE(PG8_SB(1, 1), b3 + hstep, voffB);
            PG8_WAIT_V(6); PG8_BAR; PG8_MMA(1, 1, At, B1); PG8_BAR;
            }
        }
        if constexpr (ALIGN_EPI) { if (wr == 0) PG8_BAR; }
        if constexpr (!Epi::AFTER_DRAIN) { E(acc, cur, wr, wc, fr, fq); S.done(cur); }
        if (!has_next) break;
#pragma unroll
        for (int a = 0; a < 2; ++a)
#pragma unroll
            for (int b = 0; b < 2; ++b)
#pragma unroll
                for (int m = 0; m < 4; ++m)
#pragma unroll
                    for (int n = 0; n < 2; ++n) acc[a][b][m][n] = (f32x4){0.f, 0.f, 0.f, 0.f};
        cur = nxt; cA = nA; cB = nB; ++ui;
        if constexpr (ALIGN_EPI) { if (wr == 1) PG8_BAR; }
    }
    PG8_WAIT_V(0);
    if constexpr (!ALIGN_EPI) { if (wr == 0) PG8_BAR; }
    PG8_BAR;
    if constexpr (Epi::AFTER_DRAIN) { E.fused(acc, cur, wr, wc, fr, fq, lds, wid, lane); S.done(cur); }
#undef PG8_SA
#undef PG8_SB
#undef PG8_STAGE
#undef PG8_LDA
#undef PG8_LDB
#undef PG8_MMA
#undef PG8_WAIT_V
#undef PG8_WAIT_L
#undef PG8_BAR
#undef PG8_SCHED
}
}

constexpr int NWAVES = 8, NTHR = 512;
constexpr int DM = 2048, SEQ = 4096, NBP = 2, DEPTH = 4, NBS = 32, TS = 8;
constexpr int MP = NBP * SEQ, MS = NBS * TS, M = MP + MS;
constexpr int MIXW = 1024, GH = 4, GDK = 128, GDV = 256, GRANK = 16;
constexpr int SH = 16, SKV = 2, SHD = 64, WIN = 128;
constexpr int NMEM = 256, XH = 4, XHD = 128, XW = XH * XHD;
constexpr int DFF = 5504, NIN = 13584, NINP = 13824;
constexpr float EPS = 1e-6f;
constexpr int ZC_GQ = 0, ZC_GK = 512, ZC_GV = 1024, ZC_GR = 2048, ZC_SQ = 3072, ZC_SK = 4096, ZC_SV = 4224, ZC_CB = 4352, ZC_CC = 5376, ZC_CH = 6400, ZC_GATE = 7424, ZC_GLR = 13568;
static_assert(ZC_GATE % 256 == 0 && ZC_GLR % 256 == 0 && ZC_GLR + 16 == NIN && NINP % 256 == 0, "z layout");
constexpr size_t O_YP = 0, O_YS = O_YP + (size_t)MP * DM, O_GLAP = O_YS + (size_t)MS * DM, O_GLAS = O_GLAP + (size_t)DEPTH * NBP * GH * GDK * GDV,
                 O_SKP = O_GLAS + (size_t)DEPTH * NBS * GH * GDK * GDV, O_SVP = O_SKP + (size_t)DEPTH * NBP * WIN * SKV * SHD, O_SKS = O_SVP + (size_t)DEPTH * NBP * WIN * SKV * SHD,
                 O_SVS = O_SKS + (size_t)DEPTH * NBS * WIN * SKV * SHD, O_CONVP = O_SVS + (size_t)DEPTH * NBS * WIN * SKV * SHD, O_CONVS = O_CONVP + (size_t)DEPTH * NBP * 2 * MIXW,
                 O_FFNP = O_CONVS + (size_t)DEPTH * NBS * 2 * MIXW, O_FFNS = O_FFNP + (size_t)DEPTH * NBP * 2 * DFF, O_MKP = O_FFNS + (size_t)DEPTH * NBS * 2 * DFF,
                 O_MVP = O_MKP + (size_t)DEPTH * NBP * NMEM * XW, O_END = O_MVP + (size_t)DEPTH * NBP * NMEM * XW;
static_assert(O_END == 43456512, "output size");
enum { I_XP = 0, I_XS, I_SGLA, I_CSK, I_CSV, I_SCONV, I_SFFN, I_CMK, I_CMV, I_MEMP, I_NMIX, I_WIN, I_GUP, I_GB, I_GNORM, I_SINK, I_RELB, I_CONVW, I_WBR, I_WOUT, I_NX, I_WXQ, I_WXK, I_WXV, I_WXO,
       I_NFFN, I_FUP, I_FCW, I_FCB, I_FDN, I_NFIN, N_INPUTS };
static_assert(N_INPUTS == 31, "inputs");

constexpr size_t MiB = 1u << 20;
constexpr size_t al1m(size_t x) { return (x + MiB - 1) / MiB * MiB; }
constexpr size_t WS_CTL = 0, CTL_ZERO_BYTES = 1 * MiB;
constexpr size_t SZ_WIN = (size_t)NINP * DM * 2, SZ_WBR = (size_t)3 * DM * MIXW * 2, SZ_WOUT = (size_t)DM * DM * 2, SZ_WXQ = (size_t)XW * DM * 2, SZ_WXKV = (size_t)2 * XW * DM * 2,
                 SZ_WXO = (size_t)DM * XW * 2, SZ_WUP = (size_t)2 * DFF * DM * 2, SZ_WDN = (size_t)DM * DFF * 2;
constexpr size_t WS_WIN = 2 * MiB, WS_WBR = al1m(WS_WIN + DEPTH * SZ_WIN), WS_WOUT = al1m(WS_WBR + DEPTH * SZ_WBR), WS_WXQ = al1m(WS_WOUT + DEPTH * SZ_WOUT),
                 WS_WXKV = al1m(WS_WXQ + DEPTH * SZ_WXQ), WS_WXO = al1m(WS_WXKV + DEPTH * SZ_WXKV), WS_WUP = al1m(WS_WXO + DEPTH * SZ_WXO), WS_WDN = al1m(WS_WUP + DEPTH * SZ_WUP);
constexpr size_t WS_X = al1m(WS_WDN + DEPTH * SZ_WDN), WS_XB = al1m(WS_X + (size_t)M * DM * 4), WS_SSQ = al1m(WS_XB + (size_t)M * DM * 2), WS_Z = al1m(WS_SSQ + (size_t)M * 32 * 4),
                 WS_BR = al1m(WS_Z + (size_t)M * NINP * 2), WS_MG = al1m(WS_BR + (size_t)3 * M * MIXW * 2), WS_XQ = al1m(WS_MG + (size_t)M * DM * 2), WS_XO = al1m(WS_XQ + (size_t)M * XW * 2),
                 WS_UG = al1m(WS_XO + (size_t)M * XW * 2), WS_ACT = al1m(WS_UG + (size_t)M * 2 * DFF * 2), WS_MEMB = al1m(WS_ACT + (size_t)M * DFF * 2), WS_MEMKV = al1m(WS_MEMB + (size_t)NBP * NMEM * DM * 2),
                 WS_GLAU = al1m(WS_MEMKV + (size_t)DEPTH * NBP * NMEM * 2 * XW * 2), WS_GLAD = al1m(WS_GLAU + (size_t)512 * GDK * GDV * 4), WS_END = al1m(WS_GLAD + (size_t)512 * GDK * 4);
constexpr int CW_TMO = 0, CW_CODE = 1, CW_BAR = 4096;

constexpr int RING_OFF = 0, RING_BYTES = 131072;
constexpr int LDSCTL_OFF = RING_BYTES, MISC_OFF = LDSCTL_OFF + 320;
constexpr int LDS_BYTES = 147456;
static_assert(MISC_OFF + 128 <= LDS_BYTES, "LDS map");

#define GAS __attribute__((address_space(1)))
#define LAS __attribute__((address_space(3)))
typedef unsigned short bf16;
typedef unsigned v4u __attribute__((ext_vector_type(4)));
typedef unsigned v2u __attribute__((ext_vector_type(2)));
typedef float f32x4 __attribute__((ext_vector_type(4)));
typedef float f32x2 __attribute__((ext_vector_type(2)));
typedef GAS unsigned gu32;
#define RLX_AGENT __ATOMIC_RELAXED, __HIP_MEMORY_SCOPE_AGENT
#define LDS_WAIT() asm volatile("s_waitcnt lgkmcnt(0)" ::: "memory")
#define VM_WAIT() asm volatile("s_waitcnt vmcnt(0)" ::: "memory")
__device__ __forceinline__ float bflo(unsigned w) { return __uint_as_float(w << 16); }
__device__ __forceinline__ float bfhi(unsigned w) { return __uint_as_float(w & 0xffff0000u); }
__device__ __forceinline__ float bf1(bf16 h) { return __uint_as_float(((unsigned)h) << 16); }
__device__ __forceinline__ unsigned pk2(float lo, float hi) { return pg8::cvt_pk_bf16(lo, hi); }
__device__ __forceinline__ void unpack8(const v4u w, float (&f)[8]) { f[0] = bflo(w.x); f[1] = bfhi(w.x); f[2] = bflo(w.y); f[3] = bfhi(w.y); f[4] = bflo(w.z); f[5] = bfhi(w.z); f[6] = bflo(w.w); f[7] = bfhi(w.w); }
__device__ __forceinline__ v4u pack8(const float (&f)[8]) { v4u w; w.x = pk2(f[0], f[1]); w.y = pk2(f[2], f[3]); w.z = pk2(f[4], f[5]); w.w = pk2(f[6], f[7]); return w; }
__device__ __forceinline__ float sigm(float v) { return 1.0f / (1.0f + __expf(-v)); }
__device__ __forceinline__ float wave_sum(float v) {
#pragma unroll
    for (int o = 1; o < 64; o <<= 1) v += __shfl_xor(v, o);
    return v;
}
#define XB_TMO      128
#define XB_XCNT(j)  (256  + 64 * (j))
#define XB_XSUB(j)  (1280 + 64 * (j))
#define XB_XGEN(j)  (2304 + 64 * (j))
#define XB_TOP      3328
#define XB_TOPGEN   3392
#define XCD_BAR_WORDS 3456
#define XB_SPIN_CAP (1u << 18)

__device__ __forceinline__ unsigned xb_ld(unsigned* p)              { return __hip_atomic_load(p, __ATOMIC_RELAXED, __HIP_MEMORY_SCOPE_AGENT); }
__device__ __forceinline__ unsigned xb_add(unsigned* p, unsigned v) { return __hip_atomic_fetch_add(p, v, __ATOMIC_RELAXED, __HIP_MEMORY_SCOPE_AGENT); }
__device__ __forceinline__ unsigned xb_xcc_id() { return (unsigned)__builtin_amdgcn_s_getreg((3 << 11) | 20) & 0xFu; }
#define XB_SPIN(cond, bar) do { unsigned _sp = 0; while (cond) { __builtin_amdgcn_s_sleep(1); \
    if ((++_sp & 255u) == 0u) { if (xb_ld(&(bar)[XB_TMO])) break; if (_sp > XB_SPIN_CAP) { atomicAdd(&(bar)[XB_TMO], 1u); break; } } } } while (0)

struct XcdBarrier {
    unsigned* bar; unsigned x;
    volatile LAS unsigned* st;
};

__device__ __forceinline__ XcdBarrier xcd_barrier_post(unsigned* bar, volatile LAS unsigned* st) {
    XcdBarrier b; b.bar = bar; b.x = xb_xcc_id(); b.st = st;
    if (threadIdx.x == 0) (void)xb_add(&bar[XB_XCNT(b.x)], 1u);
    return b;
}
__device__ __forceinline__ void xcd_barrier_complete(unsigned* bar, unsigned x, unsigned& nloc, unsigned& nx) {
    const unsigned G = gridDim.x * gridDim.y * gridDim.z;
    unsigned sum, cnt, mine, sp = 0u;
    for (;;) {
        sum = 0u; cnt = 0u; mine = 0u;
#pragma unroll
        for (unsigned j = 0; j < 16; ++j) { const unsigned c = xb_ld(&bar[XB_XCNT(j)]); sum += c; cnt += (c > 0u) ? 1u : 0u; mine = (j == x) ? c : mine; }
        if (sum == G) break;
        __builtin_amdgcn_s_sleep(1);
        if ((++sp & 255u) == 0u) { if (xb_ld(&bar[XB_TMO])) break; if (sp > XB_SPIN_CAP) { atomicAdd(&bar[XB_TMO], 1u); break; } }
    }
    nloc = mine > 0u ? mine : 1u; nx = cnt > 0u ? cnt : 1u;
}

__device__ __forceinline__ void xcd_barrier(const XcdBarrier& b) {
    asm volatile("s_waitcnt vmcnt(0)" ::: "memory");
    __syncthreads();
    if (threadIdx.x == 0) {
        unsigned* bar = b.bar;
        __builtin_amdgcn_s_waitcnt(0);
        unsigned nloc = b.st[0], nx = b.st[1];
        if (nloc == 0u) { xcd_barrier_complete(bar, b.x, nloc, nx); b.st[0] = nloc; b.st[1] = nx; }
        const unsigned old = xb_add(&bar[XB_XSUB(b.x)], 1u);
        const unsigned gen = old / nloc;
        if (old + 1u == (gen + 1u) * nloc) {
            __builtin_amdgcn_fence(__ATOMIC_RELEASE, "agent");
            asm volatile("s_waitcnt vmcnt(0)" ::: "memory");
            const unsigned og = xb_add(&bar[XB_TOP], 1u);
            const unsigned tg = og / nx;
            if (og + 1u == (tg + 1u) * nx) xb_add(&bar[XB_TOPGEN], 1u);
            else XB_SPIN(xb_ld(&bar[XB_TOPGEN]) == tg, bar);
            __builtin_amdgcn_fence(__ATOMIC_ACQUIRE, "agent");
            xb_add(&bar[XB_XGEN(b.x)], 1u);
            asm volatile("s_waitcnt vmcnt(0)" ::: "memory");
        } else {
            XB_SPIN(xb_ld(&bar[XB_XGEN(b.x)]) == gen, bar);
            __builtin_amdgcn_fence(__ATOMIC_ACQUIRE, "agent");
            asm volatile("s_waitcnt vmcnt(0)" ::: "memory");
        }
    }
    __syncthreads();
}

struct Args { const float* in[N_INPUTS]; float* out; unsigned char* ws; int ph_lo, ph_hi; };
static_assert(sizeof(Args) == N_INPUTS * 8 + 8 + 8 + 8, "Args has no padding");

struct Frame {
    LAS unsigned char* lds;
    volatile LAS unsigned* MISC;
    gu32* ctl;
    int tid, lane, wave, vcu, G;
};

#define LAUNDER(F) do { asm volatile("" : "+v"((F).tid), "+v"((F).lane)); asm volatile("" : "+s"((F).wave), "+s"((F).vcu), "+s"((F).G)); } while (0)
__device__ __forceinline__ void tr_item(const float* W, int K, int Nsrc, bf16* WT, int dstrow0, int k0, int srccol, float cscale, const float* gain, LAS float* scr, int lane) {
#pragma unroll 8
    for (int i = 0; i < 32; ++i) { const int kk = 2 * i + (lane >> 5); float v = 0.f; if (srccol >= 0) v = W[(size_t)(k0 + kk) * Nsrc + srccol]; if (gain) v *= gain[k0 + kk]; scr[kk * 33 + (lane & 31)] = v * cscale; }
    LDS_WAIT(); asm volatile("" ::: "memory");
    const int c = lane & 7;
#pragma unroll
    for (int j = 0; j < 4; ++j) { const int n = (lane >> 3) + 8 * j; const LAS float* s = scr + (8 * c) * 33 + n;
        v4u o; o.x = pk2(s[0 * 33], s[1 * 33]); o.y = pk2(s[2 * 33], s[3 * 33]); o.z = pk2(s[4 * 33], s[5 * 33]); o.w = pk2(s[6 * 33], s[7 * 33]);
        *(v4u*)(WT + (size_t)(dstrow0 + n) * K + k0 + 8 * c) = o; }
    LDS_WAIT(); asm volatile("" ::: "memory");
}
__device__ __forceinline__ void tr_plain(const float* W, int K, int N, bf16* WT, int dst_off, int r, float cscale, const float* gain, LAS float* scr, int lane) {
    const int nblk = N / 32, kb = r / nblk, nb = r % nblk;
    tr_item(W, K, N, WT, dst_off + 32 * nb, 64 * kb, 32 * nb + (lane & 31), cscale, gain, scr, lane);
}
constexpr int IT_IN = (DM / 64) * (NINP / 32), IT_BR = (MIXW / 64) * (DM / 32), IT_OUT = (DM / 64) * (DM / 32), IT_XQ = (DM / 64) * (XW / 32), IT_XO = (XW / 64) * (DM / 32),
              IT_UP = (DM / 64) * (2 * DFF / 32), IT_DN = (DFF / 64) * (DM / 32), IT_LAYER = IT_IN + 3 * IT_BR + IT_OUT + 3 * IT_XQ + IT_XO + IT_UP + IT_DN;
__device__ __forceinline__ void p0_convert(const Args& A, Frame& F0) {
    Frame F = F0; LAUNDER(F);
    LAS float* scr = (LAS float*)(F.lds + RING_OFF + F.wave * 16384);
    const int gw = F.vcu * NWAVES + F.wave, NGW = F.G * NWAVES, lane = F.lane;
    for (int it = gw; it < DEPTH * IT_LAYER; it += NGW) {
        const int l = it / IT_LAYER; int r = it % IT_LAYER;
        if (r < IT_IN) {
            const int nblk = NINP / 32, kb = r / nblk, nb = r % nblk, n = 32 * nb + (lane & 31);
            int src; if (n < 3072) src = n; else if (n < ZC_GLR) src = n + 16; else if (n < NIN) src = 3072 + (n - ZC_GLR); else src = -1;
            const float cs = (n < 512) ? 0.08838834764831845f : ((n >= ZC_SQ && n < ZC_SK) ? 0.125f : 1.0f);
            tr_item(A.in[I_WIN] + (size_t)l * DM * NIN, DM, NIN, ((bf16*)(A.ws + WS_WIN)) + (size_t)l * NINP * DM, 32 * nb, 64 * kb, src, cs, A.in[I_NMIX] + l * DM, scr, lane); continue; }
        r -= IT_IN;
        if (r < 3 * IT_BR) { const int i = r / IT_BR; r %= IT_BR;
            tr_plain(A.in[I_WBR] + ((size_t)l * 3 + i) * MIXW * DM, MIXW, DM, ((bf16*)(A.ws + WS_WBR)) + ((size_t)l * 3 + i) * DM * MIXW, 0, r, 1.0f, nullptr, scr, lane); continue; }
        r -= 3 * IT_BR;
        if (r < IT_OUT) { tr_plain(A.in[I_WOUT] + (size_t)l * DM * DM, DM, DM, ((bf16*)(A.ws + WS_WOUT)) + (size_t)l * DM * DM, 0, r, 1.0f, nullptr, scr, lane); continue; }
        r -= IT_OUT;
        if (r < IT_XQ) { tr_plain(A.in[I_WXQ] + (size_t)l * DM * XW, DM, XW, ((bf16*)(A.ws + WS_WXQ)) + (size_t)l * XW * DM, 0, r, 0.08838834764831845f, A.in[I_NX] + l * DM, scr, lane); continue; }
        r -= IT_XQ;
        if (r < IT_XQ) { tr_plain(A.in[I_WXK] + (size_t)l * DM * XW, DM, XW, ((bf16*)(A.ws + WS_WXKV)) + (size_t)l * 2 * XW * DM, 0, r, 1.0f, nullptr, scr, lane); continue; }
        r -= IT_XQ;
        if (r < IT_XQ) { tr_plain(A.in[I_WXV] + (size_t)l * DM * XW, DM, XW, ((bf16*)(A.ws + WS_WXKV)) + (size_t)l * 2 * XW * DM, XW, r, 1.0f, nullptr, scr, lane); continue; }
        r -= IT_XQ;
        if (r < IT_XO) { tr_plain(A.in[I_WXO] + (size_t)l * XW * DM, XW, DM, ((bf16*)(A.ws + WS_WXO)) + (size_t)l * DM * XW, 0, r, 1.0f, nullptr, scr, lane); continue; }
        r -= IT_XO;
        if (r < IT_UP) { tr_plain(A.in[I_FUP] + (size_t)l * DM * 2 * DFF, DM, 2 * DFF, ((bf16*)(A.ws + WS_WUP)) + (size_t)l * 2 * DFF * DM, 0, r, 1.0f, A.in[I_NFFN] + l * DM, scr, lane); continue; }
        r -= IT_UP;
        tr_plain(A.in[I_FDN] + (size_t)l * DFF * DM, DFF, DM, ((bf16*)(A.ws + WS_WDN)) + (size_t)l * DM * DFF, 0, r, 1.0f, nullptr, scr, lane);
    }
    for (int m = gw; m < M + NBP * NMEM; m += NGW) {
        if (m < M) {
            const float* src = (m < MP) ? A.in[I_XP] + (size_t)m * DM : A.in[I_XS] + (size_t)(m - MP) * DM;
            float ss = 0.f;
#pragma unroll
            for (int j = 0; j < 8; ++j) { const f32x4 v = *((const f32x4*)src + lane + 64 * j); *((f32x4*)(((float*)(A.ws + WS_X)) + (size_t)m * DM) + lane + 64 * j) = v;
                v2u w; w.x = pk2(v[0], v[1]); w.y = pk2(v[2], v[3]); *((v2u*)(((bf16*)(A.ws + WS_XB)) + (size_t)m * DM) + lane + 64 * j) = w; ss += (v[0] * v[0] + v[1] * v[1]) + (v[2] * v[2] + v[3] * v[3]); }
            ss = wave_sum(ss);
            if (lane < 32) ((float*)(A.ws + WS_SSQ))[(size_t)m * 32 + lane] = (lane == 0) ? ss : 0.f;
        } else {
            const int r = m - M; const float* src = A.in[I_MEMP] + (size_t)r * DM;
#pragma unroll
            for (int j = 0; j < 8; ++j) { const f32x4 v = *((const f32x4*)src + lane + 64 * j); v2u w; w.x = pk2(v[0], v[1]); w.y = pk2(v[2], v[3]); *((v2u*)(((bf16*)(A.ws + WS_MEMB)) + (size_t)r * DM) + lane + 64 * j) = w; }
        }
    }
}

__device__ __forceinline__ int t5_bucket(int n) {
    if (n < 16) return n;
    const float v = logf((float)n / 16.0f) / logf(8.0f) * 16.0f; const int lg = 16 + (int)v; return lg < 31 ? lg : 31;
}
template <int STRIDE, bool PAIR, bool BIAS>
__device__ __forceinline__ void attn_core(const float (&q)[64], LAS const unsigned char* kp, LAS const unsigned char* vp, int nsteps, int jmin, LAS const float* bp, float& m, float& lsum, float (&o)[64]) {
    for (int j = 0; j < nsteps; ++j) {
        LAS const v4u* kr = (LAS const v4u*)(kp + j * STRIDE);
        float s0 = 0.f, s1 = 0.f;
#pragma unroll
        for (int c = 0; c < 8; ++c) { const v4u kk = kr[c];
            s0 += q[8 * c + 0] * bflo(kk.x) + q[8 * c + 2] * bflo(kk.y) + q[8 * c + 4] * bflo(kk.z) + q[8 * c + 6] * bflo(kk.w);
            s1 += q[8 * c + 1] * bfhi(kk.x) + q[8 * c + 3] * bfhi(kk.y) + q[8 * c + 5] * bfhi(kk.z) + q[8 * c + 7] * bfhi(kk.w); }
        float s = s0 + s1;
        if (PAIR) s += __shfl_xor(s, 1);
        if (BIAS) s += bp[-j];
        s = (j >= jmin) ? s : -INFINITY;
        const float mn = fmaxf(m, s), sc = __expf(m - mn), p = __expf(s - mn);
        lsum = lsum * sc + p; m = mn;
        LAS const v4u* vr = (LAS const v4u*)(vp + j * STRIDE);
#pragma unroll
        for (int c = 0; c < 8; ++c) { const v4u vv = vr[c];
            o[8 * c + 0] = o[8 * c + 0] * sc + p * bflo(vv.x); o[8 * c + 1] = o[8 * c + 1] * sc + p * bfhi(vv.x);
            o[8 * c + 2] = o[8 * c + 2] * sc + p * bflo(vv.y); o[8 * c + 3] = o[8 * c + 3] * sc + p * bfhi(vv.y);
            o[8 * c + 4] = o[8 * c + 4] * sc + p * bflo(vv.z); o[8 * c + 5] = o[8 * c + 5] * sc + p * bfhi(vv.z);
            o[8 * c + 6] = o[8 * c + 6] * sc + p * bflo(vv.w); o[8 * c + 7] = o[8 * c + 7] * sc + p * bfhi(vv.w); }
    }
}
__device__ __forceinline__ void load_q64(const bf16* p, float (&q)[64]) {
#pragma unroll
    for (int c = 0; c < 8; ++c) { const v4u w = *((const v4u*)p + c); float f[8]; unpack8(w, f);
#pragma unroll
        for (int i = 0; i < 8; ++i) q[8 * c + i] = f[i]; }
}
__device__ __forceinline__ void store_o64(bf16* p, const float (&o)[64], float inv) {
#pragma unroll
    for (int c = 0; c < 8; ++c) { float f[8];
#pragma unroll
        for (int i = 0; i < 8; ++i) f[i] = o[8 * c + i] * inv;
        *((v4u*)p + c) = pack8(f); }
}

constexpr int SWA_STR = 144, SWA_K = 0, SWA_V = 192 * SWA_STR, SWA_BT = 2 * 192 * SWA_STR, SWA_BTS = 132;
__device__ __forceinline__ void swa_phase(const Args& A, Frame& F0, int l) {
    Frame F = F0; LAUNDER(F);
    LAS unsigned char* Ks = F.lds + SWA_K; LAS unsigned char* Vs = F.lds + SWA_V; LAS float* BT = (LAS float*)(F.lds + SWA_BT);
    for (int i = F.tid; i < SH * 129; i += NTHR) { const int h = i / 129, d = i % 129; BT[h * SWA_BTS + d] = A.in[I_RELB][t5_bucket(d) * SH + h]; }
    const float* sinks = A.in[I_SINK] + l * SH;
    for (int u = F.vcu; u < 256 + 64; u += F.G) {
        __syncthreads();
        if (u < 256) {
            const int b = u >> 7, kvh = (u >> 6) & 1, qb = u & 63, q0 = qb * 64;
            for (int i = F.tid; i < 192 * 8; i += NTHR) { const int r = i >> 3, c8 = i & 7, pos = q0 - 128 + r; v4u kv = (v4u){0u, 0u, 0u, 0u}, vv = kv;
                if (pos >= 0) { const bf16* zr = ((bf16*)(A.ws + WS_Z)) + (size_t)(b * SEQ + pos) * NINP + kvh * 64 + c8 * 8; kv = *(const v4u*)(zr + ZC_SK); vv = *(const v4u*)(zr + ZC_SV); }
                *(LAS v4u*)(Ks + r * SWA_STR + c8 * 16) = kv; *(LAS v4u*)(Vs + r * SWA_STR + c8 * 16) = vv;
                if (qb == 63 && r >= 64) { float fk[8], fv[8]; unpack8(kv, fk); unpack8(vv, fv); const size_t o = ((((size_t)l * NBP + b) * WIN + (r - 64)) * SKV + kvh) * SHD + c8 * 8;
                    *(f32x4*)(A.out + O_SKP + o) = (f32x4){fk[0], fk[1], fk[2], fk[3]}; *(f32x4*)(A.out + O_SKP + o + 4) = (f32x4){fk[4], fk[5], fk[6], fk[7]};
                    *(f32x4*)(A.out + O_SVP + o) = (f32x4){fv[0], fv[1], fv[2], fv[3]}; *(f32x4*)(A.out + O_SVP + o + 4) = (f32x4){fv[4], fv[5], fv[6], fv[7]}; }
            }
            __syncthreads();
            const int head = kvh * 8 + F.wave, t = q0 + F.lane, row = b * SEQ + t;
            float q[64], o[64]; load_q64(((bf16*)(A.ws + WS_Z)) + (size_t)row * NINP + ZC_SQ + head * 64, q);
#pragma unroll
            for (int i = 0; i < 64; ++i) o[i] = 0.f;
            float m = sinks[head], ls = 1.0f;
            attn_core<SWA_STR, false, true>(q, Ks + F.lane * SWA_STR, Vs + F.lane * SWA_STR, 129, 128 - t, BT + head * SWA_BTS + 128, m, ls, o);
            store_o64(((bf16*)(A.ws + WS_BR)) + (size_t)1 * M * MIXW + (size_t)row * MIXW + head * 64, o, 1.0f / ls);
        } else {
            const int su = u - 256, b = su >> 1, kvh = su & 1;
            for (int i = F.tid; i < 136 * 8; i += NTHR) { const int r = i >> 3, c8 = i & 7; float fk[8], fv[8];
                if (r < 128) { const size_t o = ((((size_t)l * NBS + b) * WIN + r) * SKV + kvh) * SHD + c8 * 8; const f32x4 a0 = *(const f32x4*)(A.in[I_CSK] + o), a1 = *(const f32x4*)(A.in[I_CSK] + o + 4), b0 = *(const f32x4*)(A.in[I_CSV] + o), b1 = *(const f32x4*)(A.in[I_CSV] + o + 4);
#pragma unroll
                    for (int k = 0; k < 4; ++k) { fk[k] = a0[k]; fk[4 + k] = a1[k]; fv[k] = b0[k]; fv[4 + k] = b1[k]; } }
                else { const bf16* zr = ((bf16*)(A.ws + WS_Z)) + (size_t)(MP + b * TS + (r - 128)) * NINP + kvh * 64 + c8 * 8; unpack8(*(const v4u*)(zr + ZC_SK), fk); unpack8(*(const v4u*)(zr + ZC_SV), fv); }
                *(LAS v4u*)(Ks + r * SWA_STR + c8 * 16) = pack8(fk); *(LAS v4u*)(Vs + r * SWA_STR + c8 * 16) = pack8(fv);
                if (r >= 8) { const size_t o = ((((size_t)l * NBS + b) * WIN + (r - 8)) * SKV + kvh) * SHD + c8 * 8;
                    *(f32x4*)(A.out + O_SKS + o) = (f32x4){fk[0], fk[1], fk[2], fk[3]}; *(f32x4*)(A.out + O_SKS + o + 4) = (f32x4){fk[4], fk[5], fk[6], fk[7]};
                    *(f32x4*)(A.out + O_SVS + o) = (f32x4){fv[0], fv[1], fv[2], fv[3]}; *(f32x4*)(A.out + O_SVS + o + 4) = (f32x4){fv[4], fv[5], fv[6], fv[7]}; }
            }
            __syncthreads();
            if (F.wave == 0) {
                const int t = F.lane & 7, head = kvh * 8 + (F.lane >> 3), row = MP + b * TS + t;
                float q[64], o[64]; load_q64(((bf16*)(A.ws + WS_Z)) + (size_t)row * NINP + ZC_SQ + head * 64, q);
#pragma unroll
                for (int i = 0; i < 64; ++i) o[i] = 0.f;
                float m = sinks[head], ls = 1.0f;
                attn_core<SWA_STR, false, true>(q, Ks + t * SWA_STR, Vs + t * SWA_STR, 129, 0, BT + head * SWA_BTS + 128, m, ls, o);
                store_o64(((bf16*)(A.ws + WS_BR)) + (size_t)1 * M * MIXW + (size_t)row * MIXW + head * 64, o, 1.0f / ls);
            }
        }
    }
    __syncthreads();
}

__device__ __forceinline__ void conv_phase(const Args& A, Frame& F0, int l) {
    Frame F = F0; LAUNDER(F);
    const float* cw = A.in[I_CONVW] + (size_t)l * 3 * MIXW;
    for (int idx = F.vcu * NTHR + F.tid; idx < M * (MIXW / 8); idx += F.G * NTHR) {
        const int row = idx >> 7, c = (idx & 127) * 8; int b, t, T; const bool smp = row >= MP;
        if (!smp) { b = row >> 12; t = row & (SEQ - 1); T = SEQ; } else { b = (row - MP) >> 3; t = (row - MP) & 7; T = TS; }
        float u[3][8];
#pragma unroll
        for (int k = 0; k < 3; ++k) {
            if (t - k >= 0) { const bf16* zr = ((bf16*)(A.ws + WS_Z)) + (size_t)(row - k) * NINP + c; float a[8], d[8]; unpack8(*(const v4u*)(zr + ZC_CC), a); unpack8(*(const v4u*)(zr + ZC_CH), d);
#pragma unroll
                for (int i = 0; i < 8; ++i) u[k][i] = a[i] * d[i]; }
            else if (smp) { const float* sp = A.in[I_SCONV] + (((size_t)l * NBS + b) * 2 + (2 + t - k)) * MIXW + c; const f32x4 a0 = *(const f32x4*)sp, a1 = *(const f32x4*)(sp + 4);
#pragma unroll
                for (int i = 0; i < 4; ++i) { u[k][i] = a0[i]; u[k][4 + i] = a1[i]; } }
            else {
#pragma unroll
                for (int i = 0; i < 8; ++i) u[k][i] = 0.f; }
        }
        float cb[8], o[8]; unpack8(*(const v4u*)(((bf16*)(A.ws + WS_Z)) + (size_t)row * NINP + ZC_CB + c), cb);
#pragma unroll
        for (int i = 0; i < 8; ++i) o[i] = cb[i] * (cw[c + i] * u[2][i] + cw[MIXW + c + i] * u[1][i] + cw[2 * MIXW + c + i] * u[0][i]);
        *(v4u*)(((bf16*)(A.ws + WS_BR)) + (size_t)2 * M * MIXW + (size_t)row * MIXW + c) = pack8(o);
        if (t >= T - 2) { float* dst = A.out + (smp ? O_CONVS + (((size_t)l * NBS + b) * 2 + (t - (T - 2))) * MIXW : O_CONVP + (((size_t)l * NBP + b) * 2 + (t - (T - 2))) * MIXW) + c;
            *(f32x4*)dst = (f32x4){u[0][0], u[0][1], u[0][2], u[0][3]}; *(f32x4*)(dst + 4) = (f32x4){u[0][4], u[0][5], u[0][6], u[0][7]}; }
    }
}

__device__ __forceinline__ void gla_stage_wg(const Args& A, Frame& F, int l, int h, LAS float* wgs) {
    for (int i = F.tid; i < 16 * 128; i += NTHR) wgs[i] = A.in[I_GUP][(size_t)l * GRANK * 512 + (i >> 7) * 512 + h * 128 + (i & 127)];
    if (F.tid < 128) wgs[2048 + F.tid] = A.in[I_GB][l * 512 + h * 128 + F.tid];
}
__device__ __forceinline__ float gla_lg(const float (&gl)[16], LAS const float* wgs, int d) {
    float zg = wgs[2048 + d];
#pragma unroll
    for (int r = 0; r < 16; ++r) zg += gl[r] * wgs[r * 128 + d];
    return (fminf(zg, 0.f) - log1pf(__expf(-fabsf(zg)))) * (1.0f / 16.0f);
}
__device__ __forceinline__ void load_glr(const bf16* zr, float (&gl)[16]) {
    float a[8], b[8]; unpack8(*(const v4u*)zr, a); unpack8(*(const v4u*)(zr + 8), b);
#pragma unroll
    for (int i = 0; i < 8; ++i) { gl[i] = a[i]; gl[8 + i] = b[i]; }
}
__device__ __forceinline__ void gla_chunk_b(const Args& A, Frame& F, int l, int row0, int h, LAS float* bl, LAS float* wgs) {
    gla_stage_wg(A, F, l, h, wgs);
    __syncthreads();
    { const int t = F.tid >> 3, dg = F.tid & 7; float gl[16]; load_glr(((bf16*)(A.ws + WS_Z)) + (size_t)(row0 + t) * NINP + ZC_GLR, gl);
#pragma unroll 4
      for (int dd = 0; dd < 16; ++dd) { const int d = dg * 16 + dd; bl[t * 128 + d] = gla_lg(gl, wgs, d); } }
    __syncthreads();
    if (F.tid < 128) { float a = 0.f; for (int t = 0; t < 64; ++t) { a += bl[t * 128 + F.tid]; bl[t * 128 + F.tid] = a; } }
    __syncthreads();
}
__device__ __forceinline__ void gla_pass1(const Args& A, Frame& F0, int l) {
    Frame F = F0; LAUNDER(F);
    LAS float* bl = (LAS float*)(F.lds); LAS float* kt = (LAS float*)(F.lds + 32768); LAS float* wgs = (LAS float*)(F.lds + 65536);
    for (int u = F.vcu; u < 512 + 128; u += F.G) {
        __syncthreads();
        if (u < 512) {
            const int bh = u >> 6, c = u & 63, b = bh >> 2, h = bh & 3, row0 = b * SEQ + c * 64;
            gla_chunk_b(A, F, l, row0, h, bl, wgs);
            for (int i8 = F.tid; i8 < 64 * 16; i8 += NTHR) { const int t = i8 >> 4, d0 = (i8 & 15) * 8; float k[8]; unpack8(*(const v4u*)(((bf16*)(A.ws + WS_Z)) + (size_t)(row0 + t) * NINP + ZC_GK + h * 128 + d0), k);
#pragma unroll
                for (int i = 0; i < 8; ++i) kt[t * 128 + d0 + i] = k[i] * __expf(bl[63 * 128 + d0 + i] - bl[t * 128 + d0 + i]); }
            __syncthreads();
            const int d0 = (F.tid >> 5) * 8, v0 = (F.tid & 31) * 8;
            float acc[8][8];
#pragma unroll
            for (int i = 0; i < 8; ++i)
#pragma unroll
                for (int j = 0; j < 8; ++j) acc[i][j] = 0.f;
            for (int t = 0; t < 64; ++t) { const f32x4 k0 = *(LAS const f32x4*)(kt + t * 128 + d0), k1 = *(LAS const f32x4*)(kt + t * 128 + d0 + 4); float vv[8]; unpack8(*(const v4u*)(((bf16*)(A.ws + WS_Z)) + (size_t)(row0 + t) * NINP + ZC_GV + h * 256 + v0), vv);
#pragma unroll
                for (int i = 0; i < 4; ++i)
#pragma unroll
                    for (int j = 0; j < 8; ++j) { acc[i][j] += k0[i] * vv[j]; acc[4 + i][j] += k1[i] * vv[j]; } }
            float* U = ((float*)(A.ws + WS_GLAU)) + (size_t)u * GDK * GDV;
#pragma unroll
            for (int i = 0; i < 8; ++i) { *(f32x4*)(U + (d0 + i) * 256 + v0) = (f32x4){acc[i][0], acc[i][1], acc[i][2], acc[i][3]}; *(f32x4*)(U + (d0 + i) * 256 + v0 + 4) = (f32x4){acc[i][4], acc[i][5], acc[i][6], acc[i][7]}; }
            if (F.tid < 128) ((float*)(A.ws + WS_GLAD))[(size_t)u * 128 + F.tid] = __expf(bl[63 * 128 + F.tid]);
        } else {
            const int su = u - 512, b = su >> 2, h = su & 3, row0 = MP + b * TS;
            LAS float* qs = (LAS float*)(F.lds); LAS float* ks = qs + 1024; LAS float* es = qs + 2048; LAS float* vs = qs + 3072; LAS float* red = qs + 5120;
            gla_stage_wg(A, F, l, h, wgs);
            __syncthreads();
            { const int t = F.tid >> 6, dp = F.tid & 63; float gl[16]; load_glr(((bf16*)(A.ws + WS_Z)) + (size_t)(row0 + t) * NINP + ZC_GLR, gl);
              es[t * 128 + 2 * dp] = __expf(gla_lg(gl, wgs, 2 * dp)); es[t * 128 + 2 * dp + 1] = __expf(gla_lg(gl, wgs, 2 * dp + 1)); }
            for (int i = F.tid; i < 8 * 128; i += NTHR) { const int t = i >> 7, d = i & 127; const bf16* zr = ((bf16*)(A.ws + WS_Z)) + (size_t)(row0 + t) * NINP + h * 128 + d; qs[i] = bf1(zr[ZC_GQ]); ks[i] = bf1(zr[ZC_GK]); }
            for (int i = F.tid; i < 8 * 256; i += NTHR) { const int t = i >> 8, v = i & 255; vs[i] = bf1(((bf16*)(A.ws + WS_Z))[(size_t)(row0 + t) * NINP + ZC_GV + h * 256 + v]); }
            __syncthreads();
            const int v = F.tid & 255, half = F.tid >> 8; const size_t sidx = (((size_t)l * NBS + b) * GH + h) * GDK * GDV;
            const float* S0 = A.in[I_SGLA] + sidx + (size_t)(64 * half) * 256 + v;
            float S[64];
#pragma unroll
            for (int i = 0; i < 64; ++i) S[i] = S0[i * 256];
            for (int t = 0; t < 8; ++t) { const float vv = vs[t * 256 + v]; float part = 0.f;
#pragma unroll
                for (int i = 0; i < 64; ++i) { const int d = 64 * half + i; S[i] = es[t * 128 + d] * S[i] + ks[t * 128 + d] * vv; part += qs[t * 128 + d] * S[i]; }
                red[(t * 2 + half) * 256 + v] = part; }
            float* So = A.out + O_GLAS + sidx + (size_t)(64 * half) * 256 + v;
#pragma unroll
            for (int i = 0; i < 64; ++i) So[i * 256] = S[i];
            __syncthreads();
            { const int t = F.wave, row = row0 + t; float o[4]; float ss = 0.f;
#pragma unroll
              for (int k = 0; k < 4; ++k) { const int vv = F.lane + 64 * k; o[k] = red[(t * 2) * 256 + vv] + red[(t * 2 + 1) * 256 + vv]; ss += o[k] * o[k]; }
              ss = wave_sum(ss); const float rs = rsqrtf(ss * (1.0f / 256.0f) + EPS);
#pragma unroll
              for (int k = 0; k < 4; ++k) { const int vv = F.lane + 64 * k; const float g = bf1(((bf16*)(A.ws + WS_Z))[(size_t)row * NINP + ZC_GR + h * 256 + vv]);
                  ((bf16*)(A.ws + WS_BR))[(size_t)row * MIXW + h * 256 + vv] = (bf16)(pk2(o[k] * rs * A.in[I_GNORM][l * GDV + vv] * g * sigm(g), 0.f) & 0xffffu); } }
        }
    }
    __syncthreads();
}
__device__ __forceinline__ void gla_pass2(const Args& A, Frame& F0, int l) {
    Frame F = F0; LAUNDER(F);
    for (int e = F.vcu * NTHR + F.tid; e < 8 * GDK * GDV; e += F.G * NTHR) {
        const int bh = e >> 15, dv = e & 32767, d = dv >> 8;
        float* U = ((float*)(A.ws + WS_GLAU)) + (size_t)bh * 64 * GDK * GDV + dv; const float* D = ((float*)(A.ws + WS_GLAD)) + (size_t)bh * 64 * 128 + d;
        float S = 0.f;
        for (int c0 = 0; c0 < 64; c0 += 8) { float uu[8], dd[8];
#pragma unroll
            for (int k = 0; k < 8; ++k) { uu[k] = U[(size_t)(c0 + k) * GDK * GDV]; dd[k] = D[(c0 + k) * 128]; }
#pragma unroll
            for (int k = 0; k < 8; ++k) { U[(size_t)(c0 + k) * GDK * GDV] = S; S = dd[k] * S + uu[k]; } }
        A.out[O_GLAP + ((size_t)l * 8 + bh) * GDK * GDV + dv] = S;
    }
}
__device__ __forceinline__ void gla_pass3(const Args& A, Frame& F0, int l) {
    Frame F = F0; LAUNDER(F);
    LAS float* bl = (LAS float*)(F.lds); LAS float* qdT = (LAS float*)(F.lds + 32768); LAS float* kdT = (LAS float*)(F.lds + 67584); LAS float* Am = (LAS float*)(F.lds + 102400); LAS float* wgs = (LAS float*)(F.lds + 119808);
    for (int u = F.vcu; u < 512; u += F.G) {
        __syncthreads();
        const int bh = u >> 6, c = u & 63, b = bh >> 2, h = bh & 3, row0 = b * SEQ + c * 64;
        gla_chunk_b(A, F, l, row0, h, bl, wgs);
        { const int t = F.tid & 63, dg = F.tid >> 6; const bf16* zr = ((bf16*)(A.ws + WS_Z)) + (size_t)(row0 + t) * NINP + h * 128 + dg * 16; float q[16], k[16];
          { float a[8], bb[8]; unpack8(*(const v4u*)(zr + ZC_GQ), a); unpack8(*(const v4u*)(zr + ZC_GQ + 8), bb);
#pragma unroll
            for (int i = 0; i < 8; ++i) { q[i] = a[i]; q[8 + i] = bb[i]; }
            unpack8(*(const v4u*)(zr + ZC_GK), a); unpack8(*(const v4u*)(zr + ZC_GK + 8), bb);
#pragma unroll
            for (int i = 0; i < 8; ++i) { k[i] = a[i]; k[8 + i] = bb[i]; } }
#pragma unroll
          for (int i = 0; i < 16; ++i) { const int d = dg * 16 + i; const float bb = bl[t * 128 + d]; qdT[d * 68 + t] = q[i] * __expf(bb); kdT[d * 68 + t] = k[i] * __expf(-bb); } }
        __syncthreads();
        const int tb = F.tid >> 5, vb = F.tid & 31;
        {
            float a[4][2];
#pragma unroll
            for (int i = 0; i < 4; ++i) { a[i][0] = 0.f; a[i][1] = 0.f; }
            for (int d = 0; d < 128; ++d) { const f32x4 qq = *(LAS const f32x4*)(qdT + d * 68 + 4 * tb); const f32x2 kk = *(LAS const f32x2*)(kdT + d * 68 + 2 * vb);
#pragma unroll
                for (int i = 0; i < 4; ++i) { a[i][0] += qq[i] * kk[0]; a[i][1] += qq[i] * kk[1]; } }
#pragma unroll
            for (int i = 0; i < 4; ++i)
#pragma unroll
                for (int j = 0; j < 2; ++j) { const int t = 4 * tb + i, s = 2 * vb + j; Am[s * 68 + t] = (s <= t) ? a[i][j] : 0.f; }
        }
        float o[4][8];
#pragma unroll
        for (int i = 0; i < 4; ++i)
#pragma unroll
            for (int j = 0; j < 8; ++j) o[i][j] = 0.f;
        { const float* S = ((float*)(A.ws + WS_GLAU)) + (size_t)u * GDK * GDV + 8 * vb;
          for (int d = 0; d < 128; ++d) { const f32x4 qq = *(LAS const f32x4*)(qdT + d * 68 + 4 * tb); const f32x4 s0 = *(const f32x4*)(S + d * 256), s1 = *(const f32x4*)(S + d * 256 + 4);
#pragma unroll
              for (int i = 0; i < 4; ++i)
#pragma unroll
                  for (int j = 0; j < 4; ++j) { o[i][j] += qq[i] * s0[j]; o[i][4 + j] += qq[i] * s1[j]; } } }
        __syncthreads();
        for (int s = 0; s < 64; ++s) { const f32x4 aa = *(LAS const f32x4*)(Am + s * 68 + 4 * tb); float vv[8]; unpack8(*(const v4u*)(((bf16*)(A.ws + WS_Z)) + (size_t)(row0 + s) * NINP + ZC_GV + h * 256 + 8 * vb), vv);
#pragma unroll
            for (int i = 0; i < 4; ++i)
#pragma unroll
                for (int j = 0; j < 8; ++j) o[i][j] += aa[i] * vv[j]; }
        float gn[8];
#pragma unroll
        for (int j = 0; j < 8; ++j) gn[j] = A.in[I_GNORM][l * GDV + 8 * vb + j];
#pragma unroll
        for (int i = 0; i < 4; ++i) { float ss = 0.f;
#pragma unroll
            for (int j = 0; j < 8; ++j) ss += o[i][j] * o[i][j];
#pragma unroll
            for (int x = 1; x < 32; x <<= 1) ss += __shfl_xor(ss, x);
            const float rs = rsqrtf(ss * (1.0f / 256.0f) + EPS); const int row = row0 + 4 * tb + i; float g[8], r[8]; unpack8(*(const v4u*)(((bf16*)(A.ws + WS_Z)) + (size_t)row * NINP + ZC_GR + h * 256 + 8 * vb), g);
#pragma unroll
            for (int j = 0; j < 8; ++j) r[j] = o[i][j] * rs * gn[j] * g[j] * sigm(g[j]);
            *(v4u*)(((bf16*)(A.ws + WS_BR)) + (size_t)row * MIXW + h * 256 + 8 * vb) = pack8(r); }
    }
    __syncthreads();
}

__device__ __forceinline__ void xattn_phase(const Args& A, Frame& F0, int l) {
    Frame F = F0; LAUNDER(F);
    LAS unsigned char* Ks = F.lds; LAS unsigned char* Vs = F.lds + 65536;
    for (int u = F.vcu; u < 128 + 128; u += F.G) {
        __syncthreads();
        if (u < 128) {
            const int b = u >> 6, h = (u >> 4) & 3, q0 = (u & 15) * 256;
            for (int i = F.tid; i < 256 * 16; i += NTHR) { const int mrow = i >> 4, c8 = i & 15; const bf16* src = ((bf16*)(A.ws + WS_MEMKV)) + ((size_t)l * 512 + b * 256 + mrow) * 1024 + h * 128 + c8 * 8;
                *(LAS v4u*)(Ks + mrow * 256 + c8 * 16) = *(const v4u*)src; *(LAS v4u*)(Vs + mrow * 256 + c8 * 16) = *(const v4u*)(src + 512); }
            __syncthreads();
            const int qi = F.tid >> 1, half = F.tid & 1, row = b * SEQ + q0 + qi;
            float q[64], o[64]; load_q64(((bf16*)(A.ws + WS_XQ)) + (size_t)row * XW + h * 128 + 64 * half, q);
#pragma unroll
            for (int i = 0; i < 64; ++i) o[i] = 0.f;
            float m = -INFINITY, ls = 0.f;
            attn_core<256, true, false>(q, Ks + half * 128, Vs + half * 128, 256, 0, nullptr, m, ls, o);
            store_o64(((bf16*)(A.ws + WS_XO)) + (size_t)row * XW + h * 128 + 64 * half, o, 1.0f / ls);
        } else {
            const int su = u - 128, b = su >> 2, h = su & 3;
            for (int i = F.tid; i < 256 * 16; i += NTHR) { const int mrow = i >> 4, c8 = i & 15; const size_t o = (((size_t)l * NBS + b) * NMEM + mrow) * XW + h * 128 + c8 * 8; float fk[8], fv[8];
                const f32x4 a0 = *(const f32x4*)(A.in[I_CMK] + o), a1 = *(const f32x4*)(A.in[I_CMK] + o + 4), b0 = *(const f32x4*)(A.in[I_CMV] + o), b1 = *(const f32x4*)(A.in[I_CMV] + o + 4);
#pragma unroll
                for (int k = 0; k < 4; ++k) { fk[k] = a0[k]; fk[4 + k] = a1[k]; fv[k] = b0[k]; fv[4 + k] = b1[k]; }
                *(LAS v4u*)(Ks + mrow * 256 + c8 * 16) = pack8(fk); *(LAS v4u*)(Vs + mrow * 256 + c8 * 16) = pack8(fv); }
            __syncthreads();
            if (F.tid < 16) {
                const int qi = F.tid >> 1, half = F.tid & 1, row = MP + b * TS + qi;
                float q[64], o[64]; load_q64(((bf16*)(A.ws + WS_XQ)) + (size_t)row * XW + h * 128 + 64 * half, q);
#pragma unroll
                for (int i = 0; i < 64; ++i) o[i] = 0.f;
                float m = -INFINITY, ls = 0.f;
                attn_core<256, true, false>(q, Ks + half * 128, Vs + half * 128, 256, 0, nullptr, m, ls, o);
                store_o64(((bf16*)(A.ws + WS_XO)) + (size_t)row * XW + h * 128 + 64 * half, o, 1.0f / ls);
            }
        }
    }
    __syncthreads();
}

__device__ __forceinline__ void ffnact_phase(const Args& A, Frame& F0, int l) {
    Frame F = F0; LAUNDER(F);
    const float* cw = A.in[I_FCW] + (size_t)l * 3 * DFF; const float* cbv = A.in[I_FCB] + (size_t)l * DFF;
    constexpr int NG = DFF / 8;
    for (int idx = F.vcu * NTHR + F.tid; idx < M * NG; idx += F.G * NTHR) {
        const int row = idx / NG, c = (idx % NG) * 8; int b, t, T; const bool smp = row >= MP;
        if (!smp) { b = row >> 12; t = row & (SEQ - 1); T = SEQ; } else { b = (row - MP) >> 3; t = (row - MP) & 7; T = TS; }
        float g[3][8];
#pragma unroll
        for (int k = 0; k < 3; ++k) {
            if (t - k >= 0) unpack8(*(const v4u*)(((bf16*)(A.ws + WS_UG)) + (size_t)(row - k) * 2 * DFF + DFF + c), g[k]);
            else if (smp) { const float* sp = A.in[I_SFFN] + (((size_t)l * NBS + b) * 2 + (2 + t - k)) * DFF + c; const f32x4 a0 = *(const f32x4*)sp, a1 = *(const f32x4*)(sp + 4);
#pragma unroll
                for (int i = 0; i < 4; ++i) { g[k][i] = a0[i]; g[k][4 + i] = a1[i]; } }
            else {
#pragma unroll
                for (int i = 0; i < 8; ++i) g[k][i] = 0.f; }
        }
        float uu[8], o[8]; unpack8(*(const v4u*)(((bf16*)(A.ws + WS_UG)) + (size_t)row * 2 * DFF + c), uu);
#pragma unroll
        for (int i = 0; i < 8; ++i) { const float gc = cw[c + i] * g[2][i] + cw[DFF + c + i] * g[1][i] + cw[2 * DFF + c + i] * g[0][i] + cbv[c + i]; o[i] = gc * sigm(gc) * uu[i]; }
        *(v4u*)(((bf16*)(A.ws + WS_ACT)) + (size_t)row * DFF + c) = pack8(o);
        if (t >= T - 2) { float* dst = A.out + (smp ? O_FFNS + (((size_t)l * NBS + b) * 2 + (t - (T - 2))) * DFF : O_FFNP + (((size_t)l * NBP + b) * 2 + (t - (T - 2))) * DFF) + c;
            *(f32x4*)dst = (f32x4){g[0][0], g[0][1], g[0][2], g[0][3]}; *(f32x4*)(dst + 4) = (f32x4){g[0][4], g[0][5], g[0][6], g[0][7]}; }
    }
}

__device__ __forceinline__ void final_phase(const Args& A, Frame& F0) {
    Frame F = F0; LAUNDER(F);
    const int gw = F.vcu * NWAVES + F.wave, NGW = F.G * NWAVES, lane = F.lane; const float* g = A.in[I_NFIN];
    for (int m = gw; m < M; m += NGW) {
        float s = (lane < 32) ? ((float*)(A.ws + WS_SSQ))[(size_t)m * 32 + lane] : 0.f; s = wave_sum(s);
        const float rs = rsqrtf(s * (1.0f / DM) + EPS);
        float* dst = A.out + ((m < MP) ? O_YP + (size_t)m * DM : O_YS + (size_t)(m - MP) * DM);
#pragma unroll
        for (int j = 0; j < 8; ++j) { const f32x4 v = *((const f32x4*)(((float*)(A.ws + WS_X)) + (size_t)m * DM) + lane + 64 * j); const f32x4 gg = *((const f32x4*)g + lane + 64 * j); *((f32x4*)dst + lane + 64 * j) = v * rs * gg; }
    }
}

#ifndef PH_MASK
#define PH_MASK 0xffffffffu
#endif
#define PON(i) constexpr ((PH_MASK >> (i)) & 1u)
#ifndef MK_PER_PHASE
#define MK_PER_PHASE 0
#endif
constexpr int PH_PER_LAYER = 12, N_PHASES = 2 + DEPTH * PH_PER_LAYER + 1;

__global__ void __launch_bounds__(NTHR, 2) fwd(const Args A) {
    extern __shared__ __attribute__((aligned(16))) unsigned char lds[];
    Frame F;
    F.lds = (LAS unsigned char*)lds;
    F.MISC = (volatile LAS unsigned*)(F.lds + MISC_OFF);
    F.tid = threadIdx.x; F.lane = F.tid & 63; F.wave = __builtin_amdgcn_readfirstlane(F.tid >> 6);
    F.G = gridDim.x; { const int bx = blockIdx.x; F.vcu = (F.G % 8 == 0) ? (bx % 8) * (F.G / 8) + bx / 8 : bx; }
    F.ctl = (gu32*)(A.ws + WS_CTL);
    for (int u = F.tid; u < (LDS_BYTES - LDSCTL_OFF) / 4; u += NTHR) ((LAS unsigned*)(F.lds + LDSCTL_OFF))[u] = 0u;
    __syncthreads();
    XcdBarrier bar; bar.bar = (unsigned*)(F.ctl + CW_BAR); bar.x = 0; bar.st = nullptr;
    if (!MK_PER_PHASE) bar = xcd_barrier_post((unsigned*)(F.ctl + CW_BAR), F.MISC + 8);
    const int lo = A.ph_lo, hi = A.ph_hi;
#define IN(k) (lo <= (k) && (k) < hi)
#define SEAM(k) do { if (IN(k) && IN((k) + 1)) xcd_barrier(bar); } while (0)
    typedef pg8::StaticOrder SO;
    LAS unsigned char* ring = F.lds + RING_OFF;

    if (IN(0)) { if PON(0) p0_convert(A, F); }
    SEAM(0);
    if (IN(1)) { if PON(1)
        for (int l = 0; l < DEPTH; ++l) {
            pg8::Gemm g{((bf16*)(A.ws + WS_MEMB)), ((bf16*)(A.ws + WS_WXKV)) + (size_t)l * 2 * XW * DM, NBP * NMEM, 2 * XW, DM}; SO S; S.init(NBP * NMEM, 2 * XW, F.G, (int)((blockIdx.x + F.G - 8 * l) % F.G));
            pg8::EpiMemKV E{A.out + O_MKP + (size_t)l * NBP * NMEM * XW, A.out + O_MVP + (size_t)l * NBP * NMEM * XW, ((bf16*)(A.ws + WS_MEMKV)) + (size_t)l * NBP * NMEM * 2 * XW};
            pg8::gemm_phase<pg8::EpiMemKV, SO, true, true>(ring, g, S, E);
        }
    }
    SEAM(1);
    for (int l = 0; l < DEPTH; ++l) {
        const int pb = 2 + l * PH_PER_LAYER;
        if (IN(pb + 0)) { if PON(2) {
            pg8::Gemm g{((bf16*)(A.ws + WS_XB)), ((bf16*)(A.ws + WS_WIN)) + (size_t)l * NINP * DM, M, NINP, DM}; SO S; S.init(M, NINP, F.G, (int)blockIdx.x);
            pg8::EpiScaleBf16 E{((bf16*)(A.ws + WS_Z)), NINP, ((float*)(A.ws + WS_SSQ)), ZC_GATE / 256, ZC_GLR / 256};
            pg8::gemm_phase<pg8::EpiScaleBf16, SO, true, true>(ring, g, S, E);
        } }
        SEAM(pb + 0);
        if (IN(pb + 1)) { if PON(3) conv_phase(A, F, l); if PON(4) swa_phase(A, F, l); if PON(5) gla_pass1(A, F, l); }
        SEAM(pb + 1);
        if (IN(pb + 2)) { if PON(6) gla_pass2(A, F, l); }
        SEAM(pb + 2);
        if (IN(pb + 3)) { if PON(7) gla_pass3(A, F, l); }
        SEAM(pb + 3);
        if (IN(pb + 4)) { if PON(8) {
            for (int i = 0; i < 3; ++i) {
                pg8::Gemm g{((bf16*)(A.ws + WS_BR)) + (size_t)i * M * MIXW, ((bf16*)(A.ws + WS_WBR)) + ((size_t)l * 3 + i) * DM * MIXW, M, DM, MIXW}; SO S; S.init(M, DM, F.G, (int)blockIdx.x);
                pg8::EpiBranch E{((bf16*)(A.ws + WS_MG)), ((bf16*)(A.ws + WS_Z)) + ZC_GATE + i * DM, NINP, i == 0 ? 1 : 0};
                pg8::gemm_phase<pg8::EpiBranch, SO, true, true>(ring, g, S, E);
            }
        } }
        SEAM(pb + 4);
        if (IN(pb + 5)) { if PON(9) {
            pg8::Gemm g{((bf16*)(A.ws + WS_MG)), ((bf16*)(A.ws + WS_WOUT)) + (size_t)l * DM * DM, M, DM, DM}; SO S; S.init(M, DM, F.G, (int)blockIdx.x);
            pg8::EpiResidual E{((float*)(A.ws + WS_X)), ((bf16*)(A.ws + WS_XB)), ((float*)(A.ws + WS_SSQ))};
            pg8::gemm_phase<pg8::EpiResidual, SO, true, true>(ring, g, S, E);
        } }
        SEAM(pb + 5);
        if (IN(pb + 6)) { if PON(10) {
            pg8::Gemm g{((bf16*)(A.ws + WS_XB)), ((bf16*)(A.ws + WS_WXQ)) + (size_t)l * XW * DM, M, XW, DM}; SO S; S.init(M, XW, F.G, (int)blockIdx.x);
            pg8::EpiScaleBf16 E{((bf16*)(A.ws + WS_XQ)), XW, ((float*)(A.ws + WS_SSQ)), 0, 0};
            pg8::gemm_phase<pg8::EpiScaleBf16, SO, true, true>(ring, g, S, E);
        } }
        SEAM(pb + 6);
        if (IN(pb + 7)) { if PON(11) xattn_phase(A, F, l); }
        SEAM(pb + 7);
        if (IN(pb + 8)) { if PON(12) {
            pg8::Gemm g{((bf16*)(A.ws + WS_XO)), ((bf16*)(A.ws + WS_WXO)) + (size_t)l * DM * XW, M, DM, XW}; SO S; S.init(M, DM, F.G, (int)blockIdx.x);
            pg8::EpiResidual E{((float*)(A.ws + WS_X)), ((bf16*)(A.ws + WS_XB)), ((float*)(A.ws + WS_SSQ))};
            pg8::gemm_phase<pg8::EpiResidual, SO, true, true>(ring, g, S, E);
        } }
        SEAM(pb + 8);
        if (IN(pb + 9)) { if PON(13) {
            pg8::Gemm g{((bf16*)(A.ws + WS_XB)), ((bf16*)(A.ws + WS_WUP)) + (size_t)l * 2 * DFF * DM, M, 2 * DFF, DM}; SO S; S.init(M, 2 * DFF, F.G, (int)blockIdx.x);
            pg8::EpiScaleBf16 E{((bf16*)(A.ws + WS_UG)), 2 * DFF, ((float*)(A.ws + WS_SSQ)), 0, 0};
            pg8::gemm_phase<pg8::EpiScaleBf16, SO, true, true>(ring, g, S, E);
        } }
        SEAM(pb + 9);
        if (IN(pb + 10)) { if PON(14) ffnact_phase(A, F, l); }
        SEAM(pb + 10);
        if (IN(pb + 11)) { if PON(15) {
            pg8::Gemm g{((bf16*)(A.ws + WS_ACT)), ((bf16*)(A.ws + WS_WDN)) + (size_t)l * DM * DFF, M, DM, DFF}; SO S; S.init(M, DM, F.G, (int)blockIdx.x);
            pg8::EpiResidual E{((float*)(A.ws + WS_X)), ((bf16*)(A.ws + WS_XB)), ((float*)(A.ws + WS_SSQ))};
            pg8::gemm_phase<pg8::EpiResidual, SO, true, true>(ring, g, S, E);
        } }
        SEAM(pb + 11);
    }
    if (IN(N_PHASES - 1)) { if PON(16) final_phase(A, F); }
#undef IN
#undef SEAM
}

extern "C" void kernel_launch(void* const* d_in, const int* in_sizes, int n_in, void* d_out, int out_size, void* d_ws, size_t ws_size, hipStream_t stream) {
    static int grid = 0;
    if (grid == 0) {
        if (n_in != N_INPUTS || (size_t)out_size != O_END || ws_size < WS_END) { fprintf(stderr, "kernel_launch: built for %d inputs, %zu outputs, >= %zu bytes of workspace; got n_in %d, out %d, ws %zu; nothing launched\n", N_INPUTS, (size_t)O_END, (size_t)WS_END, n_in, out_size, ws_size); grid = -1; return; }
        int dev = 0, cus = 0, per_cu = 0;
        if (hipGetDevice(&dev) != hipSuccess || hipDeviceGetAttribute(&cus, hipDeviceAttributeMultiprocessorCount, dev) != hipSuccess) { fprintf(stderr, "kernel_launch: device query failed\n"); grid = -1; return; }
        if (hipFuncSetAttribute((const void*)fwd, hipFuncAttributeMaxDynamicSharedMemorySize, LDS_BYTES) != hipSuccess) { fprintf(stderr, "kernel_launch: hipFuncSetAttribute failed\n"); grid = -1; return; }
        if (hipOccupancyMaxActiveBlocksPerMultiprocessor(&per_cu, (const void*)fwd, NTHR, LDS_BYTES) != hipSuccess || per_cu < 1) { fprintf(stderr, "kernel_launch: occupancy query reports %d workgroups per CU\n", per_cu); }
        (void)hipGetLastError();
        grid = cus;
    }
    if (grid < 0) return;
    if (hipMemsetAsync((char*)d_ws + WS_CTL, 0, CTL_ZERO_BYTES, stream) != hipSuccess) { fprintf(stderr, "kernel_launch: memset failed\n"); return; }
    Args a{};
    for (int i = 0; i < N_INPUTS; ++i) a.in[i] = (const float*)d_in[i];
    a.out = (float*)d_out; a.ws = (unsigned char*)d_ws;
#if MK_PER_PHASE
    for (int p = 0; p < N_PHASES; ++p) {
        a.ph_lo = p; a.ph_hi = p + 1;
        hipLaunchKernelGGL(fwd, dim3(grid), dim3(NTHR), LDS_BYTES, stream, a);
    }
#else
    a.ph_lo = 0; a.ph_hi = N_PHASES;
    hipLaunchKernelGGL(fwd, dim3(grid), dim3(NTHR), LDS_BYTES, stream, a);
#endif
    const hipError_t le = hipPeekAtLastError();
    if (le != hipSuccess) fprintf(stderr, "kernel_launch: launch failed: %s\n", hipGetErrorName(le));
}
```

```cpp
#include <hip/hip_runtime.h>
#include <cstdio>
#include <cstdint>
#include <cmath>
#define MK_PER_PHASE 0
namespace pg8 {
#define PG8_LAS __attribute__((address_space(3)))
typedef unsigned short bf16_t;
typedef short bf16x8 __attribute__((ext_vector_type(8)));
typedef float f32x4 __attribute__((ext_vector_type(4)));
typedef unsigned u32x4 __attribute__((ext_vector_type(4)));
constexpr int BM = 256, BK = 64, HALF = 128, HTB = HALF * BK * 2  , STAGE_BYTES = 8 * HTB, NXCD = 8, WGM = 8;

__host__ __device__ __forceinline__ int lds_byte(int r, int c) { const int st = (r >> 4) * 2 + (c >> 5), rr = r & 15, cc = c & 31, ob = rr * 64 + cc * 2; return st * 1024 + (ob ^ (((ob >> 9) & 1) << 5)); }
__host__ __device__ __forceinline__ void stage_rc(int b, int& R, int& C) { const int st = b / 1024, sb = b % 1024, swz = sb ^ (((sb >> 9) & 1) << 5); R = (st >> 1) * 16 + swz / 64; C = (st & 1) * 32 + (swz % 64) / 2; }
__host__ __device__ __forceinline__ int perm32(int rho) { const int n = rho >> 4, i = rho & 15; return 8 * (i >> 2) + 4 * n + (i & 3); }

struct Unit { int pm, pn; };
struct Gemm { const bf16_t* A; const bf16_t* Bt; int M, N, K; };

struct StaticOrder {
    int nM, nN, nwg, G, c;
    __host__ __device__ void init(int M, int N, int G_, int c_) { nM = M / BM; nN = N / BM; nwg = nM * nN; G = G_; c = c_; }
    __host__ __device__ bool next(int i, Unit& u) const {
        const long L = (long)i * G + c; if (L >= nwg) return false;
        int wgid = (int)L; { const int q = nwg / NXCD, r = nwg % NXCD, xcd = wgid % NXCD, off = wgid / NXCD; wgid = (xcd < r ? xcd * (q + 1) : r * (q + 1) + (xcd - r) * q) + off; }
        const int nig = WGM * nN, gid = wgid / nig, fm = gid * WGM, gsz = (nM - fm) < WGM ? (nM - fm) : WGM;
        u.pm = fm + ((wgid % nig) % gsz); u.pn = (wgid % nig) / gsz; return true;
    }
    __device__ __forceinline__ void a_ready(const Unit&) const {}
    __device__ __forceinline__ void done(const Unit&) const {}
};

__device__ __forceinline__ unsigned cvt_pk_bf16(float lo, float hi) { unsigned r; asm volatile("v_cvt_pk_bf16_f32 %0, %1, %2" : "=v"(r) : "v"(lo), "v"(hi)); return r; }
typedef float f32x2 __attribute__((ext_vector_type(2)));
typedef unsigned u32x2 __attribute__((ext_vector_type(2)));
__device__ __forceinline__ float bf_lo(unsigned w) { return __uint_as_float(w << 16); }
__device__ __forceinline__ float bf_hi(unsigned w) { return __uint_as_float(w & 0xffff0000u); }
__device__ __forceinline__ float sigmoidf_(float v) { return 1.0f / (1.0f + __expf(-v)); }

struct EpiScaleBf16 {
    static constexpr bool PERM = true, AFTER_DRAIN = false;
    bf16_t* O; int ldc; const float* ssq; int sig_lo, sig_hi;
    __device__ __forceinline__ void operator()(const f32x4 (&acc)[2][2][4][2], const Unit& u, int wr, int wc, int fr, int fq) const {
        const int row0 = u.pm * BM + wr * 64 + fr, col0 = u.pn * BM + wc * 32 + 8 * fq;
        const bool sig = (u.pn >= sig_lo) && (u.pn < sig_hi);
#pragma unroll
        for (int ai = 0; ai < 2; ++ai)
#pragma unroll
            for (int m = 0; m < 4; ++m) {
                const int row = row0 + ai * HALF + m * 16;
                float rs = 1.0f;
                if (ssq) { const f32x4* p = (const f32x4*)(ssq + (size_t)row * 32); f32x4 s = p[0];
#pragma unroll
                    for (int i = 1; i < 8; ++i) s += p[i];
                    rs = rsqrtf(((s[0] + s[1]) + (s[2] + s[3])) * (1.0f / 2048.0f) + 1e-6f); }
                bf16_t* rowp = O + (size_t)row * ldc + col0;
#pragma unroll
                for (int bj = 0; bj < 2; ++bj) { f32x4 v0 = acc[ai][bj][m][0] * rs, v1 = acc[ai][bj][m][1] * rs;
                    if (sig) { v0 = (f32x4){sigmoidf_(v0[0]), sigmoidf_(v0[1]), sigmoidf_(v0[2]), sigmoidf_(v0[3])}; v1 = (f32x4){sigmoidf_(v1[0]), sigmoidf_(v1[1]), sigmoidf_(v1[2]), sigmoidf_(v1[3])}; }
                    u32x4 w; w.x = cvt_pk_bf16(v0[0], v0[1]); w.y = cvt_pk_bf16(v0[2], v0[3]); w.z = cvt_pk_bf16(v1[0], v1[1]); w.w = cvt_pk_bf16(v1[2], v1[3]);
                    *(u32x4*)(rowp + bj * HALF) = w; }
            }
    }
};

struct EpiResidual {
    static constexpr bool PERM = false, AFTER_DRAIN = false;
    float* X; bf16_t* XB; float* ssq;
    __device__ __forceinline__ void operator()(const f32x4 (&acc)[2][2][4][2], const Unit& u, int wr, int wc, int fr, int fq) const {
        const int row0 = u.pm * BM + wr * 64 + fr, col0 = u.pn * BM + wc * 32 + 4 * fq;
#pragma unroll
        for (int ai = 0; ai < 2; ++ai)
#pragma unroll
            for (int m = 0; m < 4; ++m) {
                const int row = row0 + ai * HALF + m * 16; float ss = 0.f;
#pragma unroll
                for (int bj = 0; bj < 2; ++bj)
#pragma unroll
                    for (int n = 0; n < 2; ++n) { const size_t off = (size_t)row * 2048 + col0 + bj * HALF + n * 16;
                        const f32x4 x = *(const f32x4*)(X + off) + acc[ai][bj][m][n];
                        *(f32x4*)(X + off) = x;
                        u32x2 w; w.x = cvt_pk_bf16(x[0], x[1]); w.y = cvt_pk_bf16(x[2], x[3]); *(u32x2*)(XB + off) = w;
                        ss += (x[0] * x[0] + x[1] * x[1]) + (x[2] * x[2] + x[3] * x[3]); }
                ss += __shfl_xor(ss, 16); ss += __shfl_xor(ss, 32);
                if (fq == 0) ssq[(size_t)row * 32 + u.pn * 4 + wc] = ss;
            }
    }
};

struct EpiBranch {
    static constexpr bool PERM = true, AFTER_DRAIN = false;
    bf16_t* MG; const bf16_t* G; int ldg; int first;
    __device__ __forceinline__ void operator()(const f32x4 (&acc)[2][2][4][2], const Unit& u, int wr, int wc, int fr, int fq) const {
        const int row0 = u.pm * BM + wr * 64 + fr, col0 = u.pn * BM + wc * 32 + 8 * fq;
#pragma unroll
        for (int ai = 0; ai < 2; ++ai)
#pragma unroll
            for (int m = 0; m < 4; ++m) {
                const int row = row0 + ai * HALF + m * 16;
#pragma unroll
                for (int bj = 0; bj < 2; ++bj) { const int col = col0 + bj * HALF;
                    const u32x4 g = *(const u32x4*)(G + (size_t)row * ldg + col);
                    f32x4 v0 = acc[ai][bj][m][0], v1 = acc[ai][bj][m][1];
                    v0 = v0 * (f32x4){bf_lo(g.x), bf_hi(g.x), bf_lo(g.y), bf_hi(g.y)}; v1 = v1 * (f32x4){bf_lo(g.z), bf_hi(g.z), bf_lo(g.w), bf_hi(g.w)};
                    bf16_t* dst = MG + (size_t)row * 2048 + col;
                    if (!first) { const u32x4 o = *(const u32x4*)dst; v0 += (f32x4){bf_lo(o.x), bf_hi(o.x), bf_lo(o.y), bf_hi(o.y)}; v1 += (f32x4){bf_lo(o.z), bf_hi(o.z), bf_lo(o.w), bf_hi(o.w)}; }
                    u32x4 w; w.x = cvt_pk_bf16(v0[0], v0[1]); w.y = cvt_pk_bf16(v0[2], v0[3]); w.z = cvt_pk_bf16(v1[0], v1[1]); w.w = cvt_pk_bf16(v1[2], v1[3]);
                    *(u32x4*)dst = w; }
            }
    }
};

struct EpiMemKV {
    static constexpr bool PERM = false, AFTER_DRAIN = false;
    float* outk; float* outv; bf16_t* KV;
    __device__ __forceinline__ void operator()(const f32x4 (&acc)[2][2][4][2], const Unit& u, int wr, int wc, int fr, int fq) const {
        const int row0 = u.pm * BM + wr * 64 + fr, col0 = u.pn * BM + wc * 32 + 4 * fq;
#pragma unroll
        for (int ai = 0; ai < 2; ++ai)
#pragma unroll
            for (int m = 0; m < 4; ++m) {
                const int row = row0 + ai * HALF + m * 16;
#pragma unroll
                for (int bj = 0; bj < 2; ++bj)
#pragma unroll
                    for (int n = 0; n < 2; ++n) { const int col = col0 + bj * HALF + n * 16; const f32x4 a = acc[ai][bj][m][n];
                        float* dst = (col < 512) ? (outk + (size_t)row * 512 + col) : (outv + (size_t)row * 512 + (col - 512));
                        *(f32x4*)dst = a;
                        u32x2 w; w.x = cvt_pk_bf16(a[0], a[1]); w.y = cvt_pk_bf16(a[2], a[3]); *(u32x2*)(KV + (size_t)row * 1024 + col) = w; }
            }
    }
};
template <class Epi, class Sched, bool ALIGN_EPI = false, bool SP2 = false>
__device__ __forceinline__ void gemm_phase(PG8_LAS unsigned char* lds, const Gemm g, const Sched& S, const Epi& E, int tid_in) {
    int tid_ = tid_in; asm volatile("" : "+v"(tid_));
    const int tid = tid_, wid = __builtin_amdgcn_readfirstlane(tid >> 6), lane = tid & 63, wr = wid >> 2, wc = wid & 3, fr = lane & 15, fq = lane >> 4;
    const int K = g.K, nt = K / BK;
    unsigned voffA[2], voffB[2];
#pragma unroll
    for (int i = 0; i < 2; ++i) { int R, C; stage_rc(tid * 16 + i * 8192, R, C); const int Rb = Epi::PERM ? ((R & ~31) + perm32(R & 31)) : R;
        voffA[i] = (unsigned)(R * K + C) * 2u; voffB[i] = (unsigned)(Rb * K + C) * 2u; }
    const size_t kstep = (size_t)(BK * 2);
    const size_t hstep = (size_t)HALF * K * 2;
    const size_t tstep = 2 * hstep;
    const unsigned ldsw = (unsigned)wid * 1024u;
    const int aoff = lds_byte(wr * 64 + fr, fq * 8), boff = lds_byte(wc * 32 + fr, fq * 8);
#define PG8_SA(b, h) (((b) * 2 + (h)) * HTB)
#define PG8_SB(b, h) ((4 + (b) * 2 + (h)) * HTB)
#define PG8_STAGE(bufoff, gbase, voff) do { _Pragma("unroll") for (int _i = 0; _i < 2; ++_i) \
        __builtin_amdgcn_global_load_lds((const unsigned*)((const char*)(gbase) + (voff)[_i]), (PG8_LAS unsigned*)(lds + (bufoff) + ldsw + _i * 8192), 16, 0, 0); } while (0)
#define PG8_LDA(dst, b, h) do { _Pragma("unroll") for (int m = 0; m < 4; ++m) _Pragma("unroll") for (int k = 0; k < 2; ++k) dst[m][k] = *(const PG8_LAS bf16x8*)(lds + PG8_SA(b, h) + aoff + m * 2048 + k * 1024); } while (0)
#define PG8_LDB(dst, b, h) do { _Pragma("unroll") for (int n = 0; n < 2; ++n) _Pragma("unroll") for (int k = 0; k < 2; ++k) dst[n][k] = *(const PG8_LAS bf16x8*)(lds + PG8_SB(b, h) + boff + n * 2048 + k * 1024); } while (0)
#define PG8_MMA(ai, bj, At, Bt) do { __builtin_amdgcn_s_setprio(1); _Pragma("unroll") for (int m = 0; m < 4; ++m) _Pragma("unroll") for (int n = 0; n < 2; ++n) _Pragma("unroll") for (int k = 0; k < 2; ++k) \
        acc[ai][bj][m][n] = __builtin_amdgcn_mfma_f32_16x16x32_bf16(Bt[n][k], At[m][k], acc[ai][bj][m][n], 0, 0, 0); __builtin_amdgcn_s_setprio(0); } while (0)
#define PG8_WAIT_V(n) asm volatile("s_waitcnt vmcnt(" #n ")" ::: "memory")
#define PG8_WAIT_L(n) asm volatile("s_waitcnt lgkmcnt(" #n ")" ::: "memory")
#define PG8_BAR __builtin_amdgcn_s_barrier()
#define PG8_SCHED __builtin_amdgcn_sched_barrier(0)
    Unit cur, nxt; int ui = 0;
    if (!S.next(0, cur)) return;
    f32x4 acc[2][2][4][2];
#pragma unroll
    for (int a = 0; a < 2; ++a)
#pragma unroll
        for (int b = 0; b < 2; ++b)
#pragma unroll
            for (int m = 0; m < 4; ++m)
#pragma unroll
                for (int n = 0; n < 2; ++n) acc[a][b][m][n] = (f32x4){0.f, 0.f, 0.f, 0.f};
    bf16x8 At[4][2], B0[2][2], B1[2][2];
    const char* cA = (const char*)g.A + (size_t)cur.pm * tstep; const char* cB = (const char*)g.Bt + (size_t)cur.pn * tstep;
    S.a_ready(cur);
    if constexpr (SP2) {
        PG8_STAGE(PG8_SB(0, 0), cB, voffB); PG8_STAGE(PG8_SB(0, 1), cB + hstep, voffB); PG8_STAGE(PG8_SA(0, 0), cA, voffA); PG8_STAGE(PG8_SA(0, 1), cA + hstep, voffA);
        if (wr == 1) PG8_BAR;
        PG8_WAIT_V(2); PG8_BAR;
        PG8_STAGE(PG8_SB(1, 0), cB + kstep, voffB); PG8_STAGE(PG8_SA(1, 0), cA + kstep, voffA); PG8_STAGE(PG8_SB(1, 1), cB + hstep + kstep, voffB);
        PG8_WAIT_V(6); PG8_BAR;
    } else {
        PG8_STAGE(PG8_SB(0, 0), cB, voffB); PG8_STAGE(PG8_SA(0, 0), cA, voffA); PG8_STAGE(PG8_SB(0, 1), cB + hstep, voffB); PG8_STAGE(PG8_SA(0, 1), cA + hstep, voffA);
        if (wr == 1) PG8_BAR;
        PG8_WAIT_V(4); PG8_BAR;
        PG8_STAGE(PG8_SB(1, 0), cB + kstep, voffB); PG8_STAGE(PG8_SA(1, 0), cA + kstep, voffA); PG8_STAGE(PG8_SB(1, 1), cB + hstep + kstep, voffB);
        PG8_WAIT_V(6); PG8_BAR;
    }
    for (;;) {
        const bool has_next = S.next(ui + 1, nxt);
        const char* nA = has_next ? (const char*)g.A + (size_t)nxt.pm * tstep : cA; const char* nB = has_next ? (const char*)g.Bt + (size_t)nxt.pn * tstep : cB;
        for (int t = 0; t < nt; t += 2) {
            const bool last = (t == nt - 2);
            const char* a1 = cA + (size_t)(t + 1) * kstep;
            const char* a2 = last ? nA : cA + (size_t)(t + 2) * kstep; const char* b2 = last ? nB : cB + (size_t)(t + 2) * kstep;
            const char* a3 = a2 + kstep; const char* b3 = b2 + kstep;
            if (last && has_next) S.a_ready(nxt);
            if constexpr (SP2) {
            PG8_LDB(B0, 0, 0); PG8_LDB(B1, 0, 1); PG8_SCHED; PG8_LDA(At, 0, 0); PG8_STAGE(PG8_SA(1, 1), a1 + hstep, voffA);
            PG8_WAIT_V(8); PG8_WAIT_L(0); PG8_BAR; PG8_MMA(0, 0, At, B0); PG8_MMA(0, 1, At, B1); PG8_BAR; PG8_SCHED;
            PG8_LDA(At, 0, 1); PG8_STAGE(PG8_SB(0, 0), b2, voffB); PG8_STAGE(PG8_SB(0, 1), b2 + hstep, voffB); PG8_STAGE(PG8_SA(0, 0), a2, voffA);
            PG8_WAIT_V(8); PG8_WAIT_L(0); PG8_BAR; PG8_MMA(1, 0, At, B0); PG8_MMA(1, 1, At, B1); PG8_BAR; PG8_SCHED;
            PG8_LDB(B0, 1, 0); PG8_LDB(B1, 1, 1); PG8_SCHED; PG8_LDA(At, 1, 0); PG8_STAGE(PG8_SA(0, 1), a2 + hstep, voffA);
            PG8_WAIT_V(8); PG8_WAIT_L(0); PG8_BAR; PG8_MMA(0, 0, At, B0); PG8_MMA(0, 1, At, B1); PG8_BAR; PG8_SCHED;
            PG8_LDA(At, 1, 1); PG8_STAGE(PG8_SB(1, 0), b3, voffB); PG8_STAGE(PG8_SB(1, 1), b3 + hstep, voffB); PG8_STAGE(PG8_SA(1, 0), a3, voffA);
            PG8_WAIT_V(8); PG8_WAIT_L(0); PG8_BAR; PG8_MMA(1, 0, At, B0); PG8_MMA(1, 1, At, B1); PG8_BAR; PG8_SCHED;
            } else {
            PG8_LDB(B0, 0, 0); PG8_SCHED; PG8_LDA(At, 0, 0); PG8_STAGE(PG8_SA(1, 1), a1 + hstep, voffA);
            PG8_WAIT_L(8); PG8_BAR; PG8_WAIT_L(0); PG8_MMA(0, 0, At, B0); PG8_BAR; PG8_SCHED;
            PG8_LDB(B1, 0, 1); PG8_STAGE(PG8_SB(0, 0), b2, voffB);
            PG8_BAR; PG8_WAIT_L(0); PG8_MMA(0, 1, At, B1); PG8_BAR;
            PG8_LDA(At, 0, 1); PG8_STAGE(PG8_SA(0, 0), a2, voffA);
            PG8_BAR; PG8_WAIT_L(0); PG8_MMA(1, 0, At, B0); PG8_BAR; PG8_SCHED;
            PG8_STAGE(PG8_SB(0, 1), b2 + hstep, voffB);
            PG8_WAIT_V(6); PG8_BAR; PG8_MMA(1, 1, At, B1); PG8_BAR;
            PG8_LDB(B0, 1, 0); PG8_SCHED; PG8_LDA(At, 1, 0); PG8_STAGE(PG8_SA(0, 1), a2 + hstep, voffA);
            PG8_WAIT_L(8); PG8_BAR; PG8_WAIT_L(0); PG8_MMA(0, 0, At, B0); PG8_BAR; PG8_SCHED;
            PG8_LDB(B1, 1, 1); PG8_STAGE(PG8_SB(1, 0), b3, voffB);
            PG8_BAR; PG8_WAIT_L(0); PG8_MMA(0, 1, At, B1); PG8_BAR;
            PG8_LDA(At, 1, 1); PG8_STAGE(PG8_SA(1, 0), a3, voffA);
            PG8_BAR; PG8_WAIT_L(0); PG8_MMA(1, 0, At, B0); PG8_BAR; PG8_SCHED;
            PG8_STAGE(PG8_SB(1, 1), b3 + hstep, voffB);
            PG8_WAIT_V(6); PG8_BAR; PG8_MMA(1, 1, At, B1); PG8_BAR;
            }
        }
        if constexpr (ALIGN_EPI) { if (wr == 0) PG8_BAR; }
        if constexpr (!Epi::AFTER_DRAIN) { E(acc, cur, wr, wc, fr, fq); S.done(cur); }
        if (!has_next) break;
#pragma unroll
        for (int a = 0; a < 2; ++a)
#pragma unroll
            for (int b = 0; b < 2; ++b)
#pragma unroll
                for (int m = 0; m < 4; ++m)
#pragma unroll
                    for (int n = 0; n < 2; ++n) acc[a][b][m][n] = (f32x4){0.f, 0.f, 0.f, 0.f};
        cur = nxt; cA = nA; cB = nB; ++ui;
        if constexpr (ALIGN_EPI) { if (wr == 1) PG8_BAR; }
    }
    PG8_WAIT_V(0);
    if constexpr (!ALIGN_EPI) { if (wr == 0) PG8_BAR; }
    PG8_BAR;
    if constexpr (Epi::AFTER_DRAIN) { E.fused(acc, cur, wr, wc, fr, fq, lds, wid, lane); S.done(cur); }
#undef PG8_SA
#undef PG8_SB
#undef PG8_STAGE
#undef PG8_LDA
#undef PG8_LDB
#undef PG8_MMA
#undef PG8_WAIT_V
#undef PG8_WAIT_L
#undef PG8_BAR
#undef PG8_SCHED
}
}

constexpr int NWAVES = 8, NTHR = 512;
constexpr int DM = 2048, SEQ = 4096, NBP = 2, DEPTH = 4, NBS = 32, TS = 8;
constexpr int MP = NBP * SEQ, MS = NBS * TS, M = MP + MS;
constexpr int MIXW = 1024, GH = 4, GDK = 128, GDV = 256, GRANK = 16;
constexpr int SH = 16, SKV = 2, SHD = 64, WIN = 128;
constexpr int NMEM = 256, XH = 4, XHD = 128, XW = XH * XHD;
constexpr int DFF = 5504, NIN = 13584, NINP = 13824;
constexpr float EPS = 1e-6f;
constexpr int ZC_GQ = 0, ZC_GK = 512, ZC_GV = 1024, ZC_GR = 2048, ZC_SQ = 3072, ZC_SK = 4096, ZC_SV = 4224, ZC_CB = 4352, ZC_CC = 5376, ZC_CH = 6400, ZC_GATE = 7424, ZC_GLR = 13568;
static_assert(ZC_GATE % 256 == 0 && ZC_GLR % 256 == 0 && ZC_GLR + 16 == NIN && NINP % 256 == 0, "z layout");
constexpr size_t O_YP = 0, O_YS = O_YP + (size_t)MP * DM, O_GLAP = O_YS + (size_t)MS * DM, O_GLAS = O_GLAP + (size_t)DEPTH * NBP * GH * GDK * GDV,
                 O_SKP = O_GLAS + (size_t)DEPTH * NBS * GH * GDK * GDV, O_SVP = O_SKP + (size_t)DEPTH * NBP * WIN * SKV * SHD, O_SKS = O_SVP + (size_t)DEPTH * NBP * WIN * SKV * SHD,
                 O_SVS = O_SKS + (size_t)DEPTH * NBS * WIN * SKV * SHD, O_CONVP = O_SVS + (size_t)DEPTH * NBS * WIN * SKV * SHD, O_CONVS = O_CONVP + (size_t)DEPTH * NBP * 2 * MIXW,
                 O_FFNP = O_CONVS + (size_t)DEPTH * NBS * 2 * MIXW, O_FFNS = O_FFNP + (size_t)DEPTH * NBP * 2 * DFF, O_MKP = O_FFNS + (size_t)DEPTH * NBS * 2 * DFF,
                 O_MVP = O_MKP + (size_t)DEPTH * NBP * NMEM * XW, O_END = O_MVP + (size_t)DEPTH * NBP * NMEM * XW;
static_assert(O_END == 43456512, "output size");
enum { I_XP = 0, I_XS, I_SGLA, I_CSK, I_CSV, I_SCONV, I_SFFN, I_CMK, I_CMV, I_MEMP, I_NMIX, I_WIN, I_GUP, I_GB, I_GNORM, I_SINK, I_RELB, I_CONVW, I_WBR, I_WOUT, I_NX, I_WXQ, I_WXK, I_WXV, I_WXO,
       I_NFFN, I_FUP, I_FCW, I_FCB, I_FDN, I_NFIN, N_INPUTS };
static_assert(N_INPUTS == 31, "inputs");

constexpr size_t MiB = 1u << 20;
constexpr size_t al1m(size_t x) { return (x + MiB - 1) / MiB * MiB; }
constexpr size_t WS_CTL = 0, CTL_ZERO_BYTES = 1 * MiB;
constexpr size_t SZ_WIN = (size_t)NINP * DM * 2, SZ_WBR = (size_t)3 * DM * MIXW * 2, SZ_WOUT = (size_t)DM * DM * 2, SZ_WXQ = (size_t)XW * DM * 2, SZ_WXKV = (size_t)2 * XW * DM * 2,
                 SZ_WXO = (size_t)DM * XW * 2, SZ_WUP = (size_t)2 * DFF * DM * 2, SZ_WDN = (size_t)DM * DFF * 2;
constexpr size_t WS_WIN = 2 * MiB, WS_WBR = al1m(WS_WIN + DEPTH * SZ_WIN), WS_WOUT = al1m(WS_WBR + DEPTH * SZ_WBR), WS_WXQ = al1m(WS_WOUT + DEPTH * SZ_WOUT),
                 WS_WXKV = al1m(WS_WXQ + DEPTH * SZ_WXQ), WS_WXO = al1m(WS_WXKV + DEPTH * SZ_WXKV), WS_WUP = al1m(WS_WXO + DEPTH * SZ_WXO), WS_WDN = al1m(WS_WUP + DEPTH * SZ_WUP);
constexpr size_t WS_X = al1m(WS_WDN + DEPTH * SZ_WDN), WS_XB = al1m(WS_X + (size_t)M * DM * 4), WS_SSQ = al1m(WS_XB + (size_t)M * DM * 2), WS_Z = al1m(WS_SSQ + (size_t)M * 32 * 4),
                 WS_BR = al1m(WS_Z + (size_t)M * NINP * 2), WS_MG = al1m(WS_BR + (size_t)3 * M * MIXW * 2), WS_XQ = al1m(WS_MG + (size_t)M * DM * 2), WS_XO = al1m(WS_XQ + (size_t)M * XW * 2),
                 WS_UG = al1m(WS_XO + (size_t)M * XW * 2), WS_ACT = al1m(WS_UG + (size_t)M * 2 * DFF * 2), WS_MEMB = al1m(WS_ACT + (size_t)M * DFF * 2), WS_MEMKV = al1m(WS_MEMB + (size_t)NBP * NMEM * DM * 2),
                 WS_GLAU = al1m(WS_MEMKV + (size_t)DEPTH * NBP * NMEM * 2 * XW * 2), WS_GLAD = al1m(WS_GLAU + (size_t)512 * GDK * GDV * 4), WS_END = al1m(WS_GLAD + (size_t)512 * GDK * 4);
constexpr int CW_TMO = 0, CW_CODE = 1, CW_BAR = 4096;

constexpr int RING_OFF = 0, RING_BYTES = 131072;
constexpr int LDSCTL_OFF = 146944, MISC_OFF = LDSCTL_OFF + 320;
constexpr int LDS_BYTES = 147456;
static_assert(MISC_OFF + 128 <= LDS_BYTES && LDSCTL_OFF >= RING_BYTES, "LDS map");

#define GAS __attribute__((address_space(1)))
#define LAS __attribute__((address_space(3)))
typedef unsigned short bf16;
typedef unsigned v4u __attribute__((ext_vector_type(4)));
typedef unsigned v2u __attribute__((ext_vector_type(2)));
typedef float f32x4 __attribute__((ext_vector_type(4)));
typedef float f32x2 __attribute__((ext_vector_type(2)));
typedef GAS unsigned gu32;
#define RLX_AGENT __ATOMIC_RELAXED, __HIP_MEMORY_SCOPE_AGENT
#define LDS_WAIT() asm volatile("s_waitcnt lgkmcnt(0)" ::: "memory")
#define VM_WAIT() asm volatile("s_waitcnt vmcnt(0)" ::: "memory")
__device__ __forceinline__ float bflo(unsigned w) { return __uint_as_float(w << 16); }
__device__ __forceinline__ float bfhi(unsigned w) { return __uint_as_float(w & 0xffff0000u); }
__device__ __forceinline__ float bf1(bf16 h) { return __uint_as_float(((unsigned)h) << 16); }
__device__ __forceinline__ unsigned pk2(float lo, float hi) { return pg8::cvt_pk_bf16(lo, hi); }
__device__ __forceinline__ void unpack8(const v4u w, float (&f)[8]) { f[0] = bflo(w.x); f[1] = bfhi(w.x); f[2] = bflo(w.y); f[3] = bfhi(w.y); f[4] = bflo(w.z); f[5] = bfhi(w.z); f[6] = bflo(w.w); f[7] = bfhi(w.w); }
__device__ __forceinline__ v4u pack8(const float (&f)[8]) { v4u w; w.x = pk2(f[0], f[1]); w.y = pk2(f[2], f[3]); w.z = pk2(f[4], f[5]); w.w = pk2(f[6], f[7]); return w; }
__device__ __forceinline__ float sigm(float v) { return 1.0f / (1.0f + __expf(-v)); }
__device__ __forceinline__ float wave_sum(float v) {
#pragma unroll
    for (int o = 1; o < 64; o <<= 1) v += __shfl_xor(v, o);
    return v;
}
#define XB_TMO      128
#define XB_XCNT(j)  (256  + 64 * (j))
#define XB_XSUB(j)  (1280 + 64 * (j))
#define XB_XGEN(j)  (2304 + 64 * (j))
#define XB_TOP      3328
#define XB_TOPGEN   3392
#define XCD_BAR_WORDS 3456
#define XB_SPIN_CAP (1u << 18)

__device__ __forceinline__ unsigned xb_ld(unsigned* p)              { return __hip_atomic_load(p, __ATOMIC_RELAXED, __HIP_MEMORY_SCOPE_AGENT); }
__device__ __forceinline__ unsigned xb_add(unsigned* p, unsigned v) { return __hip_atomic_fetch_add(p, v, __ATOMIC_RELAXED, __HIP_MEMORY_SCOPE_AGENT); }
__device__ __forceinline__ unsigned xb_xcc_id() { return (unsigned)__builtin_amdgcn_s_getreg((3 << 11) | 20) & 0xFu; }
#define XB_SPIN(cond, bar) do { unsigned _sp = 0; while (cond) { __builtin_amdgcn_s_sleep(1); \
    if ((++_sp & 255u) == 0u) { if (xb_ld(&(bar)[XB_TMO])) break; if (_sp > XB_SPIN_CAP) { atomicAdd(&(bar)[XB_TMO], 1u); break; } } } } while (0)

struct XcdBarrier {
    unsigned* bar; unsigned x; unsigned wv;
    volatile LAS unsigned* st;
};

__device__ __forceinline__ unsigned xb_lane() { return __builtin_amdgcn_mbcnt_hi(~0u, __builtin_amdgcn_mbcnt_lo(~0u, 0u)); }
__device__ __forceinline__ XcdBarrier xcd_barrier_post(unsigned* bar, volatile LAS unsigned* st, unsigned wv) {
    XcdBarrier b; b.bar = bar; b.x = xb_xcc_id(); b.st = st; b.wv = wv;
    if (wv == 0u && xb_lane() == 0u) (void)xb_add(&bar[XB_XCNT(b.x)], 1u);
    return b;
}
__device__ __forceinline__ void xcd_barrier_complete(unsigned* bar, unsigned x, unsigned& nloc, unsigned& nx) {
    const unsigned G = gridDim.x * gridDim.y * gridDim.z;
    unsigned sum, cnt, mine, sp = 0u;
    for (;;) {
        sum = 0u; cnt = 0u; mine = 0u;
#pragma unroll
        for (unsigned j = 0; j < 16; ++j) { const unsigned c = xb_ld(&bar[XB_XCNT(j)]); sum += c; cnt += (c > 0u) ? 1u : 0u; mine = (j == x) ? c : mine; }
        if (sum == G) break;
        __builtin_amdgcn_s_sleep(1);
        if ((++sp & 255u) == 0u) { if (xb_ld(&bar[XB_TMO])) break; if (sp > XB_SPIN_CAP) { atomicAdd(&bar[XB_TMO], 1u); break; } }
    }
    nloc = mine > 0u ? mine : 1u; nx = cnt > 0u ? cnt : 1u;
}

__device__ __forceinline__ void xcd_barrier(const XcdBarrier& b) {
    asm volatile("s_waitcnt vmcnt(0)" ::: "memory");
    __syncthreads();
    if (b.wv == 0u && xb_lane() == 0u) {
        unsigned* bar = b.bar;
        __builtin_amdgcn_s_waitcnt(0);
        unsigned nloc = b.st[0], nx = b.st[1];
        if (nloc == 0u) { xcd_barrier_complete(bar, b.x, nloc, nx); b.st[0] = nloc; b.st[1] = nx; }
        const unsigned old = xb_add(&bar[XB_XSUB(b.x)], 1u);
        const unsigned gen = old / nloc;
        if (old + 1u == (gen + 1u) * nloc) {
            __builtin_amdgcn_fence(__ATOMIC_RELEASE, "agent");
            asm volatile("s_waitcnt vmcnt(0)" ::: "memory");
            const unsigned og = xb_add(&bar[XB_TOP], 1u);
            const unsigned tg = og / nx;
            if (og + 1u == (tg + 1u) * nx) xb_add(&bar[XB_TOPGEN], 1u);
            else XB_SPIN(xb_ld(&bar[XB_TOPGEN]) == tg, bar);
            __builtin_amdgcn_fence(__ATOMIC_ACQUIRE, "agent");
            xb_add(&bar[XB_XGEN(b.x)], 1u);
            asm volatile("s_waitcnt vmcnt(0)" ::: "memory");
        } else {
            XB_SPIN(xb_ld(&bar[XB_XGEN(b.x)]) == gen, bar);
            __builtin_amdgcn_fence(__ATOMIC_ACQUIRE, "agent");
            asm volatile("s_waitcnt vmcnt(0)" ::: "memory");
        }
    }
    __syncthreads();
}

struct Args { const float* in[N_INPUTS]; float* out; unsigned char* ws; int ph_lo, ph_hi; };
static_assert(sizeof(Args) == N_INPUTS * 8 + 8 + 8 + 8, "Args has no padding");


constexpr int KA_OUT = 8 * N_INPUTS, KA_WS = KA_OUT + 8, KA_LO = KA_WS + 8, KA_HI = KA_LO + 4;
template <int OFF> __device__ __forceinline__ unsigned long long karg64() {
    unsigned long long v; auto kp = __builtin_amdgcn_kernarg_segment_ptr();
    asm volatile("s_load_dwordx2 %0, %1, %2\n\ts_waitcnt lgkmcnt(0)" : "=s"(v) : "s"(kp), "n"(OFF) : "memory"); return v;
}
template <int OFF> __device__ __forceinline__ int karg32() {
    int v; auto kp = __builtin_amdgcn_kernarg_segment_ptr();
    asm volatile("s_load_dword %0, %1, %2\n\ts_waitcnt lgkmcnt(0)" : "=s"(v) : "s"(kp), "n"(OFF) : "memory"); return v;
}
struct Frame {
    LAS unsigned char* lds;
    volatile LAS unsigned* MISC;
    gu32* ctl;
    int tid, lane, wave, vcu, G;
};

__device__ __forceinline__ int lane_id() { int l; asm volatile("v_mbcnt_lo_u32_b32 %0, -1, 0\n\tv_mbcnt_hi_u32_b32 %0, -1, %0" : "=v"(l)); return l; }
__device__ __forceinline__ int launder_s(int v) { asm volatile("" : "+s"(v)); return v; }
#define LAUNDER(F) do { asm volatile("" : "+s"((F).wave), "+s"((F).vcu), "+s"((F).G)); (F).lane = lane_id(); asm volatile("" : "+v"((F).lane)); (F).tid = (F).wave * 64 + (F).lane; } while (0)
__device__ __forceinline__ void tr_item(const float* W, int K, int Nsrc, bf16* WT, int dstrow0, int k0, int srccol, float cscale, const float* gain, LAS float* scr, int lane) {
#pragma unroll 8
    for (int i = 0; i < 32; ++i) { const int kk = 2 * i + (lane >> 5); float v = 0.f; if (srccol >= 0) v = W[(size_t)(k0 + kk) * Nsrc + srccol]; if (gain) v *= gain[k0 + kk]; scr[kk * 33 + (lane & 31)] = v * cscale; }
    LDS_WAIT(); asm volatile("" ::: "memory");
    const int c = lane & 7;
#pragma unroll
    for (int j = 0; j < 4; ++j) { const int n = (lane >> 3) + 8 * j; const LAS float* s = scr + (8 * c) * 33 + n;
        v4u o; o.x = pk2(s[0 * 33], s[1 * 33]); o.y = pk2(s[2 * 33], s[3 * 33]); o.z = pk2(s[4 * 33], s[5 * 33]); o.w = pk2(s[6 * 33], s[7 * 33]);
        *(v4u*)(WT + (size_t)(dstrow0 + n) * K + k0 + 8 * c) = o; }
    LDS_WAIT(); asm volatile("" ::: "memory");
}
__device__ __forceinline__ void tr_plain(const float* W, int K, int N, bf16* WT, int dst_off, int r, float cscale, const float* gain, LAS float* scr, int lane) {
    const int nblk = N / 32, kb = r / nblk, nb = r % nblk;
    tr_item(W, K, N, WT, dst_off + 32 * nb, 64 * kb, 32 * nb + (lane & 31), cscale, gain, scr, lane);
}
constexpr int IT_IN = (DM / 64) * (NINP / 32), IT_BR = (MIXW / 64) * (DM / 32), IT_OUT = (DM / 64) * (DM / 32), IT_XQ = (DM / 64) * (XW / 32), IT_XO = (XW / 64) * (DM / 32),
              IT_UP = (DM / 64) * (2 * DFF / 32), IT_DN = (DFF / 64) * (DM / 32), IT_LAYER = IT_IN + 3 * IT_BR + IT_OUT + 3 * IT_XQ + IT_XO + IT_UP + IT_DN;
__device__ __forceinline__ void p0_convert(const Args& A, Frame& F0) {
    unsigned char* const ws_ = (unsigned char*)karg64<KA_WS>();
    const float* const in_I_FDN = (const float*)karg64<8 * I_FDN>();
    const float* const in_I_FUP = (const float*)karg64<8 * I_FUP>();
    const float* const in_I_MEMP = (const float*)karg64<8 * I_MEMP>();
    const float* const in_I_NFFN = (const float*)karg64<8 * I_NFFN>();
    const float* const in_I_NMIX = (const float*)karg64<8 * I_NMIX>();
    const float* const in_I_NX = (const float*)karg64<8 * I_NX>();
    const float* const in_I_WBR = (const float*)karg64<8 * I_WBR>();
    const float* const in_I_WIN = (const float*)karg64<8 * I_WIN>();
    const float* const in_I_WOUT = (const float*)karg64<8 * I_WOUT>();
    const float* const in_I_WXK = (const float*)karg64<8 * I_WXK>();
    const float* const in_I_WXO = (const float*)karg64<8 * I_WXO>();
    const float* const in_I_WXQ = (const float*)karg64<8 * I_WXQ>();
    const float* const in_I_WXV = (const float*)karg64<8 * I_WXV>();
    const float* const in_I_XP = (const float*)karg64<8 * I_XP>();
    const float* const in_I_XS = (const float*)karg64<8 * I_XS>();
    Frame F = F0; LAUNDER(F);
    LAS float* scr = (LAS float*)(F.lds + RING_OFF + F.wave * 16384);
    const int gw = F.vcu * NWAVES + F.wave, NGW = F.G * NWAVES, lane = F.lane;
    for (int it = gw; it < DEPTH * IT_LAYER; it += NGW) {
        const int l = it / IT_LAYER; int r = it % IT_LAYER;
        if (r < IT_IN) {
            const int nblk = NINP / 32, kb = r / nblk, nb = r % nblk, n = 32 * nb + (lane & 31);
            int src; if (n < 3072) src = n; else if (n < ZC_GLR) src = n + 16; else if (n < NIN) src = 3072 + (n - ZC_GLR); else src = -1;
            const float cs = (n < 512) ? 0.08838834764831845f : ((n >= ZC_SQ && n < ZC_SK) ? 0.125f : 1.0f);
            tr_item(in_I_WIN + (size_t)l * DM * NIN, DM, NIN, ((bf16*)(ws_ + WS_WIN)) + (size_t)l * NINP * DM, 32 * nb, 64 * kb, src, cs, in_I_NMIX + l * DM, scr, lane); continue; }
        r -= IT_IN;
        if (r < 3 * IT_BR) { const int i = r / IT_BR; r %= IT_BR;
            tr_plain(in_I_WBR + ((size_t)l * 3 + i) * MIXW * DM, MIXW, DM, ((bf16*)(ws_ + WS_WBR)) + ((size_t)l * 3 + i) * DM * MIXW, 0, r, 1.0f, nullptr, scr, lane); continue; }
        r -= 3 * IT_BR;
        if (r < IT_OUT) { tr_plain(in_I_WOUT + (size_t)l * DM * DM, DM, DM, ((bf16*)(ws_ + WS_WOUT)) + (size_t)l * DM * DM, 0, r, 1.0f, nullptr, scr, lane); continue; }
        r -= IT_OUT;
        if (r < IT_XQ) { tr_plain(in_I_WXQ + (size_t)l * DM * XW, DM, XW, ((bf16*)(ws_ + WS_WXQ)) + (size_t)l * XW * DM, 0, r, 0.08838834764831845f, in_I_NX + l * DM, scr, lane); continue; }
        r -= IT_XQ;
        if (r < IT_XQ) { tr_plain(in_I_WXK + (size_t)l * DM * XW, DM, XW, ((bf16*)(ws_ + WS_WXKV)) + (size_t)l * 2 * XW * DM, 0, r, 1.0f, nullptr, scr, lane); continue; }
        r -= IT_XQ;
        if (r < IT_XQ) { tr_plain(in_I_WXV + (size_t)l * DM * XW, DM, XW, ((bf16*)(ws_ + WS_WXKV)) + (size_t)l * 2 * XW * DM, XW, r, 1.0f, nullptr, scr, lane); continue; }
        r -= IT_XQ;
        if (r < IT_XO) { tr_plain(in_I_WXO + (size_t)l * XW * DM, XW, DM, ((bf16*)(ws_ + WS_WXO)) + (size_t)l * DM * XW, 0, r, 1.0f, nullptr, scr, lane); continue; }
        r -= IT_XO;
        if (r < IT_UP) { tr_plain(in_I_FUP + (size_t)l * DM * 2 * DFF, DM, 2 * DFF, ((bf16*)(ws_ + WS_WUP)) + (size_t)l * 2 * DFF * DM, 0, r, 1.0f, in_I_NFFN + l * DM, scr, lane); continue; }
        r -= IT_UP;
        tr_plain(in_I_FDN + (size_t)l * DFF * DM, DFF, DM, ((bf16*)(ws_ + WS_WDN)) + (size_t)l * DM * DFF, 0, r, 1.0f, nullptr, scr, lane);
    }
    for (int m = gw; m < M + NBP * NMEM; m += NGW) {
        if (m < M) {
            const float* src = (m < MP) ? in_I_XP + (size_t)m * DM : in_I_XS + (size_t)(m - MP) * DM;
            float ss = 0.f;
#pragma unroll
            for (int j = 0; j < 8; ++j) { const f32x4 v = *((const f32x4*)src + lane + 64 * j); *((f32x4*)(((float*)(ws_ + WS_X)) + (size_t)m * DM) + lane + 64 * j) = v;
                v2u w; w.x = pk2(v[0], v[1]); w.y = pk2(v[2], v[3]); *((v2u*)(((bf16*)(ws_ + WS_XB)) + (size_t)m * DM) + lane + 64 * j) = w; ss += (v[0] * v[0] + v[1] * v[1]) + (v[2] * v[2] + v[3] * v[3]); }
            ss = wave_sum(ss);
            if (lane < 32) ((float*)(ws_ + WS_SSQ))[(size_t)m * 32 + lane] = (lane == 0) ? ss : 0.f;
        } else {
            const int r = m - M; const float* src = in_I_MEMP + (size_t)r * DM;
#pragma unroll
            for (int j = 0; j < 8; ++j) { const f32x4 v = *((const f32x4*)src + lane + 64 * j); v2u w; w.x = pk2(v[0], v[1]); w.y = pk2(v[2], v[3]); *((v2u*)(((bf16*)(ws_ + WS_MEMB)) + (size_t)r * DM) + lane + 64 * j) = w; }
        }
    }
}

__device__ __forceinline__ int t5_bucket(int n) {
    if (n < 16) return n;
    const float v = logf((float)n / 16.0f) / logf(8.0f) * 16.0f; const int lg = 16 + (int)v; return lg < 31 ? lg : 31;
}
template <int STRIDE, bool PAIR, bool BIAS>
__device__ __forceinline__ void attn_core(const float (&q)[64], LAS const unsigned char* kp, LAS const unsigned char* vp, int nsteps, int jmin, LAS const float* bp, float& m, float& lsum, float (&o)[64]) {
    for (int j = 0; j < nsteps; ++j) {
        LAS const v4u* kr = (LAS const v4u*)(kp + j * STRIDE);
        float s0 = 0.f, s1 = 0.f;
#pragma unroll
        for (int c = 0; c < 8; ++c) { const v4u kk = kr[c];
            s0 += q[8 * c + 0] * bflo(kk.x) + q[8 * c + 2] * bflo(kk.y) + q[8 * c + 4] * bflo(kk.z) + q[8 * c + 6] * bflo(kk.w);
            s1 += q[8 * c + 1] * bfhi(kk.x) + q[8 * c + 3] * bfhi(kk.y) + q[8 * c + 5] * bfhi(kk.z) + q[8 * c + 7] * bfhi(kk.w); }
        float s = s0 + s1;
        if (PAIR) s += __shfl_xor(s, 1);
        if (BIAS) s += bp[-j];
        s = (j >= jmin) ? s : -INFINITY;
        const float mn = fmaxf(m, s), sc = __expf(m - mn), p = __expf(s - mn);
        lsum = lsum * sc + p; m = mn;
        LAS const v4u* vr = (LAS const v4u*)(vp + j * STRIDE);
#pragma unroll
        for (int c = 0; c < 8; ++c) { const v4u vv = vr[c];
            o[8 * c + 0] = o[8 * c + 0] * sc + p * bflo(vv.x); o[8 * c + 1] = o[8 * c + 1] * sc + p * bfhi(vv.x);
            o[8 * c + 2] = o[8 * c + 2] * sc + p * bflo(vv.y); o[8 * c + 3] = o[8 * c + 3] * sc + p * bfhi(vv.y);
            o[8 * c + 4] = o[8 * c + 4] * sc + p * bflo(vv.z); o[8 * c + 5] = o[8 * c + 5] * sc + p * bfhi(vv.z);
            o[8 * c + 6] = o[8 * c + 6] * sc + p * bflo(vv.w); o[8 * c + 7] = o[8 * c + 7] * sc + p * bfhi(vv.w); }
    }
}
__device__ __forceinline__ void load_q64(const bf16* p, float (&q)[64]) {
#pragma unroll
    for (int c = 0; c < 8; ++c) { const v4u w = *((const v4u*)p + c); float f[8]; unpack8(w, f);
#pragma unroll
        for (int i = 0; i < 8; ++i) q[8 * c + i] = f[i]; }
}
__device__ __forceinline__ void store_o64(bf16* p, const float (&o)[64], float inv) {
#pragma unroll
    for (int c = 0; c < 8; ++c) { float f[8];
#pragma unroll
        for (int i = 0; i < 8; ++i) f[i] = o[8 * c + i] * inv;
        *((v4u*)p + c) = pack8(f); }
}

constexpr int SWA_STR = 144, SWA_K = 0, SWA_V = 192 * SWA_STR, SWA_BT = 2 * 192 * SWA_STR, SWA_BTS = 132;
__device__ __forceinline__ void swa_phase(const Args& A, Frame& F0, int l) {
    unsigned char* const ws_ = (unsigned char*)karg64<KA_WS>();
    float* const out_ = (float*)karg64<KA_OUT>();
    const float* const in_I_CSK = (const float*)karg64<8 * I_CSK>();
    const float* const in_I_CSV = (const float*)karg64<8 * I_CSV>();
    const float* const in_I_RELB = (const float*)karg64<8 * I_RELB>();
    const float* const in_I_SINK = (const float*)karg64<8 * I_SINK>();
    Frame F = F0; LAUNDER(F);
    LAS unsigned char* Ks = F.lds + SWA_K; LAS unsigned char* Vs = F.lds + SWA_V; LAS float* BT = (LAS float*)(F.lds + SWA_BT);
    for (int i = F.tid; i < SH * 129; i += NTHR) { const int h = i / 129, d = i % 129; BT[h * SWA_BTS + d] = in_I_RELB[t5_bucket(d) * SH + h]; }
    const float* sinks = in_I_SINK + l * SH;
    for (int u = F.vcu; u < 256 + 64; u += F.G) {
        __syncthreads();
        if (u < 256) {
            const int b = u >> 7, kvh = (u >> 6) & 1, qb = u & 63, q0 = qb * 64;
            for (int i = F.tid; i < 192 * 8; i += NTHR) { const int r = i >> 3, c8 = i & 7, pos = q0 - 128 + r; v4u kv = (v4u){0u, 0u, 0u, 0u}, vv = kv;
                if (pos >= 0) { const bf16* zr = ((bf16*)(ws_ + WS_Z)) + (size_t)(b * SEQ + pos) * NINP + kvh * 64 + c8 * 8; kv = *(const v4u*)(zr + ZC_SK); vv = *(const v4u*)(zr + ZC_SV); }
                *(LAS v4u*)(Ks + r * SWA_STR + c8 * 16) = kv; *(LAS v4u*)(Vs + r * SWA_STR + c8 * 16) = vv;
                if (qb == 63 && r >= 64) { float fk[8], fv[8]; unpack8(kv, fk); unpack8(vv, fv); const size_t o = ((((size_t)l * NBP + b) * WIN + (r - 64)) * SKV + kvh) * SHD + c8 * 8;
                    *(f32x4*)(out_ + O_SKP + o) = (f32x4){fk[0], fk[1], fk[2], fk[3]}; *(f32x4*)(out_ + O_SKP + o + 4) = (f32x4){fk[4], fk[5], fk[6], fk[7]};
                    *(f32x4*)(out_ + O_SVP + o) = (f32x4){fv[0], fv[1], fv[2], fv[3]}; *(f32x4*)(out_ + O_SVP + o + 4) = (f32x4){fv[4], fv[5], fv[6], fv[7]}; }
            }
            __syncthreads();
            const int head = kvh * 8 + F.wave, t = q0 + F.lane, row = b * SEQ + t;
            float q[64], o[64]; load_q64(((bf16*)(ws_ + WS_Z)) + (size_t)row * NINP + ZC_SQ + head * 64, q);
#pragma unroll
            for (int i = 0; i < 64; ++i) o[i] = 0.f;
            float m = sinks[head], ls = 1.0f;
            attn_core<SWA_STR, false, true>(q, Ks + F.lane * SWA_STR, Vs + F.lane * SWA_STR, 129, 128 - t, BT + head * SWA_BTS + 128, m, ls, o);
            store_o64(((bf16*)(ws_ + WS_BR)) + (size_t)1 * M * MIXW + (size_t)row * MIXW + head * 64, o, 1.0f / ls);
        } else {
            const int su = u - 256, b = su >> 1, kvh = su & 1;
            for (int i = F.tid; i < 136 * 8; i += NTHR) { const int r = i >> 3, c8 = i & 7; float fk[8], fv[8];
                if (r < 128) { const size_t o = ((((size_t)l * NBS + b) * WIN + r) * SKV + kvh) * SHD + c8 * 8; const f32x4 a0 = *(const f32x4*)(in_I_CSK + o), a1 = *(const f32x4*)(in_I_CSK + o + 4), b0 = *(const f32x4*)(in_I_CSV + o), b1 = *(const f32x4*)(in_I_CSV + o + 4);
#pragma unroll
                    for (int k = 0; k < 4; ++k) { fk[k] = a0[k]; fk[4 + k] = a1[k]; fv[k] = b0[k]; fv[4 + k] = b1[k]; } }
                else { const bf16* zr = ((bf16*)(ws_ + WS_Z)) + (size_t)(MP + b * TS + (r - 128)) * NINP + kvh * 64 + c8 * 8; unpack8(*(const v4u*)(zr + ZC_SK), fk); unpack8(*(const v4u*)(zr + ZC_SV), fv); }
                *(LAS v4u*)(Ks + r * SWA_STR + c8 * 16) = pack8(fk); *(LAS v4u*)(Vs + r * SWA_STR + c8 * 16) = pack8(fv);
                if (r >= 8) { const size_t o = ((((size_t)l * NBS + b) * WIN + (r - 8)) * SKV + kvh) * SHD + c8 * 8;
                    *(f32x4*)(out_ + O_SKS + o) = (f32x4){fk[0], fk[1], fk[2], fk[3]}; *(f32x4*)(out_ + O_SKS + o + 4) = (f32x4){fk[4], fk[5], fk[6], fk[7]};
                    *(f32x4*)(out_ + O_SVS + o) = (f32x4){fv[0], fv[1], fv[2], fv[3]}; *(f32x4*)(out_ + O_SVS + o + 4) = (f32x4){fv[4], fv[5], fv[6], fv[7]}; }
            }
            __syncthreads();
            if (F.wave == 0) {
                const int t = F.lane & 7, head = kvh * 8 + (F.lane >> 3), row = MP + b * TS + t;
                float q[64], o[64]; load_q64(((bf16*)(ws_ + WS_Z)) + (size_t)row * NINP + ZC_SQ + head * 64, q);
#pragma unroll
                for (int i = 0; i < 64; ++i) o[i] = 0.f;
                float m = sinks[head], ls = 1.0f;
                attn_core<SWA_STR, false, true>(q, Ks + t * SWA_STR, Vs + t * SWA_STR, 129, 0, BT + head * SWA_BTS + 128, m, ls, o);
                store_o64(((bf16*)(ws_ + WS_BR)) + (size_t)1 * M * MIXW + (size_t)row * MIXW + head * 64, o, 1.0f / ls);
            }
        }
    }
    __syncthreads();
}

__device__ __forceinline__ void conv_phase(const Args& A, Frame& F0, int l) {
    unsigned char* const ws_ = (unsigned char*)karg64<KA_WS>();
    float* const out_ = (float*)karg64<KA_OUT>();
    const float* const in_I_CONVW = (const float*)karg64<8 * I_CONVW>();
    const float* const in_I_SCONV = (const float*)karg64<8 * I_SCONV>();
    Frame F = F0; LAUNDER(F);
    const float* cw = in_I_CONVW + (size_t)l * 3 * MIXW;
    for (int idx = F.vcu * NTHR + F.tid; idx < M * (MIXW / 8); idx += F.G * NTHR) {
        const int row = idx >> 7, c = (idx & 127) * 8; int b, t, T; const bool smp = row >= MP;
        if (!smp) { b = row >> 12; t = row & (SEQ - 1); T = SEQ; } else { b = (row - MP) >> 3; t = (row - MP) & 7; T = TS; }
        float u[3][8];
#pragma unroll
        for (int k = 0; k < 3; ++k) {
            if (t - k >= 0) { const bf16* zr = ((bf16*)(ws_ + WS_Z)) + (size_t)(row - k) * NINP + c; float a[8], d[8]; unpack8(*(const v4u*)(zr + ZC_CC), a); unpack8(*(const v4u*)(zr + ZC_CH), d);
#pragma unroll
                for (int i = 0; i < 8; ++i) u[k][i] = a[i] * d[i]; }
            else if (smp) { const float* sp = in_I_SCONV + (((size_t)l * NBS + b) * 2 + (2 + t - k)) * MIXW + c; const f32x4 a0 = *(const f32x4*)sp, a1 = *(const f32x4*)(sp + 4);
#pragma unroll
                for (int i = 0; i < 4; ++i) { u[k][i] = a0[i]; u[k][4 + i] = a1[i]; } }
            else {
#pragma unroll
                for (int i = 0; i < 8; ++i) u[k][i] = 0.f; }
        }
        float cb[8], o[8]; unpack8(*(const v4u*)(((bf16*)(ws_ + WS_Z)) + (size_t)row * NINP + ZC_CB + c), cb);
#pragma unroll
        for (int i = 0; i < 8; ++i) o[i] = cb[i] * (cw[c + i] * u[2][i] + cw[MIXW + c + i] * u[1][i] + cw[2 * MIXW + c + i] * u[0][i]);
        *(v4u*)(((bf16*)(ws_ + WS_BR)) + (size_t)2 * M * MIXW + (size_t)row * MIXW + c) = pack8(o);
        if (t >= T - 2) { float* dst = out_ + (smp ? O_CONVS + (((size_t)l * NBS + b) * 2 + (t - (T - 2))) * MIXW : O_CONVP + (((size_t)l * NBP + b) * 2 + (t - (T - 2))) * MIXW) + c;
            *(f32x4*)dst = (f32x4){u[0][0], u[0][1], u[0][2], u[0][3]}; *(f32x4*)(dst + 4) = (f32x4){u[0][4], u[0][5], u[0][6], u[0][7]}; }
    }
}

__device__ __forceinline__ void gla_stage_wg(const Args& A, Frame& F, int l, int h, LAS float* wgs) {
    const float* const in_I_GB = (const float*)karg64<8 * I_GB>();
    const float* const in_I_GUP = (const float*)karg64<8 * I_GUP>();
    for (int i = F.tid; i < 16 * 128; i += NTHR) wgs[i] = in_I_GUP[(size_t)l * GRANK * 512 + (i >> 7) * 512 + h * 128 + (i & 127)];
    if (F.tid < 128) wgs[2048 + F.tid] = in_I_GB[l * 512 + h * 128 + F.tid];
}
__device__ __forceinline__ float gla_lg(const float (&gl)[16], LAS const float* wgs, int d) {
    float zg = wgs[2048 + d];
#pragma unroll
    for (int r = 0; r < 16; ++r) zg += gl[r] * wgs[r * 128 + d];
    return (fminf(zg, 0.f) - log1pf(__expf(-fabsf(zg)))) * (1.0f / 16.0f);
}
__device__ __forceinline__ void load_glr(const bf16* zr, float (&gl)[16]) {
    float a[8], b[8]; unpack8(*(const v4u*)zr, a); unpack8(*(const v4u*)(zr + 8), b);
#pragma unroll
    for (int i = 0; i < 8; ++i) { gl[i] = a[i]; gl[8 + i] = b[i]; }
}
__device__ __forceinline__ void gla_chunk_b(const Args& A, Frame& F, int l, int row0, int h, LAS float* bl, LAS float* wgs) {
    unsigned char* const ws_ = (unsigned char*)karg64<KA_WS>();
    gla_stage_wg(A, F, l, h, wgs);
    __syncthreads();
    { const int t = F.tid >> 3, dg = F.tid & 7; float gl[16]; load_glr(((bf16*)(ws_ + WS_Z)) + (size_t)(row0 + t) * NINP + ZC_GLR, gl);
#pragma unroll 4
      for (int dd = 0; dd < 16; ++dd) { const int d = dg * 16 + dd; bl[t * 128 + d] = gla_lg(gl, wgs, d); } }
    __syncthreads();
    if (F.tid < 128) { float a = 0.f; for (int t = 0; t < 64; ++t) { a += bl[t * 128 + F.tid]; bl[t * 128 + F.tid] = a; } }
    __syncthreads();
}

typedef short bf16x8 __attribute__((ext_vector_type(8)));
typedef short v4i16_t __attribute__((ext_vector_type(4)));
#define MFMA16(a, b, c) __builtin_amdgcn_mfma_f32_16x16x32_bf16((a), (b), (c), 0, 0, 0)
__device__ __forceinline__ bf16x8 frag_row(LAS const unsigned char* T, int stride, int r0, int k0, int lane) {
    return *(LAS const bf16x8*)(T + (r0 + (lane & 15)) * stride + (k0 + 8 * (lane >> 4)) * 2);
}
__device__ __forceinline__ bf16x8 frag_tr(LAS const unsigned char* T, int stride, int rlo, int rhi, int n0, int lane) {
    const int q = (lane & 15) >> 2, p = lane & 3;
    const v4i16_t lo = __builtin_amdgcn_ds_read_tr16_b64_v4i16((LAS v4i16_t*)(T + (rlo + q) * stride + n0 * 2 + 8 * p));
    const v4i16_t hi = __builtin_amdgcn_ds_read_tr16_b64_v4i16((LAS v4i16_t*)(T + (rhi + q) * stride + n0 * 2 + 8 * p));
    return (bf16x8){lo[0], lo[1], lo[2], lo[3], hi[0], hi[1], hi[2], hi[3]};
}
__device__ __forceinline__ bf16x8 pack_p(const f32x4 a, const f32x4 b) {
    v4u w; w.x = pk2(a[0], a[1]); w.y = pk2(a[2], a[3]); w.z = pk2(b[0], b[1]); w.w = pk2(b[2], b[3]); return __builtin_bit_cast(bf16x8, w);
}

constexpr int SW_STR = 160, SW_ROWS = 208, SW_K = 0, SW_V = SW_ROWS * SW_STR, SW_BT = 2 * SW_ROWS * SW_STR;
__device__ __forceinline__ void swa_tile(LAS const unsigned char* Ks, LAS const unsigned char* Vs, LAS const float* bt, float sink, const bf16* qrow, bf16* orow, int krow0, int kmin, bool store, int lane) {
    const int n = lane & 15, g = lane >> 4;
    bf16x8 qf[2];
#pragma unroll
    for (int ks = 0; ks < 2; ++ks) qf[ks] = *(const bf16x8*)(qrow + 32 * ks + 8 * g);
    f32x4 s[10];
#pragma unroll
    for (int mt = 0; mt < 10; ++mt) { s[mt] = (f32x4){0.f, 0.f, 0.f, 0.f};
#pragma unroll
        for (int ks = 0; ks < 2; ++ks) s[mt] = MFMA16(frag_row(Ks, SW_STR, krow0 + 16 * mt, 32 * ks, lane), qf[ks], s[mt]); }
    float mx = sink;
#pragma unroll
    for (int mt = 0; mt < 10; ++mt)
#pragma unroll
        for (int i = 0; i < 4; ++i) { const int kcol = 16 * mt + 4 * g + i, dist = n + 128 - kcol; const bool valid = (dist >= 0) && (dist <= 128) && (kcol >= kmin);
            const int di = dist < 0 ? 0 : (dist > 128 ? 128 : dist); const float v = valid ? s[mt][i] + bt[di] : -INFINITY; s[mt][i] = v; mx = fmaxf(mx, v); }
    mx = fmaxf(mx, __shfl_xor(mx, 16)); mx = fmaxf(mx, __shfl_xor(mx, 32));
    float sum = 0.f;
#pragma unroll
    for (int mt = 0; mt < 10; ++mt)
#pragma unroll
        for (int i = 0; i < 4; ++i) { const float p = __expf(s[mt][i] - mx); s[mt][i] = p; sum += p; }
    sum += __shfl_xor(sum, 16); sum += __shfl_xor(sum, 32);
    const float inv = 1.0f / (sum + __expf(sink - mx));
    f32x4 o[4];
#pragma unroll
    for (int mt = 0; mt < 4; ++mt) o[mt] = (f32x4){0.f, 0.f, 0.f, 0.f};
#pragma unroll
    for (int k2 = 0; k2 < 5; ++k2) { const bf16x8 pf = pack_p(s[2 * k2], s[2 * k2 + 1]);
#pragma unroll
        for (int mt = 0; mt < 4; ++mt) o[mt] = MFMA16(frag_tr(Vs, SW_STR, krow0 + 32 * k2 + 4 * g, krow0 + 32 * k2 + 16 + 4 * g, 16 * mt, lane), pf, o[mt]); }
    if (store) {
#pragma unroll
        for (int mt = 0; mt < 4; ++mt) { v2u w; w.x = pk2(o[mt][0] * inv, o[mt][1] * inv); w.y = pk2(o[mt][2] * inv, o[mt][3] * inv); *(v2u*)(orow + 16 * mt + 4 * g) = w; } }
}
__device__ __forceinline__ void swa_phase_mfma(const Args& A, Frame& F0, int l) {
    unsigned char* const ws_ = (unsigned char*)karg64<KA_WS>();
    float* const out_ = (float*)karg64<KA_OUT>();
    const float* const in_I_CSK = (const float*)karg64<8 * I_CSK>();
    const float* const in_I_CSV = (const float*)karg64<8 * I_CSV>();
    const float* const in_I_RELB = (const float*)karg64<8 * I_RELB>();
    const float* const in_I_SINK = (const float*)karg64<8 * I_SINK>();
    Frame F = F0; LAUNDER(F);
    LAS unsigned char* Ks = F.lds + SW_K; LAS unsigned char* Vs = F.lds + SW_V; LAS float* BT = (LAS float*)(F.lds + SW_BT);
    const bf16* Z = (const bf16*)(ws_ + WS_Z); bf16* BRB = (bf16*)(ws_ + WS_BR) + (size_t)M * MIXW;
    for (int i = F.tid; i < SH * 129; i += NTHR) { const int h = i / 129, d = i % 129; BT[h * SWA_BTS + d] = in_I_RELB[t5_bucket(d) * SH + h]; }
    const float* sinks = in_I_SINK + l * SH;
#pragma unroll 1
    for (int u = F.vcu; u < 256 + 64; u += F.G) {
        asm volatile("" : "+v"(F.tid), "+v"(F.lane));
        __syncthreads();
        if (u < 256) {
            const int b = u >> 7, kvh = (u >> 6) & 1, qb = u & 63, q0 = qb * 64;
            for (int i = F.tid; i < SW_ROWS * 8; i += NTHR) { const int r = i >> 3, c8 = i & 7, pos = q0 - 128 + r; v4u kv = (v4u){0u, 0u, 0u, 0u}, vv = kv;
                if (pos >= 0 && pos < SEQ) { const bf16* zr = Z + (size_t)(b * SEQ + pos) * NINP + kvh * 64 + c8 * 8; kv = *(const v4u*)(zr + ZC_SK); vv = *(const v4u*)(zr + ZC_SV); }
                *(LAS v4u*)(Ks + r * SW_STR + c8 * 16) = kv; *(LAS v4u*)(Vs + r * SW_STR + c8 * 16) = vv;
                if (qb == 63 && r >= 64 && r < 192) { float fk[8], fv[8]; unpack8(kv, fk); unpack8(vv, fv); const size_t o = ((((size_t)l * NBP + b) * WIN + (r - 64)) * SKV + kvh) * SHD + c8 * 8;
                    *(f32x4*)(out_ + O_SKP + o) = (f32x4){fk[0], fk[1], fk[2], fk[3]}; *(f32x4*)(out_ + O_SKP + o + 4) = (f32x4){fk[4], fk[5], fk[6], fk[7]};
                    *(f32x4*)(out_ + O_SVP + o) = (f32x4){fv[0], fv[1], fv[2], fv[3]}; *(f32x4*)(out_ + O_SVP + o + 4) = (f32x4){fv[4], fv[5], fv[6], fv[7]}; }
            }
            __syncthreads();
            const int head = kvh * 8 + F.wave; const float sink = sinks[head];
#pragma unroll 1
            for (int mq = 0; mq < 4; ++mq) {
                int ln = F.lane; asm volatile("" : "+v"(ln));
                const int t0 = q0 + 16 * mq; const size_t row = (size_t)b * SEQ + t0 + (ln & 15);
                swa_tile(Ks, Vs, BT + head * SWA_BTS, sink, Z + row * NINP + ZC_SQ + head * 64, BRB + row * MIXW + head * 64, 16 * mq, 128 - t0, true, ln);
            }
        } else {
            const int su = u - 256, b = su >> 1, kvh = su & 1;
            for (int i = F.tid; i < 160 * 8; i += NTHR) { const int r = i >> 3, c8 = i & 7; float fk[8], fv[8];
                if (r < 128) { const size_t o = ((((size_t)l * NBS + b) * WIN + r) * SKV + kvh) * SHD + c8 * 8; const f32x4 a0 = *(const f32x4*)(in_I_CSK + o), a1 = *(const f32x4*)(in_I_CSK + o + 4), b0 = *(const f32x4*)(in_I_CSV + o), b1 = *(const f32x4*)(in_I_CSV + o + 4);
#pragma unroll
                    for (int k = 0; k < 4; ++k) { fk[k] = a0[k]; fk[4 + k] = a1[k]; fv[k] = b0[k]; fv[4 + k] = b1[k]; } }
                else if (r < 136) { const bf16* zr = Z + (size_t)(MP + b * TS + (r - 128)) * NINP + kvh * 64 + c8 * 8; unpack8(*(const v4u*)(zr + ZC_SK), fk); unpack8(*(const v4u*)(zr + ZC_SV), fv); }
                else {
#pragma unroll
                    for (int k = 0; k < 8; ++k) { fk[k] = 0.f; fv[k] = 0.f; } }
                *(LAS v4u*)(Ks + r * SW_STR + c8 * 16) = pack8(fk); *(LAS v4u*)(Vs + r * SW_STR + c8 * 16) = pack8(fv);
                if (r >= 8 && r < 136) { const size_t o = ((((size_t)l * NBS + b) * WIN + (r - 8)) * SKV + kvh) * SHD + c8 * 8;
                    *(f32x4*)(out_ + O_SKS + o) = (f32x4){fk[0], fk[1], fk[2], fk[3]}; *(f32x4*)(out_ + O_SKS + o + 4) = (f32x4){fk[4], fk[5], fk[6], fk[7]};
                    *(f32x4*)(out_ + O_SVS + o) = (f32x4){fv[0], fv[1], fv[2], fv[3]}; *(f32x4*)(out_ + O_SVS + o + 4) = (f32x4){fv[4], fv[5], fv[6], fv[7]}; }
            }
            __syncthreads();
            const int head = kvh * 8 + F.wave, n = F.lane & 15; const size_t row = (size_t)MP + b * TS + (n & 7);
            swa_tile(Ks, Vs, BT + head * SWA_BTS, sinks[head], Z + row * NINP + ZC_SQ + head * 64, BRB + row * MIXW + head * 64, 0, 0, n < 8, F.lane);
        }
    }
    __syncthreads();
}

constexpr int XA_STR = 272, XA_K = 0, XA_V = 256 * XA_STR;
__device__ __forceinline__ void xattn_tile(LAS const unsigned char* Ks, LAS const unsigned char* Vs, const bf16* qrow, bf16* orow, bool store, int lane) {
    const int g = lane >> 4;
    bf16x8 qf[4];
#pragma unroll
    for (int ks = 0; ks < 4; ++ks) qf[ks] = *(const bf16x8*)(qrow + 32 * ks + 8 * g);
    f32x4 s[16]; float mx = -INFINITY;
#pragma unroll
    for (int mt = 0; mt < 16; ++mt) { s[mt] = (f32x4){0.f, 0.f, 0.f, 0.f};
#pragma unroll
        for (int ks = 0; ks < 4; ++ks) s[mt] = MFMA16(frag_row(Ks, XA_STR, 16 * mt, 32 * ks, lane), qf[ks], s[mt]);
        mx = fmaxf(mx, fmaxf(fmaxf(s[mt][0], s[mt][1]), fmaxf(s[mt][2], s[mt][3]))); }
    mx = fmaxf(mx, __shfl_xor(mx, 16)); mx = fmaxf(mx, __shfl_xor(mx, 32));
    float sum = 0.f;
#pragma unroll
    for (int mt = 0; mt < 16; ++mt)
#pragma unroll
        for (int i = 0; i < 4; ++i) { const float p = __expf(s[mt][i] - mx); s[mt][i] = p; sum += p; }
    sum += __shfl_xor(sum, 16); sum += __shfl_xor(sum, 32);
    const float inv = 1.0f / sum;
    f32x4 o[8];
#pragma unroll
    for (int mt = 0; mt < 8; ++mt) o[mt] = (f32x4){0.f, 0.f, 0.f, 0.f};
#pragma unroll
    for (int k2 = 0; k2 < 8; ++k2) { const bf16x8 pf = pack_p(s[2 * k2], s[2 * k2 + 1]);
#pragma unroll
        for (int mt = 0; mt < 8; ++mt) o[mt] = MFMA16(frag_tr(Vs, XA_STR, 32 * k2 + 4 * g, 32 * k2 + 16 + 4 * g, 16 * mt, lane), pf, o[mt]); }
    if (store) {
#pragma unroll
        for (int mt = 0; mt < 8; ++mt) { v2u w; w.x = pk2(o[mt][0] * inv, o[mt][1] * inv); w.y = pk2(o[mt][2] * inv, o[mt][3] * inv); *(v2u*)(orow + 16 * mt + 4 * g) = w; } }
}
__device__ __forceinline__ void xattn_phase_mfma(const Args& A, Frame& F0, int l) {
    unsigned char* const ws_ = (unsigned char*)karg64<KA_WS>();
    const float* const in_I_CMK = (const float*)karg64<8 * I_CMK>();
    const float* const in_I_CMV = (const float*)karg64<8 * I_CMV>();
    Frame F = F0; LAUNDER(F);
    LAS unsigned char* Ks = F.lds + XA_K; LAS unsigned char* Vs = F.lds + XA_V;
    const bf16* XQ = (const bf16*)(ws_ + WS_XQ); bf16* XO = (bf16*)(ws_ + WS_XO);
#pragma unroll 1
    for (int u = F.vcu; u < 128 + 128; u += F.G) {
        asm volatile("" : "+v"(F.tid), "+v"(F.lane));
        __syncthreads();
        if (u < 128) {
            const int b = u >> 6, h = (u >> 4) & 3, q0 = (u & 15) * 256;
            for (int i = F.tid; i < 256 * 16; i += NTHR) { const int mrow = i >> 4, c8 = i & 15; const bf16* src = (const bf16*)(ws_ + WS_MEMKV) + ((size_t)l * 512 + b * 256 + mrow) * 1024 + h * 128 + c8 * 8;
                *(LAS v4u*)(Ks + mrow * XA_STR + c8 * 16) = *(const v4u*)src; *(LAS v4u*)(Vs + mrow * XA_STR + c8 * 16) = *(const v4u*)(src + 512); }
            __syncthreads();
#pragma unroll 1
            for (int qt = F.wave; qt < 16; qt += NWAVES) { int ln = F.lane; asm volatile("" : "+v"(ln)); const size_t row = (size_t)b * SEQ + q0 + 16 * qt + (ln & 15);
                xattn_tile(Ks, Vs, XQ + row * XW + h * 128, XO + row * XW + h * 128, true, ln); }
        } else {
            const int su = u - 128, b = su >> 2, h = su & 3;
            for (int i = F.tid; i < 256 * 16; i += NTHR) { const int mrow = i >> 4, c8 = i & 15; const size_t o = (((size_t)l * NBS + b) * NMEM + mrow) * XW + h * 128 + c8 * 8; float fk[8], fv[8];
                const f32x4 a0 = *(const f32x4*)(in_I_CMK + o), a1 = *(const f32x4*)(in_I_CMK + o + 4), b0 = *(const f32x4*)(in_I_CMV + o), b1 = *(const f32x4*)(in_I_CMV + o + 4);
#pragma unroll
                for (int k = 0; k < 4; ++k) { fk[k] = a0[k]; fk[4 + k] = a1[k]; fv[k] = b0[k]; fv[4 + k] = b1[k]; }
                *(LAS v4u*)(Ks + mrow * XA_STR + c8 * 16) = pack8(fk); *(LAS v4u*)(Vs + mrow * XA_STR + c8 * 16) = pack8(fv); }
            __syncthreads();
            if (F.wave == 0) { const int n = F.lane & 15; const size_t row = (size_t)MP + b * TS + (n & 7);
                xattn_tile(Ks, Vs, XQ + row * XW + h * 128, XO + row * XW + h * 128, n < 8, F.lane); }
        }
    }
    __syncthreads();
}

__device__ __forceinline__ void gla_scan16(const bf16* Z, int row0, int lane, int wave, LAS const float* wgs, float (&bb)[16], float (&bend)[16]) {
    float gl[16]; load_glr(Z + (size_t)(row0 + lane) * NINP + ZC_GLR, gl);
#pragma unroll
    for (int dd = 0; dd < 16; ++dd) { float x = gla_lg(gl, wgs, 16 * wave + dd);
#pragma unroll
        for (int off = 1; off < 64; off <<= 1) { const float y = __shfl_up(x, off); if (lane >= off) x += y; }
        bb[dd] = x; bend[dd] = __shfl(x, 63); }
}
__device__ __forceinline__ void load16(const bf16* p, float (&f)[16]) {
    float a[8], b[8]; unpack8(*(const v4u*)p, a); unpack8(*(const v4u*)(p + 8), b);
#pragma unroll
    for (int i = 0; i < 8; ++i) { f[i] = a[i]; f[8 + i] = b[i]; }
}
__device__ __forceinline__ void store16_lds(LAS unsigned char* p, const float (&f)[16]) {
    v4u w0, w1; w0.x = pk2(f[0], f[1]); w0.y = pk2(f[2], f[3]); w0.z = pk2(f[4], f[5]); w0.w = pk2(f[6], f[7]); w1.x = pk2(f[8], f[9]); w1.y = pk2(f[10], f[11]); w1.z = pk2(f[12], f[13]); w1.w = pk2(f[14], f[15]);
    *(LAS v4u*)p = w0; *(LAS v4u*)(p + 16) = w1;
}
constexpr int G1_KSTR = 288, G1_VSTR = 544, G1_WGS = 0, G1_KT = 9216, G1_V = G1_KT + 64 * G1_KSTR;
__device__ __forceinline__ void gla_pass1_prompt_mfma(const Args& A, Frame& F, int l, int u) {
    unsigned char* const ws_ = (unsigned char*)karg64<KA_WS>();
    LAS float* wgs = (LAS float*)(F.lds + G1_WGS); LAS unsigned char* Kt = F.lds + G1_KT; LAS unsigned char* Vb = F.lds + G1_V;
    const bf16* Z = (const bf16*)(ws_ + WS_Z);
    const int bh = u >> 6, c = u & 63, b = bh >> 2, h = bh & 3, row0 = b * SEQ + c * 64, lane = F.lane, w = F.wave;
    gla_stage_wg(A, F, l, h, wgs);
#pragma unroll 2
    for (int i = F.tid; i < 64 * 32; i += NTHR) { const int t = i >> 5, c8 = i & 31; *(LAS v4u*)(Vb + t * G1_VSTR + c8 * 16) = *(const v4u*)(Z + (size_t)(row0 + t) * NINP + ZC_GV + h * 256 + c8 * 8); }
    __syncthreads();
    { float bb[16], bend[16], k[16]; gla_scan16(Z, row0, lane, w, wgs, bb, bend); load16(Z + (size_t)(row0 + lane) * NINP + ZC_GK + h * 128 + 16 * w, k);
#pragma unroll
      for (int dd = 0; dd < 16; ++dd) k[dd] *= __expf(bend[dd] - bb[dd]);
      store16_lds(Kt + lane * G1_KSTR + 32 * w, k);
      if (lane == 0) {
#pragma unroll
          for (int dd = 0; dd < 16; ++dd) ((float*)(ws_ + WS_GLAD))[(size_t)u * 128 + 16 * w + dd] = __expf(bend[dd]); } }
    __syncthreads();
    const int g = lane >> 4, n = lane & 15;
    bf16x8 af[2];
#pragma unroll
    for (int ks = 0; ks < 2; ++ks) af[ks] = frag_tr(Kt, G1_KSTR, 32 * ks + 8 * g, 32 * ks + 8 * g + 4, 16 * w, lane);
    float* U = (float*)(ws_ + WS_GLAU) + (size_t)u * GDK * GDV;
#pragma unroll 4
    for (int nt = 0; nt < 16; ++nt) { f32x4 acc = (f32x4){0.f, 0.f, 0.f, 0.f};
#pragma unroll
        for (int ks = 0; ks < 2; ++ks) acc = MFMA16(af[ks], frag_tr(Vb, G1_VSTR, 32 * ks + 8 * g, 32 * ks + 8 * g + 4, 16 * nt, lane), acc);
#pragma unroll
        for (int i = 0; i < 4; ++i) U[(size_t)(16 * w + 4 * g + i) * 256 + 16 * nt + n] = acc[i]; }
}
constexpr int G3_QSTR = 272, G3_VSTR = 528, G3_PSTR = 160, G3_QD = 0, G3_KD = 64 * G3_QSTR, G3_V = 2 * 64 * G3_QSTR, G3_S = G3_V + 64 * G3_VSTR, G3_PM = G3_S + 128 * G3_VSTR, G3_END = G3_PM + 64 * G3_PSTR;
static_assert(G3_END <= 146944 && 64 * 260 * 4 <= 128 * G3_VSTR && 8704 <= 64 * G3_PSTR, "pass-3 LDS map");
__device__ __forceinline__ void gla_pass3_mfma(const Args& A, Frame& F0, int l) {
    unsigned char* const ws_ = (unsigned char*)karg64<KA_WS>();
    const float* const in_I_GNORM = (const float*)karg64<8 * I_GNORM>();
    Frame F = F0; LAUNDER(F);
    LAS unsigned char* Qd = F.lds + G3_QD; LAS unsigned char* Kd = F.lds + G3_KD; LAS unsigned char* Vb = F.lds + G3_V; LAS unsigned char* Sb = F.lds + G3_S; LAS unsigned char* Pm = F.lds + G3_PM;
    LAS float* wgs = (LAS float*)Pm; LAS float* Of = (LAS float*)Sb;
    const bf16* Z = (const bf16*)(ws_ + WS_Z); bf16* BRA = (bf16*)(ws_ + WS_BR);
#pragma unroll 1
    for (int u = F.vcu; u < 512; u += F.G) {
        asm volatile("" : "+v"(F.tid), "+v"(F.lane));
        const int lane = F.lane, w = F.wave, g = lane >> 4, n = lane & 15;
        __syncthreads();
        const int bh = u >> 6, c = u & 63, b = bh >> 2, h = bh & 3, row0 = b * SEQ + c * 64;
        gla_stage_wg(A, F, l, h, wgs);
#pragma unroll 2
        for (int i = F.tid; i < 64 * 32; i += NTHR) { const int t = i >> 5, c8 = i & 31; *(LAS v4u*)(Vb + t * G3_VSTR + c8 * 16) = *(const v4u*)(Z + (size_t)(row0 + t) * NINP + ZC_GV + h * 256 + c8 * 8); }
        { const float* S = (const float*)(ws_ + WS_GLAU) + (size_t)u * GDK * GDV;
#pragma unroll 2
          for (int i = F.tid; i < 128 * 32; i += NTHR) { const int d = i >> 5, c8 = i & 31; const f32x4 s0 = *(const f32x4*)(S + d * 256 + c8 * 8), s1 = *(const f32x4*)(S + d * 256 + c8 * 8 + 4);
              v4u wv; wv.x = pk2(s0[0], s0[1]); wv.y = pk2(s0[2], s0[3]); wv.z = pk2(s1[0], s1[1]); wv.w = pk2(s1[2], s1[3]); *(LAS v4u*)(Sb + d * G3_VSTR + c8 * 16) = wv; } }
        __syncthreads();
        { float bb[16], bend[16], q[16], k[16]; gla_scan16(Z, row0, lane, w, wgs, bb, bend);
          load16(Z + (size_t)(row0 + lane) * NINP + ZC_GQ + h * 128 + 16 * w, q); load16(Z + (size_t)(row0 + lane) * NINP + ZC_GK + h * 128 + 16 * w, k);
#pragma unroll
          for (int dd = 0; dd < 16; ++dd) { q[dd] *= __expf(bb[dd]); k[dd] *= __expf(-bb[dd]); }
          store16_lds(Qd + lane * G3_QSTR + 32 * w, q); store16_lds(Kd + lane * G3_QSTR + 32 * w, k); }
        __syncthreads();
        {
            const int mt = w >> 1;
#pragma unroll
            for (int j = 0; j < 2; ++j) { const int nt = 2 * (w & 1) + j; f32x4 acc = (f32x4){0.f, 0.f, 0.f, 0.f};
#pragma unroll
                for (int ks = 0; ks < 4; ++ks) acc = MFMA16(frag_row(Qd, G3_QSTR, 16 * mt, 32 * ks, lane), frag_row(Kd, G3_QSTR, 16 * nt, 32 * ks, lane), acc);
#pragma unroll
                for (int i = 0; i < 4; ++i) { const int t = 16 * mt + 4 * g + i, s = 16 * nt + n; *(LAS bf16*)(Pm + t * G3_PSTR + s * 2) = (bf16)(pk2((s <= t) ? acc[i] : 0.f, 0.f) & 0xffffu); } }
        }
        __syncthreads();
        f32x4 o[4][2];
#pragma unroll
        for (int mt = 0; mt < 4; ++mt) { o[mt][0] = (f32x4){0.f, 0.f, 0.f, 0.f}; o[mt][1] = (f32x4){0.f, 0.f, 0.f, 0.f}; }
#pragma unroll
        for (int j = 0; j < 2; ++j) { const int nt = 2 * w + j;
#pragma unroll
            for (int ks = 0; ks < 4; ++ks) { const bf16x8 bf = frag_tr(Sb, G3_VSTR, 32 * ks + 8 * g, 32 * ks + 8 * g + 4, 16 * nt, lane);
#pragma unroll
                for (int mt = 0; mt < 4; ++mt) o[mt][j] = MFMA16(frag_row(Qd, G3_QSTR, 16 * mt, 32 * ks, lane), bf, o[mt][j]); }
#pragma unroll
            for (int ks = 0; ks < 2; ++ks) { const bf16x8 bf = frag_tr(Vb, G3_VSTR, 32 * ks + 8 * g, 32 * ks + 8 * g + 4, 16 * nt, lane);
#pragma unroll
                for (int mt = 0; mt < 4; ++mt) o[mt][j] = MFMA16(frag_row(Pm, G3_PSTR, 16 * mt, 32 * ks, lane), bf, o[mt][j]); } }
        __syncthreads();
#pragma unroll
        for (int mt = 0; mt < 4; ++mt)
#pragma unroll
            for (int j = 0; j < 2; ++j)
#pragma unroll
                for (int i = 0; i < 4; ++i) Of[(16 * mt + 4 * g + i) * 260 + 16 * (2 * w + j) + n] = o[mt][j][i];
        __syncthreads();
        {
            const int tb = F.tid >> 5, vb = F.tid & 31; float gn[8];
#pragma unroll
            for (int j = 0; j < 8; ++j) gn[j] = in_I_GNORM[l * GDV + 8 * vb + j];
#pragma unroll
            for (int i = 0; i < 4; ++i) { const int t = 4 * tb + i; const f32x4 o0 = *(LAS const f32x4*)(Of + t * 260 + 8 * vb), o1 = *(LAS const f32x4*)(Of + t * 260 + 8 * vb + 4);
                float ov[8] = {o0[0], o0[1], o0[2], o0[3], o1[0], o1[1], o1[2], o1[3]}; float ss = 0.f;
#pragma unroll
                for (int j = 0; j < 8; ++j) ss += ov[j] * ov[j];
#pragma unroll
                for (int x = 1; x < 32; x <<= 1) ss += __shfl_xor(ss, x);
                const float rs = rsqrtf(ss * (1.0f / 256.0f) + EPS); const int row = row0 + t; float gv[8], r[8]; unpack8(*(const v4u*)(Z + (size_t)row * NINP + ZC_GR + h * 256 + 8 * vb), gv);
#pragma unroll
                for (int j = 0; j < 8; ++j) r[j] = ov[j] * rs * gn[j] * gv[j] * sigm(gv[j]);
                *(v4u*)(BRA + (size_t)row * MIXW + h * 256 + 8 * vb) = pack8(r); }
        }
    }
    __syncthreads();
}
__device__ __forceinline__ void gla_pass1(const Args& A, Frame& F0, int l) {
    unsigned char* const ws_ = (unsigned char*)karg64<KA_WS>();
    float* const out_ = (float*)karg64<KA_OUT>();
    const float* const in_I_GNORM = (const float*)karg64<8 * I_GNORM>();
    const float* const in_I_SGLA = (const float*)karg64<8 * I_SGLA>();
    Frame F = F0; LAUNDER(F);
    LAS float* bl = (LAS float*)(F.lds); LAS float* kt = (LAS float*)(F.lds + 32768); LAS float* wgs = (LAS float*)(F.lds + 65536);
#pragma unroll 1
    for (int u = F.vcu; u < 512 + 128; u += F.G) {
        asm volatile("" : "+v"(F.tid), "+v"(F.lane));
        __syncthreads();
        if (u < 512) {
            gla_pass1_prompt_mfma(A, F, l, u);
        } else {
            const int su = u - 512, b = su >> 2, h = su & 3, row0 = MP + b * TS;
            LAS float* qs = (LAS float*)(F.lds); LAS float* ks = qs + 1024; LAS float* es = qs + 2048; LAS float* vs = qs + 3072; LAS float* red = qs + 5120;
            gla_stage_wg(A, F, l, h, wgs);
            __syncthreads();
            { const int t = F.tid >> 6, dp = F.tid & 63; float gl[16]; load_glr(((bf16*)(ws_ + WS_Z)) + (size_t)(row0 + t) * NINP + ZC_GLR, gl);
              es[t * 128 + 2 * dp] = __expf(gla_lg(gl, wgs, 2 * dp)); es[t * 128 + 2 * dp + 1] = __expf(gla_lg(gl, wgs, 2 * dp + 1)); }
            for (int i = F.tid; i < 8 * 128; i += NTHR) { const int t = i >> 7, d = i & 127; const bf16* zr = ((bf16*)(ws_ + WS_Z)) + (size_t)(row0 + t) * NINP + h * 128 + d; qs[i] = bf1(zr[ZC_GQ]); ks[i] = bf1(zr[ZC_GK]); }
            for (int i = F.tid; i < 8 * 256; i += NTHR) { const int t = i >> 8, v = i & 255; vs[i] = bf1(((bf16*)(ws_ + WS_Z))[(size_t)(row0 + t) * NINP + ZC_GV + h * 256 + v]); }
            __syncthreads();
            const int v = F.tid & 255, half = F.tid >> 8; const size_t sidx = (((size_t)l * NBS + b) * GH + h) * GDK * GDV;
            const float* S0 = in_I_SGLA + sidx + (size_t)(64 * half) * 256 + v;
            float S[64];
#pragma unroll
            for (int i = 0; i < 64; ++i) S[i] = S0[i * 256];
            for (int t = 0; t < 8; ++t) { const float vv = vs[t * 256 + v]; float part = 0.f;
#pragma unroll
                for (int i = 0; i < 64; ++i) { const int d = 64 * half + i; S[i] = es[t * 128 + d] * S[i] + ks[t * 128 + d] * vv; part += qs[t * 128 + d] * S[i]; }
                red[(t * 2 + half) * 256 + v] = part; }
            float* So = out_ + O_GLAS + sidx + (size_t)(64 * half) * 256 + v;
#pragma unroll
            for (int i = 0; i < 64; ++i) So[i * 256] = S[i];
            __syncthreads();
            { const int t = F.wave, row = row0 + t; float o[4]; float ss = 0.f;
#pragma unroll
              for (int k = 0; k < 4; ++k) { const int vv = F.lane + 64 * k; o[k] = red[(t * 2) * 256 + vv] + red[(t * 2 + 1) * 256 + vv]; ss += o[k] * o[k]; }
              ss = wave_sum(ss); const float rs = rsqrtf(ss * (1.0f / 256.0f) + EPS);
#pragma unroll
              for (int k = 0; k < 4; ++k) { const int vv = F.lane + 64 * k; const float g = bf1(((bf16*)(ws_ + WS_Z))[(size_t)row * NINP + ZC_GR + h * 256 + vv]);
                  ((bf16*)(ws_ + WS_BR))[(size_t)row * MIXW + h * 256 + vv] = (bf16)(pk2(o[k] * rs * in_I_GNORM[l * GDV + vv] * g * sigm(g), 0.f) & 0xffffu); } }
        }
    }
    __syncthreads();
}
__device__ __forceinline__ void gla_pass2(const Args& A, Frame& F0, int l) {
    unsigned char* const ws_ = (unsigned char*)karg64<KA_WS>();
    float* const out_ = (float*)karg64<KA_OUT>();
    Frame F = F0; LAUNDER(F);
    for (int e = F.vcu * NTHR + F.tid; e < 8 * GDK * GDV; e += F.G * NTHR) {
        const int bh = e >> 15, dv = e & 32767, d = dv >> 8;
        float* U = ((float*)(ws_ + WS_GLAU)) + (size_t)bh * 64 * GDK * GDV + dv; const float* D = ((float*)(ws_ + WS_GLAD)) + (size_t)bh * 64 * 128 + d;
        float S = 0.f;
        for (int c0 = 0; c0 < 64; c0 += 8) { float uu[8], dd[8];
#pragma unroll
            for (int k = 0; k < 8; ++k) { uu[k] = U[(size_t)(c0 + k) * GDK * GDV]; dd[k] = D[(c0 + k) * 128]; }
#pragma unroll
            for (int k = 0; k < 8; ++k) { U[(size_t)(c0 + k) * GDK * GDV] = S; S = dd[k] * S + uu[k]; } }
        out_[O_GLAP + ((size_t)l * 8 + bh) * GDK * GDV + dv] = S;
    }
}
__device__ __forceinline__ void gla_pass3(const Args& A, Frame& F0, int l) {
    unsigned char* const ws_ = (unsigned char*)karg64<KA_WS>();
    const float* const in_I_GNORM = (const float*)karg64<8 * I_GNORM>();
    Frame F = F0; LAUNDER(F);
    LAS float* bl = (LAS float*)(F.lds); LAS float* qdT = (LAS float*)(F.lds + 32768); LAS float* kdT = (LAS float*)(F.lds + 67584); LAS float* Am = (LAS float*)(F.lds + 102400); LAS float* wgs = (LAS float*)(F.lds + 119808);
    for (int u = F.vcu; u < 512; u += F.G) {
        __syncthreads();
        const int bh = u >> 6, c = u & 63, b = bh >> 2, h = bh & 3, row0 = b * SEQ + c * 64;
        gla_chunk_b(A, F, l, row0, h, bl, wgs);
        { const int t = F.tid & 63, dg = F.tid >> 6; const bf16* zr = ((bf16*)(ws_ + WS_Z)) + (size_t)(row0 + t) * NINP + h * 128 + dg * 16; float q[16], k[16];
          { float a[8], bb[8]; unpack8(*(const v4u*)(zr + ZC_GQ), a); unpack8(*(const v4u*)(zr + ZC_GQ + 8), bb);
#pragma unroll
            for (int i = 0; i < 8; ++i) { q[i] = a[i]; q[8 + i] = bb[i]; }
            unpack8(*(const v4u*)(zr + ZC_GK), a); unpack8(*(const v4u*)(zr + ZC_GK + 8), bb);
#pragma unroll
            for (int i = 0; i < 8; ++i) { k[i] = a[i]; k[8 + i] = bb[i]; } }
#pragma unroll
          for (int i = 0; i < 16; ++i) { const int d = dg * 16 + i; const float bb = bl[t * 128 + d]; qdT[d * 68 + t] = q[i] * __expf(bb); kdT[d * 68 + t] = k[i] * __expf(-bb); } }
        __syncthreads();
        const int tb = F.tid >> 5, vb = F.tid & 31;
        {
            float a[4][2];
#pragma unroll
            for (int i = 0; i < 4; ++i) { a[i][0] = 0.f; a[i][1] = 0.f; }
            for (int d = 0; d < 128; ++d) { const f32x4 qq = *(LAS const f32x4*)(qdT + d * 68 + 4 * tb); const f32x2 kk = *(LAS const f32x2*)(kdT + d * 68 + 2 * vb);
#pragma unroll
                for (int i = 0; i < 4; ++i) { a[i][0] += qq[i] * kk[0]; a[i][1] += qq[i] * kk[1]; } }
#pragma unroll
            for (int i = 0; i < 4; ++i)
#pragma unroll
                for (int j = 0; j < 2; ++j) { const int t = 4 * tb + i, s = 2 * vb + j; Am[s * 68 + t] = (s <= t) ? a[i][j] : 0.f; }
        }
        float o[4][8];
#pragma unroll
        for (int i = 0; i < 4; ++i)
#pragma unroll
            for (int j = 0; j < 8; ++j) o[i][j] = 0.f;
        { const float* S = ((float*)(ws_ + WS_GLAU)) + (size_t)u * GDK * GDV + 8 * vb;
          for (int d = 0; d < 128; ++d) { const f32x4 qq = *(LAS const f32x4*)(qdT + d * 68 + 4 * tb); const f32x4 s0 = *(const f32x4*)(S + d * 256), s1 = *(const f32x4*)(S + d * 256 + 4);
#pragma unroll
              for (int i = 0; i < 4; ++i)
#pragma unroll
                  for (int j = 0; j < 4; ++j) { o[i][j] += qq[i] * s0[j]; o[i][4 + j] += qq[i] * s1[j]; } } }
        __syncthreads();
        for (int s = 0; s < 64; ++s) { const f32x4 aa = *(LAS const f32x4*)(Am + s * 68 + 4 * tb); float vv[8]; unpack8(*(const v4u*)(((bf16*)(ws_ + WS_Z)) + (size_t)(row0 + s) * NINP + ZC_GV + h * 256 + 8 * vb), vv);
#pragma unroll
            for (int i = 0; i < 4; ++i)
#pragma unroll
                for (int j = 0; j < 8; ++j) o[i][j] += aa[i] * vv[j]; }
        float gn[8];
#pragma unroll
        for (int j = 0; j < 8; ++j) gn[j] = in_I_GNORM[l * GDV + 8 * vb + j];
#pragma unroll
        for (int i = 0; i < 4; ++i) { float ss = 0.f;
#pragma unroll
            for (int j = 0; j < 8; ++j) ss += o[i][j] * o[i][j];
#pragma unroll
            for (int x = 1; x < 32; x <<= 1) ss += __shfl_xor(ss, x);
            const float rs = rsqrtf(ss * (1.0f / 256.0f) + EPS); const int row = row0 + 4 * tb + i; float g[8], r[8]; unpack8(*(const v4u*)(((bf16*)(ws_ + WS_Z)) + (size_t)row * NINP + ZC_GR + h * 256 + 8 * vb), g);
#pragma unroll
            for (int j = 0; j < 8; ++j) r[j] = o[i][j] * rs * gn[j] * g[j] * sigm(g[j]);
            *(v4u*)(((bf16*)(ws_ + WS_BR)) + (size_t)row * MIXW + h * 256 + 8 * vb) = pack8(r); }
    }
    __syncthreads();
}

__device__ __forceinline__ void xattn_phase(const Args& A, Frame& F0, int l) {
    unsigned char* const ws_ = (unsigned char*)karg64<KA_WS>();
    const float* const in_I_CMK = (const float*)karg64<8 * I_CMK>();
    const float* const in_I_CMV = (const float*)karg64<8 * I_CMV>();
    Frame F = F0; LAUNDER(F);
    LAS unsigned char* Ks = F.lds; LAS unsigned char* Vs = F.lds + 65536;
    for (int u = F.vcu; u < 128 + 128; u += F.G) {
        __syncthreads();
        if (u < 128) {
            const int b = u >> 6, h = (u >> 4) & 3, q0 = (u & 15) * 256;
            for (int i = F.tid; i < 256 * 16; i += NTHR) { const int mrow = i >> 4, c8 = i & 15; const bf16* src = ((bf16*)(ws_ + WS_MEMKV)) + ((size_t)l * 512 + b * 256 + mrow) * 1024 + h * 128 + c8 * 8;
                *(LAS v4u*)(Ks + mrow * 256 + c8 * 16) = *(const v4u*)src; *(LAS v4u*)(Vs + mrow * 256 + c8 * 16) = *(const v4u*)(src + 512); }
            __syncthreads();
            const int qi = F.tid >> 1, half = F.tid & 1, row = b * SEQ + q0 + qi;
            float q[64], o[64]; load_q64(((bf16*)(ws_ + WS_XQ)) + (size_t)row * XW + h * 128 + 64 * half, q);
#pragma unroll
            for (int i = 0; i < 64; ++i) o[i] = 0.f;
            float m = -INFINITY, ls = 0.f;
            attn_core<256, true, false>(q, Ks + half * 128, Vs + half * 128, 256, 0, nullptr, m, ls, o);
            store_o64(((bf16*)(ws_ + WS_XO)) + (size_t)row * XW + h * 128 + 64 * half, o, 1.0f / ls);
        } else {
            const int su = u - 128, b = su >> 2, h = su & 3;
            for (int i = F.tid; i < 256 * 16; i += NTHR) { const int mrow = i >> 4, c8 = i & 15; const size_t o = (((size_t)l * NBS + b) * NMEM + mrow) * XW + h * 128 + c8 * 8; float fk[8], fv[8];
                const f32x4 a0 = *(const f32x4*)(in_I_CMK + o), a1 = *(const f32x4*)(in_I_CMK + o + 4), b0 = *(const f32x4*)(in_I_CMV + o), b1 = *(const f32x4*)(in_I_CMV + o + 4);
#pragma unroll
                for (int k = 0; k < 4; ++k) { fk[k] = a0[k]; fk[4 + k] = a1[k]; fv[k] = b0[k]; fv[4 + k] = b1[k]; }
                *(LAS v4u*)(Ks + mrow * 256 + c8 * 16) = pack8(fk); *(LAS v4u*)(Vs + mrow * 256 + c8 * 16) = pack8(fv); }
            __syncthreads();
            if (F.tid < 16) {
                const int qi = F.tid >> 1, half = F.tid & 1, row = MP + b * TS + qi;
                float q[64], o[64]; load_q64(((bf16*)(ws_ + WS_XQ)) + (size_t)row * XW + h * 128 + 64 * half, q);
#pragma unroll
                for (int i = 0; i < 64; ++i) o[i] = 0.f;
                float m = -INFINITY, ls = 0.f;
                attn_core<256, true, false>(q, Ks + half * 128, Vs + half * 128, 256, 0, nullptr, m, ls, o);
                store_o64(((bf16*)(ws_ + WS_XO)) + (size_t)row * XW + h * 128 + 64 * half, o, 1.0f / ls);
            }
        }
    }
    __syncthreads();
}

__device__ __forceinline__ void ffnact_phase(const Args& A, Frame& F0, int l) {
    unsigned char* const ws_ = (unsigned char*)karg64<KA_WS>();
    float* const out_ = (float*)karg64<KA_OUT>();
    const float* const in_I_FCB = (const float*)karg64<8 * I_FCB>();
    const float* const in_I_FCW = (const float*)karg64<8 * I_FCW>();
    const float* const in_I_SFFN = (const float*)karg64<8 * I_SFFN>();
    Frame F = F0; LAUNDER(F);
    const float* cw = in_I_FCW + (size_t)l * 3 * DFF; const float* cbv = in_I_FCB + (size_t)l * DFF;
    constexpr int NG = DFF / 8;
    for (int idx = F.vcu * NTHR + F.tid; idx < M * NG; idx += F.G * NTHR) {
        const int row = idx / NG, c = (idx % NG) * 8; int b, t, T; const bool smp = row >= MP;
        if (!smp) { b = row >> 12; t = row & (SEQ - 1); T = SEQ; } else { b = (row - MP) >> 3; t = (row - MP) & 7; T = TS; }
        float g[3][8];
#pragma unroll
        for (int k = 0; k < 3; ++k) {
            if (t - k >= 0) unpack8(*(const v4u*)(((bf16*)(ws_ + WS_UG)) + (size_t)(row - k) * 2 * DFF + DFF + c), g[k]);
            else if (smp) { const float* sp = in_I_SFFN + (((size_t)l * NBS + b) * 2 + (2 + t - k)) * DFF + c; const f32x4 a0 = *(const f32x4*)sp, a1 = *(const f32x4*)(sp + 4);
#pragma unroll
                for (int i = 0; i < 4; ++i) { g[k][i] = a0[i]; g[k][4 + i] = a1[i]; } }
            else {
#pragma unroll
                for (int i = 0; i < 8; ++i) g[k][i] = 0.f; }
        }
        float uu[8], o[8]; unpack8(*(const v4u*)(((bf16*)(ws_ + WS_UG)) + (size_t)row * 2 * DFF + c), uu);
#pragma unroll
        for (int i = 0; i < 8; ++i) { const float gc = cw[c + i] * g[2][i] + cw[DFF + c + i] * g[1][i] + cw[2 * DFF + c + i] * g[0][i] + cbv[c + i]; o[i] = gc * sigm(gc) * uu[i]; }
        *(v4u*)(((bf16*)(ws_ + WS_ACT)) + (size_t)row * DFF + c) = pack8(o);
        if (t >= T - 2) { float* dst = out_ + (smp ? O_FFNS + (((size_t)l * NBS + b) * 2 + (t - (T - 2))) * DFF : O_FFNP + (((size_t)l * NBP + b) * 2 + (t - (T - 2))) * DFF) + c;
            *(f32x4*)dst = (f32x4){g[0][0], g[0][1], g[0][2], g[0][3]}; *(f32x4*)(dst + 4) = (f32x4){g[0][4], g[0][5], g[0][6], g[0][7]}; }
    }
}

__device__ __forceinline__ void final_phase(const Args& A, Frame& F0) {
    unsigned char* const ws_ = (unsigned char*)karg64<KA_WS>();
    float* const out_ = (float*)karg64<KA_OUT>();
    const float* const in_I_NFIN = (const float*)karg64<8 * I_NFIN>();
    Frame F = F0; LAUNDER(F);
    const int gw = F.vcu * NWAVES + F.wave, NGW = F.G * NWAVES, lane = F.lane; const float* g = in_I_NFIN;
    for (int m = gw; m < M; m += NGW) {
        float s = (lane < 32) ? ((float*)(ws_ + WS_SSQ))[(size_t)m * 32 + lane] : 0.f; s = wave_sum(s);
        const float rs = rsqrtf(s * (1.0f / DM) + EPS);
        float* dst = out_ + ((m < MP) ? O_YP + (size_t)m * DM : O_YS + (size_t)(m - MP) * DM);
#pragma unroll
        for (int j = 0; j < 8; ++j) { const f32x4 v = *((const f32x4*)(((float*)(ws_ + WS_X)) + (size_t)m * DM) + lane + 64 * j); const f32x4 gg = *((const f32x4*)g + lane + 64 * j); *((f32x4*)dst + lane + 64 * j) = v * rs * gg; }
    }
}

#ifndef PH_MASK
#define PH_MASK 0xffffffffu
#endif
#define PON(i) constexpr ((PH_MASK >> (i)) & 1u) for (int rep_ = 0; rep_ <= (int)((PROBE_MASK >> (i)) & 1u); ++rep_)
#ifndef PROBE_MASK
#define PROBE_MASK 0u
#endif
#ifndef USE_MFMA
#define USE_MFMA 7
#endif
#ifndef MK_PER_PHASE
#define MK_PER_PHASE 0
#endif
constexpr int PH_PER_LAYER = 12, N_PHASES = 2 + DEPTH * PH_PER_LAYER + 1;

__global__ void __launch_bounds__(NTHR, 2) fwd(const Args A) {
    extern __shared__ __attribute__((aligned(16))) unsigned char lds[];
    Frame F;
    F.lds = (LAS unsigned char*)lds;
    F.MISC = (volatile LAS unsigned*)(F.lds + MISC_OFF);
    F.wave = __builtin_amdgcn_readfirstlane((int)threadIdx.x >> 6); F.lane = 0; F.tid = 0;
    F.G = gridDim.x; { const int bx = blockIdx.x; F.vcu = (F.G % 8 == 0) ? (bx % 8) * (F.G / 8) + bx / 8 : bx; }
    F.ctl = (gu32*)(((unsigned char*)karg64<KA_WS>()) + WS_CTL);
    for (int u = F.wave * 64 + lane_id(); u < (LDS_BYTES - LDSCTL_OFF) / 4; u += NTHR) ((LAS unsigned*)(F.lds + LDSCTL_OFF))[u] = 0u;
    __syncthreads();
    XcdBarrier bar; bar.bar = (unsigned*)(F.ctl + CW_BAR); bar.x = 0; bar.st = nullptr; bar.wv = (unsigned)F.wave;
    if (!MK_PER_PHASE) bar = xcd_barrier_post((unsigned*)(F.ctl + CW_BAR), F.MISC + 8, (unsigned)F.wave);
    const int lo = karg32<KA_LO>(), hi = karg32<KA_HI>();
#define IN(k) (lo <= (k) && (k) < hi)
#define SEAM(k) do { if (IN(k) && IN((k) + 1)) xcd_barrier(bar); } while (0)
    typedef pg8::StaticOrder SO;
#define BX_ launder_s((int)blockIdx.x)
#define G_ launder_s(F.G)
    LAS unsigned char* ring = F.lds + RING_OFF;

    if (IN(0)) { if PON(0) p0_convert(A, F); }
    SEAM(0);
    if (IN(1)) { if PON(1)
        for (int l = 0; l < DEPTH; ++l) {
            pg8::Gemm g{((bf16*)(((unsigned char*)karg64<KA_WS>()) + WS_MEMB)), ((bf16*)(((unsigned char*)karg64<KA_WS>()) + WS_WXKV)) + (size_t)l * 2 * XW * DM, NBP * NMEM, 2 * XW, DM}; SO S; S.init(NBP * NMEM, 2 * XW, G_, (int)((BX_ + G_ - 8 * l) % G_));
            pg8::EpiMemKV E{((float*)karg64<KA_OUT>()) + O_MKP + (size_t)l * NBP * NMEM * XW, ((float*)karg64<KA_OUT>()) + O_MVP + (size_t)l * NBP * NMEM * XW, ((bf16*)(((unsigned char*)karg64<KA_WS>()) + WS_MEMKV)) + (size_t)l * NBP * NMEM * 2 * XW};
            pg8::gemm_phase<pg8::EpiMemKV, SO, true, true>(ring, g, S, E, F.wave * 64 + lane_id());
        }
    }
    SEAM(1);
    for (int l = 0; l < DEPTH; ++l) {
        const int pb = 2 + l * PH_PER_LAYER;
        if (IN(pb + 0)) { if PON(2) {
            pg8::Gemm g{((bf16*)(((unsigned char*)karg64<KA_WS>()) + WS_XB)), ((bf16*)(((unsigned char*)karg64<KA_WS>()) + WS_WIN)) + (size_t)l * NINP * DM, M, NINP, DM}; SO S; S.init(M, NINP, G_, BX_);
            pg8::EpiScaleBf16 E{((bf16*)(((unsigned char*)karg64<KA_WS>()) + WS_Z)), NINP, ((float*)(((unsigned char*)karg64<KA_WS>()) + WS_SSQ)), ZC_GATE / 256, ZC_GLR / 256};
            pg8::gemm_phase<pg8::EpiScaleBf16, SO, true, true>(ring, g, S, E, F.wave * 64 + lane_id());
        } }
        SEAM(pb + 0);
        if (IN(pb + 1)) { if PON(3) conv_phase(A, F, l); if PON(4) { if (USE_MFMA & 1) swa_phase_mfma(A, F, l); else swa_phase(A, F, l); } if PON(5) gla_pass1(A, F, l); }
        SEAM(pb + 1);
        if (IN(pb + 2)) { if PON(6) gla_pass2(A, F, l); }
        SEAM(pb + 2);
        if (IN(pb + 3)) { if PON(7) { if (USE_MFMA & 2) gla_pass3_mfma(A, F, l); else gla_pass3(A, F, l); } }
        SEAM(pb + 3);
        if (IN(pb + 4)) { if PON(8) {
            for (int i = 0; i < 3; ++i) {
                pg8::Gemm g{((bf16*)(((unsigned char*)karg64<KA_WS>()) + WS_BR)) + (size_t)i * M * MIXW, ((bf16*)(((unsigned char*)karg64<KA_WS>()) + WS_WBR)) + ((size_t)l * 3 + i) * DM * MIXW, M, DM, MIXW}; SO S; S.init(M, DM, G_, BX_);
                pg8::EpiBranch E{((bf16*)(((unsigned char*)karg64<KA_WS>()) + WS_MG)), ((bf16*)(((unsigned char*)karg64<KA_WS>()) + WS_Z)) + ZC_GATE + i * DM, NINP, i == 0 ? 1 : 0};
                pg8::gemm_phase<pg8::EpiBranch, SO, true, true>(ring, g, S, E, F.wave * 64 + lane_id());
            }
        } }
        SEAM(pb + 4);
        if (IN(pb + 5)) { if PON(9) {
            pg8::Gemm g{((bf16*)(((unsigned char*)karg64<KA_WS>()) + WS_MG)), ((bf16*)(((unsigned char*)karg64<KA_WS>()) + WS_WOUT)) + (size_t)l * DM * DM, M, DM, DM}; SO S; S.init(M, DM, G_, BX_);
            pg8::EpiResidual E{((float*)(((unsigned char*)karg64<KA_WS>()) + WS_X)), ((bf16*)(((unsigned char*)karg64<KA_WS>()) + WS_XB)), ((float*)(((unsigned char*)karg64<KA_WS>()) + WS_SSQ))};
            pg8::gemm_phase<pg8::EpiResidual, SO, true, true>(ring, g, S, E, F.wave * 64 + lane_id());
        } }
        SEAM(pb + 5);
        if (IN(pb + 6)) { if PON(10) {
            pg8::Gemm g{((bf16*)(((unsigned char*)karg64<KA_WS>()) + WS_XB)), ((bf16*)(((unsigned char*)karg64<KA_WS>()) + WS_WXQ)) + (size_t)l * XW * DM, M, XW, DM}; SO S; S.init(M, XW, G_, BX_);
            pg8::EpiScaleBf16 E{((bf16*)(((unsigned char*)karg64<KA_WS>()) + WS_XQ)), XW, ((float*)(((unsigned char*)karg64<KA_WS>()) + WS_SSQ)), 0, 0};
            pg8::gemm_phase<pg8::EpiScaleBf16, SO, true, true>(ring, g, S, E, F.wave * 64 + lane_id());
        } }
        SEAM(pb + 6);
        if (IN(pb + 7)) { if PON(11) { if (USE_MFMA & 4) xattn_phase_mfma(A, F, l); else xattn_phase(A, F, l); } }
        SEAM(pb + 7);
        if (IN(pb + 8)) { if PON(12) {
            pg8::Gemm g{((bf16*)(((unsigned char*)karg64<KA_WS>()) + WS_XO)), ((bf16*)(((unsigned char*)karg64<KA_WS>()) + WS_WXO)) + (size_t)l * DM * XW, M, DM, XW}; SO S; S.init(M, DM, G_, BX_);
            pg8::EpiResidual E{((float*)(((unsigned char*)karg64<KA_WS>()) + WS_X)), ((bf16*)(((unsigned char*)karg64<KA_WS>()) + WS_XB)), ((float*)(((unsigned char*)karg64<KA_WS>()) + WS_SSQ))};
            pg8::gemm_phase<pg8::EpiResidual, SO, true, true>(ring, g, S, E, F.wave * 64 + lane_id());
        } }
        SEAM(pb + 8);
        if (IN(pb + 9)) { if PON(13) {
            pg8::Gemm g{((bf16*)(((unsigned char*)karg64<KA_WS>()) + WS_XB)), ((bf16*)(((unsigned char*)karg64<KA_WS>()) + WS_WUP)) + (size_t)l * 2 * DFF * DM, M, 2 * DFF, DM}; SO S; S.init(M, 2 * DFF, G_, BX_);
            pg8::EpiScaleBf16 E{((bf16*)(((unsigned char*)karg64<KA_WS>()) + WS_UG)), 2 * DFF, ((float*)(((unsigned char*)karg64<KA_WS>()) + WS_SSQ)), 0, 0};
            pg8::gemm_phase<pg8::EpiScaleBf16, SO, true, true>(ring, g, S, E, F.wave * 64 + lane_id());
        } }
        SEAM(pb + 9);
        if (IN(pb + 10)) { if PON(14) ffnact_phase(A, F, l); }
        SEAM(pb + 10);
        if (IN(pb + 11)) { if PON(15) {
            pg8::Gemm g{((bf16*)(((unsigned char*)karg64<KA_WS>()) + WS_ACT)), ((bf16*)(((unsigned char*)karg64<KA_WS>()) + WS_WDN)) + (size_t)l * DM * DFF, M, DM, DFF}; SO S; S.init(M, DM, G_, BX_);
            pg8::EpiResidual E{((float*)(((unsigned char*)karg64<KA_WS>()) + WS_X)), ((bf16*)(((unsigned char*)karg64<KA_WS>()) + WS_XB)), ((float*)(((unsigned char*)karg64<KA_WS>()) + WS_SSQ))};
            pg8::gemm_phase<pg8::EpiResidual, SO, true, true>(ring, g, S, E, F.wave * 64 + lane_id());
        } }
        SEAM(pb + 11);
    }
    if (IN(N_PHASES - 1)) { if PON(16) final_phase(A, F); }
#undef IN
#undef SEAM
}

extern "C" void kernel_launch(void* const* d_in, const int* in_sizes, int n_in, void* d_out, int out_size, void* d_ws, size_t ws_size, hipStream_t stream) {
    static int grid = 0;
    if (grid == 0) {
        if (n_in != N_INPUTS || (size_t)out_size != O_END || ws_size < WS_END) { fprintf(stderr, "kernel_launch: built for %d inputs, %zu outputs, >= %zu bytes of workspace; got n_in %d, out %d, ws %zu; nothing launched\n", N_INPUTS, (size_t)O_END, (size_t)WS_END, n_in, out_size, ws_size); grid = -1; return; }
        int dev = 0, cus = 0, per_cu = 0;
        if (hipGetDevice(&dev) != hipSuccess || hipDeviceGetAttribute(&cus, hipDeviceAttributeMultiprocessorCount, dev) != hipSuccess) { fprintf(stderr, "kernel_launch: device query failed\n"); grid = -1; return; }
        if (hipFuncSetAttribute((const void*)fwd, hipFuncAttributeMaxDynamicSharedMemorySize, LDS_BYTES) != hipSuccess) { fprintf(stderr, "kernel_launch: hipFuncSetAttribute failed\n"); grid = -1; return; }
        if (hipOccupancyMaxActiveBlocksPerMultiprocessor(&per_cu, (const void*)fwd, NTHR, LDS_BYTES) != hipSuccess || per_cu < 1) { fprintf(stderr, "kernel_launch: occupancy query reports %d workgroups per CU\n", per_cu); }
        (void)hipGetLastError();
        grid = cus;
    }
    if (grid < 0) return;
    if (hipMemsetAsync((char*)d_ws + WS_CTL, 0, CTL_ZERO_BYTES, stream) != hipSuccess) { fprintf(stderr, "kernel_launch: memset failed\n"); return; }
    Args a{};
    for (int i = 0; i < N_INPUTS; ++i) a.in[i] = (const float*)d_in[i];
    a.out = (float*)d_out; a.ws = (unsigned char*)d_ws;
#if MK_PER_PHASE
    for (int p = 0; p < N_PHASES; ++p) {
        a.ph_lo = p; a.ph_hi = p + 1;
        hipLaunchKernelGGL(fwd, dim3(grid), dim3(NTHR), LDS_BYTES, stream, a);
    }
#else
    a.ph_lo = 0; a.ph_hi = N_PHASES;
    hipLaunchKernelGGL(fwd, dim3(grid), dim3(NTHR), LDS_BYTES, stream, a);
#endif
    const hipError_t le = hipPeekAtLastError();
    if (le != hipSuccess) fprintf(stderr, "kernel_launch: launch failed: %s\n", hipGetErrorName(le));
}
```

```cpp
#include <hip/hip_runtime.h>
#include <cstdio>
#include <cstdint>
#include <cmath>
#define MK_PER_PHASE 0
namespace pg8 {
#define PG8_LAS __attribute__((address_space(3)))
typedef unsigned short bf16_t;
typedef short bf16x8 __attribute__((ext_vector_type(8)));
typedef float f32x4 __attribute__((ext_vector_type(4)));
typedef unsigned u32x4 __attribute__((ext_vector_type(4)));
constexpr int BM = 256, BK = 64, HALF = 128, HTB = HALF * BK * 2  , STAGE_BYTES = 8 * HTB, NXCD = 8, WGM = 8;

__host__ __device__ __forceinline__ int lds_byte(int r, int c) { const int st = (r >> 4) * 2 + (c >> 5), rr = r & 15, cc = c & 31, ob = rr * 64 + cc * 2; return st * 1024 + (ob ^ (((ob >> 9) & 1) << 5)); }
__host__ __device__ __forceinline__ void stage_rc(int b, int& R, int& C) { const int st = b / 1024, sb = b % 1024, swz = sb ^ (((sb >> 9) & 1) << 5); R = (st >> 1) * 16 + swz / 64; C = (st & 1) * 32 + (swz % 64) / 2; }
__host__ __device__ __forceinline__ int perm32(int rho) { const int n = rho >> 4, i = rho & 15; return 8 * (i >> 2) + 4 * n + (i & 3); }

struct Unit { int pm, pn; };
struct Gemm { const bf16_t* A; const bf16_t* Bt; int M, N, K; };

struct StaticOrder {
    int nM, nN, nwg, G, c;
    __host__ __device__ void init(int M, int N, int G_, int c_) { nM = M / BM; nN = N / BM; nwg = nM * nN; G = G_; c = c_; }
    __host__ __device__ bool next(int i, Unit& u) const {
        const long L = (long)i * G + c; if (L >= nwg) return false;
        int wgid = (int)L; { const int q = nwg / NXCD, r = nwg % NXCD, xcd = wgid % NXCD, off = wgid / NXCD; wgid = (xcd < r ? xcd * (q + 1) : r * (q + 1) + (xcd - r) * q) + off; }
        const int nig = WGM * nN, gid = wgid / nig, fm = gid * WGM, gsz = (nM - fm) < WGM ? (nM - fm) : WGM;
        u.pm = fm + ((wgid % nig) % gsz); u.pn = (wgid % nig) / gsz; return true;
    }
    __device__ __forceinline__ void a_ready(const Unit&) const {}
    __device__ __forceinline__ void done(const Unit&) const {}
};

__device__ __forceinline__ unsigned cvt_pk_bf16(float lo, float hi) { unsigned r; asm volatile("v_cvt_pk_bf16_f32 %0, %1, %2" : "=v"(r) : "v"(lo), "v"(hi)); return r; }
typedef float f32x2 __attribute__((ext_vector_type(2)));
typedef unsigned u32x2 __attribute__((ext_vector_type(2)));
__device__ __forceinline__ float bf_lo(unsigned w) { return __uint_as_float(w << 16); }
__device__ __forceinline__ float bf_hi(unsigned w) { return __uint_as_float(w & 0xffff0000u); }
__device__ __forceinline__ float sigmoidf_(float v) { return 1.0f / (1.0f + __expf(-v)); }

struct EpiScaleBf16 {
    static constexpr bool PERM = true, AFTER_DRAIN = false;
    bf16_t* O; int ldc; const float* ssq; int sig_lo, sig_hi;
    __device__ __forceinline__ void operator()(const f32x4 (&acc)[2][2][4][2], const Unit& u, int wr, int wc, int fr, int fq) const {
        const int row0 = u.pm * BM + wr * 64 + fr, col0 = u.pn * BM + wc * 32 + 8 * fq;
        const bool sig = (u.pn >= sig_lo) && (u.pn < sig_hi);
#pragma unroll
        for (int ai = 0; ai < 2; ++ai)
#pragma unroll
            for (int m = 0; m < 4; ++m) {
                const int row = row0 + ai * HALF + m * 16;
                float rs = 1.0f;
                if (ssq) { const f32x4* p = (const f32x4*)(ssq + (size_t)row * 32); f32x4 s = p[0];
#pragma unroll
                    for (int i = 1; i < 8; ++i) s += p[i];
                    rs = rsqrtf(((s[0] + s[1]) + (s[2] + s[3])) * (1.0f / 2048.0f) + 1e-6f); }
                bf16_t* rowp = O + (size_t)row * ldc + col0;
#pragma unroll
                for (int bj = 0; bj < 2; ++bj) { f32x4 v0 = acc[ai][bj][m][0] * rs, v1 = acc[ai][bj][m][1] * rs;
                    if (sig) { v0 = (f32x4){sigmoidf_(v0[0]), sigmoidf_(v0[1]), sigmoidf_(v0[2]), sigmoidf_(v0[3])}; v1 = (f32x4){sigmoidf_(v1[0]), sigmoidf_(v1[1]), sigmoidf_(v1[2]), sigmoidf_(v1[3])}; }
                    u32x4 w; w.x = cvt_pk_bf16(v0[0], v0[1]); w.y = cvt_pk_bf16(v0[2], v0[3]); w.z = cvt_pk_bf16(v1[0], v1[1]); w.w = cvt_pk_bf16(v1[2], v1[3]);
                    *(u32x4*)(rowp + bj * HALF) = w; }
            }
    }
};

struct EpiResidual {
    static constexpr bool PERM = false, AFTER_DRAIN = false;
    float* X; bf16_t* XB; float* ssq;
    __device__ __forceinline__ void operator()(const f32x4 (&acc)[2][2][4][2], const Unit& u, int wr, int wc, int fr, int fq) const {
        const int row0 = u.pm * BM + wr * 64 + fr, col0 = u.pn * BM + wc * 32 + 4 * fq;
#pragma unroll
        for (int ai = 0; ai < 2; ++ai)
#pragma unroll
            for (int m = 0; m < 4; ++m) {
                const int row = row0 + ai * HALF + m * 16; float ss = 0.f;
#pragma unroll
                for (int bj = 0; bj < 2; ++bj)
#pragma unroll
                    for (int n = 0; n < 2; ++n) { const size_t off = (size_t)row * 2048 + col0 + bj * HALF + n * 16;
                        const f32x4 x = *(const f32x4*)(X + off) + acc[ai][bj][m][n];
                        *(f32x4*)(X + off) = x;
                        u32x2 w; w.x = cvt_pk_bf16(x[0], x[1]); w.y = cvt_pk_bf16(x[2], x[3]); *(u32x2*)(XB + off) = w;
                        ss += (x[0] * x[0] + x[1] * x[1]) + (x[2] * x[2] + x[3] * x[3]); }
                ss += __shfl_xor(ss, 16); ss += __shfl_xor(ss, 32);
                if (fq == 0) ssq[(size_t)row * 32 + u.pn * 4 + wc] = ss;
            }
    }
};

struct EpiBranch {
    static constexpr bool PERM = true, AFTER_DRAIN = false;
    bf16_t* MG; const bf16_t* G; int ldg; int first;
    __device__ __forceinline__ void operator()(const f32x4 (&acc)[2][2][4][2], const Unit& u, int wr, int wc, int fr, int fq) const {
        const int row0 = u.pm * BM + wr * 64 + fr, col0 = u.pn * BM + wc * 32 + 8 * fq;
#pragma unroll
        for (int ai = 0; ai < 2; ++ai)
#pragma unroll
            for (int m = 0; m < 4; ++m) {
                const int row = row0 + ai * HALF + m * 16;
#pragma unroll
                for (int bj = 0; bj < 2; ++bj) { const int col = col0 + bj * HALF;
                    const u32x4 g = *(const u32x4*)(G + (size_t)row * ldg + col);
                    f32x4 v0 = acc[ai][bj][m][0], v1 = acc[ai][bj][m][1];
                    v0 = v0 * (f32x4){bf_lo(g.x), bf_hi(g.x), bf_lo(g.y), bf_hi(g.y)}; v1 = v1 * (f32x4){bf_lo(g.z), bf_hi(g.z), bf_lo(g.w), bf_hi(g.w)};
                    bf16_t* dst = MG + (size_t)row * 2048 + col;
                    if (!first) { const u32x4 o = *(const u32x4*)dst; v0 += (f32x4){bf_lo(o.x), bf_hi(o.x), bf_lo(o.y), bf_hi(o.y)}; v1 += (f32x4){bf_lo(o.z), bf_hi(o.z), bf_lo(o.w), bf_hi(o.w)}; }
                    u32x4 w; w.x = cvt_pk_bf16(v0[0], v0[1]); w.y = cvt_pk_bf16(v0[2], v0[3]); w.z = cvt_pk_bf16(v1[0], v1[1]); w.w = cvt_pk_bf16(v1[2], v1[3]);
                    *(u32x4*)dst = w; }
            }
    }
};

struct EpiMemKV {
    static constexpr bool PERM = false, AFTER_DRAIN = false;
    float* outk; float* outv; bf16_t* KV;
    __device__ __forceinline__ void operator()(const f32x4 (&acc)[2][2][4][2], const Unit& u, int wr, int wc, int fr, int fq) const {
        const int row0 = u.pm * BM + wr * 64 + fr, col0 = u.pn * BM + wc * 32 + 4 * fq;
#pragma unroll
        for (int ai = 0; ai < 2; ++ai)
#pragma unroll
            for (int m = 0; m < 4; ++m) {
                const int row = row0 + ai * HALF + m * 16;
#pragma unroll
                for (int bj = 0; bj < 2; ++bj)
#pragma unroll
                    for (int n = 0; n < 2; ++n) { const int col = col0 + bj * HALF + n * 16; const f32x4 a = acc[ai][bj][m][n];
                        float* dst = (col < 512) ? (outk + (size_t)row * 512 + col) : (outv + (size_t)row * 512 + (col - 512));
                        *(f32x4*)dst = a;
                        u32x2 w; w.x = cvt_pk_bf16(a[0], a[1]); w.y = cvt_pk_bf16(a[2], a[3]); *(u32x2*)(KV + (size_t)row * 1024 + col) = w; }
            }
    }
};
template <class Epi, class Sched, bool ALIGN_EPI = false, bool SP2 = false>
__device__ __forceinline__ void gemm_phase(PG8_LAS unsigned char* lds, const Gemm g, const Sched& S, const Epi& E, int tid_in) {
    int tid_ = tid_in; asm volatile("" : "+v"(tid_));
    const int tid = tid_, wid = __builtin_amdgcn_readfirstlane(tid >> 6), lane = tid & 63, wr = wid >> 2, wc = wid & 3, fr = lane & 15, fq = lane >> 4;
    const int K = g.K, nt = K / BK;
    unsigned voffA[2], voffB[2];
#pragma unroll
    for (int i = 0; i < 2; ++i) { int R, C; stage_rc(tid * 16 + i * 8192, R, C); const int Rb = Epi::PERM ? ((R & ~31) + perm32(R & 31)) : R;
        voffA[i] = (unsigned)(R * K + C) * 2u; voffB[i] = (unsigned)(Rb * K + C) * 2u; }
    const size_t kstep = (size_t)(BK * 2);
    const size_t hstep = (size_t)HALF * K * 2;
    const size_t tstep = 2 * hstep;
    const unsigned ldsw = (unsigned)wid * 1024u;
    const int aoff = lds_byte(wr * 64 + fr, fq * 8), boff = lds_byte(wc * 32 + fr, fq * 8);
#define PG8_SA(b, h) (((b) * 2 + (h)) * HTB)
#define PG8_SB(b, h) ((4 + (b) * 2 + (h)) * HTB)
#define PG8_STAGE(bufoff, gbase, voff) do { _Pragma("unroll") for (int _i = 0; _i < 2; ++_i) \
        __builtin_amdgcn_global_load_lds((const unsigned*)((const char*)(gbase) + (voff)[_i]), (PG8_LAS unsigned*)(lds + (bufoff) + ldsw + _i * 8192), 16, 0, 0); } while (0)
#define PG8_LDA(dst, b, h) do { _Pragma("unroll") for (int m = 0; m < 4; ++m) _Pragma("unroll") for (int k = 0; k < 2; ++k) dst[m][k] = *(const PG8_LAS bf16x8*)(lds + PG8_SA(b, h) + aoff + m * 2048 + k * 1024); } while (0)
#define PG8_LDB(dst, b, h) do { _Pragma("unroll") for (int n = 0; n < 2; ++n) _Pragma("unroll") for (int k = 0; k < 2; ++k) dst[n][k] = *(const PG8_LAS bf16x8*)(lds + PG8_SB(b, h) + boff + n * 2048 + k * 1024); } while (0)
#define PG8_MMA(ai, bj, At, Bt) do { __builtin_amdgcn_s_setprio(1); _Pragma("unroll") for (int m = 0; m < 4; ++m) _Pragma("unroll") for (int n = 0; n < 2; ++n) _Pragma("unroll") for (int k = 0; k < 2; ++k) \
        acc[ai][bj][m][n] = __builtin_amdgcn_mfma_f32_16x16x32_bf16(Bt[n][k], At[m][k], acc[ai][bj][m][n], 0, 0, 0); __builtin_amdgcn_s_setprio(0); } while (0)
#define PG8_WAIT_V(n) asm volatile("s_waitcnt vmcnt(" #n ")" ::: "memory")
#define PG8_WAIT_L(n) asm volatile("s_waitcnt lgkmcnt(" #n ")" ::: "memory")
#define PG8_BAR __builtin_amdgcn_s_barrier()
#define PG8_SCHED __builtin_amdgcn_sched_barrier(0)
    Unit cur, nxt; int ui = 0;
    if (!S.next(0, cur)) return;
    f32x4 acc[2][2][4][2];
#pragma unroll
    for (int a = 0; a < 2; ++a)
#pragma unroll
        for (int b = 0; b < 2; ++b)
#pragma unroll
            for (int m = 0; m < 4; ++m)
#pragma unroll
                for (int n = 0; n < 2; ++n) acc[a][b][m][n] = (f32x4){0.f, 0.f, 0.f, 0.f};
    bf16x8 At[4][2], B0[2][2], B1[2][2];
    const char* cA = (const char*)g.A + (size_t)cur.pm * tstep; const char* cB = (const char*)g.Bt + (size_t)cur.pn * tstep;
    S.a_ready(cur);
    if constexpr (SP2) {
        PG8_STAGE(PG8_SB(0, 0), cB, voffB); PG8_STAGE(PG8_SB(0, 1), cB + hstep, voffB); PG8_STAGE(PG8_SA(0, 0), cA, voffA); PG8_STAGE(PG8_SA(0, 1), cA + hstep, voffA);
        if (wr == 1) PG8_BAR;
        PG8_WAIT_V(2); PG8_BAR;
        PG8_STAGE(PG8_SB(1, 0), cB + kstep, voffB); PG8_STAGE(PG8_SA(1, 0), cA + kstep, voffA); PG8_STAGE(PG8_SB(1, 1), cB + hstep + kstep, voffB);
        PG8_WAIT_V(6); PG8_BAR;
    } else {
        PG8_STAGE(PG8_SB(0, 0), cB, voffB); PG8_STAGE(PG8_SA(0, 0), cA, voffA); PG8_STAGE(PG8_SB(0, 1), cB + hstep, voffB); PG8_STAGE(PG8_SA(0, 1), cA + hstep, voffA);
        if (wr == 1) PG8_BAR;
        PG8_WAIT_V(4); PG8_BAR;
        PG8_STAGE(PG8_SB(1, 0), cB + kstep, voffB); PG8_STAGE(PG8_SA(1, 0), cA + kstep, voffA); PG8_STAGE(PG8_SB(1, 1), cB + hstep + kstep, voffB);
        PG8_WAIT_V(6); PG8_BAR;
    }
    for (;;) {
        const bool has_next = S.next(ui + 1, nxt);
        const char* nA = has_next ? (const char*)g.A + (size_t)nxt.pm * tstep : cA; const char* nB = has_next ? (const char*)g.Bt + (size_t)nxt.pn * tstep : cB;
        for (int t = 0; t < nt; t += 2) {
            const bool last = (t == nt - 2);
            const char* a1 = cA + (size_t)(t + 1) * kstep;
            const char* a2 = last ? nA : cA + (size_t)(t + 2) * kstep; const char* b2 = last ? nB : cB + (size_t)(t + 2) * kstep;
            const char* a3 = a2 + kstep; const char* b3 = b2 + kstep;
            if (last && has_next) S.a_ready(nxt);
            if constexpr (SP2) {
            PG8_LDB(B0, 0, 0); PG8_LDB(B1, 0, 1); PG8_SCHED; PG8_LDA(At, 0, 0); PG8_STAGE(PG8_SA(1, 1), a1 + hstep, voffA);
            PG8_WAIT_V(8); PG8_WAIT_L(0); PG8_BAR; PG8_MMA(0, 0, At, B0); PG8_MMA(0, 1, At, B1); PG8_BAR; PG8_SCHED;
            PG8_LDA(At, 0, 1); PG8_STAGE(PG8_SB(0, 0), b2, voffB); PG8_STAGE(PG8_SB(0, 1), b2 + hstep, voffB); PG8_STAGE(PG8_SA(0, 0), a2, voffA);
            PG8_WAIT_V(8); PG8_WAIT_L(0); PG8_BAR; PG8_MMA(1, 0, At, B0); PG8_MMA(1, 1, At, B1); PG8_BAR; PG8_SCHED;
            PG8_LDB(B0, 1, 0); PG8_LDB(B1, 1, 1); PG8_SCHED; PG8_LDA(At, 1, 0); PG8_STAGE(PG8_SA(0, 1), a2 + hstep, voffA);
            PG8_WAIT_V(8); PG8_WAIT_L(0); PG8_BAR; PG8_MMA(0, 0, At, B0); PG8_MMA(0, 1, At, B1); PG8_BAR; PG8_SCHED;
            PG8_LDA(At, 1, 1); PG8_STAGE(PG8_SB(1, 0), b3, voffB); PG8_STAGE(PG8_SB(1, 1), b3 + hstep, voffB); PG8_STAGE(PG8_SA(1, 0), a3, voffA);
            PG8_WAIT_V(8); PG8_WAIT_L(0); PG8_BAR; PG8_MMA(1, 0, At, B0); PG8_MMA(1, 1, At, B1); PG8_BAR; PG8_SCHED;
            } else {
            PG8_LDB(B0, 0, 0); PG8_SCHED; PG8_LDA(At, 0, 0); PG8_STAGE(PG8_SA(1, 1), a1 + hstep, voffA);
            PG8_WAIT_L(8); PG8_BAR; PG8_WAIT_L(0); PG8_MMA(0, 0, At, B0); PG8_BAR; PG8_SCHED;
            PG8_LDB(B1, 0, 1); PG8_STAGE(PG8_SB(0, 0), b2, voffB);
            PG8_BAR; PG8_WAIT_L(0); PG8_MMA(0, 1, At, B1); PG8_BAR;
            PG8_LDA(At, 0, 1); PG8_STAGE(PG8_SA(0, 0), a2, voffA);
            PG8_BAR; PG8_WAIT_L(0); PG8_MMA(1, 0, At, B0); PG8_BAR; PG8_SCHED;
            PG8_STAGE(PG8_SB(0, 1), b2 + hstep, voffB);
            PG8_WAIT_V(6); PG8_BAR; PG8_MMA(1, 1, At, B1); PG8_BAR;
            PG8_LDB(B0, 1, 0); PG8_SCHED; PG8_LDA(At, 1, 0); PG8_STAGE(PG8_SA(0, 1), a2 + hstep, voffA);
            PG8_WAIT_L(8); PG8_BAR; PG8_WAIT_L(0); PG8_MMA(0, 0, At, B0); PG8_BAR; PG8_SCHED;
            PG8_LDB(B1, 1, 1); PG8_STAGE(PG8_SB(1, 0), b3, voffB);
            PG8_BAR; PG8_WAIT_L(0); PG8_MMA(0, 1, At, B1); PG8_BAR;
            PG8_LDA(At, 1, 1); PG8_STAGE(PG8_SA(1, 0), a3, voffA);
            PG8_BAR; PG8_WAIT_L(0); PG8_MMA(1, 0, At, B0); PG8_BAR; PG8_SCHED;
            PG8_STAGE(PG8_SB(1, 1), b3 + hstep, voffB);
            PG8_WAIT_V(6); PG8_BAR; PG8_MMA(1, 1, At, B1); PG8_BAR;
            }
        }
        if constexpr (ALIGN_EPI) { if (wr == 0) PG8_BAR; }
        if constexpr (!Epi::AFTER_DRAIN) { E(acc, cur, wr, wc, fr, fq); S.done(cur); }
        if (!has_next) break;
#pragma unroll
        for (int a = 0; a < 2; ++a)
#pragma unroll
            for (int b = 0; b < 2; ++b)
#pragma unroll
                for (int m = 0; m < 4; ++m)
#pragma unroll
                    for (int n = 0; n < 2; ++n) acc[a][b][m][n] = (f32x4){0.f, 0.f, 0.f, 0.f};
        cur = nxt; cA = nA; cB = nB; ++ui;
        if constexpr (ALIGN_EPI) { if (wr == 1) PG8_BAR; }
    }
    PG8_WAIT_V(0);
    if constexpr (!ALIGN_EPI) { if (wr == 0) PG8_BAR; }
    PG8_BAR;
    if constexpr (Epi::AFTER_DRAIN) { E.fused(acc, cur, wr, wc, fr, fq, lds, wid, lane); S.done(cur); }
#undef PG8_SA
#undef PG8_SB
#undef PG8_STAGE
#undef PG8_LDA
#undef PG8_LDB
#undef PG8_MMA
#undef PG8_WAIT_V
#undef PG8_WAIT_L
#undef PG8_BAR
#undef PG8_SCHED
}
}

constexpr int NWAVES = 8, NTHR = 512;
constexpr int DM = 2048, SEQ = 4096, NBP = 2, DEPTH = 4, NBS = 32, TS = 8;
constexpr int MP = NBP * SEQ, MS = NBS * TS, M = MP + MS;
constexpr int MIXW = 1024, GH = 4, GDK = 128, GDV = 256, GRANK = 16;
constexpr int SH = 16, SKV = 2, SHD = 64, WIN = 128;
constexpr int NMEM = 256, XH = 4, XHD = 128, XW = XH * XHD;
constexpr int DFF = 5504, NIN = 13584, NINP = 13824;
constexpr float EPS = 1e-6f;
constexpr int ZC_GQ = 0, ZC_GK = 512, ZC_GV = 1024, ZC_GR = 2048, ZC_SQ = 3072, ZC_SK = 4096, ZC_SV = 4224, ZC_CB = 4352, ZC_CC = 5376, ZC_CH = 6400, ZC_GATE = 7424, ZC_GLR = 13568;
static_assert(ZC_GATE % 256 == 0 && ZC_GLR % 256 == 0 && ZC_GLR + 16 == NIN && NINP % 256 == 0, "z layout");
constexpr size_t O_YP = 0, O_YS = O_YP + (size_t)MP * DM, O_GLAP = O_YS + (size_t)MS * DM, O_GLAS = O_GLAP + (size_t)DEPTH * NBP * GH * GDK * GDV,
                 O_SKP = O_GLAS + (size_t)DEPTH * NBS * GH * GDK * GDV, O_SVP = O_SKP + (size_t)DEPTH * NBP * WIN * SKV * SHD, O_SKS = O_SVP + (size_t)DEPTH * NBP * WIN * SKV * SHD,
                 O_SVS = O_SKS + (size_t)DEPTH * NBS * WIN * SKV * SHD, O_CONVP = O_SVS + (size_t)DEPTH * NBS * WIN * SKV * SHD, O_CONVS = O_CONVP + (size_t)DEPTH * NBP * 2 * MIXW,
                 O_FFNP = O_CONVS + (size_t)DEPTH * NBS * 2 * MIXW, O_FFNS = O_FFNP + (size_t)DEPTH * NBP * 2 * DFF, O_MKP = O_FFNS + (size_t)DEPTH * NBS * 2 * DFF,
                 O_MVP = O_MKP + (size_t)DEPTH * NBP * NMEM * XW, O_END = O_MVP + (size_t)DEPTH * NBP * NMEM * XW;
static_assert(O_END == 43456512, "output size");
enum { I_XP = 0, I_XS, I_SGLA, I_CSK, I_CSV, I_SCONV, I_SFFN, I_CMK, I_CMV, I_MEMP, I_NMIX, I_WIN, I_GUP, I_GB, I_GNORM, I_SINK, I_RELB, I_CONVW, I_WBR, I_WOUT, I_NX, I_WXQ, I_WXK, I_WXV, I_WXO,
       I_NFFN, I_FUP, I_FCW, I_FCB, I_FDN, I_NFIN, N_INPUTS };
static_assert(N_INPUTS == 31, "inputs");

constexpr size_t MiB = 1u << 20;
constexpr size_t al1m(size_t x) { return (x + MiB - 1) / MiB * MiB; }
constexpr size_t WS_CTL = 0, CTL_ZERO_BYTES = 1 * MiB;
constexpr size_t SZ_WIN = (size_t)NINP * DM * 2, SZ_WBR = (size_t)3 * DM * MIXW * 2, SZ_WOUT = (size_t)DM * DM * 2, SZ_WXQ = (size_t)XW * DM * 2, SZ_WXKV = (size_t)2 * XW * DM * 2,
                 SZ_WXO = (size_t)DM * XW * 2, SZ_WUP = (size_t)2 * DFF * DM * 2, SZ_WDN = (size_t)DM * DFF * 2;
constexpr size_t WS_WIN = 2 * MiB, WS_WBR = al1m(WS_WIN + DEPTH * SZ_WIN), WS_WOUT = al1m(WS_WBR + DEPTH * SZ_WBR), WS_WXQ = al1m(WS_WOUT + DEPTH * SZ_WOUT),
                 WS_WXKV = al1m(WS_WXQ + DEPTH * SZ_WXQ), WS_WXO = al1m(WS_WXKV + DEPTH * SZ_WXKV), WS_WUP = al1m(WS_WXO + DEPTH * SZ_WXO), WS_WDN = al1m(WS_WUP + DEPTH * SZ_WUP);
constexpr size_t WS_X = al1m(WS_WDN + DEPTH * SZ_WDN), WS_XB = al1m(WS_X + (size_t)M * DM * 4), WS_SSQ = al1m(WS_XB + (size_t)M * DM * 2), WS_Z = al1m(WS_SSQ + (size_t)M * 32 * 4),
                 WS_BR = al1m(WS_Z + (size_t)M * NINP * 2), WS_MG = al1m(WS_BR + (size_t)3 * M * MIXW * 2), WS_XQ = al1m(WS_MG + (size_t)M * DM * 2), WS_XO = al1m(WS_XQ + (size_t)M * XW * 2),
                 WS_UG = al1m(WS_XO + (size_t)M * XW * 2), WS_ACT = al1m(WS_UG + (size_t)M * 2 * DFF * 2), WS_MEMB = al1m(WS_ACT + (size_t)M * DFF * 2), WS_MEMKV = al1m(WS_MEMB + (size_t)NBP * NMEM * DM * 2),
                 WS_GLAU = al1m(WS_MEMKV + (size_t)DEPTH * NBP * NMEM * 2 * XW * 2), WS_GLAD = al1m(WS_GLAU + (size_t)512 * GDK * GDV * 4), WS_END = al1m(WS_GLAD + (size_t)512 * GDK * 4);
constexpr int CW_TMO = 0, CW_CODE = 1, CW_BAR = 4096;

constexpr int RING_OFF = 0, RING_BYTES = 131072;
constexpr int LDSCTL_OFF = 146944, MISC_OFF = LDSCTL_OFF + 320;
constexpr int LDS_BYTES = 147456;
static_assert(MISC_OFF + 128 <= LDS_BYTES && LDSCTL_OFF >= RING_BYTES, "LDS map");

#define GAS __attribute__((address_space(1)))
#define LAS __attribute__((address_space(3)))
typedef unsigned short bf16;
typedef unsigned v4u __attribute__((ext_vector_type(4)));
typedef unsigned v2u __attribute__((ext_vector_type(2)));
typedef float f32x4 __attribute__((ext_vector_type(4)));
typedef float f32x2 __attribute__((ext_vector_type(2)));
typedef GAS unsigned gu32;
#define RLX_AGENT __ATOMIC_RELAXED, __HIP_MEMORY_SCOPE_AGENT
#define LDS_WAIT() asm volatile("s_waitcnt lgkmcnt(0)" ::: "memory")
#define VM_WAIT() asm volatile("s_waitcnt vmcnt(0)" ::: "memory")
__device__ __forceinline__ float bflo(unsigned w) { return __uint_as_float(w << 16); }
__device__ __forceinline__ float bfhi(unsigned w) { return __uint_as_float(w & 0xffff0000u); }
__device__ __forceinline__ float bf1(bf16 h) { return __uint_as_float(((unsigned)h) << 16); }
__device__ __forceinline__ unsigned pk2(float lo, float hi) { return pg8::cvt_pk_bf16(lo, hi); }
__device__ __forceinline__ void unpack8(const v4u w, float (&f)[8]) { f[0] = bflo(w.x); f[1] = bfhi(w.x); f[2] = bflo(w.y); f[3] = bfhi(w.y); f[4] = bflo(w.z); f[5] = bfhi(w.z); f[6] = bflo(w.w); f[7] = bfhi(w.w); }
__device__ __forceinline__ v4u pack8(const float (&f)[8]) { v4u w; w.x = pk2(f[0], f[1]); w.y = pk2(f[2], f[3]); w.z = pk2(f[4], f[5]); w.w = pk2(f[6], f[7]); return w; }
__device__ __forceinline__ float sigm(float v) { return 1.0f / (1.0f + __expf(-v)); }
__device__ __forceinline__ float wave_sum(float v) {
#pragma unroll
    for (int o = 1; o < 64; o <<= 1) v += __shfl_xor(v, o);
    return v;
}
#define XB_TMO      128
#define XB_XCNT(j)  (256  + 64 * (j))
#define XB_XSUB(j)  (1280 + 64 * (j))
#define XB_XGEN(j)  (2304 + 64 * (j))
#define XB_TOP      3328
#define XB_TOPGEN   3392
#define XCD_BAR_WORDS 3456
#define XB_SPIN_CAP (1u << 18)

__device__ __forceinline__ unsigned xb_ld(unsigned* p)              { return __hip_atomic_load(p, __ATOMIC_RELAXED, __HIP_MEMORY_SCOPE_AGENT); }
__device__ __forceinline__ unsigned xb_add(unsigned* p, unsigned v) { return __hip_atomic_fetch_add(p, v, __ATOMIC_RELAXED, __HIP_MEMORY_SCOPE_AGENT); }
__device__ __forceinline__ unsigned xb_xcc_id() { return (unsigned)__builtin_amdgcn_s_getreg((3 << 11) | 20) & 0xFu; }
#define XB_SPIN(cond, bar) do { unsigned _sp = 0; while (cond) { __builtin_amdgcn_s_sleep(1); \
    if ((++_sp & 255u) == 0u) { if (xb_ld(&(bar)[XB_TMO])) break; if (_sp > XB_SPIN_CAP) { atomicAdd(&(bar)[XB_TMO], 1u); break; } } } } while (0)

struct XcdBarrier {
    unsigned* bar; unsigned x; unsigned wv;
    volatile LAS unsigned* st;
};

__device__ __forceinline__ unsigned xb_lane() { return __builtin_amdgcn_mbcnt_hi(~0u, __builtin_amdgcn_mbcnt_lo(~0u, 0u)); }
__device__ __forceinline__ XcdBarrier xcd_barrier_post(unsigned* bar, volatile LAS unsigned* st, unsigned wv) {
    XcdBarrier b; b.bar = bar; b.x = xb_xcc_id(); b.st = st; b.wv = wv;
    if (wv == 0u && xb_lane() == 0u) (void)xb_add(&bar[XB_XCNT(b.x)], 1u);
    return b;
}
__device__ __forceinline__ void xcd_barrier_complete(unsigned* bar, unsigned x, unsigned& nloc, unsigned& nx) {
    const unsigned G = gridDim.x * gridDim.y * gridDim.z;
    unsigned sum, cnt, mine, sp = 0u;
    for (;;) {
        sum = 0u; cnt = 0u; mine = 0u;
#pragma unroll
        for (unsigned j = 0; j < 16; ++j) { const unsigned c = xb_ld(&bar[XB_XCNT(j)]); sum += c; cnt += (c > 0u) ? 1u : 0u; mine = (j == x) ? c : mine; }
        if (sum == G) break;
        __builtin_amdgcn_s_sleep(1);
        if ((++sp & 255u) == 0u) { if (xb_ld(&bar[XB_TMO])) break; if (sp > XB_SPIN_CAP) { atomicAdd(&bar[XB_TMO], 1u); break; } }
    }
    nloc = mine > 0u ? mine : 1u; nx = cnt > 0u ? cnt : 1u;
}

__device__ __forceinline__ void xcd_barrier(const XcdBarrier& b) {
    asm volatile("s_waitcnt vmcnt(0)" ::: "memory");
    __syncthreads();
    if (b.wv == 0u && xb_lane() == 0u) {
        unsigned* bar = b.bar;
        __builtin_amdgcn_s_waitcnt(0);
        unsigned nloc = b.st[0], nx = b.st[1];
        if (nloc == 0u) { xcd_barrier_complete(bar, b.x, nloc, nx); b.st[0] = nloc; b.st[1] = nx; }
        const unsigned old = xb_add(&bar[XB_XSUB(b.x)], 1u);
        const unsigned gen = old / nloc;
        if (old + 1u == (gen + 1u) * nloc) {
            __builtin_amdgcn_fence(__ATOMIC_RELEASE, "agent");
            asm volatile("s_waitcnt vmcnt(0)" ::: "memory");
            const unsigned og = xb_add(&bar[XB_TOP], 1u);
            const unsigned tg = og / nx;
            if (og + 1u == (tg + 1u) * nx) xb_add(&bar[XB_TOPGEN], 1u);
            else XB_SPIN(xb_ld(&bar[XB_TOPGEN]) == tg, bar);
            __builtin_amdgcn_fence(__ATOMIC_ACQUIRE, "agent");
            xb_add(&bar[XB_XGEN(b.x)], 1u);
            asm volatile("s_waitcnt vmcnt(0)" ::: "memory");
        } else {
            XB_SPIN(xb_ld(&bar[XB_XGEN(b.x)]) == gen, bar);
            __builtin_amdgcn_fence(__ATOMIC_ACQUIRE, "agent");
            asm volatile("s_waitcnt vmcnt(0)" ::: "memory");
        }
    }
    __syncthreads();
}

struct Args { const float* in[N_INPUTS]; float* out; unsigned char* ws; int ph_lo, ph_hi; };
static_assert(sizeof(Args) == N_INPUTS * 8 + 8 + 8 + 8, "Args has no padding");


constexpr int KA_OUT = 8 * N_INPUTS, KA_WS = KA_OUT + 8, KA_LO = KA_WS + 8, KA_HI = KA_LO + 4;
template <int OFF> __device__ __forceinline__ unsigned long long karg64() {
    unsigned long long v; auto kp = __builtin_amdgcn_kernarg_segment_ptr();
    asm volatile("s_load_dwordx2 %0, %1, %2\n\ts_waitcnt lgkmcnt(0)" : "=s"(v) : "s"(kp), "n"(OFF) : "memory"); return v;
}
template <int OFF> __device__ __forceinline__ int karg32() {
    int v; auto kp = __builtin_amdgcn_kernarg_segment_ptr();
    asm volatile("s_load_dword %0, %1, %2\n\ts_waitcnt lgkmcnt(0)" : "=s"(v) : "s"(kp), "n"(OFF) : "memory"); return v;
}
struct Frame {
    LAS unsigned char* lds;
    volatile LAS unsigned* MISC;
    gu32* ctl;
    int tid, lane, wave, vcu, G;
};

__device__ __forceinline__ int lane_id() { int l; asm volatile("v_mbcnt_lo_u32_b32 %0, -1, 0\n\tv_mbcnt_hi_u32_b32 %0, -1, %0" : "=v"(l)); return l; }
__device__ __forceinline__ int launder_s(int v) { asm volatile("" : "+s"(v)); return v; }
#define LAUNDER(F) do { asm volatile("" : "+s"((F).wave), "+s"((F).vcu), "+s"((F).G)); (F).lane = lane_id(); asm volatile("" : "+v"((F).lane)); (F).tid = (F).wave * 64 + (F).lane; } while (0)
__device__ __forceinline__ void tr_item(const float* W, int K, int Nsrc, bf16* WT, int dstrow0, int k0, int srccol, float cscale, const float* gain, LAS float* scr, int lane) {
#pragma unroll 8
    for (int i = 0; i < 32; ++i) { const int kk = 2 * i + (lane >> 5); float v = 0.f; if (srccol >= 0) v = W[(size_t)(k0 + kk) * Nsrc + srccol]; if (gain) v *= gain[k0 + kk]; scr[kk * 33 + (lane & 31)] = v * cscale; }
    LDS_WAIT(); asm volatile("" ::: "memory");
    const int c = lane & 7;
#pragma unroll
    for (int j = 0; j < 4; ++j) { const int n = (lane >> 3) + 8 * j; const LAS float* s = scr + (8 * c) * 33 + n;
        v4u o; o.x = pk2(s[0 * 33], s[1 * 33]); o.y = pk2(s[2 * 33], s[3 * 33]); o.z = pk2(s[4 * 33], s[5 * 33]); o.w = pk2(s[6 * 33], s[7 * 33]);
        *(v4u*)(WT + (size_t)(dstrow0 + n) * K + k0 + 8 * c) = o; }
    LDS_WAIT(); asm volatile("" ::: "memory");
}
__device__ __forceinline__ void tr_plain(const float* W, int K, int N, bf16* WT, int dst_off, int r, float cscale, const float* gain, LAS float* scr, int lane) {
    const int nblk = N / 32, kb = r / nblk, nb = r % nblk;
    tr_item(W, K, N, WT, dst_off + 32 * nb, 64 * kb, 32 * nb + (lane & 31), cscale, gain, scr, lane);
}
constexpr int IT_IN = (DM / 64) * (NINP / 32), IT_BR = (MIXW / 64) * (DM / 32), IT_OUT = (DM / 64) * (DM / 32), IT_XQ = (DM / 64) * (XW / 32), IT_XO = (XW / 64) * (DM / 32),
              IT_UP = (DM / 64) * (2 * DFF / 32), IT_DN = (DFF / 64) * (DM / 32), IT_LAYER = IT_IN + 3 * IT_BR + IT_OUT + 3 * IT_XQ + IT_XO + IT_UP + IT_DN;
__device__ __forceinline__ void p0_convert(const Args& A, Frame& F0) {
    unsigned char* const ws_ = (unsigned char*)karg64<KA_WS>();
    const float* const in_I_FDN = (const float*)karg64<8 * I_FDN>();
    const float* const in_I_FUP = (const float*)karg64<8 * I_FUP>();
    const float* const in_I_MEMP = (const float*)karg64<8 * I_MEMP>();
    const float* const in_I_NFFN = (const float*)karg64<8 * I_NFFN>();
    const float* const in_I_NMIX = (const float*)karg64<8 * I_NMIX>();
    const float* const in_I_NX = (const float*)karg64<8 * I_NX>();
    const float* const in_I_WBR = (const float*)karg64<8 * I_WBR>();
    const float* const in_I_WIN = (const float*)karg64<8 * I_WIN>();
    const float* const in_I_WOUT = (const float*)karg64<8 * I_WOUT>();
    const float* const in_I_WXK = (const float*)karg64<8 * I_WXK>();
    const float* const in_I_WXO = (const float*)karg64<8 * I_WXO>();
    const float* const in_I_WXQ = (const float*)karg64<8 * I_WXQ>();
    const float* const in_I_WXV = (const float*)karg64<8 * I_WXV>();
    const float* const in_I_XP = (const float*)karg64<8 * I_XP>();
    const float* const in_I_XS = (const float*)karg64<8 * I_XS>();
    Frame F = F0; LAUNDER(F);
    LAS float* scr = (LAS float*)(F.lds + RING_OFF + F.wave * 16384);
    const int gw = F.vcu * NWAVES + F.wave, NGW = F.G * NWAVES, lane = F.lane;
    for (int it = gw; it < DEPTH * IT_LAYER; it += NGW) {
        const int l = it / IT_LAYER; int r = it % IT_LAYER;
        if (r < IT_IN) {
            const int nblk = NINP / 32, kb = r / nblk, nb = r % nblk, n = 32 * nb + (lane & 31);
            int src; if (n < 3072) src = n; else if (n < ZC_GLR) src = n + 16; else if (n < NIN) src = 3072 + (n - ZC_GLR); else src = -1;
            const float cs = (n < 512) ? 0.08838834764831845f : ((n >= ZC_SQ && n < ZC_SK) ? 0.125f : 1.0f);
            tr_item(in_I_WIN + (size_t)l * DM * NIN, DM, NIN, ((bf16*)(ws_ + WS_WIN)) + (size_t)l * NINP * DM, 32 * nb, 64 * kb, src, cs, in_I_NMIX + l * DM, scr, lane); continue; }
        r -= IT_IN;
        if (r < 3 * IT_BR) { const int i = r / IT_BR; r %= IT_BR;
            tr_plain(in_I_WBR + ((size_t)l * 3 + i) * MIXW * DM, MIXW, DM, ((bf16*)(ws_ + WS_WBR)) + ((size_t)l * 3 + i) * DM * MIXW, 0, r, 1.0f, nullptr, scr, lane); continue; }
        r -= 3 * IT_BR;
        if (r < IT_OUT) { tr_plain(in_I_WOUT + (size_t)l * DM * DM, DM, DM, ((bf16*)(ws_ + WS_WOUT)) + (size_t)l * DM * DM, 0, r, 1.0f, nullptr, scr, lane); continue; }
        r -= IT_OUT;
        if (r < IT_XQ) { tr_plain(in_I_WXQ + (size_t)l * DM * XW, DM, XW, ((bf16*)(ws_ + WS_WXQ)) + (size_t)l * XW * DM, 0, r, 0.08838834764831845f, in_I_NX + l * DM, scr, lane); continue; }
        r -= IT_XQ;
        if (r < IT_XQ) { tr_plain(in_I_WXK + (size_t)l * DM * XW, DM, XW, ((bf16*)(ws_ + WS_WXKV)) + (size_t)l * 2 * XW * DM, 0, r, 1.0f, nullptr, scr, lane); continue; }
        r -= IT_XQ;
        if (r < IT_XQ) { tr_plain(in_I_WXV + (size_t)l * DM * XW, DM, XW, ((bf16*)(ws_ + WS_WXKV)) + (size_t)l * 2 * XW * DM, XW, r, 1.0f, nullptr, scr, lane); continue; }
        r -= IT_XQ;
        if (r < IT_XO) { tr_plain(in_I_WXO + (size_t)l * XW * DM, XW, DM, ((bf16*)(ws_ + WS_WXO)) + (size_t)l * DM * XW, 0, r, 1.0f, nullptr, scr, lane); continue; }
        r -= IT_XO;
        if (r < IT_UP) { tr_plain(in_I_FUP + (size_t)l * DM * 2 * DFF, DM, 2 * DFF, ((bf16*)(ws_ + WS_WUP)) + (size_t)l * 2 * DFF * DM, 0, r, 1.0f, in_I_NFFN + l * DM, scr, lane); continue; }
        r -= IT_UP;
        tr_plain(in_I_FDN + (size_t)l * DFF * DM, DFF, DM, ((bf16*)(ws_ + WS_WDN)) + (size_t)l * DM * DFF, 0, r, 1.0f, nullptr, scr, lane);
    }
    for (int m = gw; m < M + NBP * NMEM; m += NGW) {
        if (m < M) {
            const float* src = (m < MP) ? in_I_XP + (size_t)m * DM : in_I_XS + (size_t)(m - MP) * DM;
            float ss = 0.f;
#pragma unroll
            for (int j = 0; j < 8; ++j) { const f32x4 v = *((const f32x4*)src + lane + 64 * j); *((f32x4*)(((float*)(ws_ + WS_X)) + (size_t)m * DM) + lane + 64 * j) = v;
                v2u w; w.x = pk2(v[0], v[1]); w.y = pk2(v[2], v[3]); *((v2u*)(((bf16*)(ws_ + WS_XB)) + (size_t)m * DM) + lane + 64 * j) = w; ss += (v[0] * v[0] + v[1] * v[1]) + (v[2] * v[2] + v[3] * v[3]); }
            ss = wave_sum(ss);
            if (lane < 32) ((float*)(ws_ + WS_SSQ))[(size_t)m * 32 + lane] = (lane == 0) ? ss : 0.f;
        } else {
            const int r = m - M; const float* src = in_I_MEMP + (size_t)r * DM;
#pragma unroll
            for (int j = 0; j < 8; ++j) { const f32x4 v = *((const f32x4*)src + lane + 64 * j); v2u w; w.x = pk2(v[0], v[1]); w.y = pk2(v[2], v[3]); *((v2u*)(((bf16*)(ws_ + WS_MEMB)) + (size_t)r * DM) + lane + 64 * j) = w; }
        }
    }
}

__device__ __forceinline__ int t5_bucket(int n) {
    if (n < 16) return n;
    const float v = logf((float)n / 16.0f) / logf(8.0f) * 16.0f; const int lg = 16 + (int)v; return lg < 31 ? lg : 31;
}
template <int STRIDE, bool PAIR, bool BIAS>
__device__ __forceinline__ void attn_core(const float (&q)[64], LAS const unsigned char* kp, LAS const unsigned char* vp, int nsteps, int jmin, LAS const float* bp, float& m, float& lsum, float (&o)[64]) {
    for (int j = 0; j < nsteps; ++j) {
        LAS const v4u* kr = (LAS const v4u*)(kp + j * STRIDE);
        float s0 = 0.f, s1 = 0.f;
#pragma unroll
        for (int c = 0; c < 8; ++c) { const v4u kk = kr[c];
            s0 += q[8 * c + 0] * bflo(kk.x) + q[8 * c + 2] * bflo(kk.y) + q[8 * c + 4] * bflo(kk.z) + q[8 * c + 6] * bflo(kk.w);
            s1 += q[8 * c + 1] * bfhi(kk.x) + q[8 * c + 3] * bfhi(kk.y) + q[8 * c + 5] * bfhi(kk.z) + q[8 * c + 7] * bfhi(kk.w); }
        float s = s0 + s1;
        if (PAIR) s += __shfl_xor(s, 1);
        if (BIAS) s += bp[-j];
        s = (j >= jmin) ? s : -INFINITY;
        const float mn = fmaxf(m, s), sc = __expf(m - mn), p = __expf(s - mn);
        lsum = lsum * sc + p; m = mn;
        LAS const v4u* vr = (LAS const v4u*)(vp + j * STRIDE);
#pragma unroll
        for (int c = 0; c < 8; ++c) { const v4u vv = vr[c];
            o[8 * c + 0] = o[8 * c + 0] * sc + p * bflo(vv.x); o[8 * c + 1] = o[8 * c + 1] * sc + p * bfhi(vv.x);
            o[8 * c + 2] = o[8 * c + 2] * sc + p * bflo(vv.y); o[8 * c + 3] = o[8 * c + 3] * sc + p * bfhi(vv.y);
            o[8 * c + 4] = o[8 * c + 4] * sc + p * bflo(vv.z); o[8 * c + 5] = o[8 * c + 5] * sc + p * bfhi(vv.z);
            o[8 * c + 6] = o[8 * c + 6] * sc + p * bflo(vv.w); o[8 * c + 7] = o[8 * c + 7] * sc + p * bfhi(vv.w); }
    }
}
__device__ __forceinline__ void load_q64(const bf16* p, float (&q)[64]) {
#pragma unroll
    for (int c = 0; c < 8; ++c) { const v4u w = *((const v4u*)p + c); float f[8]; unpack8(w, f);
#pragma unroll
        for (int i = 0; i < 8; ++i) q[8 * c + i] = f[i]; }
}
__device__ __forceinline__ void store_o64(bf16* p, const float (&o)[64], float inv) {
#pragma unroll
    for (int c = 0; c < 8; ++c) { float f[8];
#pragma unroll
        for (int i = 0; i < 8; ++i) f[i] = o[8 * c + i] * inv;
        *((v4u*)p + c) = pack8(f); }
}

constexpr int SWA_STR = 144, SWA_K = 0, SWA_V = 192 * SWA_STR, SWA_BT = 2 * 192 * SWA_STR, SWA_BTS = 132;
__device__ __forceinline__ void swa_phase(const Args& A, Frame& F0, int l) {
    unsigned char* const ws_ = (unsigned char*)karg64<KA_WS>();
    float* const out_ = (float*)karg64<KA_OUT>();
    const float* const in_I_CSK = (const float*)karg64<8 * I_CSK>();
    const float* const in_I_CSV = (const float*)karg64<8 * I_CSV>();
    const float* const in_I_RELB = (const float*)karg64<8 * I_RELB>();
    const float* const in_I_SINK = (const float*)karg64<8 * I_SINK>();
    Frame F = F0; LAUNDER(F);
    LAS unsigned char* Ks = F.lds + SWA_K; LAS unsigned char* Vs = F.lds + SWA_V; LAS float* BT = (LAS float*)(F.lds + SWA_BT);
    for (int i = F.tid; i < SH * 129; i += NTHR) { const int h = i / 129, d = i % 129; BT[h * SWA_BTS + d] = in_I_RELB[t5_bucket(d) * SH + h]; }
    const float* sinks = in_I_SINK + l * SH;
    for (int u = F.vcu; u < 256 + 64; u += F.G) {
        __syncthreads();
        if (u < 256) {
            const int b = u >> 7, kvh = (u >> 6) & 1, qb = u & 63, q0 = qb * 64;
            for (int i = F.tid; i < 192 * 8; i += NTHR) { const int r = i >> 3, c8 = i & 7, pos = q0 - 128 + r; v4u kv = (v4u){0u, 0u, 0u, 0u}, vv = kv;
                if (pos >= 0) { const bf16* zr = ((bf16*)(ws_ + WS_Z)) + (size_t)(b * SEQ + pos) * NINP + kvh * 64 + c8 * 8; kv = *(const v4u*)(zr + ZC_SK); vv = *(const v4u*)(zr + ZC_SV); }
                *(LAS v4u*)(Ks + r * SWA_STR + c8 * 16) = kv; *(LAS v4u*)(Vs + r * SWA_STR + c8 * 16) = vv;
                if (qb == 63 && r >= 64) { float fk[8], fv[8]; unpack8(kv, fk); unpack8(vv, fv); const size_t o = ((((size_t)l * NBP + b) * WIN + (r - 64)) * SKV + kvh) * SHD + c8 * 8;
                    *(f32x4*)(out_ + O_SKP + o) = (f32x4){fk[0], fk[1], fk[2], fk[3]}; *(f32x4*)(out_ + O_SKP + o + 4) = (f32x4){fk[4], fk[5], fk[6], fk[7]};
                    *(f32x4*)(out_ + O_SVP + o) = (f32x4){fv[0], fv[1], fv[2], fv[3]}; *(f32x4*)(out_ + O_SVP + o + 4) = (f32x4){fv[4], fv[5], fv[6], fv[7]}; }
            }
            __syncthreads();
            const int head = kvh * 8 + F.wave, t = q0 + F.lane, row = b * SEQ + t;
            float q[64], o[64]; load_q64(((bf16*)(ws_ + WS_Z)) + (size_t)row * NINP + ZC_SQ + head * 64, q);
#pragma unroll
            for (int i = 0; i < 64; ++i) o[i] = 0.f;
            float m = sinks[head], ls = 1.0f;
            attn_core<SWA_STR, false, true>(q, Ks + F.lane * SWA_STR, Vs + F.lane * SWA_STR, 129, 128 - t, BT + head * SWA_BTS + 128, m, ls, o);
            store_o64(((bf16*)(ws_ + WS_BR)) + (size_t)1 * M * MIXW + (size_t)row * MIXW + head * 64, o, 1.0f / ls);
        } else {
            const int su = u - 256, b = su >> 1, kvh = su & 1;
            for (int i = F.tid; i < 136 * 8; i += NTHR) { const int r = i >> 3, c8 = i & 7; float fk[8], fv[8];
                if (r < 128) { const size_t o = ((((size_t)l * NBS + b) * WIN + r) * SKV + kvh) * SHD + c8 * 8; const f32x4 a0 = *(const f32x4*)(in_I_CSK + o), a1 = *(const f32x4*)(in_I_CSK + o + 4), b0 = *(const f32x4*)(in_I_CSV + o), b1 = *(const f32x4*)(in_I_CSV + o + 4);
#pragma unroll
                    for (int k = 0; k < 4; ++k) { fk[k] = a0[k]; fk[4 + k] = a1[k]; fv[k] = b0[k]; fv[4 + k] = b1[k]; } }
                else { const bf16* zr = ((bf16*)(ws_ + WS_Z)) + (size_t)(MP + b * TS + (r - 128)) * NINP + kvh * 64 + c8 * 8; unpack8(*(const v4u*)(zr + ZC_SK), fk); unpack8(*(const v4u*)(zr + ZC_SV), fv); }
                *(LAS v4u*)(Ks + r * SWA_STR + c8 * 16) = pack8(fk); *(LAS v4u*)(Vs + r * SWA_STR + c8 * 16) = pack8(fv);
                if (r >= 8) { const size_t o = ((((size_t)l * NBS + b) * WIN + (r - 8)) * SKV + kvh) * SHD + c8 * 8;
                    *(f32x4*)(out_ + O_SKS + o) = (f32x4){fk[0], fk[1], fk[2], fk[3]}; *(f32x4*)(out_ + O_SKS + o + 4) = (f32x4){fk[4], fk[5], fk[6], fk[7]};
                    *(f32x4*)(out_ + O_SVS + o) = (f32x4){fv[0], fv[1], fv[2], fv[3]}; *(f32x4*)(out_ + O_SVS + o + 4) = (f32x4){fv[4], fv[5], fv[6], fv[7]}; }
            }
            __syncthreads();
            if (F.wave == 0) {
                const int t = F.lane & 7, head = kvh * 8 + (F.lane >> 3), row = MP + b * TS + t;
                float q[64], o[64]; load_q64(((bf16*)(ws_ + WS_Z)) + (size_t)row * NINP + ZC_SQ + head * 64, q);
#pragma unroll
                for (int i = 0; i < 64; ++i) o[i] = 0.f;
                float m = sinks[head], ls = 1.0f;
                attn_core<SWA_STR, false, true>(q, Ks + t * SWA_STR, Vs + t * SWA_STR, 129, 0, BT + head * SWA_BTS + 128, m, ls, o);
                store_o64(((bf16*)(ws_ + WS_BR)) + (size_t)1 * M * MIXW + (size_t)row * MIXW + head * 64, o, 1.0f / ls);
            }
        }
    }
    __syncthreads();
}

__device__ __forceinline__ void conv_phase(const Args& A, Frame& F0, int l) {
    unsigned char* const ws_ = (unsigned char*)karg64<KA_WS>();
    float* const out_ = (float*)karg64<KA_OUT>();
    const float* const in_I_CONVW = (const float*)karg64<8 * I_CONVW>();
    const float* const in_I_SCONV = (const float*)karg64<8 * I_SCONV>();
    Frame F = F0; LAUNDER(F);
    const float* cw = in_I_CONVW + (size_t)l * 3 * MIXW;
    for (int idx = F.vcu * NTHR + F.tid; idx < M * (MIXW / 8); idx += F.G * NTHR) {
        const int row = idx >> 7, c = (idx & 127) * 8; int b, t, T; const bool smp = row >= MP;
        if (!smp) { b = row >> 12; t = row & (SEQ - 1); T = SEQ; } else { b = (row - MP) >> 3; t = (row - MP) & 7; T = TS; }
        float u[3][8];
#pragma unroll
        for (int k = 0; k < 3; ++k) {
            if (t - k >= 0) { const bf16* zr = ((bf16*)(ws_ + WS_Z)) + (size_t)(row - k) * NINP + c; float a[8], d[8]; unpack8(*(const v4u*)(zr + ZC_CC), a); unpack8(*(const v4u*)(zr + ZC_CH), d);
#pragma unroll
                for (int i = 0; i < 8; ++i) u[k][i] = a[i] * d[i]; }
            else if (smp) { const float* sp = in_I_SCONV + (((size_t)l * NBS + b) * 2 + (2 + t - k)) * MIXW + c; const f32x4 a0 = *(const f32x4*)sp, a1 = *(const f32x4*)(sp + 4);
#pragma unroll
                for (int i = 0; i < 4; ++i) { u[k][i] = a0[i]; u[k][4 + i] = a1[i]; } }
            else {
#pragma unroll
                for (int i = 0; i < 8; ++i) u[k][i] = 0.f; }
        }
        float cb[8], o[8]; unpack8(*(const v4u*)(((bf16*)(ws_ + WS_Z)) + (size_t)row * NINP + ZC_CB + c), cb);
#pragma unroll
        for (int i = 0; i < 8; ++i) o[i] = cb[i] * (cw[c + i] * u[2][i] + cw[MIXW + c + i] * u[1][i] + cw[2 * MIXW + c + i] * u[0][i]);
        *(v4u*)(((bf16*)(ws_ + WS_BR)) + (size_t)2 * M * MIXW + (size_t)row * MIXW + c) = pack8(o);
        if (t >= T - 2) { float* dst = out_ + (smp ? O_CONVS + (((size_t)l * NBS + b) * 2 + (t - (T - 2))) * MIXW : O_CONVP + (((size_t)l * NBP + b) * 2 + (t - (T - 2))) * MIXW) + c;
            *(f32x4*)dst = (f32x4){u[0][0], u[0][1], u[0][2], u[0][3]}; *(f32x4*)(dst + 4) = (f32x4){u[0][4], u[0][5], u[0][6], u[0][7]}; }
    }
}

__device__ __forceinline__ void gla_stage_wg(const Args& A, Frame& F, int l, int h, LAS float* wgs) {
    const float* const in_I_GB = (const float*)karg64<8 * I_GB>();
    const float* const in_I_GUP = (const float*)karg64<8 * I_GUP>();
    for (int i = F.tid; i < 16 * 128; i += NTHR) wgs[i] = in_I_GUP[(size_t)l * GRANK * 512 + (i >> 7) * 512 + h * 128 + (i & 127)];
    if (F.tid < 128) wgs[2048 + F.tid] = in_I_GB[l * 512 + h * 128 + F.tid];
}
__device__ __forceinline__ float gla_lg(const float (&gl)[16], LAS const float* wgs, int d) {
    float zg = wgs[2048 + d];
#pragma unroll
    for (int r = 0; r < 16; ++r) zg += gl[r] * wgs[r * 128 + d];
    return (fminf(zg, 0.f) - log1pf(__expf(-fabsf(zg)))) * (1.0f / 16.0f);
}
__device__ __forceinline__ void load_glr(const bf16* zr, float (&gl)[16]) {
    float a[8], b[8]; unpack8(*(const v4u*)zr, a); unpack8(*(const v4u*)(zr + 8), b);
#pragma unroll
    for (int i = 0; i < 8; ++i) { gl[i] = a[i]; gl[8 + i] = b[i]; }
}
__device__ __forceinline__ void gla_chunk_b(const Args& A, Frame& F, int l, int row0, int h, LAS float* bl, LAS float* wgs) {
    unsigned char* const ws_ = (unsigned char*)karg64<KA_WS>();
    gla_stage_wg(A, F, l, h, wgs);
    __syncthreads();
    { const int t = F.tid >> 3, dg = F.tid & 7; float gl[16]; load_glr(((bf16*)(ws_ + WS_Z)) + (size_t)(row0 + t) * NINP + ZC_GLR, gl);
#pragma unroll 4
      for (int dd = 0; dd < 16; ++dd) { const int d = dg * 16 + dd; bl[t * 128 + d] = gla_lg(gl, wgs, d); } }
    __syncthreads();
    if (F.tid < 128) { float a = 0.f; for (int t = 0; t < 64; ++t) { a += bl[t * 128 + F.tid]; bl[t * 128 + F.tid] = a; } }
    __syncthreads();
}

typedef short bf16x8 __attribute__((ext_vector_type(8)));
typedef short v4i16_t __attribute__((ext_vector_type(4)));
#define MFMA16(a, b, c) __builtin_amdgcn_mfma_f32_16x16x32_bf16((a), (b), (c), 0, 0, 0)
__device__ __forceinline__ bf16x8 frag_row(LAS const unsigned char* T, int stride, int r0, int k0, int lane) {
    return *(LAS const bf16x8*)(T + (r0 + (lane & 15)) * stride + (k0 + 8 * (lane >> 4)) * 2);
}
__device__ __forceinline__ bf16x8 frag_tr(LAS const unsigned char* T, int stride, int rlo, int rhi, int n0, int lane) {
    const int q = (lane & 15) >> 2, p = lane & 3;
    const v4i16_t lo = __builtin_amdgcn_ds_read_tr16_b64_v4i16((LAS v4i16_t*)(T + (rlo + q) * stride + n0 * 2 + 8 * p));
    const v4i16_t hi = __builtin_amdgcn_ds_read_tr16_b64_v4i16((LAS v4i16_t*)(T + (rhi + q) * stride + n0 * 2 + 8 * p));
    return (bf16x8){lo[0], lo[1], lo[2], lo[3], hi[0], hi[1], hi[2], hi[3]};
}
__device__ __forceinline__ bf16x8 pack_p(const f32x4 a, const f32x4 b) {
    v4u w; w.x = pk2(a[0], a[1]); w.y = pk2(a[2], a[3]); w.z = pk2(b[0], b[1]); w.w = pk2(b[2], b[3]); return __builtin_bit_cast(bf16x8, w);
}

constexpr int SW_STR = 160, SW_ROWS = 208, SW_K = 0, SW_V = SW_ROWS * SW_STR, SW_BT = 2 * SW_ROWS * SW_STR;
__device__ __forceinline__ void swa_tile(LAS const unsigned char* Ks, LAS const unsigned char* Vs, LAS const float* bt, float sink, const bf16* qrow, bf16* orow, int krow0, int kmin, bool store, int lane) {
    const int n = lane & 15, g = lane >> 4;
    bf16x8 qf[2];
#pragma unroll
    for (int ks = 0; ks < 2; ++ks) qf[ks] = *(const bf16x8*)(qrow + 32 * ks + 8 * g);
    f32x4 s[10];
#pragma unroll
    for (int mt = 0; mt < 10; ++mt) { s[mt] = (f32x4){0.f, 0.f, 0.f, 0.f};
#pragma unroll
        for (int ks = 0; ks < 2; ++ks) s[mt] = MFMA16(frag_row(Ks, SW_STR, krow0 + 16 * mt, 32 * ks, lane), qf[ks], s[mt]); }
    float mx = sink;
#pragma unroll
    for (int mt = 0; mt < 10; ++mt)
#pragma unroll
        for (int i = 0; i < 4; ++i) { const int kcol = 16 * mt + 4 * g + i, dist = n + 128 - kcol; const bool valid = (dist >= 0) && (dist <= 128) && (kcol >= kmin);
            const int di = dist < 0 ? 0 : (dist > 128 ? 128 : dist); const float v = valid ? s[mt][i] + bt[di] : -INFINITY; s[mt][i] = v; mx = fmaxf(mx, v); }
    mx = fmaxf(mx, __shfl_xor(mx, 16)); mx = fmaxf(mx, __shfl_xor(mx, 32));
    float sum = 0.f;
#pragma unroll
    for (int mt = 0; mt < 10; ++mt)
#pragma unroll
        for (int i = 0; i < 4; ++i) { const float p = __expf(s[mt][i] - mx); s[mt][i] = p; sum += p; }
    sum += __shfl_xor(sum, 16); sum += __shfl_xor(sum, 32);
    const float inv = 1.0f / (sum + __expf(sink - mx));
    f32x4 o[4];
#pragma unroll
    for (int mt = 0; mt < 4; ++mt) o[mt] = (f32x4){0.f, 0.f, 0.f, 0.f};
#pragma unroll
    for (int k2 = 0; k2 < 5; ++k2) { const bf16x8 pf = pack_p(s[2 * k2], s[2 * k2 + 1]);
#pragma unroll
        for (int mt = 0; mt < 4; ++mt) o[mt] = MFMA16(frag_tr(Vs, SW_STR, krow0 + 32 * k2 + 4 * g, krow0 + 32 * k2 + 16 + 4 * g, 16 * mt, lane), pf, o[mt]); }
    if (store) {
#pragma unroll
        for (int mt = 0; mt < 4; ++mt) { v2u w; w.x = pk2(o[mt][0] * inv, o[mt][1] * inv); w.y = pk2(o[mt][2] * inv, o[mt][3] * inv); *(v2u*)(orow + 16 * mt + 4 * g) = w; } }
}
__device__ __forceinline__ void swa_phase_mfma(const Args& A, Frame& F0, int l) {
    unsigned char* const ws_ = (unsigned char*)karg64<KA_WS>();
    float* const out_ = (float*)karg64<KA_OUT>();
    const float* const in_I_CSK = (const float*)karg64<8 * I_CSK>();
    const float* const in_I_CSV = (const float*)karg64<8 * I_CSV>();
    const float* const in_I_RELB = (const float*)karg64<8 * I_RELB>();
    const float* const in_I_SINK = (const float*)karg64<8 * I_SINK>();
    Frame F = F0; LAUNDER(F);
    LAS unsigned char* Ks = F.lds + SW_K; LAS unsigned char* Vs = F.lds + SW_V; LAS float* BT = (LAS float*)(F.lds + SW_BT);
    const bf16* Z = (const bf16*)(ws_ + WS_Z); bf16* BRB = (bf16*)(ws_ + WS_BR) + (size_t)M * MIXW;
    for (int i = F.tid; i < SH * 129; i += NTHR) { const int h = i / 129, d = i % 129; BT[h * SWA_BTS + d] = in_I_RELB[t5_bucket(d) * SH + h]; }
    const float* sinks = in_I_SINK + l * SH;
#pragma unroll 1
    for (int u = F.vcu; u < 256 + 64; u += F.G) {
        asm volatile("" : "+v"(F.tid), "+v"(F.lane));
        __syncthreads();
        if (u < 256) {
            const int b = u >> 7, kvh = (u >> 6) & 1, qb = u & 63, q0 = qb * 64;
            for (int i = F.tid; i < SW_ROWS * 8; i += NTHR) { const int r = i >> 3, c8 = i & 7, pos = q0 - 128 + r; v4u kv = (v4u){0u, 0u, 0u, 0u}, vv = kv;
                if (pos >= 0 && pos < SEQ) { const bf16* zr = Z + (size_t)(b * SEQ + pos) * NINP + kvh * 64 + c8 * 8; kv = *(const v4u*)(zr + ZC_SK); vv = *(const v4u*)(zr + ZC_SV); }
                *(LAS v4u*)(Ks + r * SW_STR + c8 * 16) = kv; *(LAS v4u*)(Vs + r * SW_STR + c8 * 16) = vv;
                if (qb == 63 && r >= 64 && r < 192) { float fk[8], fv[8]; unpack8(kv, fk); unpack8(vv, fv); const size_t o = ((((size_t)l * NBP + b) * WIN + (r - 64)) * SKV + kvh) * SHD + c8 * 8;
                    *(f32x4*)(out_ + O_SKP + o) = (f32x4){fk[0], fk[1], fk[2], fk[3]}; *(f32x4*)(out_ + O_SKP + o + 4) = (f32x4){fk[4], fk[5], fk[6], fk[7]};
                    *(f32x4*)(out_ + O_SVP + o) = (f32x4){fv[0], fv[1], fv[2], fv[3]}; *(f32x4*)(out_ + O_SVP + o + 4) = (f32x4){fv[4], fv[5], fv[6], fv[7]}; }
            }
            __syncthreads();
            const int head = kvh * 8 + F.wave; const float sink = sinks[head];
#pragma unroll 1
            for (int mq = 0; mq < 4; ++mq) {
                int ln = F.lane; asm volatile("" : "+v"(ln));
                const int t0 = q0 + 16 * mq; const size_t row = (size_t)b * SEQ + t0 + (ln & 15);
                swa_tile(Ks, Vs, BT + head * SWA_BTS, sink, Z + row * NINP + ZC_SQ + head * 64, BRB + row * MIXW + head * 64, 16 * mq, 128 - t0, true, ln);
            }
        } else {
            const int su = u - 256, b = su >> 1, kvh = su & 1;
            for (int i = F.tid; i < 160 * 8; i += NTHR) { const int r = i >> 3, c8 = i & 7; float fk[8], fv[8];
                if (r < 128) { const size_t o = ((((size_t)l * NBS + b) * WIN + r) * SKV + kvh) * SHD + c8 * 8; const f32x4 a0 = *(const f32x4*)(in_I_CSK + o), a1 = *(const f32x4*)(in_I_CSK + o + 4), b0 = *(const f32x4*)(in_I_CSV + o), b1 = *(const f32x4*)(in_I_CSV + o + 4);
#pragma unroll
                    for (int k = 0; k < 4; ++k) { fk[k] = a0[k]; fk[4 + k] = a1[k]; fv[k] = b0[k]; fv[4 + k] = b1[k]; } }
                else if (r < 136) { const bf16* zr = Z + (size_t)(MP + b * TS + (r - 128)) * NINP + kvh * 64 + c8 * 8; unpack8(*(const v4u*)(zr + ZC_SK), fk); unpack8(*(const v4u*)(zr + ZC_SV), fv); }
                else {
#pragma unroll
                    for (int k = 0; k < 8; ++k) { fk[k] = 0.f; fv[k] = 0.f; } }
                *(LAS v4u*)(Ks + r * SW_STR + c8 * 16) = pack8(fk); *(LAS v4u*)(Vs + r * SW_STR + c8 * 16) = pack8(fv);
                if (r >= 8 && r < 136) { const size_t o = ((((size_t)l * NBS + b) * WIN + (r - 8)) * SKV + kvh) * SHD + c8 * 8;
                    *(f32x4*)(out_ + O_SKS + o) = (f32x4){fk[0], fk[1], fk[2], fk[3]}; *(f32x4*)(out_ + O_SKS + o + 4) = (f32x4){fk[4], fk[5], fk[6], fk[7]};
                    *(f32x4*)(out_ + O_SVS + o) = (f32x4){fv[0], fv[1], fv[2], fv[3]}; *(f32x4*)(out_ + O_SVS + o + 4) = (f32x4){fv[4], fv[5], fv[6], fv[7]}; }
            }
            __syncthreads();
            const int head = kvh * 8 + F.wave, n = F.lane & 15; const size_t row = (size_t)MP + b * TS + (n & 7);
            swa_tile(Ks, Vs, BT + head * SWA_BTS, sinks[head], Z + row * NINP + ZC_SQ + head * 64, BRB + row * MIXW + head * 64, 0, 0, n < 8, F.lane);
        }
    }
    __syncthreads();
}

constexpr int XA_STR = 272, XA_K = 0, XA_V = 256 * XA_STR;
__device__ __forceinline__ void xattn_tile(LAS const unsigned char* Ks, LAS const unsigned char* Vs, const bf16* qrow, bf16* orow, bool store, int lane) {
    const int g = lane >> 4;
    bf16x8 qf[4];
#pragma unroll
    for (int ks = 0; ks < 4; ++ks) qf[ks] = *(const bf16x8*)(qrow + 32 * ks + 8 * g);
    f32x4 s[16]; float mx = -INFINITY;
#pragma unroll
    for (int mt = 0; mt < 16; ++mt) { s[mt] = (f32x4){0.f, 0.f, 0.f, 0.f};
#pragma unroll
        for (int ks = 0; ks < 4; ++ks) s[mt] = MFMA16(frag_row(Ks, XA_STR, 16 * mt, 32 * ks, lane), qf[ks], s[mt]);
        mx = fmaxf(mx, fmaxf(fmaxf(s[mt][0], s[mt][1]), fmaxf(s[mt][2], s[mt][3]))); }
    mx = fmaxf(mx, __shfl_xor(mx, 16)); mx = fmaxf(mx, __shfl_xor(mx, 32));
    float sum = 0.f;
#pragma unroll
    for (int mt = 0; mt < 16; ++mt)
#pragma unroll
        for (int i = 0; i < 4; ++i) { const float p = __expf(s[mt][i] - mx); s[mt][i] = p; sum += p; }
    sum += __shfl_xor(sum, 16); sum += __shfl_xor(sum, 32);
    const float inv = 1.0f / sum;
    f32x4 o[8];
#pragma unroll
    for (int mt = 0; mt < 8; ++mt) o[mt] = (f32x4){0.f, 0.f, 0.f, 0.f};
#pragma unroll
    for (int k2 = 0; k2 < 8; ++k2) { const bf16x8 pf = pack_p(s[2 * k2], s[2 * k2 + 1]);
#pragma unroll
        for (int mt = 0; mt < 8; ++mt) o[mt] = MFMA16(frag_tr(Vs, XA_STR, 32 * k2 + 4 * g, 32 * k2 + 16 + 4 * g, 16 * mt, lane), pf, o[mt]); }
    if (store) {
#pragma unroll
        for (int mt = 0; mt < 8; ++mt) { v2u w; w.x = pk2(o[mt][0] * inv, o[mt][1] * inv); w.y = pk2(o[mt][2] * inv, o[mt][3] * inv); *(v2u*)(orow + 16 * mt + 4 * g) = w; } }
}
__device__ __forceinline__ void xattn_phase_mfma(const Args& A, Frame& F0, int l) {
    unsigned char* const ws_ = (unsigned char*)karg64<KA_WS>();
    const float* const in_I_CMK = (const float*)karg64<8 * I_CMK>();
    const float* const in_I_CMV = (const float*)karg64<8 * I_CMV>();
    Frame F = F0; LAUNDER(F);
    LAS unsigned char* Ks = F.lds + XA_K; LAS unsigned char* Vs = F.lds + XA_V;
    const bf16* XQ = (const bf16*)(ws_ + WS_XQ); bf16* XO = (bf16*)(ws_ + WS_XO);
#pragma unroll 1
    for (int u = F.vcu; u < 128 + 128; u += F.G) {
        asm volatile("" : "+v"(F.tid), "+v"(F.lane));
        __syncthreads();
        if (u < 128) {
            const int b = u >> 6, h = (u >> 4) & 3, q0 = (u & 15) * 256;
            for (int i = F.tid; i < 256 * 16; i += NTHR) { const int mrow = i >> 4, c8 = i & 15; const bf16* src = (const bf16*)(ws_ + WS_MEMKV) + ((size_t)l * 512 + b * 256 + mrow) * 1024 + h * 128 + c8 * 8;
                *(LAS v4u*)(Ks + mrow * XA_STR + c8 * 16) = *(const v4u*)src; *(LAS v4u*)(Vs + mrow * XA_STR + c8 * 16) = *(const v4u*)(src + 512); }
            __syncthreads();
#pragma unroll 1
            for (int qt = F.wave; qt < 16; qt += NWAVES) { int ln = F.lane; asm volatile("" : "+v"(ln)); const size_t row = (size_t)b * SEQ + q0 + 16 * qt + (ln & 15);
                xattn_tile(Ks, Vs, XQ + row * XW + h * 128, XO + row * XW + h * 128, true, ln); }
        } else {
            const int su = u - 128, b = su >> 2, h = su & 3;
            for (int i = F.tid; i < 256 * 16; i += NTHR) { const int mrow = i >> 4, c8 = i & 15; const size_t o = (((size_t)l * NBS + b) * NMEM + mrow) * XW + h * 128 + c8 * 8; float fk[8], fv[8];
                const f32x4 a0 = *(const f32x4*)(in_I_CMK + o), a1 = *(const f32x4*)(in_I_CMK + o + 4), b0 = *(const f32x4*)(in_I_CMV + o), b1 = *(const f32x4*)(in_I_CMV + o + 4);
#pragma unroll
                for (int k = 0; k < 4; ++k) { fk[k] = a0[k]; fk[4 + k] = a1[k]; fv[k] = b0[k]; fv[4 + k] = b1[k]; }
                *(LAS v4u*)(Ks + mrow * XA_STR + c8 * 16) = pack8(fk); *(LAS v4u*)(Vs + mrow * XA_STR + c8 * 16) = pack8(fv); }
            __syncthreads();
            if (F.wave == 0) { const int n = F.lane & 15; const size_t row = (size_t)MP + b * TS + (n & 7);
                xattn_tile(Ks, Vs, XQ + row * XW + h * 128, XO + row * XW + h * 128, n < 8, F.lane); }
        }
    }
    __syncthreads();
}

__device__ __forceinline__ void gla_scan16(const bf16* Z, int row0, int lane, int wave, LAS const float* wgs, float (&bb)[16], float (&bend)[16]) {
    float gl[16]; load_glr(Z + (size_t)(row0 + lane) * NINP + ZC_GLR, gl);
#pragma unroll
    for (int dd = 0; dd < 16; ++dd) { float x = gla_lg(gl, wgs, 16 * wave + dd);
#pragma unroll
        for (int off = 1; off < 64; off <<= 1) { const float y = __shfl_up(x, off); if (lane >= off) x += y; }
        bb[dd] = x; bend[dd] = __shfl(x, 63); }
}
__device__ __forceinline__ void load16(const bf16* p, float (&f)[16]) {
    float a[8], b[8]; unpack8(*(const v4u*)p, a); unpack8(*(const v4u*)(p + 8), b);
#pragma unroll
    for (int i = 0; i < 8; ++i) { f[i] = a[i]; f[8 + i] = b[i]; }
}
__device__ __forceinline__ void store16_lds(LAS unsigned char* p, const float (&f)[16]) {
    v4u w0, w1; w0.x = pk2(f[0], f[1]); w0.y = pk2(f[2], f[3]); w0.z = pk2(f[4], f[5]); w0.w = pk2(f[6], f[7]); w1.x = pk2(f[8], f[9]); w1.y = pk2(f[10], f[11]); w1.z = pk2(f[12], f[13]); w1.w = pk2(f[14], f[15]);
    *(LAS v4u*)p = w0; *(LAS v4u*)(p + 16) = w1;
}
constexpr int G1_KSTR = 288, G1_VSTR = 544, G1_WGS = 0, G1_KT = 9216, G1_V = G1_KT + 64 * G1_KSTR;
__device__ __forceinline__ void gla_pass1_prompt_mfma(const Args& A, Frame& F, int l, int u) {
    unsigned char* const ws_ = (unsigned char*)karg64<KA_WS>();
    LAS float* wgs = (LAS float*)(F.lds + G1_WGS); LAS unsigned char* Kt = F.lds + G1_KT; LAS unsigned char* Vb = F.lds + G1_V;
    const bf16* Z = (const bf16*)(ws_ + WS_Z);
    const int bh = u >> 6, c = u & 63, b = bh >> 2, h = bh & 3, row0 = b * SEQ + c * 64, lane = F.lane, w = F.wave;
    gla_stage_wg(A, F, l, h, wgs);
#pragma unroll 2
    for (int i = F.tid; i < 64 * 32; i += NTHR) { const int t = i >> 5, c8 = i & 31; *(LAS v4u*)(Vb + t * G1_VSTR + c8 * 16) = *(const v4u*)(Z + (size_t)(row0 + t) * NINP + ZC_GV + h * 256 + c8 * 8); }
    __syncthreads();
    { float bb[16], bend[16], k[16]; gla_scan16(Z, row0, lane, w, wgs, bb, bend); load16(Z + (size_t)(row0 + lane) * NINP + ZC_GK + h * 128 + 16 * w, k);
#pragma unroll
      for (int dd = 0; dd < 16; ++dd) k[dd] *= __expf(bend[dd] - bb[dd]);
      store16_lds(Kt + lane * G1_KSTR + 32 * w, k);
      if (lane == 0) {
#pragma unroll
          for (int dd = 0; dd < 16; ++dd) ((float*)(ws_ + WS_GLAD))[(size_t)u * 128 + 16 * w + dd] = __expf(bend[dd]); } }
    __syncthreads();
    const int g = lane >> 4, n = lane & 15;
    bf16x8 af[2];
#pragma unroll
    for (int ks = 0; ks < 2; ++ks) af[ks] = frag_tr(Kt, G1_KSTR, 32 * ks + 8 * g, 32 * ks + 8 * g + 4, 16 * w, lane);
    float* U = (float*)(ws_ + WS_GLAU) + (size_t)u * GDK * GDV;
#pragma unroll 4
    for (int nt = 0; nt < 16; ++nt) { f32x4 acc = (f32x4){0.f, 0.f, 0.f, 0.f};
#pragma unroll
        for (int ks = 0; ks < 2; ++ks) acc = MFMA16(af[ks], frag_tr(Vb, G1_VSTR, 32 * ks + 8 * g, 32 * ks + 8 * g + 4, 16 * nt, lane), acc);
#pragma unroll
        for (int i = 0; i < 4; ++i) U[(size_t)(16 * w + 4 * g + i) * 256 + 16 * nt + n] = acc[i]; }
}
constexpr int G3_QSTR = 272, G3_VSTR = 528, G3_PSTR = 160, G3_QD = 0, G3_KD = 64 * G3_QSTR, G3_V = 2 * 64 * G3_QSTR, G3_S = G3_V + 64 * G3_VSTR, G3_PM = G3_S + 128 * G3_VSTR, G3_END = G3_PM + 64 * G3_PSTR;
static_assert(G3_END <= 146944 && 64 * 260 * 4 <= 128 * G3_VSTR && 8704 <= 64 * G3_PSTR, "pass-3 LDS map");
__device__ __forceinline__ void gla_pass3_mfma(const Args& A, Frame& F0, int l) {
    unsigned char* const ws_ = (unsigned char*)karg64<KA_WS>();
    const float* const in_I_GNORM = (const float*)karg64<8 * I_GNORM>();
    Frame F = F0; LAUNDER(F);
    LAS unsigned char* Qd = F.lds + G3_QD; LAS unsigned char* Kd = F.lds + G3_KD; LAS unsigned char* Vb = F.lds + G3_V; LAS unsigned char* Sb = F.lds + G3_S; LAS unsigned char* Pm = F.lds + G3_PM;
    LAS float* wgs = (LAS float*)Pm; LAS float* Of = (LAS float*)Sb;
    const bf16* Z = (const bf16*)(ws_ + WS_Z); bf16* BRA = (bf16*)(ws_ + WS_BR);
#pragma unroll 1
    for (int u = F.vcu; u < 512; u += F.G) {
        asm volatile("" : "+v"(F.tid), "+v"(F.lane));
        const int lane = F.lane, w = F.wave, g = lane >> 4, n = lane & 15;
        __syncthreads();
        const int bh = u >> 6, c = u & 63, b = bh >> 2, h = bh & 3, row0 = b * SEQ + c * 64;
        gla_stage_wg(A, F, l, h, wgs);
#pragma unroll 2
        for (int i = F.tid; i < 64 * 32; i += NTHR) { const int t = i >> 5, c8 = i & 31; *(LAS v4u*)(Vb + t * G3_VSTR + c8 * 16) = *(const v4u*)(Z + (size_t)(row0 + t) * NINP + ZC_GV + h * 256 + c8 * 8); }
        { const float* S = (const float*)(ws_ + WS_GLAU) + (size_t)u * GDK * GDV;
#pragma unroll 2
          for (int i = F.tid; i < 128 * 32; i += NTHR) { const int d = i >> 5, c8 = i & 31; const f32x4 s0 = *(const f32x4*)(S + d * 256 + c8 * 8), s1 = *(const f32x4*)(S + d * 256 + c8 * 8 + 4);
              v4u wv; wv.x = pk2(s0[0], s0[1]); wv.y = pk2(s0[2], s0[3]); wv.z = pk2(s1[0], s1[1]); wv.w = pk2(s1[2], s1[3]); *(LAS v4u*)(Sb + d * G3_VSTR + c8 * 16) = wv; } }
        __syncthreads();
        { float bb[16], bend[16], q[16], k[16]; gla_scan16(Z, row0, lane, w, wgs, bb, bend);
          load16(Z + (size_t)(row0 + lane) * NINP + ZC_GQ + h * 128 + 16 * w, q); load16(Z + (size_t)(row0 + lane) * NINP + ZC_GK + h * 128 + 16 * w, k);
#pragma unroll
          for (int dd = 0; dd < 16; ++dd) { q[dd] *= __expf(bb[dd]); k[dd] *= __expf(-bb[dd]); }
          store16_lds(Qd + lane * G3_QSTR + 32 * w, q); store16_lds(Kd + lane * G3_QSTR + 32 * w, k); }
        __syncthreads();
        {
            const int mt = w >> 1;
#pragma unroll
            for (int j = 0; j < 2; ++j) { const int nt = 2 * (w & 1) + j; f32x4 acc = (f32x4){0.f, 0.f, 0.f, 0.f};
#pragma unroll
                for (int ks = 0; ks < 4; ++ks) acc = MFMA16(frag_row(Qd, G3_QSTR, 16 * mt, 32 * ks, lane), frag_row(Kd, G3_QSTR, 16 * nt, 32 * ks, lane), acc);
#pragma unroll
                for (int i = 0; i < 4; ++i) { const int t = 16 * mt + 4 * g + i, s = 16 * nt + n; *(LAS bf16*)(Pm + t * G3_PSTR + s * 2) = (bf16)(pk2((s <= t) ? acc[i] : 0.f, 0.f) & 0xffffu); } }
        }
        __syncthreads();
        f32x4 o[4][2];
#pragma unroll
        for (int mt = 0; mt < 4; ++mt) { o[mt][0] = (f32x4){0.f, 0.f, 0.f, 0.f}; o[mt][1] = (f32x4){0.f, 0.f, 0.f, 0.f}; }
#pragma unroll
        for (int j = 0; j < 2; ++j) { const int nt = 2 * w + j;
#pragma unroll
            for (int ks = 0; ks < 4; ++ks) { const bf16x8 bf = frag_tr(Sb, G3_VSTR, 32 * ks + 8 * g, 32 * ks + 8 * g + 4, 16 * nt, lane);
#pragma unroll
                for (int mt = 0; mt < 4; ++mt) o[mt][j] = MFMA16(frag_row(Qd, G3_QSTR, 16 * mt, 32 * ks, lane), bf, o[mt][j]); }
#pragma unroll
            for (int ks = 0; ks < 2; ++ks) { const bf16x8 bf = frag_tr(Vb, G3_VSTR, 32 * ks + 8 * g, 32 * ks + 8 * g + 4, 16 * nt, lane);
#pragma unroll
                for (int mt = 0; mt < 4; ++mt) o[mt][j] = MFMA16(frag_row(Pm, G3_PSTR, 16 * mt, 32 * ks, lane), bf, o[mt][j]); } }
        __syncthreads();
#pragma unroll
        for (int mt = 0; mt < 4; ++mt)
#pragma unroll
            for (int j = 0; j < 2; ++j)
#pragma unroll
                for (int i = 0; i < 4; ++i) Of[(16 * mt + 4 * g + i) * 260 + 16 * (2 * w + j) + n] = o[mt][j][i];
        __syncthreads();
        {
            const int tb = F.tid >> 5, vb = F.tid & 31; float gn[8];
#pragma unroll
            for (int j = 0; j < 8; ++j) gn[j] = in_I_GNORM[l * GDV + 8 * vb + j];
#pragma unroll
            for (int i = 0; i < 4; ++i) { const int t = 4 * tb + i; const f32x4 o0 = *(LAS const f32x4*)(Of + t * 260 + 8 * vb), o1 = *(LAS const f32x4*)(Of + t * 260 + 8 * vb + 4);
                float ov[8] = {o0[0], o0[1], o0[2], o0[3], o1[0], o1[1], o1[2], o1[3]}; float ss = 0.f;
#pragma unroll
                for (int j = 0; j < 8; ++j) ss += ov[j] * ov[j];
#pragma unroll
                for (int x = 1; x < 32; x <<= 1) ss += __shfl_xor(ss, x);
                const float rs = rsqrtf(ss * (1.0f / 256.0f) + EPS); const int row = row0 + t; float gv[8], r[8]; unpack8(*(const v4u*)(Z + (size_t)row * NINP + ZC_GR + h * 256 + 8 * vb), gv);
#pragma unroll
                for (int j = 0; j < 8; ++j) r[j] = ov[j] * rs * gn[j] * gv[j] * sigm(gv[j]);
                *(v4u*)(BRA + (size_t)row * MIXW + h * 256 + 8 * vb) = pack8(r); }
        }
    }
    __syncthreads();
}
__device__ __forceinline__ void gla_pass1(const Args& A, Frame& F0, int l) {
    unsigned char* const ws_ = (unsigned char*)karg64<KA_WS>();
    float* const out_ = (float*)karg64<KA_OUT>();
    const float* const in_I_GNORM = (const float*)karg64<8 * I_GNORM>();
    const float* const in_I_SGLA = (const float*)karg64<8 * I_SGLA>();
    Frame F = F0; LAUNDER(F);
    LAS float* bl = (LAS float*)(F.lds); LAS float* kt = (LAS float*)(F.lds + 32768); LAS float* wgs = (LAS float*)(F.lds + 65536);
#pragma unroll 1
    for (int u = F.vcu; u < 512 + 128; u += F.G) {
        asm volatile("" : "+v"(F.tid), "+v"(F.lane));
        __syncthreads();
        if (u < 512) {
            gla_pass1_prompt_mfma(A, F, l, u);
        } else {
            const int su = u - 512, b = su >> 2, h = su & 3, row0 = MP + b * TS;
            LAS float* qs = (LAS float*)(F.lds); LAS float* ks = qs + 1024; LAS float* es = qs + 2048; LAS float* vs = qs + 3072; LAS float* red = qs + 5120;
            gla_stage_wg(A, F, l, h, wgs);
            __syncthreads();
            { const int t = F.tid >> 6, dp = F.tid & 63; float gl[16]; load_glr(((bf16*)(ws_ + WS_Z)) + (size_t)(row0 + t) * NINP + ZC_GLR, gl);
              es[t * 128 + 2 * dp] = __expf(gla_lg(gl, wgs, 2 * dp)); es[t * 128 + 2 * dp + 1] = __expf(gla_lg(gl, wgs, 2 * dp + 1)); }
            for (int i = F.tid; i < 8 * 128; i += NTHR) { const int t = i >> 7, d = i & 127; const bf16* zr = ((bf16*)(ws_ + WS_Z)) + (size_t)(row0 + t) * NINP + h * 128 + d; qs[i] = bf1(zr[ZC_GQ]); ks[i] = bf1(zr[ZC_GK]); }
            for (int i = F.tid; i < 8 * 256; i += NTHR) { const int t = i >> 8, v = i & 255; vs[i] = bf1(((bf16*)(ws_ + WS_Z))[(size_t)(row0 + t) * NINP + ZC_GV + h * 256 + v]); }
            __syncthreads();
            const int v = F.tid & 255, half = F.tid >> 8; const size_t sidx = (((size_t)l * NBS + b) * GH + h) * GDK * GDV;
            const float* S0 = in_I_SGLA + sidx + (size_t)(64 * half) * 256 + v;
            float S[64];
#pragma unroll
            for (int i = 0; i < 64; ++i) S[i] = S0[i * 256];
            for (int t = 0; t < 8; ++t) { const float vv = vs[t * 256 + v]; float part = 0.f;
#pragma unroll
                for (int i = 0; i < 64; ++i) { const int d = 64 * half + i; S[i] = es[t * 128 + d] * S[i] + ks[t * 128 + d] * vv; part += qs[t * 128 + d] * S[i]; }
                red[(t * 2 + half) * 256 + v] = part; }
            float* So = out_ + O_GLAS + sidx + (size_t)(64 * half) * 256 + v;
#pragma unroll
            for (int i = 0; i < 64; ++i) So[i * 256] = S[i];
            __syncthreads();
            { const int t = F.wave, row = row0 + t; float o[4]; float ss = 0.f;
#pragma unroll
              for (int k = 0; k < 4; ++k) { const int vv = F.lane + 64 * k; o[k] = red[(t * 2) * 256 + vv] + red[(t * 2 + 1) * 256 + vv]; ss += o[k] * o[k]; }
              ss = wave_sum(ss); const float rs = rsqrtf(ss * (1.0f / 256.0f) + EPS);
#pragma unroll
              for (int k = 0; k < 4; ++k) { const int vv = F.lane + 64 * k; const float g = bf1(((bf16*)(ws_ + WS_Z))[(size_t)row * NINP + ZC_GR + h * 256 + vv]);
                  ((bf16*)(ws_ + WS_BR))[(size_t)row * MIXW + h * 256 + vv] = (bf16)(pk2(o[k] * rs * in_I_GNORM[l * GDV + vv] * g * sigm(g), 0.f) & 0xffffu); } }
        }
    }
    __syncthreads();
}
__device__ __forceinline__ void gla_pass2(const Args& A, Frame& F0, int l) {
    unsigned char* const ws_ = (unsigned char*)karg64<KA_WS>();
    float* const out_ = (float*)karg64<KA_OUT>();
    Frame F = F0; LAUNDER(F);
    for (int e = F.vcu * NTHR + F.tid; e < 8 * GDK * GDV; e += F.G * NTHR) {
        const int bh = e >> 15, dv = e & 32767, d = dv >> 8;
        float* U = ((float*)(ws_ + WS_GLAU)) + (size_t)bh * 64 * GDK * GDV + dv; const float* D = ((float*)(ws_ + WS_GLAD)) + (size_t)bh * 64 * 128 + d;
        float S = 0.f;
        for (int c0 = 0; c0 < 64; c0 += 8) { float uu[8], dd[8];
#pragma unroll
            for (int k = 0; k < 8; ++k) { uu[k] = U[(size_t)(c0 + k) * GDK * GDV]; dd[k] = D[(c0 + k) * 128]; }
#pragma unroll
            for (int k = 0; k < 8; ++k) { U[(size_t)(c0 + k) * GDK * GDV] = S; S = dd[k] * S + uu[k]; } }
        out_[O_GLAP + ((size_t)l * 8 + bh) * GDK * GDV + dv] = S;
    }
}
__device__ __forceinline__ void gla_pass3(const Args& A, Frame& F0, int l) {
    unsigned char* const ws_ = (unsigned char*)karg64<KA_WS>();
    const float* const in_I_GNORM = (const float*)karg64<8 * I_GNORM>();
    Frame F = F0; LAUNDER(F);
    LAS float* bl = (LAS float*)(F.lds); LAS float* qdT = (LAS float*)(F.lds + 32768); LAS float* kdT = (LAS float*)(F.lds + 67584); LAS float* Am = (LAS float*)(F.lds + 102400); LAS float* wgs = (LAS float*)(F.lds + 119808);
    for (int u = F.vcu; u < 512; u += F.G) {
        __syncthreads();
        const int bh = u >> 6, c = u & 63, b = bh >> 2, h = bh & 3, row0 = b * SEQ + c * 64;
        gla_chunk_b(A, F, l, row0, h, bl, wgs);
        { const int t = F.tid & 63, dg = F.tid >> 6; const bf16* zr = ((bf16*)(ws_ + WS_Z)) + (size_t)(row0 + t) * NINP + h * 128 + dg * 16; float q[16], k[16];
          { float a[8], bb[8]; unpack8(*(const v4u*)(zr + ZC_GQ), a); unpack8(*(const v4u*)(zr + ZC_GQ + 8), bb);
#pragma unroll
            for (int i = 0; i < 8; ++i) { q[i] = a[i]; q[8 + i] = bb[i]; }
            unpack8(*(const v4u*)(zr + ZC_GK), a); unpack8(*(const v4u*)(zr + ZC_GK + 8), bb);
#pragma unroll
            for (int i = 0; i < 8; ++i) { k[i] = a[i]; k[8 + i] = bb[i]; } }
#pragma unroll
          for (int i = 0; i < 16; ++i) { const int d = dg * 16 + i; const float bb = bl[t * 128 + d]; qdT[d * 68 + t] = q[i] * __expf(bb); kdT[d * 68 + t] = k[i] * __expf(-bb); } }
        __syncthreads();
        const int tb = F.tid >> 5, vb = F.tid & 31;
        {
            float a[4][2];
#pragma unroll
            for (int i = 0; i < 4; ++i) { a[i][0] = 0.f; a[i][1] = 0.f; }
            for (int d = 0; d < 128; ++d) { const f32x4 qq = *(LAS const f32x4*)(qdT + d * 68 + 4 * tb); const f32x2 kk = *(LAS const f32x2*)(kdT + d * 68 + 2 * vb);
#pragma unroll
                for (int i = 0; i < 4; ++i) { a[i][0] += qq[i] * kk[0]; a[i][1] += qq[i] * kk[1]; } }
#pragma unroll
            for (int i = 0; i < 4; ++i)
#pragma unroll
                for (int j = 0; j < 2; ++j) { const int t = 4 * tb + i, s = 2 * vb + j; Am[s * 68 + t] = (s <= t) ? a[i][j] : 0.f; }
        }
        float o[4][8];
#pragma unroll
        for (int i = 0; i < 4; ++i)
#pragma unroll
            for (int j = 0; j < 8; ++j) o[i][j] = 0.f;
        { const float* S = ((float*)(ws_ + WS_GLAU)) + (size_t)u * GDK * GDV + 8 * vb;
          for (int d = 0; d < 128; ++d) { const f32x4 qq = *(LAS const f32x4*)(qdT + d * 68 + 4 * tb); const f32x4 s0 = *(const f32x4*)(S + d * 256), s1 = *(const f32x4*)(S + d * 256 + 4);
#pragma unroll
              for (int i = 0; i < 4; ++i)
#pragma unroll
                  for (int j = 0; j < 4; ++j) { o[i][j] += qq[i] * s0[j]; o[i][4 + j] += qq[i] * s1[j]; } } }
        __syncthreads();
        for (int s = 0; s < 64; ++s) { const f32x4 aa = *(LAS const f32x4*)(Am + s * 68 + 4 * tb); float vv[8]; unpack8(*(const v4u*)(((bf16*)(ws_ + WS_Z)) + (size_t)(row0 + s) * NINP + ZC_GV + h * 256 + 8 * vb), vv);
#pragma unroll
            for (int i = 0; i < 4; ++i)
#pragma unroll
                for (int j = 0; j < 8; ++j) o[i][j] += aa[i] * vv[j]; }
        float gn[8];
#pragma unroll
        for (int j = 0; j < 8; ++j) gn[j] = in_I_GNORM[l * GDV + 8 * vb + j];
#pragma unroll
        for (int i = 0; i < 4; ++i) { float ss = 0.f;
#pragma unroll
            for (int j = 0; j < 8; ++j) ss += o[i][j] * o[i][j];
#pragma unroll
            for (int x = 1; x < 32; x <<= 1) ss += __shfl_xor(ss, x);
            const float rs = rsqrtf(ss * (1.0f / 256.0f) + EPS); const int row = row0 + 4 * tb + i; float g[8], r[8]; unpack8(*(const v4u*)(((bf16*)(ws_ + WS_Z)) + (size_t)row * NINP + ZC_GR + h * 256 + 8 * vb), g);
#pragma unroll
            for (int j = 0; j < 8; ++j) r[j] = o[i][j] * rs * gn[j] * g[j] * sigm(g[j]);
            *(v4u*)(((bf16*)(ws_ + WS_BR)) + (size_t)row * MIXW + h * 256 + 8 * vb) = pack8(r); }
    }
    __syncthreads();
}

__device__ __forceinline__ void xattn_phase(const Args& A, Frame& F0, int l) {
    unsigned char* const ws_ = (unsigned char*)karg64<KA_WS>();
    const float* const in_I_CMK = (const float*)karg64<8 * I_CMK>();
    const float* const in_I_CMV = (const float*)karg64<8 * I_CMV>();
    Frame F = F0; LAUNDER(F);
    LAS unsigned char* Ks = F.lds; LAS unsigned char* Vs = F.lds + 65536;
    for (int u = F.vcu; u < 128 + 128; u += F.G) {
        __syncthreads();
        if (u < 128) {
            const int b = u >> 6, h = (u >> 4) & 3, q0 = (u & 15) * 256;
            for (int i = F.tid; i < 256 * 16; i += NTHR) { const int mrow = i >> 4, c8 = i & 15; const bf16* src = ((bf16*)(ws_ + WS_MEMKV)) + ((size_t)l * 512 + b * 256 + mrow) * 1024 + h * 128 + c8 * 8;
                *(LAS v4u*)(Ks + mrow * 256 + c8 * 16) = *(const v4u*)src; *(LAS v4u*)(Vs + mrow * 256 + c8 * 16) = *(const v4u*)(src + 512); }
            __syncthreads();
            const int qi = F.tid >> 1, half = F.tid & 1, row = b * SEQ + q0 + qi;
            float q[64], o[64]; load_q64(((bf16*)(ws_ + WS_XQ)) + (size_t)row * XW + h * 128 + 64 * half, q);
#pragma unroll
            for (int i = 0; i < 64; ++i) o[i] = 0.f;
            float m = -INFINITY, ls = 0.f;
            attn_core<256, true, false>(q, Ks + half * 128, Vs + half * 128, 256, 0, nullptr, m, ls, o);
            store_o64(((bf16*)(ws_ + WS_XO)) + (size_t)row * XW + h * 128 + 64 * half, o, 1.0f / ls);
        } else {
            const int su = u - 128, b = su >> 2, h = su & 3;
            for (int i = F.tid; i < 256 * 16; i += NTHR) { const int mrow = i >> 4, c8 = i & 15; const size_t o = (((size_t)l * NBS + b) * NMEM + mrow) * XW + h * 128 + c8 * 8; float fk[8], fv[8];
                const f32x4 a0 = *(const f32x4*)(in_I_CMK + o), a1 = *(const f32x4*)(in_I_CMK + o + 4), b0 = *(const f32x4*)(in_I_CMV + o), b1 = *(const f32x4*)(in_I_CMV + o + 4);
#pragma unroll
                for (int k = 0; k < 4; ++k) { fk[k] = a0[k]; fk[4 + k] = a1[k]; fv[k] = b0[k]; fv[4 + k] = b1[k]; }
                *(LAS v4u*)(Ks + mrow * 256 + c8 * 16) = pack8(fk); *(LAS v4u*)(Vs + mrow * 256 + c8 * 16) = pack8(fv); }
            __syncthreads();
            if (F.tid < 16) {
                const int qi = F.tid >> 1, half = F.tid & 1, row = MP + b * TS + qi;
                float q[64], o[64]; load_q64(((bf16*)(ws_ + WS_XQ)) + (size_t)row * XW + h * 128 + 64 * half, q);
#pragma unroll
                for (int i = 0; i < 64; ++i) o[i] = 0.f;
                float m = -INFINITY, ls = 0.f;
                attn_core<256, true, false>(q, Ks + half * 128, Vs + half * 128, 256, 0, nullptr, m, ls, o);
                store_o64(((bf16*)(ws_ + WS_XO)) + (size_t)row * XW + h * 128 + 64 * half, o, 1.0f / ls);
            }
        }
    }
    __syncthreads();
}

__device__ __forceinline__ void ffnact_phase(const Args& A, Frame& F0, int l) {
    unsigned char* const ws_ = (unsigned char*)karg64<KA_WS>();
    float* const out_ = (float*)karg64<KA_OUT>();
    const float* const in_I_FCB = (const float*)karg64<8 * I_FCB>();
    const float* const in_I_FCW = (const float*)karg64<8 * I_FCW>();
    const float* const in_I_SFFN = (const float*)karg64<8 * I_SFFN>();
    Frame F = F0; LAUNDER(F);
    const float* cw = in_I_FCW + (size_t)l * 3 * DFF; const float* cbv = in_I_FCB + (size_t)l * DFF;
    constexpr int NG = DFF / 8;
    for (int idx = F.vcu * NTHR + F.tid; idx < M * NG; idx += F.G * NTHR) {
        const int row = idx / NG, c = (idx % NG) * 8; int b, t, T; const bool smp = row >= MP;
        if (!smp) { b = row >> 12; t = row & (SEQ - 1); T = SEQ; } else { b = (row - MP) >> 3; t = (row - MP) & 7; T = TS; }
        float g[3][8];
#pragma unroll
        for (int k = 0; k < 3; ++k) {
            if (t - k >= 0) unpack8(*(const v4u*)(((bf16*)(ws_ + WS_UG)) + (size_t)(row - k) * 2 * DFF + DFF + c), g[k]);
            else if (smp) { const float* sp = in_I_SFFN + (((size_t)l * NBS + b) * 2 + (2 + t - k)) * DFF + c; const f32x4 a0 = *(const f32x4*)sp, a1 = *(const f32x4*)(sp + 4);
#pragma unroll
                for (int i = 0; i < 4; ++i) { g[k][i] = a0[i]; g[k][4 + i] = a1[i]; } }
            else {
#pragma unroll
                for (int i = 0; i < 8; ++i) g[k][i] = 0.f; }
        }
        float uu[8], o[8]; unpack8(*(const v4u*)(((bf16*)(ws_ + WS_UG)) + (size_t)row * 2 * DFF + c), uu);
#pragma unroll
        for (int i = 0; i < 8; ++i) { const float gc = cw[c + i] * g[2][i] + cw[DFF + c + i] * g[1][i] + cw[2 * DFF + c + i] * g[0][i] + cbv[c + i]; o[i] = gc * sigm(gc) * uu[i]; }
        *(v4u*)(((bf16*)(ws_ + WS_ACT)) + (size_t)row * DFF + c) = pack8(o);
        if (t >= T - 2) { float* dst = out_ + (smp ? O_FFNS + (((size_t)l * NBS + b) * 2 + (t - (T - 2))) * DFF : O_FFNP + (((size_t)l * NBP + b) * 2 + (t - (T - 2))) * DFF) + c;
            *(f32x4*)dst = (f32x4){g[0][0], g[0][1], g[0][2], g[0][3]}; *(f32x4*)(dst + 4) = (f32x4){g[0][4], g[0][5], g[0][6], g[0][7]}; }
    }
}

__device__ __forceinline__ void final_phase(const Args& A, Frame& F0) {
    unsigned char* const ws_ = (unsigned char*)karg64<KA_WS>();
    float* const out_ = (float*)karg64<KA_OUT>();
    const float* const in_I_NFIN = (const float*)karg64<8 * I_NFIN>();
    Frame F = F0; LAUNDER(F);
    const int gw = F.vcu * NWAVES + F.wave, NGW = F.G * NWAVES, lane = F.lane; const float* g = in_I_NFIN;
    for (int m = gw; m < M; m += NGW) {
        float s = (lane < 32) ? ((float*)(ws_ + WS_SSQ))[(size_t)m * 32 + lane] : 0.f; s = wave_sum(s);
        const float rs = rsqrtf(s * (1.0f / DM) + EPS);
        float* dst = out_ + ((m < MP) ? O_YP + (size_t)m * DM : O_YS + (size_t)(m - MP) * DM);
#pragma unroll
        for (int j = 0; j < 8; ++j) { const f32x4 v = *((const f32x4*)(((float*)(ws_ + WS_X)) + (size_t)m * DM) + lane + 64 * j); const f32x4 gg = *((const f32x4*)g + lane + 64 * j); *((f32x4*)dst + lane + 64 * j) = v * rs * gg; }
    }
}

__device__ __forceinline__ f32x4 sk_tile(const bf16* A, const bf16* Bt, int K, int rb, int cb, LAS float* red, int tid, int lane, int wave) {
    const int n = lane & 15, g = lane >> 4, npairs = K >> 6;
    f32x4 acc[2][4];
#pragma unroll
    for (int mt = 0; mt < 2; ++mt)
#pragma unroll
        for (int nt = 0; nt < 4; ++nt) acc[mt][nt] = (f32x4){0.f, 0.f, 0.f, 0.f};
    const bf16* ap = A + (size_t)(32 * rb + n) * K + 8 * g; const bf16* bp = Bt + (size_t)(64 * cb + n) * K + 8 * g;
#pragma unroll 2
    for (int p = wave; p < npairs; p += NWAVES) {
        bf16x8 af[2][2], bfr[4][2];
#pragma unroll
        for (int ks = 0; ks < 2; ++ks) {
#pragma unroll
            for (int mt = 0; mt < 2; ++mt) af[mt][ks] = *(const bf16x8*)(ap + (size_t)(16 * mt) * K + 64 * p + 32 * ks);
#pragma unroll
            for (int nt = 0; nt < 4; ++nt) bfr[nt][ks] = *(const bf16x8*)(bp + (size_t)(16 * nt) * K + 64 * p + 32 * ks); }
#pragma unroll
        for (int ks = 0; ks < 2; ++ks)
#pragma unroll
            for (int mt = 0; mt < 2; ++mt)
#pragma unroll
                for (int nt = 0; nt < 4; ++nt) acc[mt][nt] = MFMA16(af[mt][ks], bfr[nt][ks], acc[mt][nt]);
    }
    __syncthreads();
#pragma unroll
    for (int mt = 0; mt < 2; ++mt)
#pragma unroll
        for (int nt = 0; nt < 4; ++nt)
#pragma unroll
            for (int i = 0; i < 4; ++i) red[wave * 2048 + (16 * mt + 4 * g + i) * 64 + 16 * nt + n] = acc[mt][nt][i];
    __syncthreads();
    const int r = tid >> 4, cg = tid & 15; f32x4 s = *(LAS const f32x4*)(red + r * 64 + 4 * cg);
#pragma unroll
    for (int w = 1; w < 8; ++w) s += *(LAS const f32x4*)(red + w * 2048 + r * 64 + 4 * cg);
    return s;
}
__device__ __forceinline__ void sk_residual(const bf16* A, const bf16* Bt, int K, Frame& F0) {
    Frame F = F0; LAUNDER(F);
    unsigned char* const ws_ = (unsigned char*)karg64<KA_WS>();
    float* X = (float*)(ws_ + WS_X); bf16* XB = (bf16*)(ws_ + WS_XB); float* SSQ = (float*)(ws_ + WS_SSQ);
    LAS float* red = (LAS float*)F.lds;
#pragma unroll 1
    for (int u = F.vcu; u < 256; u += F.G) {
        asm volatile("" : "+v"(F.tid), "+v"(F.lane));
        const int rb = u >> 5, cb = u & 31;
        const f32x4 s = sk_tile(A, Bt, K, rb, cb, red, F.tid, F.lane, F.wave);
        const int row = MP + 32 * rb + (F.tid >> 4), col = 64 * cb + 4 * (F.tid & 15); const size_t off = (size_t)row * DM + col;
        const f32x4 x = *(const f32x4*)(X + off) + s; *(f32x4*)(X + off) = x;
        v2u w; w.x = pk2(x[0], x[1]); w.y = pk2(x[2], x[3]); *(v2u*)(XB + off) = w;
        float ss = (x[0] * x[0] + x[1] * x[1]) + (x[2] * x[2] + x[3] * x[3]);
        ss += __shfl_xor(ss, 1); ss += __shfl_xor(ss, 2); ss += __shfl_xor(ss, 4); ss += __shfl_xor(ss, 8);
        if ((F.tid & 15) == 0) SSQ[(size_t)row * 32 + cb] = ss;
    }
    __syncthreads();
}
__device__ __forceinline__ void sk_branch(Frame& F0, int l) {
    Frame F = F0; LAUNDER(F);
    unsigned char* const ws_ = (unsigned char*)karg64<KA_WS>();
    const bf16* BR = (const bf16*)(ws_ + WS_BR); const bf16* Wb = (const bf16*)(ws_ + WS_WBR) + (size_t)l * 3 * DM * MIXW; const bf16* Z = (const bf16*)(ws_ + WS_Z); bf16* MG = (bf16*)(ws_ + WS_MG);
    LAS float* red = (LAS float*)F.lds;
#pragma unroll 1
    for (int u = F.vcu; u < 256; u += F.G) {
        asm volatile("" : "+v"(F.tid), "+v"(F.lane));
        const int rb = u >> 5, cb = u & 31; const int row = MP + 32 * rb + (F.tid >> 4), col = 64 * cb + 4 * (F.tid & 15);
        f32x4 mg = (f32x4){0.f, 0.f, 0.f, 0.f};
#pragma unroll 1
        for (int i = 0; i < 3; ++i) {
            const f32x4 s = sk_tile(BR + (size_t)i * M * MIXW + (size_t)MP * MIXW, Wb + (size_t)i * DM * MIXW, MIXW, rb, cb, red, F.tid, F.lane, F.wave);
            const v2u gw = *(const v2u*)(Z + (size_t)row * NINP + ZC_GATE + i * DM + col);
            mg += s * (f32x4){bflo(gw.x), bfhi(gw.x), bflo(gw.y), bfhi(gw.y)};
        }
        v2u w; w.x = pk2(mg[0], mg[1]); w.y = pk2(mg[2], mg[3]); *(v2u*)(MG + (size_t)row * DM + col) = w;
    }
    __syncthreads();
}

#ifndef PH_MASK
#define PH_MASK 0xffffffffu
#endif
#define PON(i) constexpr ((PH_MASK >> (i)) & 1u) for (int rep_ = 0; rep_ <= (int)((PROBE_MASK >> (i)) & 1u); ++rep_)
#ifndef PROBE_MASK
#define PROBE_MASK 0u
#endif
#ifndef USE_MFMA
#define USE_MFMA 7
#endif
#ifndef MK_PER_PHASE
#define MK_PER_PHASE 0
#endif
constexpr int PH_PER_LAYER = 12, N_PHASES = 2 + DEPTH * PH_PER_LAYER + 1;

__global__ void __launch_bounds__(NTHR, 2) fwd(const Args A) {
    extern __shared__ __attribute__((aligned(16))) unsigned char lds[];
    Frame F;
    F.lds = (LAS unsigned char*)lds;
    F.MISC = (volatile LAS unsigned*)(F.lds + MISC_OFF);
    F.wave = __builtin_amdgcn_readfirstlane((int)threadIdx.x >> 6); F.lane = 0; F.tid = 0;
    F.G = gridDim.x; { const int bx = blockIdx.x; F.vcu = (F.G % 8 == 0) ? (bx % 8) * (F.G / 8) + bx / 8 : bx; }
    F.ctl = (gu32*)(((unsigned char*)karg64<KA_WS>()) + WS_CTL);
    for (int u = F.wave * 64 + lane_id(); u < (LDS_BYTES - LDSCTL_OFF) / 4; u += NTHR) ((LAS unsigned*)(F.lds + LDSCTL_OFF))[u] = 0u;
    __syncthreads();
    XcdBarrier bar; bar.bar = (unsigned*)(F.ctl + CW_BAR); bar.x = 0; bar.st = nullptr; bar.wv = (unsigned)F.wave;
    if (!MK_PER_PHASE) bar = xcd_barrier_post((unsigned*)(F.ctl + CW_BAR), F.MISC + 8, (unsigned)F.wave);
    const int lo = karg32<KA_LO>(), hi = karg32<KA_HI>();
#define IN(k) (lo <= (k) && (k) < hi)
#define SEAM(k) do { if (IN(k) && IN((k) + 1)) xcd_barrier(bar); } while (0)
    typedef pg8::StaticOrder SO;
#define BX_ launder_s((int)blockIdx.x)
#define G_ launder_s(F.G)
    LAS unsigned char* ring = F.lds + RING_OFF;

    if (IN(0)) { if PON(0) p0_convert(A, F); }
    SEAM(0);
    if (IN(1)) { if PON(1)
        for (int l = 0; l < DEPTH; ++l) {
            pg8::Gemm g{((bf16*)(((unsigned char*)karg64<KA_WS>()) + WS_MEMB)), ((bf16*)(((unsigned char*)karg64<KA_WS>()) + WS_WXKV)) + (size_t)l * 2 * XW * DM, NBP * NMEM, 2 * XW, DM}; SO S; S.init(NBP * NMEM, 2 * XW, G_, (int)((BX_ + G_ - 8 * l) % G_));
            pg8::EpiMemKV E{((float*)karg64<KA_OUT>()) + O_MKP + (size_t)l * NBP * NMEM * XW, ((float*)karg64<KA_OUT>()) + O_MVP + (size_t)l * NBP * NMEM * XW, ((bf16*)(((unsigned char*)karg64<KA_WS>()) + WS_MEMKV)) + (size_t)l * NBP * NMEM * 2 * XW};
            pg8::gemm_phase<pg8::EpiMemKV, SO, true, true>(ring, g, S, E, F.wave * 64 + lane_id());
        }
    }
    SEAM(1);
    for (int l = 0; l < DEPTH; ++l) {
        const int pb = 2 + l * PH_PER_LAYER;
        if (IN(pb + 0)) { if PON(2) {
            pg8::Gemm g{((bf16*)(((unsigned char*)karg64<KA_WS>()) + WS_XB)), ((bf16*)(((unsigned char*)karg64<KA_WS>()) + WS_WIN)) + (size_t)l * NINP * DM, M, NINP, DM}; SO S; S.init(M, NINP, G_, BX_);
            pg8::EpiScaleBf16 E{((bf16*)(((unsigned char*)karg64<KA_WS>()) + WS_Z)), NINP, ((float*)(((unsigned char*)karg64<KA_WS>()) + WS_SSQ)), ZC_GATE / 256, ZC_GLR / 256};
            pg8::gemm_phase<pg8::EpiScaleBf16, SO, true, true>(ring, g, S, E, F.wave * 64 + lane_id());
        } }
        SEAM(pb + 0);
        if (IN(pb + 1)) { if PON(3) conv_phase(A, F, l); if PON(4) { if (USE_MFMA & 1) swa_phase_mfma(A, F, l); else swa_phase(A, F, l); } if PON(5) gla_pass1(A, F, l); }
        SEAM(pb + 1);
        if (IN(pb + 2)) { if PON(6) gla_pass2(A, F, l); }
        SEAM(pb + 2);
        if (IN(pb + 3)) { if PON(7) { if (USE_MFMA & 2) gla_pass3_mfma(A, F, l); else gla_pass3(A, F, l); } }
        SEAM(pb + 3);
        if (IN(pb + 4)) { if PON(8) {
            for (int i = 0; i < 3; ++i) {
                pg8::Gemm g{((bf16*)(((unsigned char*)karg64<KA_WS>()) + WS_BR)) + (size_t)i * M * MIXW, ((bf16*)(((unsigned char*)karg64<KA_WS>()) + WS_WBR)) + ((size_t)l * 3 + i) * DM * MIXW, MP, DM, MIXW}; SO S; S.init(MP, DM, G_, BX_);
                pg8::EpiBranch E{((bf16*)(((unsigned char*)karg64<KA_WS>()) + WS_MG)), ((bf16*)(((unsigned char*)karg64<KA_WS>()) + WS_Z)) + ZC_GATE + i * DM, NINP, i == 0 ? 1 : 0};
                pg8::gemm_phase<pg8::EpiBranch, SO, true, true>(ring, g, S, E, F.wave * 64 + lane_id());
            }
            sk_branch(F, l);
        } }
        SEAM(pb + 4);
        if (IN(pb + 5)) { if PON(9) {
            pg8::Gemm g{((bf16*)(((unsigned char*)karg64<KA_WS>()) + WS_MG)), ((bf16*)(((unsigned char*)karg64<KA_WS>()) + WS_WOUT)) + (size_t)l * DM * DM, MP, DM, DM}; SO S; S.init(MP, DM, G_, BX_);
            pg8::EpiResidual E{((float*)(((unsigned char*)karg64<KA_WS>()) + WS_X)), ((bf16*)(((unsigned char*)karg64<KA_WS>()) + WS_XB)), ((float*)(((unsigned char*)karg64<KA_WS>()) + WS_SSQ))};
            pg8::gemm_phase<pg8::EpiResidual, SO, true, true>(ring, g, S, E, F.wave * 64 + lane_id());
            sk_residual(((const bf16*)(((unsigned char*)karg64<KA_WS>()) + WS_MG)) + (size_t)MP * DM, ((const bf16*)(((unsigned char*)karg64<KA_WS>()) + WS_WOUT)) + (size_t)l * DM * DM, DM, F);
        } }
        SEAM(pb + 5);
        if (IN(pb + 6)) { if PON(10) {
            pg8::Gemm g{((bf16*)(((unsigned char*)karg64<KA_WS>()) + WS_XB)), ((bf16*)(((unsigned char*)karg64<KA_WS>()) + WS_WXQ)) + (size_t)l * XW * DM, M, XW, DM}; SO S; S.init(M, XW, G_, BX_);
            pg8::EpiScaleBf16 E{((bf16*)(((unsigned char*)karg64<KA_WS>()) + WS_XQ)), XW, ((float*)(((unsigned char*)karg64<KA_WS>()) + WS_SSQ)), 0, 0};
            pg8::gemm_phase<pg8::EpiScaleBf16, SO, true, true>(ring, g, S, E, F.wave * 64 + lane_id());
        } }
        SEAM(pb + 6);
        if (IN(pb + 7)) { if PON(11) { if (USE_MFMA & 4) xattn_phase_mfma(A, F, l); else xattn_phase(A, F, l); } }
        SEAM(pb + 7);
        if (IN(pb + 8)) { if PON(12) {
            pg8::Gemm g{((bf16*)(((unsigned char*)karg64<KA_WS>()) + WS_XO)), ((bf16*)(((unsigned char*)karg64<KA_WS>()) + WS_WXO)) + (size_t)l * DM * XW, MP, DM, XW}; SO S; S.init(MP, DM, G_, BX_);
            pg8::EpiResidual E{((float*)(((unsigned char*)karg64<KA_WS>()) + WS_X)), ((bf16*)(((unsigned char*)karg64<KA_WS>()) + WS_XB)), ((float*)(((unsigned char*)karg64<KA_WS>()) + WS_SSQ))};
            pg8::gemm_phase<pg8::EpiResidual, SO, true, true>(ring, g, S, E, F.wave * 64 + lane_id());
            sk_residual(((const bf16*)(((unsigned char*)karg64<KA_WS>()) + WS_XO)) + (size_t)MP * XW, ((const bf16*)(((unsigned char*)karg64<KA_WS>()) + WS_WXO)) + (size_t)l * DM * XW, XW, F);
        } }
        SEAM(pb + 8);
        if (IN(pb + 9)) { if PON(13) {
            pg8::Gemm g{((bf16*)(((unsigned char*)karg64<KA_WS>()) + WS_XB)), ((bf16*)(((unsigned char*)karg64<KA_WS>()) + WS_WUP)) + (size_t)l * 2 * DFF * DM, M, 2 * DFF, DM}; SO S; S.init(M, 2 * DFF, G_, BX_);
            pg8::EpiScaleBf16 E{((bf16*)(((unsigned char*)karg64<KA_WS>()) + WS_UG)), 2 * DFF, ((float*)(((unsigned char*)karg64<KA_WS>()) + WS_SSQ)), 0, 0};
            pg8::gemm_phase<pg8::EpiScaleBf16, SO, true, true>(ring, g, S, E, F.wave * 64 + lane_id());
        } }
        SEAM(pb + 9);
        if (IN(pb + 10)) { if PON(14) ffnact_phase(A, F, l); }
        SEAM(pb + 10);
        if (IN(pb + 11)) { if PON(15) {
            pg8::Gemm g{((bf16*)(((unsigned char*)karg64<KA_WS>()) + WS_ACT)), ((bf16*)(((unsigned char*)karg64<KA_WS>()) + WS_WDN)) + (size_t)l * DM * DFF, MP, DM, DFF}; SO S; S.init(MP, DM, G_, BX_);
            pg8::EpiResidual E{((float*)(((unsigned char*)karg64<KA_WS>()) + WS_X)), ((bf16*)(((unsigned char*)karg64<KA_WS>()) + WS_XB)), ((float*)(((unsigned char*)karg64<KA_WS>()) + WS_SSQ))};
            pg8::gemm_phase<pg8::EpiResidual, SO, true, true>(ring, g, S, E, F.wave * 64 + lane_id());
            sk_residual(((const bf16*)(((unsigned char*)karg64<KA_WS>()) + WS_ACT)) + (size_t)MP * DFF, ((const bf16*)(((unsigned char*)karg64<KA_WS>()) + WS_WDN)) + (size_t)l * DM * DFF, DFF, F);
        } }
        SEAM(pb + 11);
    }
    if (IN(N_PHASES - 1)) { if PON(16) final_phase(A, F); }
#undef IN
#undef SEAM
}

extern "C" void kernel_launch(void* const* d_in, const int* in_sizes, int n_in, void* d_out, int out_size, void* d_ws, size_t ws_size, hipStream_t stream) {
    static int grid = 0;
    if (grid == 0) {
        if (n_in != N_INPUTS || (size_t)out_size != O_END || ws_size < WS_END) { fprintf(stderr, "kernel_launch: built for %d inputs, %zu outputs, >= %zu bytes of workspace; got n_in %d, out %d, ws %zu; nothing launched\n", N_INPUTS, (size_t)O_END, (size_t)WS_END, n_in, out_size, ws_size); grid = -1; return; }
        int dev = 0, cus = 0, per_cu = 0;
        if (hipGetDevice(&dev) != hipSuccess || hipDeviceGetAttribute(&cus, hipDeviceAttributeMultiprocessorCount, dev) != hipSuccess) { fprintf(stderr, "kernel_launch: device query failed\n"); grid = -1; return; }
        if (hipFuncSetAttribute((const void*)fwd, hipFuncAttributeMaxDynamicSharedMemorySize, LDS_BYTES) != hipSuccess) { fprintf(stderr, "kernel_launch: hipFuncSetAttribute failed\n"); grid = -1; return; }
        if (hipOccupancyMaxActiveBlocksPerMultiprocessor(&per_cu, (const void*)fwd, NTHR, LDS_BYTES) != hipSuccess || per_cu < 1) { fprintf(stderr, "kernel_launch: occupancy query reports %d workgroups per CU\n", per_cu); }
        (void)hipGetLastError();
        grid = cus;
    }
    if (grid < 0) return;
    if (hipMemsetAsync((char*)d_ws + WS_CTL, 0, CTL_ZERO_BYTES, stream) != hipSuccess) { fprintf(stderr, "kernel_launch: memset failed\n"); return; }
    Args a{};
    for (int i = 0; i < N_INPUTS; ++i) a.in[i] = (const float*)d_in[i];
    a.out = (float*)d_out; a.ws = (unsigned char*)d_ws;
#if MK_PER_PHASE
    for (int p = 0; p < N_PHASES; ++p) {
        a.ph_lo = p; a.ph_hi = p + 1;
        hipLaunchKernelGGL(fwd, dim3(grid), dim3(NTHR), LDS_BYTES, stream, a);
    }
#else
    a.ph_lo = 0; a.ph_hi = N_PHASES;
    hipLaunchKernelGGL(fwd, dim3(grid), dim3(NTHR), LDS_BYTES, stream, a);
#endif
    const hipError_t le = hipPeekAtLastError();
    if (le != hipSuccess) fprintf(stderr, "kernel_launch: launch failed: %s\n", hipGetErrorName(le));
}
```

```cpp
#include <hip/hip_runtime.h>
#include <cstdio>
#include <cstdint>
#include <cmath>
#define MK_PER_PHASE 0
namespace pg8 {
#define PG8_LAS __attribute__((address_space(3)))
typedef unsigned short bf16_t;
typedef short bf16x8 __attribute__((ext_vector_type(8)));
typedef float f32x4 __attribute__((ext_vector_type(4)));
typedef unsigned u32x4 __attribute__((ext_vector_type(4)));
constexpr int BM = 256, BK = 64, HALF = 128, HTB = HALF * BK * 2  , STAGE_BYTES = 8 * HTB, NXCD = 8, WGM = 8;

__host__ __device__ __forceinline__ int lds_byte(int r, int c) { const int st = (r >> 4) * 2 + (c >> 5), rr = r & 15, cc = c & 31, ob = rr * 64 + cc * 2; return st * 1024 + (ob ^ (((ob >> 9) & 1) << 5)); }
__host__ __device__ __forceinline__ void stage_rc(int b, int& R, int& C) { const int st = b / 1024, sb = b % 1024, swz = sb ^ (((sb >> 9) & 1) << 5); R = (st >> 1) * 16 + swz / 64; C = (st & 1) * 32 + (swz % 64) / 2; }
__host__ __device__ __forceinline__ int perm32(int rho) { const int n = rho >> 4, i = rho & 15; return 8 * (i >> 2) + 4 * n + (i & 3); }

struct Unit { int pm, pn; };
struct Gemm { const bf16_t* A; const bf16_t* Bt; int M, N, K; };

struct StaticOrder {
    int nM, nN, nwg, G, c;
    __host__ __device__ void init(int M, int N, int G_, int c_) { nM = M / BM; nN = N / BM; nwg = nM * nN; G = G_; c = c_; }
    __host__ __device__ bool next(int i, Unit& u) const {
        const long L = (long)i * G + c; if (L >= nwg) return false;
        int wgid = (int)L; { const int q = nwg / NXCD, r = nwg % NXCD, xcd = wgid % NXCD, off = wgid / NXCD; wgid = (xcd < r ? xcd * (q + 1) : r * (q + 1) + (xcd - r) * q) + off; }
        const int nig = WGM * nN, gid = wgid / nig, fm = gid * WGM, gsz = (nM - fm) < WGM ? (nM - fm) : WGM;
        u.pm = fm + ((wgid % nig) % gsz); u.pn = (wgid % nig) / gsz; return true;
    }
    __device__ __forceinline__ void a_ready(const Unit&) const {}
    __device__ __forceinline__ void done(const Unit&) const {}
};

__device__ __forceinline__ unsigned cvt_pk_bf16(float lo, float hi) { unsigned r; asm volatile("v_cvt_pk_bf16_f32 %0, %1, %2" : "=v"(r) : "v"(lo), "v"(hi)); return r; }
typedef float f32x2 __attribute__((ext_vector_type(2)));
typedef unsigned u32x2 __attribute__((ext_vector_type(2)));
__device__ __forceinline__ float bf_lo(unsigned w) { return __uint_as_float(w << 16); }
__device__ __forceinline__ float bf_hi(unsigned w) { return __uint_as_float(w & 0xffff0000u); }
__device__ __forceinline__ float sigmoidf_(float v) { return 1.0f / (1.0f + __expf(-v)); }

struct EpiScaleBf16 {
    static constexpr bool PERM = true, AFTER_DRAIN = false;
    bf16_t* O; int ldc; const float* ssq; int sig_lo, sig_hi;
    __device__ __forceinline__ void operator()(const f32x4 (&acc)[2][2][4][2], const Unit& u, int wr, int wc, int fr, int fq) const {
        const int row0 = u.pm * BM + wr * 64 + fr, col0 = u.pn * BM + wc * 32 + 8 * fq;
        const bool sig = (u.pn >= sig_lo) && (u.pn < sig_hi);
#pragma unroll
        for (int ai = 0; ai < 2; ++ai)
#pragma unroll
            for (int m = 0; m < 4; ++m) {
                const int row = row0 + ai * HALF + m * 16;
                float rs = 1.0f;
                if (ssq) { const f32x4* p = (const f32x4*)(ssq + (size_t)row * 32); f32x4 s = p[0];
#pragma unroll
                    for (int i = 1; i < 8; ++i) s += p[i];
                    rs = rsqrtf(((s[0] + s[1]) + (s[2] + s[3])) * (1.0f / 2048.0f) + 1e-6f); }
                bf16_t* rowp = O + (size_t)row * ldc + col0;
#pragma unroll
                for (int bj = 0; bj < 2; ++bj) { f32x4 v0 = acc[ai][bj][m][0] * rs, v1 = acc[ai][bj][m][1] * rs;
                    if (sig) { v0 = (f32x4){sigmoidf_(v0[0]), sigmoidf_(v0[1]), sigmoidf_(v0[2]), sigmoidf_(v0[3])}; v1 = (f32x4){sigmoidf_(v1[0]), sigmoidf_(v1[1]), sigmoidf_(v1[2]), sigmoidf_(v1[3])}; }
                    u32x4 w; w.x = cvt_pk_bf16(v0[0], v0[1]); w.y = cvt_pk_bf16(v0[2], v0[3]); w.z = cvt_pk_bf16(v1[0], v1[1]); w.w = cvt_pk_bf16(v1[2], v1[3]);
                    *(u32x4*)(rowp + bj * HALF) = w; }
            }
    }
};

struct EpiResidual {
    static constexpr bool PERM = false, AFTER_DRAIN = false;
    float* X; bf16_t* XB; float* ssq;
    __device__ __forceinline__ void operator()(const f32x4 (&acc)[2][2][4][2], const Unit& u, int wr, int wc, int fr, int fq) const {
        const int row0 = u.pm * BM + wr * 64 + fr, col0 = u.pn * BM + wc * 32 + 4 * fq;
#pragma unroll
        for (int ai = 0; ai < 2; ++ai)
#pragma unroll
            for (int m = 0; m < 4; ++m) {
                const int row = row0 + ai * HALF + m * 16; float ss = 0.f;
#pragma unroll
                for (int bj = 0; bj < 2; ++bj)
#pragma unroll
                    for (int n = 0; n < 2; ++n) { const size_t off = (size_t)row * 2048 + col0 + bj * HALF + n * 16;
                        const f32x4 x = *(const f32x4*)(X + off) + acc[ai][bj][m][n];
                        *(f32x4*)(X + off) = x;
                        u32x2 w; w.x = cvt_pk_bf16(x[0], x[1]); w.y = cvt_pk_bf16(x[2], x[3]); *(u32x2*)(XB + off) = w;
                        ss += (x[0] * x[0] + x[1] * x[1]) + (x[2] * x[2] + x[3] * x[3]); }
                ss += __shfl_xor(ss, 16); ss += __shfl_xor(ss, 32);
                if (fq == 0) ssq[(size_t)row * 32 + u.pn * 4 + wc] = ss;
            }
    }
};

struct EpiBranch {
    static constexpr bool PERM = true, AFTER_DRAIN = false;
    bf16_t* MG; const bf16_t* G; int ldg; int first;
    __device__ __forceinline__ void operator()(const f32x4 (&acc)[2][2][4][2], const Unit& u, int wr, int wc, int fr, int fq) const {
        const int row0 = u.pm * BM + wr * 64 + fr, col0 = u.pn * BM + wc * 32 + 8 * fq;
#pragma unroll
        for (int ai = 0; ai < 2; ++ai)
#pragma unroll
            for (int m = 0; m < 4; ++m) {
                const int row = row0 + ai * HALF + m * 16;
#pragma unroll
                for (int bj = 0; bj < 2; ++bj) { const int col = col0 + bj * HALF;
                    const u32x4 g = *(const u32x4*)(G + (size_t)row * ldg + col);
                    f32x4 v0 = acc[ai][bj][m][0], v1 = acc[ai][bj][m][1];
                    v0 = v0 * (f32x4){bf_lo(g.x), bf_hi(g.x), bf_lo(g.y), bf_hi(g.y)}; v1 = v1 * (f32x4){bf_lo(g.z), bf_hi(g.z), bf_lo(g.w), bf_hi(g.w)};
                    bf16_t* dst = MG + (size_t)row * 2048 + col;
                    if (!first) { const u32x4 o = *(const u32x4*)dst; v0 += (f32x4){bf_lo(o.x), bf_hi(o.x), bf_lo(o.y), bf_hi(o.y)}; v1 += (f32x4){bf_lo(o.z), bf_hi(o.z), bf_lo(o.w), bf_hi(o.w)}; }
                    u32x4 w; w.x = cvt_pk_bf16(v0[0], v0[1]); w.y = cvt_pk_bf16(v0[2], v0[3]); w.z = cvt_pk_bf16(v1[0], v1[1]); w.w = cvt_pk_bf16(v1[2], v1[3]);
                    *(u32x4*)dst = w; }
            }
    }
};

struct EpiMemKV {
    static constexpr bool PERM = false, AFTER_DRAIN = false;
    float* outk; float* outv; bf16_t* KV;
    __device__ __forceinline__ void operator()(const f32x4 (&acc)[2][2][4][2], const Unit& u, int wr, int wc, int fr, int fq) const {
        const int row0 = u.pm * BM + wr * 64 + fr, col0 = u.pn * BM + wc * 32 + 4 * fq;
#pragma unroll
        for (int ai = 0; ai < 2; ++ai)
#pragma unroll
            for (int m = 0; m < 4; ++m) {
                const int row = row0 + ai * HALF + m * 16;
#pragma unroll
                for (int bj = 0; bj < 2; ++bj)
#pragma unroll
                    for (int n = 0; n < 2; ++n) { const int col = col0 + bj * HALF + n * 16; const f32x4 a = acc[ai][bj][m][n];
                        float* dst = (col < 512) ? (outk + (size_t)row * 512 + col) : (outv + (size_t)row * 512 + (col - 512));
                        *(f32x4*)dst = a;
                        u32x2 w; w.x = cvt_pk_bf16(a[0], a[1]); w.y = cvt_pk_bf16(a[2], a[3]); *(u32x2*)(KV + (size_t)row * 1024 + col) = w; }
            }
    }
};
template <class Epi, class Sched, bool ALIGN_EPI = false, bool SP2 = false>
__device__ __forceinline__ void gemm_phase(PG8_LAS unsigned char* lds, const Gemm g, const Sched& S, const Epi& E, int tid_in) {
    int tid_ = tid_in; asm volatile("" : "+v"(tid_));
    const int tid = tid_, wid = __builtin_amdgcn_readfirstlane(tid >> 6), lane = tid & 63, wr = wid >> 2, wc = wid & 3, fr = lane & 15, fq = lane >> 4;
    const int K = g.K, nt = K / BK;
    unsigned voffA[2], voffB[2];
#pragma unroll
    for (int i = 0; i < 2; ++i) { int R, C; stage_rc(tid * 16 + i * 8192, R, C); const int Rb = Epi::PERM ? ((R & ~31) + perm32(R & 31)) : R;
        voffA[i] = (unsigned)(R * K + C) * 2u; voffB[i] = (unsigned)(Rb * K + C) * 2u; }
    const size_t kstep = (size_t)(BK * 2);
    const size_t hstep = (size_t)HALF * K * 2;
    const size_t tstep = 2 * hstep;
    const unsigned ldsw = (unsigned)wid * 1024u;
    const int aoff = lds_byte(wr * 64 + fr, fq * 8), boff = lds_byte(wc * 32 + fr, fq * 8);
#define PG8_SA(b, h) (((b) * 2 + (h)) * HTB)
#define PG8_SB(b, h) ((4 + (b) * 2 + (h)) * HTB)
#define PG8_STAGE(bufoff, gbase, voff) do { _Pragma("unroll") for (int _i = 0; _i < 2; ++_i) \
        __builtin_amdgcn_global_load_lds((const unsigned*)((const char*)(gbase) + (voff)[_i]), (PG8_LAS unsigned*)(lds + (bufoff) + ldsw + _i * 8192), 16, 0, 0); } while (0)
#define PG8_LDA(dst, b, h) do { _Pragma("unroll") for (int m = 0; m < 4; ++m) _Pragma("unroll") for (int k = 0; k < 2; ++k) dst[m][k] = *(const PG8_LAS bf16x8*)(lds + PG8_SA(b, h) + aoff + m * 2048 + k * 1024); } while (0)
#define PG8_LDB(dst, b, h) do { _Pragma("unroll") for (int n = 0; n < 2; ++n) _Pragma("unroll") for (int k = 0; k < 2; ++k) dst[n][k] = *(const PG8_LAS bf16x8*)(lds + PG8_SB(b, h) + boff + n * 2048 + k * 1024); } while (0)
#define PG8_MMA(ai, bj, At, Bt) do { __builtin_amdgcn_s_setprio(1); _Pragma("unroll") for (int m = 0; m < 4; ++m) _Pragma("unroll") for (int n = 0; n < 2; ++n) _Pragma("unroll") for (int k = 0; k < 2; ++k) \
        acc[ai][bj][m][n] = __builtin_amdgcn_mfma_f32_16x16x32_bf16(Bt[n][k], At[m][k], acc[ai][bj][m][n], 0, 0, 0); __builtin_amdgcn_s_setprio(0); } while (0)
#define PG8_WAIT_V(n) asm volatile("s_waitcnt vmcnt(" #n ")" ::: "memory")
#define PG8_WAIT_L(n) asm volatile("s_waitcnt lgkmcnt(" #n ")" ::: "memory")
#define PG8_BAR __builtin_amdgcn_s_barrier()
#define PG8_SCHED __builtin_amdgcn_sched_barrier(0)
    Unit cur, nxt; int ui = 0;
    if (!S.next(0, cur)) return;
    f32x4 acc[2][2][4][2];
#pragma unroll
    for (int a = 0; a < 2; ++a)
#pragma unroll
        for (int b = 0; b < 2; ++b)
#pragma unroll
            for (int m = 0; m < 4; ++m)
#pragma unroll
                for (int n = 0; n < 2; ++n) acc[a][b][m][n] = (f32x4){0.f, 0.f, 0.f, 0.f};
    bf16x8 At[4][2], B0[2][2], B1[2][2];
    const char* cA = (const char*)g.A + (size_t)cur.pm * tstep; const char* cB = (const char*)g.Bt + (size_t)cur.pn * tstep;
    S.a_ready(cur);
    if constexpr (SP2) {
        PG8_STAGE(PG8_SB(0, 0), cB, voffB); PG8_STAGE(PG8_SB(0, 1), cB + hstep, voffB); PG8_STAGE(PG8_SA(0, 0), cA, voffA); PG8_STAGE(PG8_SA(0, 1), cA + hstep, voffA);
        if (wr == 1) PG8_BAR;
        PG8_WAIT_V(2); PG8_BAR;
        PG8_STAGE(PG8_SB(1, 0), cB + kstep, voffB); PG8_STAGE(PG8_SA(1, 0), cA + kstep, voffA); PG8_STAGE(PG8_SB(1, 1), cB + hstep + kstep, voffB);
        PG8_WAIT_V(6); PG8_BAR;
    } else {
        PG8_STAGE(PG8_SB(0, 0), cB, voffB); PG8_STAGE(PG8_SA(0, 0), cA, voffA); PG8_STAGE(PG8_SB(0, 1), cB + hstep, voffB); PG8_STAGE(PG8_SA(0, 1), cA + hstep, voffA);
        if (wr == 1) PG8_BAR;
        PG8_WAIT_V(4); PG8_BAR;
        PG8_STAGE(PG8_SB(1, 0), cB + kstep, voffB); PG8_STAGE(PG8_SA(1, 0), cA + kstep, voffA); PG8_STAGE(PG8_SB(1, 1), cB + hstep + kstep, voffB);
        PG8_WAIT_V(6); PG8_BAR;
    }
    for (;;) {
        const bool has_next = S.next(ui + 1, nxt);
        const char* nA = has_next ? (const char*)g.A + (size_t)nxt.pm * tstep : cA; const char* nB = has_next ? (const char*)g.Bt + (size_t)nxt.pn * tstep : cB;
        for (int t = 0; t < nt; t += 2) {
            const bool last = (t == nt - 2);
            const char* a1 = cA + (size_t)(t + 1) * kstep;
            const char* a2 = last ? nA : cA + (size_t)(t + 2) * kstep; const char* b2 = last ? nB : cB + (size_t)(t + 2) * kstep;
            const char* a3 = a2 + kstep; const char* b3 = b2 + kstep;
            if (last && has_next) S.a_ready(nxt);
            if constexpr (SP2) {
            PG8_LDB(B0, 0, 0); PG8_LDB(B1, 0, 1); PG8_SCHED; PG8_LDA(At, 0, 0); PG8_STAGE(PG8_SA(1, 1), a1 + hstep, voffA);
            PG8_WAIT_V(8); PG8_WAIT_L(0); PG8_BAR; PG8_MMA(0, 0, At, B0); PG8_MMA(0, 1, At, B1); PG8_BAR; PG8_SCHED;
            PG8_LDA(At, 0, 1); PG8_STAGE(PG8_SB(0, 0), b2, voffB); PG8_STAGE(PG8_SB(0, 1), b2 + hstep, voffB); PG8_STAGE(PG8_SA(0, 0), a2, voffA);
            PG8_WAIT_V(8); PG8_WAIT_L(0); PG8_BAR; PG8_MMA(1, 0, At, B0); PG8_MMA(1, 1, At, B1); PG8_BAR; PG8_SCHED;
            PG8_LDB(B0, 1, 0); PG8_LDB(B1, 1, 1); PG8_SCHED; PG8_LDA(At, 1, 0); PG8_STAGE(PG8_SA(0, 1), a2 + hstep, voffA);
            PG8_WAIT_V(8); PG8_WAIT_L(0); PG8_BAR; PG8_MMA(0, 0, At, B0); PG8_MMA(0, 1, At, B1); PG8_BAR; PG8_SCHED;
            PG8_LDA(At, 1, 1); PG8_STAGE(PG8_SB(1, 0), b3, voffB); PG8_STAGE(PG8_SB(1, 1), b3 + hstep, voffB); PG8_STAGE(PG8_SA(1, 0), a3, voffA);
            PG8_WAIT_V(8); PG8_WAIT_L(0); PG8_BAR; PG8_MMA(1, 0, At, B0); PG8_MMA(1, 1, At, B1); PG8_BAR; PG8_SCHED;
            } else {
            PG8_LDB(B0, 0, 0); PG8_SCHED; PG8_LDA(At, 0, 0); PG8_STAGE(PG8_SA(1, 1), a1 + hstep, voffA);
            PG8_WAIT_L(8); PG8_BAR; PG8_WAIT_L(0); PG8_MMA(0, 0, At, B0); PG8_BAR; PG8_SCHED;
            PG8_LDB(B1, 0, 1); PG8_STAGE(PG8_SB(0, 0), b2, voffB);
            PG8_BAR; PG8_WAIT_L(0); PG8_MMA(0, 1, At, B1); PG8_BAR;
            PG8_LDA(At, 0, 1); PG8_STAGE(PG8_SA(0, 0), a2, voffA);
            PG8_BAR; PG8_WAIT_L(0); PG8_MMA(1, 0, At, B0); PG8_BAR; PG8_SCHED;
            PG8_STAGE(PG8_SB(0, 1), b2 + hstep, voffB);
            PG8_WAIT_V(6); PG8_BAR; PG8_MMA(1, 1, At, B1); PG8_BAR;
            PG8_LDB(B0, 1, 0); PG8_SCHED; PG8_LDA(At, 1, 0); PG8_STAGE(PG8_SA(0, 1), a2 + hstep, voffA);
            PG8_WAIT_L(8); PG8_BAR; PG8_WAIT_L(0); PG8_MMA(0, 0, At, B0); PG8_BAR; PG8_SCHED;
            PG8_LDB(B1, 1, 1); PG8_STAGE(PG8_SB(1, 0), b3, voffB);
            PG8_BAR; PG8_WAIT_L(0); PG8_MMA(0, 1, At, B1); PG8_BAR;
            PG8_LDA(At, 1, 1); PG8_STAGE(PG8_SA(1, 0), a3, voffA);
            PG8_BAR; PG8_WAIT_L(0); PG8_MMA(1, 0, At, B0); PG8_BAR; PG8_SCHED;
            PG8_STAGE(PG8_SB(1, 1), b3 + hstep, voffB);
            PG8_WAIT_V(6); PG8_BAR; PG8_MMA(1, 1, At, B1); PG8_BAR;
            }
        }
        if constexpr (ALIGN_EPI) { if (wr == 0) PG8_BAR; }
        if constexpr (!Epi::AFTER_DRAIN) { E(acc, cur, wr, wc, fr, fq); S.done(cur); }
        if (!has_next) break;
#pragma unroll
        for (int a = 0; a < 2; ++a)
#pragma unroll
            for (int b = 0; b < 2; ++b)
#pragma unroll
                for (int m = 0; m < 4; ++m)
#pragma unroll
                    for (int n = 0; n < 2; ++n) acc[a][b][m][n] = (f32x4){0.f, 0.f, 0.f, 0.f};
        cur = nxt; cA = nA; cB = nB; ++ui;
        if constexpr (ALIGN_EPI) { if (wr == 1) PG8_BAR; }
    }
    PG8_WAIT_V(0);
    if constexpr (!ALIGN_EPI) { if (wr == 0) PG8_BAR; }
    PG8_BAR;
    if constexpr (Epi::AFTER_DRAIN) { E.fused(acc, cur, wr, wc, fr, fq, lds, wid, lane); S.done(cur); }
#undef PG8_SA
#undef PG8_SB
#undef PG8_STAGE
#undef PG8_LDA
#undef PG8_LDB
#undef PG8_MMA
#undef PG8_WAIT_V
#undef PG8_WAIT_L
#undef PG8_BAR
#undef PG8_SCHED
}
}

constexpr int NWAVES = 8, NTHR = 512;
constexpr int DM = 2048, SEQ = 4096, NBP = 2, DEPTH = 4, NBS = 32, TS = 8;
constexpr int MP = NBP * SEQ, MS = NBS * TS, M = MP + MS;
constexpr int MIXW = 1024, GH = 4, GDK = 128, GDV = 256, GRANK = 16;
constexpr int SH = 16, SKV = 2, SHD = 64, WIN = 128;
constexpr int NMEM = 256, XH = 4, XHD = 128, XW = XH * XHD;
constexpr int DFF = 5504, NIN = 13584, NINP = 13824;
constexpr float EPS = 1e-6f;
constexpr int ZC_GQ = 0, ZC_GK = 512, ZC_GV = 1024, ZC_GR = 2048, ZC_SQ = 3072, ZC_SK = 4096, ZC_SV = 4224, ZC_CB = 4352, ZC_CC = 5376, ZC_CH = 6400, ZC_GATE = 7424, ZC_GLR = 13568;
static_assert(ZC_GATE % 256 == 0 && ZC_GLR % 256 == 0 && ZC_GLR + 16 == NIN && NINP % 256 == 0, "z layout");
constexpr size_t O_YP = 0, O_YS = O_YP + (size_t)MP * DM, O_GLAP = O_YS + (size_t)MS * DM, O_GLAS = O_GLAP + (size_t)DEPTH * NBP * GH * GDK * GDV,
                 O_SKP = O_GLAS + (size_t)DEPTH * NBS * GH * GDK * GDV, O_SVP = O_SKP + (size_t)DEPTH * NBP * WIN * SKV * SHD, O_SKS = O_SVP + (size_t)DEPTH * NBP * WIN * SKV * SHD,
                 O_SVS = O_SKS + (size_t)DEPTH * NBS * WIN * SKV * SHD, O_CONVP = O_SVS + (size_t)DEPTH * NBS * WIN * SKV * SHD, O_CONVS = O_CONVP + (size_t)DEPTH * NBP * 2 * MIXW,
                 O_FFNP = O_CONVS + (size_t)DEPTH * NBS * 2 * MIXW, O_FFNS = O_FFNP + (size_t)DEPTH * NBP * 2 * DFF, O_MKP = O_FFNS + (size_t)DEPTH * NBS * 2 * DFF,
                 O_MVP = O_MKP + (size_t)DEPTH * NBP * NMEM * XW, O_END = O_MVP + (size_t)DEPTH * NBP * NMEM * XW;
static_assert(O_END == 43456512, "output size");
enum { I_XP = 0, I_XS, I_SGLA, I_CSK, I_CSV, I_SCONV, I_SFFN, I_CMK, I_CMV, I_MEMP, I_NMIX, I_WIN, I_GUP, I_GB, I_GNORM, I_SINK, I_RELB, I_CONVW, I_WBR, I_WOUT, I_NX, I_WXQ, I_WXK, I_WXV, I_WXO,
       I_NFFN, I_FUP, I_FCW, I_FCB, I_FDN, I_NFIN, N_INPUTS };
static_assert(N_INPUTS == 31, "inputs");

constexpr size_t MiB = 1u << 20;
constexpr size_t al1m(size_t x) { return (x + MiB - 1) / MiB * MiB; }
constexpr size_t WS_CTL = 0, CTL_ZERO_BYTES = 1 * MiB;
constexpr size_t SZ_WIN = (size_t)NINP * DM * 2, SZ_WBR = (size_t)3 * DM * MIXW * 2, SZ_WOUT = (size_t)DM * DM * 2, SZ_WXQ = (size_t)XW * DM * 2, SZ_WXKV = (size_t)2 * XW * DM * 2,
                 SZ_WXO = (size_t)DM * XW * 2, SZ_WUP = (size_t)2 * DFF * DM * 2, SZ_WDN = (size_t)DM * DFF * 2;
constexpr size_t WS_WIN = 2 * MiB, WS_WBR = al1m(WS_WIN + DEPTH * SZ_WIN), WS_WOUT = al1m(WS_WBR + DEPTH * SZ_WBR), WS_WXQ = al1m(WS_WOUT + DEPTH * SZ_WOUT),
                 WS_WXKV = al1m(WS_WXQ + DEPTH * SZ_WXQ), WS_WXO = al1m(WS_WXKV + DEPTH * SZ_WXKV), WS_WUP = al1m(WS_WXO + DEPTH * SZ_WXO), WS_WDN = al1m(WS_WUP + DEPTH * SZ_WUP);
constexpr size_t WS_X = al1m(WS_WDN + DEPTH * SZ_WDN), WS_XB = al1m(WS_X + (size_t)M * DM * 4), WS_SSQ = al1m(WS_XB + (size_t)M * DM * 2), WS_Z = al1m(WS_SSQ + (size_t)M * 32 * 4),
                 WS_BR = al1m(WS_Z + (size_t)M * NINP * 2), WS_MG = al1m(WS_BR + (size_t)3 * M * MIXW * 2), WS_XQ = al1m(WS_MG + (size_t)M * DM * 2), WS_XO = al1m(WS_XQ + (size_t)M * XW * 2),
                 WS_UG = al1m(WS_XO + (size_t)M * XW * 2), WS_ACT = al1m(WS_UG + (size_t)M * 2 * DFF * 2), WS_MEMB = al1m(WS_ACT + (size_t)M * DFF * 2), WS_MEMKV = al1m(WS_MEMB + (size_t)NBP * NMEM * DM * 2),
                 WS_GLAU = al1m(WS_MEMKV + (size_t)DEPTH * NBP * NMEM * 2 * XW * 2), WS_GLAD = al1m(WS_GLAU + (size_t)512 * GDK * GDV * 4), WS_END = al1m(WS_GLAD + (size_t)512 * GDK * 4);
constexpr int CW_TMO = 0, CW_CODE = 1, CW_BAR = 4096;

constexpr int RING_OFF = 0, RING_BYTES = 131072;
constexpr int LDSCTL_OFF = 146944, MISC_OFF = LDSCTL_OFF + 320;
constexpr int LDS_BYTES = 147456;
static_assert(MISC_OFF + 128 <= LDS_BYTES && LDSCTL_OFF >= RING_BYTES, "LDS map");

#define GAS __attribute__((address_space(1)))
#define LAS __attribute__((address_space(3)))
typedef unsigned short bf16;
typedef unsigned v4u __attribute__((ext_vector_type(4)));
typedef unsigned v2u __attribute__((ext_vector_type(2)));
typedef float f32x4 __attribute__((ext_vector_type(4)));
typedef float f32x2 __attribute__((ext_vector_type(2)));
typedef GAS unsigned gu32;
#define RLX_AGENT __ATOMIC_RELAXED, __HIP_MEMORY_SCOPE_AGENT
#define LDS_WAIT() asm volatile("s_waitcnt lgkmcnt(0)" ::: "memory")
#define VM_WAIT() asm volatile("s_waitcnt vmcnt(0)" ::: "memory")
__device__ __forceinline__ float bflo(unsigned w) { return __uint_as_float(w << 16); }
__device__ __forceinline__ float bfhi(unsigned w) { return __uint_as_float(w & 0xffff0000u); }
__device__ __forceinline__ float bf1(bf16 h) { return __uint_as_float(((unsigned)h) << 16); }
__device__ __forceinline__ unsigned pk2(float lo, float hi) { return pg8::cvt_pk_bf16(lo, hi); }
__device__ __forceinline__ void unpack8(const v4u w, float (&f)[8]) { f[0] = bflo(w.x); f[1] = bfhi(w.x); f[2] = bflo(w.y); f[3] = bfhi(w.y); f[4] = bflo(w.z); f[5] = bfhi(w.z); f[6] = bflo(w.w); f[7] = bfhi(w.w); }
__device__ __forceinline__ v4u pack8(const float (&f)[8]) { v4u w; w.x = pk2(f[0], f[1]); w.y = pk2(f[2], f[3]); w.z = pk2(f[4], f[5]); w.w = pk2(f[6], f[7]); return w; }
__device__ __forceinline__ float sigm(float v) { return 1.0f / (1.0f + __expf(-v)); }
__device__ __forceinline__ float wave_sum(float v) {
#pragma unroll
    for (int o = 1; o < 64; o <<= 1) v += __shfl_xor(v, o);
    return v;
}
#define XB_TMO      128
#define XB_XCNT(j)  (256  + 64 * (j))
#define XB_XSUB(j)  (1280 + 64 * (j))
#define XB_XGEN(j)  (2304 + 64 * (j))
#define XB_TOP      3328
#define XB_TOPGEN   3392
#define XCD_BAR_WORDS 3456
#define XB_SPIN_CAP (1u << 18)

__device__ __forceinline__ unsigned xb_ld(unsigned* p)              { return __hip_atomic_load(p, __ATOMIC_RELAXED, __HIP_MEMORY_SCOPE_AGENT); }
__device__ __forceinline__ unsigned xb_add(unsigned* p, unsigned v) { return __hip_atomic_fetch_add(p, v, __ATOMIC_RELAXED, __HIP_MEMORY_SCOPE_AGENT); }
__device__ __forceinline__ unsigned xb_xcc_id() { return (unsigned)__builtin_amdgcn_s_getreg((3 << 11) | 20) & 0xFu; }
#define XB_SPIN(cond, bar) do { unsigned _sp = 0; while (cond) { __builtin_amdgcn_s_sleep(1); \
    if ((++_sp & 255u) == 0u) { if (xb_ld(&(bar)[XB_TMO])) break; if (_sp > XB_SPIN_CAP) { atomicAdd(&(bar)[XB_TMO], 1u); break; } } } } while (0)

struct XcdBarrier {
    unsigned* bar; unsigned x; unsigned wv;
    volatile LAS unsigned* st;
};

__device__ __forceinline__ unsigned xb_lane() { return __builtin_amdgcn_mbcnt_hi(~0u, __builtin_amdgcn_mbcnt_lo(~0u, 0u)); }
__device__ __forceinline__ XcdBarrier xcd_barrier_post(unsigned* bar, volatile LAS unsigned* st, unsigned wv) {
    XcdBarrier b; b.bar = bar; b.x = xb_xcc_id(); b.st = st; b.wv = wv;
    if (wv == 0u && xb_lane() == 0u) (void)xb_add(&bar[XB_XCNT(b.x)], 1u);
    return b;
}
__device__ __forceinline__ void xcd_barrier_complete(unsigned* bar, unsigned x, unsigned& nloc, unsigned& nx) {
    const unsigned G = gridDim.x * gridDim.y * gridDim.z;
    unsigned sum, cnt, mine, sp = 0u;
    for (;;) {
        sum = 0u; cnt = 0u; mine = 0u;
#pragma unroll
        for (unsigned j = 0; j < 16; ++j) { const unsigned c = xb_ld(&bar[XB_XCNT(j)]); sum += c; cnt += (c > 0u) ? 1u : 0u; mine = (j == x) ? c : mine; }
        if (sum == G) break;
        __builtin_amdgcn_s_sleep(1);
        if ((++sp & 255u) == 0u) { if (xb_ld(&bar[XB_TMO])) break; if (sp > XB_SPIN_CAP) { atomicAdd(&bar[XB_TMO], 1u); break; } }
    }
    nloc = mine > 0u ? mine : 1u; nx = cnt > 0u ? cnt : 1u;
}

__device__ __forceinline__ void xcd_barrier(const XcdBarrier& b) {
    asm volatile("s_waitcnt vmcnt(0)" ::: "memory");
    __syncthreads();
    if (b.wv == 0u && xb_lane() == 0u) {
        unsigned* bar = b.bar;
        __builtin_amdgcn_s_waitcnt(0);
        unsigned nloc = b.st[0], nx = b.st[1];
        if (nloc == 0u) { xcd_barrier_complete(bar, b.x, nloc, nx); b.st[0] = nloc; b.st[1] = nx; }
        const unsigned old = xb_add(&bar[XB_XSUB(b.x)], 1u);
        const unsigned gen = old / nloc;
        if (old + 1u == (gen + 1u) * nloc) {
            __builtin_amdgcn_fence(__ATOMIC_RELEASE, "agent");
            asm volatile("s_waitcnt vmcnt(0)" ::: "memory");
            const unsigned og = xb_add(&bar[XB_TOP], 1u);
            const unsigned tg = og / nx;
            if (og + 1u == (tg + 1u) * nx) xb_add(&bar[XB_TOPGEN], 1u);
            else XB_SPIN(xb_ld(&bar[XB_TOPGEN]) == tg, bar);
            __builtin_amdgcn_fence(__ATOMIC_ACQUIRE, "agent");
            xb_add(&bar[XB_XGEN(b.x)], 1u);
            asm volatile("s_waitcnt vmcnt(0)" ::: "memory");
        } else {
            XB_SPIN(xb_ld(&bar[XB_XGEN(b.x)]) == gen, bar);
            __builtin_amdgcn_fence(__ATOMIC_ACQUIRE, "agent");
            asm volatile("s_waitcnt vmcnt(0)" ::: "memory");
        }
    }
    __syncthreads();
}

struct Args { const float* in[N_INPUTS]; float* out; unsigned char* ws; int ph_lo, ph_hi; };
static_assert(sizeof(Args) == N_INPUTS * 8 + 8 + 8 + 8, "Args has no padding");


constexpr int KA_OUT = 8 * N_INPUTS, KA_WS = KA_OUT + 8, KA_LO = KA_WS + 8, KA_HI = KA_LO + 4;
template <int OFF> __device__ __forceinline__ unsigned long long karg64() {
    unsigned long long v; auto kp = __builtin_amdgcn_kernarg_segment_ptr();
    asm volatile("s_load_dwordx2 %0, %1, %2\n\ts_waitcnt lgkmcnt(0)" : "=s"(v) : "s"(kp), "n"(OFF) : "memory"); return v;
}
template <int OFF> __device__ __forceinline__ int karg32() {
    int v; auto kp = __builtin_amdgcn_kernarg_segment_ptr();
    asm volatile("s_load_dword %0, %1, %2\n\ts_waitcnt lgkmcnt(0)" : "=s"(v) : "s"(kp), "n"(OFF) : "memory"); return v;
}
struct Frame {
    LAS unsigned char* lds;
    volatile LAS unsigned* MISC;
    gu32* ctl;
    int tid, lane, wave, vcu, G;
};

__device__ __forceinline__ int lane_id() { int l; asm volatile("v_mbcnt_lo_u32_b32 %0, -1, 0\n\tv_mbcnt_hi_u32_b32 %0, -1, %0" : "=v"(l)); return l; }
__device__ __forceinline__ int launder_s(int v) { asm volatile("" : "+s"(v)); return v; }
#define LAUNDER(F) do { asm volatile("" : "+s"((F).wave), "+s"((F).vcu), "+s"((F).G)); (F).lane = lane_id(); asm volatile("" : "+v"((F).lane)); (F).tid = (F).wave * 64 + (F).lane; } while (0)
__device__ __forceinline__ void tr_item(const float* W, int K, int Nsrc, bf16* WT, int dstrow0, int k0, int srccol, float cscale, const float* gain, LAS float* scr, int lane) {
    const int q = lane & 15, kq = lane >> 4;
    f32x4 v[16];
#pragma unroll
    for (int i = 0; i < 16; ++i) { v[i] = (f32x4){0.f, 0.f, 0.f, 0.f}; if (srccol >= 0) v[i] = *(const f32x4*)(W + (size_t)(k0 + 4 * i + kq) * Nsrc + srccol); }
#pragma unroll
    for (int i = 0; i < 16; ++i) { const int kk = 4 * i + kq; const float s = gain ? gain[k0 + kk] * cscale : cscale; LAS float* d = scr + kk * 65 + 4 * q;
        d[0] = v[i][0] * s; d[1] = v[i][1] * s; d[2] = v[i][2] * s; d[3] = v[i][3] * s; }
    LDS_WAIT(); asm volatile("" ::: "memory");
    const int c = lane & 7;
#pragma unroll
    for (int j = 0; j < 8; ++j) { const int n = (lane >> 3) + 8 * j; const LAS float* s = scr + (8 * c) * 65 + n;
        v4u o; o.x = pk2(s[0 * 65], s[1 * 65]); o.y = pk2(s[2 * 65], s[3 * 65]); o.z = pk2(s[4 * 65], s[5 * 65]); o.w = pk2(s[6 * 65], s[7 * 65]);
        *(v4u*)(WT + (size_t)(dstrow0 + n) * K + k0 + 8 * c) = o; }
    LDS_WAIT(); asm volatile("" ::: "memory");
}
__device__ __forceinline__ void tr_plain(const float* W, int K, int N, bf16* WT, int dst_off, int r, float cscale, const float* gain, LAS float* scr, int lane) {
    const int nblk = N / 64, kb = r / nblk, nb = r % nblk;
    tr_item(W, K, N, WT, dst_off + 64 * nb, 64 * kb, 64 * nb + 4 * (lane & 15), cscale, gain, scr, lane);
}
constexpr int IT_IN = (DM / 64) * (NINP / 64), IT_BR = (MIXW / 64) * (DM / 64), IT_OUT = (DM / 64) * (DM / 64), IT_XQ = (DM / 64) * (XW / 64), IT_XO = (XW / 64) * (DM / 64),
              IT_UP = (DM / 64) * (2 * DFF / 64), IT_DN = (DFF / 64) * (DM / 64), IT_LAYER = IT_IN + 3 * IT_BR + IT_OUT + 3 * IT_XQ + IT_XO + IT_UP + IT_DN;
__device__ __forceinline__ void p0_convert(const Args& A, Frame& F0) {
    unsigned char* const ws_ = (unsigned char*)karg64<KA_WS>();
    const float* const in_I_FDN = (const float*)karg64<8 * I_FDN>();
    const float* const in_I_FUP = (const float*)karg64<8 * I_FUP>();
    const float* const in_I_MEMP = (const float*)karg64<8 * I_MEMP>();
    const float* const in_I_NFFN = (const float*)karg64<8 * I_NFFN>();
    const float* const in_I_NMIX = (const float*)karg64<8 * I_NMIX>();
    const float* const in_I_NX = (const float*)karg64<8 * I_NX>();
    const float* const in_I_WBR = (const float*)karg64<8 * I_WBR>();
    const float* const in_I_WIN = (const float*)karg64<8 * I_WIN>();
    const float* const in_I_WOUT = (const float*)karg64<8 * I_WOUT>();
    const float* const in_I_WXK = (const float*)karg64<8 * I_WXK>();
    const float* const in_I_WXO = (const float*)karg64<8 * I_WXO>();
    const float* const in_I_WXQ = (const float*)karg64<8 * I_WXQ>();
    const float* const in_I_WXV = (const float*)karg64<8 * I_WXV>();
    const float* const in_I_XP = (const float*)karg64<8 * I_XP>();
    const float* const in_I_XS = (const float*)karg64<8 * I_XS>();
    Frame F = F0; LAUNDER(F);
    LAS float* scr = (LAS float*)(F.lds + F.wave * 16640);
    const int gw = F.vcu * NWAVES + F.wave, NGW = F.G * NWAVES, lane = F.lane;
#pragma unroll 1
    for (int it = gw; it < DEPTH * IT_LAYER; it += NGW) {
        const int l = it / IT_LAYER; int r = it % IT_LAYER;
        if (r < IT_IN) {
            const int nblk = NINP / 64, kb = r / nblk, nb = r % nblk, n = 64 * nb + 4 * (lane & 15);
            int src; if (n < 3072) src = n; else if (n < ZC_GLR) src = n + 16; else if (n < NIN) src = 3072 + (n - ZC_GLR); else src = -1;
            const float cs = (n < 512) ? 0.08838834764831845f : ((n >= ZC_SQ && n < ZC_SK) ? 0.125f : 1.0f);
            tr_item(in_I_WIN + (size_t)l * DM * NIN, DM, NIN, ((bf16*)(ws_ + WS_WIN)) + (size_t)l * NINP * DM, 64 * nb, 64 * kb, src, cs, in_I_NMIX + l * DM, scr, lane); continue; }
        r -= IT_IN;
        if (r < 3 * IT_BR) { const int i = r / IT_BR; r %= IT_BR;
            tr_plain(in_I_WBR + ((size_t)l * 3 + i) * MIXW * DM, MIXW, DM, ((bf16*)(ws_ + WS_WBR)) + ((size_t)l * 3 + i) * DM * MIXW, 0, r, 1.0f, nullptr, scr, lane); continue; }
        r -= 3 * IT_BR;
        if (r < IT_OUT) { tr_plain(in_I_WOUT + (size_t)l * DM * DM, DM, DM, ((bf16*)(ws_ + WS_WOUT)) + (size_t)l * DM * DM, 0, r, 1.0f, nullptr, scr, lane); continue; }
        r -= IT_OUT;
        if (r < IT_XQ) { tr_plain(in_I_WXQ + (size_t)l * DM * XW, DM, XW, ((bf16*)(ws_ + WS_WXQ)) + (size_t)l * XW * DM, 0, r, 0.08838834764831845f, in_I_NX + l * DM, scr, lane); continue; }
        r -= IT_XQ;
        if (r < IT_XQ) { tr_plain(in_I_WXK + (size_t)l * DM * XW, DM, XW, ((bf16*)(ws_ + WS_WXKV)) + (size_t)l * 2 * XW * DM, 0, r, 1.0f, nullptr, scr, lane); continue; }
        r -= IT_XQ;
        if (r < IT_XQ) { tr_plain(in_I_WXV + (size_t)l * DM * XW, DM, XW, ((bf16*)(ws_ + WS_WXKV)) + (size_t)l * 2 * XW * DM, XW, r, 1.0f, nullptr, scr, lane); continue; }
        r -= IT_XQ;
        if (r < IT_XO) { tr_plain(in_I_WXO + (size_t)l * XW * DM, XW, DM, ((bf16*)(ws_ + WS_WXO)) + (size_t)l * DM * XW, 0, r, 1.0f, nullptr, scr, lane); continue; }
        r -= IT_XO;
        if (r < IT_UP) { tr_plain(in_I_FUP + (size_t)l * DM * 2 * DFF, DM, 2 * DFF, ((bf16*)(ws_ + WS_WUP)) + (size_t)l * 2 * DFF * DM, 0, r, 1.0f, in_I_NFFN + l * DM, scr, lane); continue; }
        r -= IT_UP;
        tr_plain(in_I_FDN + (size_t)l * DFF * DM, DFF, DM, ((bf16*)(ws_ + WS_WDN)) + (size_t)l * DM * DFF, 0, r, 1.0f, nullptr, scr, lane);
    }
    for (int m = gw; m < M + NBP * NMEM; m += NGW) {
        if (m < M) {
            const float* src = (m < MP) ? in_I_XP + (size_t)m * DM : in_I_XS + (size_t)(m - MP) * DM;
            float ss = 0.f;
#pragma unroll
            for (int j = 0; j < 8; ++j) { const f32x4 v = *((const f32x4*)src + lane + 64 * j); *((f32x4*)(((float*)(ws_ + WS_X)) + (size_t)m * DM) + lane + 64 * j) = v;
                v2u w; w.x = pk2(v[0], v[1]); w.y = pk2(v[2], v[3]); *((v2u*)(((bf16*)(ws_ + WS_XB)) + (size_t)m * DM) + lane + 64 * j) = w; ss += (v[0] * v[0] + v[1] * v[1]) + (v[2] * v[2] + v[3] * v[3]); }
            ss = wave_sum(ss);
            if (lane < 32) ((float*)(ws_ + WS_SSQ))[(size_t)m * 32 + lane] = (lane == 0) ? ss : 0.f;
        } else {
            const int r = m - M; const float* src = in_I_MEMP + (size_t)r * DM;
#pragma unroll
            for (int j = 0; j < 8; ++j) { const f32x4 v = *((const f32x4*)src + lane + 64 * j); v2u w; w.x = pk2(v[0], v[1]); w.y = pk2(v[2], v[3]); *((v2u*)(((bf16*)(ws_ + WS_MEMB)) + (size_t)r * DM) + lane + 64 * j) = w; }
        }
    }
}

__device__ __forceinline__ int t5_bucket(int n) {
    if (n < 16) return n;
    const float v = logf((float)n / 16.0f) / logf(8.0f) * 16.0f; const int lg = 16 + (int)v; return lg < 31 ? lg : 31;
}
template <int STRIDE, bool PAIR, bool BIAS>
__device__ __forceinline__ void attn_core(const float (&q)[64], LAS const unsigned char* kp, LAS const unsigned char* vp, int nsteps, int jmin, LAS const float* bp, float& m, float& lsum, float (&o)[64]) {
    for (int j = 0; j < nsteps; ++j) {
        LAS const v4u* kr = (LAS const v4u*)(kp + j * STRIDE);
        float s0 = 0.f, s1 = 0.f;
#pragma unroll
        for (int c = 0; c < 8; ++c) { const v4u kk = kr[c];
            s0 += q[8 * c + 0] * bflo(kk.x) + q[8 * c + 2] * bflo(kk.y) + q[8 * c + 4] * bflo(kk.z) + q[8 * c + 6] * bflo(kk.w);
            s1 += q[8 * c + 1] * bfhi(kk.x) + q[8 * c + 3] * bfhi(kk.y) + q[8 * c + 5] * bfhi(kk.z) + q[8 * c + 7] * bfhi(kk.w); }
        float s = s0 + s1;
        if (PAIR) s += __shfl_xor(s, 1);
        if (BIAS) s += bp[-j];
        s = (j >= jmin) ? s : -INFINITY;
        const float mn = fmaxf(m, s), sc = __expf(m - mn), p = __expf(s - mn);
        lsum = lsum * sc + p; m = mn;
        LAS const v4u* vr = (LAS const v4u*)(vp + j * STRIDE);
#pragma unroll
        for (int c = 0; c < 8; ++c) { const v4u vv = vr[c];
            o[8 * c + 0] = o[8 * c + 0] * sc + p * bflo(vv.x); o[8 * c + 1] = o[8 * c + 1] * sc + p * bfhi(vv.x);
            o[8 * c + 2] = o[8 * c + 2] * sc + p * bflo(vv.y); o[8 * c + 3] = o[8 * c + 3] * sc + p * bfhi(vv.y);
            o[8 * c + 4] = o[8 * c + 4] * sc + p * bflo(vv.z); o[8 * c + 5] = o[8 * c + 5] * sc + p * bfhi(vv.z);
            o[8 * c + 6] = o[8 * c + 6] * sc + p * bflo(vv.w); o[8 * c + 7] = o[8 * c + 7] * sc + p * bfhi(vv.w); }
    }
}
__device__ __forceinline__ void load_q64(const bf16* p, float (&q)[64]) {
#pragma unroll
    for (int c = 0; c < 8; ++c) { const v4u w = *((const v4u*)p + c); float f[8]; unpack8(w, f);
#pragma unroll
        for (int i = 0; i < 8; ++i) q[8 * c + i] = f[i]; }
}
__device__ __forceinline__ void store_o64(bf16* p, const float (&o)[64], float inv) {
#pragma unroll
    for (int c = 0; c < 8; ++c) { float f[8];
#pragma unroll
        for (int i = 0; i < 8; ++i) f[i] = o[8 * c + i] * inv;
        *((v4u*)p + c) = pack8(f); }
}

constexpr int SWA_STR = 144, SWA_K = 0, SWA_V = 192 * SWA_STR, SWA_BT = 2 * 192 * SWA_STR, SWA_BTS = 132;
__device__ __forceinline__ void swa_phase(const Args& A, Frame& F0, int l) {
    unsigned char* const ws_ = (unsigned char*)karg64<KA_WS>();
    float* const out_ = (float*)karg64<KA_OUT>();
    const float* const in_I_CSK = (const float*)karg64<8 * I_CSK>();
    const float* const in_I_CSV = (const float*)karg64<8 * I_CSV>();
    const float* const in_I_RELB = (const float*)karg64<8 * I_RELB>();
    const float* const in_I_SINK = (const float*)karg64<8 * I_SINK>();
    Frame F = F0; LAUNDER(F);
    LAS unsigned char* Ks = F.lds + SWA_K; LAS unsigned char* Vs = F.lds + SWA_V; LAS float* BT = (LAS float*)(F.lds + SWA_BT);
    for (int i = F.tid; i < SH * 129; i += NTHR) { const int h = i / 129, d = i % 129; BT[h * SWA_BTS + d] = in_I_RELB[t5_bucket(d) * SH + h]; }
    const float* sinks = in_I_SINK + l * SH;
    for (int u = F.vcu; u < 256 + 64; u += F.G) {
        __syncthreads();
        if (u < 256) {
            const int b = u >> 7, kvh = (u >> 6) & 1, qb = u & 63, q0 = qb * 64;
            for (int i = F.tid; i < 192 * 8; i += NTHR) { const int r = i >> 3, c8 = i & 7, pos = q0 - 128 + r; v4u kv = (v4u){0u, 0u, 0u, 0u}, vv = kv;
                if (pos >= 0) { const bf16* zr = ((bf16*)(ws_ + WS_Z)) + (size_t)(b * SEQ + pos) * NINP + kvh * 64 + c8 * 8; kv = *(const v4u*)(zr + ZC_SK); vv = *(const v4u*)(zr + ZC_SV); }
                *(LAS v4u*)(Ks + r * SWA_STR + c8 * 16) = kv; *(LAS v4u*)(Vs + r * SWA_STR + c8 * 16) = vv;
                if (qb == 63 && r >= 64) { float fk[8], fv[8]; unpack8(kv, fk); unpack8(vv, fv); const size_t o = ((((size_t)l * NBP + b) * WIN + (r - 64)) * SKV + kvh) * SHD + c8 * 8;
                    *(f32x4*)(out_ + O_SKP + o) = (f32x4){fk[0], fk[1], fk[2], fk[3]}; *(f32x4*)(out_ + O_SKP + o + 4) = (f32x4){fk[4], fk[5], fk[6], fk[7]};
                    *(f32x4*)(out_ + O_SVP + o) = (f32x4){fv[0], fv[1], fv[2], fv[3]}; *(f32x4*)(out_ + O_SVP + o + 4) = (f32x4){fv[4], fv[5], fv[6], fv[7]}; }
            }
            __syncthreads();
            const int head = kvh * 8 + F.wave, t = q0 + F.lane, row = b * SEQ + t;
            float q[64], o[64]; load_q64(((bf16*)(ws_ + WS_Z)) + (size_t)row * NINP + ZC_SQ + head * 64, q);
#pragma unroll
            for (int i = 0; i < 64; ++i) o[i] = 0.f;
            float m = sinks[head], ls = 1.0f;
            attn_core<SWA_STR, false, true>(q, Ks + F.lane * SWA_STR, Vs + F.lane * SWA_STR, 129, 128 - t, BT + head * SWA_BTS + 128, m, ls, o);
            store_o64(((bf16*)(ws_ + WS_BR)) + (size_t)1 * M * MIXW + (size_t)row * MIXW + head * 64, o, 1.0f / ls);
        } else {
            const int su = u - 256, b = su >> 1, kvh = su & 1;
            for (int i = F.tid; i < 136 * 8; i += NTHR) { const int r = i >> 3, c8 = i & 7; float fk[8], fv[8];
                if (r < 128) { const size_t o = ((((size_t)l * NBS + b) * WIN + r) * SKV + kvh) * SHD + c8 * 8; const f32x4 a0 = *(const f32x4*)(in_I_CSK + o), a1 = *(const f32x4*)(in_I_CSK + o + 4), b0 = *(const f32x4*)(in_I_CSV + o), b1 = *(const f32x4*)(in_I_CSV + o + 4);
#pragma unroll
                    for (int k = 0; k < 4; ++k) { fk[k] = a0[k]; fk[4 + k] = a1[k]; fv[k] = b0[k]; fv[4 + k] = b1[k]; } }
                else { const bf16* zr = ((bf16*)(ws_ + WS_Z)) + (size_t)(MP + b * TS + (r - 128)) * NINP + kvh * 64 + c8 * 8; unpack8(*(const v4u*)(zr + ZC_SK), fk); unpack8(*(const v4u*)(zr + ZC_SV), fv); }
                *(LAS v4u*)(Ks + r * SWA_STR + c8 * 16) = pack8(fk); *(LAS v4u*)(Vs + r * SWA_STR + c8 * 16) = pack8(fv);
                if (r >= 8) { const size_t o = ((((size_t)l * NBS + b) * WIN + (r - 8)) * SKV + kvh) * SHD + c8 * 8;
                    *(f32x4*)(out_ + O_SKS + o) = (f32x4){fk[0], fk[1], fk[2], fk[3]}; *(f32x4*)(out_ + O_SKS + o + 4) = (f32x4){fk[4], fk[5], fk[6], fk[7]};
                    *(f32x4*)(out_ + O_SVS + o) = (f32x4){fv[0], fv[1], fv[2], fv[3]}; *(f32x4*)(out_ + O_SVS + o + 4) = (f32x4){fv[4], fv[5], fv[6], fv[7]}; }
            }
            __syncthreads();
            if (F.wave == 0) {
                const int t = F.lane & 7, head = kvh * 8 + (F.lane >> 3), row = MP + b * TS + t;
                float q[64], o[64]; load_q64(((bf16*)(ws_ + WS_Z)) + (size_t)row * NINP + ZC_SQ + head * 64, q);
#pragma unroll
                for (int i = 0; i < 64; ++i) o[i] = 0.f;
                float m = sinks[head], ls = 1.0f;
                attn_core<SWA_STR, false, true>(q, Ks + t * SWA_STR, Vs + t * SWA_STR, 129, 0, BT + head * SWA_BTS + 128, m, ls, o);
                store_o64(((bf16*)(ws_ + WS_BR)) + (size_t)1 * M * MIXW + (size_t)row * MIXW + head * 64, o, 1.0f / ls);
            }
        }
    }
    __syncthreads();
}

__device__ __forceinline__ void conv_phase(const Args& A, Frame& F0, int l) {
    unsigned char* const ws_ = (unsigned char*)karg64<KA_WS>();
    float* const out_ = (float*)karg64<KA_OUT>();
    const float* const in_I_CONVW = (const float*)karg64<8 * I_CONVW>();
    const float* const in_I_SCONV = (const float*)karg64<8 * I_SCONV>();
    Frame F = F0; LAUNDER(F);
    const float* cw = in_I_CONVW + (size_t)l * 3 * MIXW; const bf16* Z = (const bf16*)(ws_ + WS_Z); bf16* BRC = (bf16*)(ws_ + WS_BR) + (size_t)2 * M * MIXW;
#pragma unroll 1
    for (int idx = F.vcu * NTHR + F.tid; idx < (M / 8) * (MIXW / 8); idx += F.G * NTHR) {
        const int row0 = (idx >> 7) * 8, c = (idx & 127) * 8; const bool smp = row0 >= MP; const int b = smp ? (row0 - MP) >> 3 : row0 >> 12, t0 = smp ? 0 : (row0 & (SEQ - 1));
        v4u cc[10], ch[10], cbv[8];
#pragma unroll
        for (int k = 0; k < 10; ++k) { cc[k] = (v4u){0u, 0u, 0u, 0u}; ch[k] = cc[k];
            if (k >= 2 || t0 > 0) { const bf16* zr = Z + (size_t)(row0 + k - 2) * NINP + c; cc[k] = *(const v4u*)(zr + ZC_CC); ch[k] = *(const v4u*)(zr + ZC_CH); } }
#pragma unroll
        for (int k = 0; k < 8; ++k) cbv[k] = *(const v4u*)(Z + (size_t)(row0 + k) * NINP + ZC_CB + c);
        float w0[8], w1[8], w2[8];
#pragma unroll
        for (int i = 0; i < 8; ++i) { w0[i] = cw[c + i]; w1[i] = cw[MIXW + c + i]; w2[i] = cw[2 * MIXW + c + i]; }
        float u2[8], u1[8], u0[8];
        { float a[8], d[8]; unpack8(cc[0], a); unpack8(ch[0], d);
#pragma unroll
          for (int i = 0; i < 8; ++i) u2[i] = a[i] * d[i];
          unpack8(cc[1], a); unpack8(ch[1], d);
#pragma unroll
          for (int i = 0; i < 8; ++i) u1[i] = a[i] * d[i]; }
        if (smp) { const float* sp = in_I_SCONV + (((size_t)l * NBS + b) * 2) * MIXW + c; const f32x4 a0 = *(const f32x4*)sp, a1 = *(const f32x4*)(sp + 4), b0 = *(const f32x4*)(sp + MIXW), b1 = *(const f32x4*)(sp + MIXW + 4);
#pragma unroll
            for (int i = 0; i < 4; ++i) { u2[i] = a0[i]; u2[4 + i] = a1[i]; u1[i] = b0[i]; u1[4 + i] = b1[i]; } }
#pragma unroll
        for (int k = 0; k < 8; ++k) { float a[8], d[8], cbf[8], o[8]; unpack8(cc[k + 2], a); unpack8(ch[k + 2], d); unpack8(cbv[k], cbf);
#pragma unroll
            for (int i = 0; i < 8; ++i) { u0[i] = a[i] * d[i]; o[i] = cbf[i] * (w0[i] * u2[i] + w1[i] * u1[i] + w2[i] * u0[i]); }
            *(v4u*)(BRC + (size_t)(row0 + k) * MIXW + c) = pack8(o);
            if (k >= 6 && (smp || t0 == SEQ - 8)) { float* dst = out_ + (smp ? O_CONVS + (((size_t)l * NBS + b) * 2 + (k - 6)) * MIXW : O_CONVP + (((size_t)l * NBP + b) * 2 + (k - 6)) * MIXW) + c;
                *(f32x4*)dst = (f32x4){u0[0], u0[1], u0[2], u0[3]}; *(f32x4*)(dst + 4) = (f32x4){u0[4], u0[5], u0[6], u0[7]}; }
#pragma unroll
            for (int i = 0; i < 8; ++i) { u2[i] = u1[i]; u1[i] = u0[i]; } }
    }
}

__device__ __forceinline__ void gla_stage_wg(const Args& A, Frame& F, int l, int h, LAS float* wgs) {
    const float* const in_I_GB = (const float*)karg64<8 * I_GB>();
    const float* const in_I_GUP = (const float*)karg64<8 * I_GUP>();
    for (int i = F.tid; i < 16 * 128; i += NTHR) wgs[i] = in_I_GUP[(size_t)l * GRANK * 512 + (i >> 7) * 512 + h * 128 + (i & 127)];
    if (F.tid < 128) wgs[2048 + F.tid] = in_I_GB[l * 512 + h * 128 + F.tid];
}
__device__ __forceinline__ float gla_lg(const float (&gl)[16], LAS const float* wgs, int d) {
    float zg = wgs[2048 + d];
#pragma unroll
    for (int r = 0; r < 16; ++r) zg += gl[r] * wgs[r * 128 + d];
    return (fminf(zg, 0.f) - log1pf(__expf(-fabsf(zg)))) * (1.0f / 16.0f);
}
__device__ __forceinline__ void load_glr(const bf16* zr, float (&gl)[16]) {
    float a[8], b[8]; unpack8(*(const v4u*)zr, a); unpack8(*(const v4u*)(zr + 8), b);
#pragma unroll
    for (int i = 0; i < 8; ++i) { gl[i] = a[i]; gl[8 + i] = b[i]; }
}
__device__ __forceinline__ void gla_chunk_b(const Args& A, Frame& F, int l, int row0, int h, LAS float* bl, LAS float* wgs) {
    unsigned char* const ws_ = (unsigned char*)karg64<KA_WS>();
    gla_stage_wg(A, F, l, h, wgs);
    __syncthreads();
    { const int t = F.tid >> 3, dg = F.tid & 7; float gl[16]; load_glr(((bf16*)(ws_ + WS_Z)) + (size_t)(row0 + t) * NINP + ZC_GLR, gl);
#pragma unroll 4
      for (int dd = 0; dd < 16; ++dd) { const int d = dg * 16 + dd; bl[t * 128 + d] = gla_lg(gl, wgs, d); } }
    __syncthreads();
    if (F.tid < 128) { float a = 0.f; for (int t = 0; t < 64; ++t) { a += bl[t * 128 + F.tid]; bl[t * 128 + F.tid] = a; } }
    __syncthreads();
}

typedef short bf16x8 __attribute__((ext_vector_type(8)));
typedef short v4i16_t __attribute__((ext_vector_type(4)));
#define MFMA16(a, b, c) __builtin_amdgcn_mfma_f32_16x16x32_bf16((a), (b), (c), 0, 0, 0)
__device__ __forceinline__ bf16x8 frag_row(LAS const unsigned char* T, int stride, int r0, int k0, int lane) {
    return *(LAS const bf16x8*)(T + (r0 + (lane & 15)) * stride + (k0 + 8 * (lane >> 4)) * 2);
}
__device__ __forceinline__ bf16x8 frag_tr(LAS const unsigned char* T, int stride, int rlo, int rhi, int n0, int lane) {
    const int q = (lane & 15) >> 2, p = lane & 3;
    const v4i16_t lo = __builtin_amdgcn_ds_read_tr16_b64_v4i16((LAS v4i16_t*)(T + (rlo + q) * stride + n0 * 2 + 8 * p));
    const v4i16_t hi = __builtin_amdgcn_ds_read_tr16_b64_v4i16((LAS v4i16_t*)(T + (rhi + q) * stride + n0 * 2 + 8 * p));
    return (bf16x8){lo[0], lo[1], lo[2], lo[3], hi[0], hi[1], hi[2], hi[3]};
}
__device__ __forceinline__ bf16x8 pack_p(const f32x4 a, const f32x4 b) {
    v4u w; w.x = pk2(a[0], a[1]); w.y = pk2(a[2], a[3]); w.z = pk2(b[0], b[1]); w.w = pk2(b[2], b[3]); return __builtin_bit_cast(bf16x8, w);
}

constexpr int SW_STR = 160, SW_ROWS = 208, SW_K = 0, SW_V = SW_ROWS * SW_STR, SW_BT = 2 * SW_ROWS * SW_STR;
__device__ __forceinline__ void swa_tile(LAS const unsigned char* Ks, LAS const unsigned char* Vs, LAS const float* bt, float sink, const bf16* qrow, bf16* orow, int krow0, int kmin, bool store, int lane) {
    const int n = lane & 15, g = lane >> 4;
    bf16x8 qf[2];
#pragma unroll
    for (int ks = 0; ks < 2; ++ks) qf[ks] = *(const bf16x8*)(qrow + 32 * ks + 8 * g);
    f32x4 s[10];
#pragma unroll
    for (int mt = 0; mt < 10; ++mt) { s[mt] = (f32x4){0.f, 0.f, 0.f, 0.f};
#pragma unroll
        for (int ks = 0; ks < 2; ++ks) s[mt] = MFMA16(frag_row(Ks, SW_STR, krow0 + 16 * mt, 32 * ks, lane), qf[ks], s[mt]); }
    float mx = sink;
#pragma unroll
    for (int mt = 0; mt < 10; ++mt)
#pragma unroll
        for (int i = 0; i < 4; ++i) { const int kcol = 16 * mt + 4 * g + i, dist = n + 128 - kcol; const bool valid = (dist >= 0) && (dist <= 128) && (kcol >= kmin);
            const int di = dist < 0 ? 0 : (dist > 128 ? 128 : dist); const float v = valid ? s[mt][i] + bt[di] : -INFINITY; s[mt][i] = v; mx = fmaxf(mx, v); }
    mx = fmaxf(mx, __shfl_xor(mx, 16)); mx = fmaxf(mx, __shfl_xor(mx, 32));
    float sum = 0.f;
#pragma unroll
    for (int mt = 0; mt < 10; ++mt)
#pragma unroll
        for (int i = 0; i < 4; ++i) { const float p = __expf(s[mt][i] - mx); s[mt][i] = p; sum += p; }
    sum += __shfl_xor(sum, 16); sum += __shfl_xor(sum, 32);
    const float inv = 1.0f / (sum + __expf(sink - mx));
    f32x4 o[4];
#pragma unroll
    for (int mt = 0; mt < 4; ++mt) o[mt] = (f32x4){0.f, 0.f, 0.f, 0.f};
#pragma unroll
    for (int k2 = 0; k2 < 5; ++k2) { const bf16x8 pf = pack_p(s[2 * k2], s[2 * k2 + 1]);
#pragma unroll
        for (int mt = 0; mt < 4; ++mt) o[mt] = MFMA16(frag_tr(Vs, SW_STR, krow0 + 32 * k2 + 4 * g, krow0 + 32 * k2 + 16 + 4 * g, 16 * mt, lane), pf, o[mt]); }
    if (store) {
#pragma unroll
        for (int mt = 0; mt < 4; ++mt) { v2u w; w.x = pk2(o[mt][0] * inv, o[mt][1] * inv); w.y = pk2(o[mt][2] * inv, o[mt][3] * inv); *(v2u*)(orow + 16 * mt + 4 * g) = w; } }
}
__device__ __forceinline__ void swa_phase_mfma(const Args& A, Frame& F0, int l) {
    unsigned char* const ws_ = (unsigned char*)karg64<KA_WS>();
    float* const out_ = (float*)karg64<KA_OUT>();
    const float* const in_I_CSK = (const float*)karg64<8 * I_CSK>();
    const float* const in_I_CSV = (const float*)karg64<8 * I_CSV>();
    const float* const in_I_RELB = (const float*)karg64<8 * I_RELB>();
    const float* const in_I_SINK = (const float*)karg64<8 * I_SINK>();
    Frame F = F0; LAUNDER(F);
    LAS unsigned char* Ks = F.lds + SW_K; LAS unsigned char* Vs = F.lds + SW_V; LAS float* BT = (LAS float*)(F.lds + SW_BT);
    const bf16* Z = (const bf16*)(ws_ + WS_Z); bf16* BRB = (bf16*)(ws_ + WS_BR) + (size_t)M * MIXW;
    for (int i = F.tid; i < SH * 129; i += NTHR) { const int h = i / 129, d = i % 129; BT[h * SWA_BTS + d] = in_I_RELB[t5_bucket(d) * SH + h]; }
    const float* sinks = in_I_SINK + l * SH;
#pragma unroll 1
    for (int u = F.vcu; u < 256 + 64; u += F.G) {
        asm volatile("" : "+v"(F.tid), "+v"(F.lane));
        __syncthreads();
        if (u < 256) {
            const int b = u >> 7, kvh = (u >> 6) & 1, qb = u & 63, q0 = qb * 64;
            for (int i = F.tid; i < SW_ROWS * 8; i += NTHR) { const int r = i >> 3, c8 = i & 7, pos = q0 - 128 + r; v4u kv = (v4u){0u, 0u, 0u, 0u}, vv = kv;
                if (pos >= 0 && pos < SEQ) { const bf16* zr = Z + (size_t)(b * SEQ + pos) * NINP + kvh * 64 + c8 * 8; kv = *(const v4u*)(zr + ZC_SK); vv = *(const v4u*)(zr + ZC_SV); }
                *(LAS v4u*)(Ks + r * SW_STR + c8 * 16) = kv; *(LAS v4u*)(Vs + r * SW_STR + c8 * 16) = vv;
                if (qb == 63 && r >= 64 && r < 192) { float fk[8], fv[8]; unpack8(kv, fk); unpack8(vv, fv); const size_t o = ((((size_t)l * NBP + b) * WIN + (r - 64)) * SKV + kvh) * SHD + c8 * 8;
                    *(f32x4*)(out_ + O_SKP + o) = (f32x4){fk[0], fk[1], fk[2], fk[3]}; *(f32x4*)(out_ + O_SKP + o + 4) = (f32x4){fk[4], fk[5], fk[6], fk[7]};
                    *(f32x4*)(out_ + O_SVP + o) = (f32x4){fv[0], fv[1], fv[2], fv[3]}; *(f32x4*)(out_ + O_SVP + o + 4) = (f32x4){fv[4], fv[5], fv[6], fv[7]}; }
            }
            __syncthreads();
            const int head = kvh * 8 + F.wave; const float sink = sinks[head];
#pragma unroll 1
            for (int mq = 0; mq < 4; ++mq) {
                int ln = F.lane; asm volatile("" : "+v"(ln));
                const int t0 = q0 + 16 * mq; const size_t row = (size_t)b * SEQ + t0 + (ln & 15);
                swa_tile(Ks, Vs, BT + head * SWA_BTS, sink, Z + row * NINP + ZC_SQ + head * 64, BRB + row * MIXW + head * 64, 16 * mq, 128 - t0, true, ln);
            }
        } else {
            const int su = u - 256, b = su >> 1, kvh = su & 1;
            for (int i = F.tid; i < 160 * 8; i += NTHR) { const int r = i >> 3, c8 = i & 7; float fk[8], fv[8];
                if (r < 128) { const size_t o = ((((size_t)l * NBS + b) * WIN + r) * SKV + kvh) * SHD + c8 * 8; const f32x4 a0 = *(const f32x4*)(in_I_CSK + o), a1 = *(const f32x4*)(in_I_CSK + o + 4), b0 = *(const f32x4*)(in_I_CSV + o), b1 = *(const f32x4*)(in_I_CSV + o + 4);
#pragma unroll
                    for (int k = 0; k < 4; ++k) { fk[k] = a0[k]; fk[4 + k] = a1[k]; fv[k] = b0[k]; fv[4 + k] = b1[k]; } }
                else if (r < 136) { const bf16* zr = Z + (size_t)(MP + b * TS + (r - 128)) * NINP + kvh * 64 + c8 * 8; unpack8(*(const v4u*)(zr + ZC_SK), fk); unpack8(*(const v4u*)(zr + ZC_SV), fv); }
                else {
#pragma unroll
                    for (int k = 0; k < 8; ++k) { fk[k] = 0.f; fv[k] = 0.f; } }
                *(LAS v4u*)(Ks + r * SW_STR + c8 * 16) = pack8(fk); *(LAS v4u*)(Vs + r * SW_STR + c8 * 16) = pack8(fv);
                if (r >= 8 && r < 136) { const size_t o = ((((size_t)l * NBS + b) * WIN + (r - 8)) * SKV + kvh) * SHD + c8 * 8;
                    *(f32x4*)(out_ + O_SKS + o) = (f32x4){fk[0], fk[1], fk[2], fk[3]}; *(f32x4*)(out_ + O_SKS + o + 4) = (f32x4){fk[4], fk[5], fk[6], fk[7]};
                    *(f32x4*)(out_ + O_SVS + o) = (f32x4){fv[0], fv[1], fv[2], fv[3]}; *(f32x4*)(out_ + O_SVS + o + 4) = (f32x4){fv[4], fv[5], fv[6], fv[7]}; }
            }
            __syncthreads();
            const int head = kvh * 8 + F.wave, n = F.lane & 15; const size_t row = (size_t)MP + b * TS + (n & 7);
            swa_tile(Ks, Vs, BT + head * SWA_BTS, sinks[head], Z + row * NINP + ZC_SQ + head * 64, BRB + row * MIXW + head * 64, 0, 0, n < 8, F.lane);
        }
    }
    __syncthreads();
}

constexpr int XA_STR = 272, XA_K = 0, XA_V = 256 * XA_STR;
__device__ __forceinline__ void xattn_tile(LAS const unsigned char* Ks, LAS const unsigned char* Vs, const bf16* qrow, bf16* orow, bool store, int lane) {
    const int g = lane >> 4;
    bf16x8 qf[4];
#pragma unroll
    for (int ks = 0; ks < 4; ++ks) qf[ks] = *(const bf16x8*)(qrow + 32 * ks + 8 * g);
    f32x4 s[16]; float mx = -INFINITY;
#pragma unroll
    for (int mt = 0; mt < 16; ++mt) { s[mt] = (f32x4){0.f, 0.f, 0.f, 0.f};
#pragma unroll
        for (int ks = 0; ks < 4; ++ks) s[mt] = MFMA16(frag_row(Ks, XA_STR, 16 * mt, 32 * ks, lane), qf[ks], s[mt]);
        mx = fmaxf(mx, fmaxf(fmaxf(s[mt][0], s[mt][1]), fmaxf(s[mt][2], s[mt][3]))); }
    mx = fmaxf(mx, __shfl_xor(mx, 16)); mx = fmaxf(mx, __shfl_xor(mx, 32));
    float sum = 0.f;
#pragma unroll
    for (int mt = 0; mt < 16; ++mt)
#pragma unroll
        for (int i = 0; i < 4; ++i) { const float p = __expf(s[mt][i] - mx); s[mt][i] = p; sum += p; }
    sum += __shfl_xor(sum, 16); sum += __shfl_xor(sum, 32);
    const float inv = 1.0f / sum;
    f32x4 o[8];
#pragma unroll
    for (int mt = 0; mt < 8; ++mt) o[mt] = (f32x4){0.f, 0.f, 0.f, 0.f};
#pragma unroll
    for (int k2 = 0; k2 < 8; ++k2) { const bf16x8 pf = pack_p(s[2 * k2], s[2 * k2 + 1]);
#pragma unroll
        for (int mt = 0; mt < 8; ++mt) o[mt] = MFMA16(frag_tr(Vs, XA_STR, 32 * k2 + 4 * g, 32 * k2 + 16 + 4 * g, 16 * mt, lane), pf, o[mt]); }
    if (store) {
#pragma unroll
        for (int mt = 0; mt < 8; ++mt) { v2u w; w.x = pk2(o[mt][0] * inv, o[mt][1] * inv); w.y = pk2(o[mt][2] * inv, o[mt][3] * inv); *(v2u*)(orow + 16 * mt + 4 * g) = w; } }
}
__device__ __forceinline__ void xattn_phase_mfma(const Args& A, Frame& F0, int l) {
    unsigned char* const ws_ = (unsigned char*)karg64<KA_WS>();
    const float* const in_I_CMK = (const float*)karg64<8 * I_CMK>();
    const float* const in_I_CMV = (const float*)karg64<8 * I_CMV>();
    Frame F = F0; LAUNDER(F);
    LAS unsigned char* Ks = F.lds + XA_K; LAS unsigned char* Vs = F.lds + XA_V;
    const bf16* XQ = (const bf16*)(ws_ + WS_XQ); bf16* XO = (bf16*)(ws_ + WS_XO);
#pragma unroll 1
    for (int u = F.vcu; u < 128 + 128; u += F.G) {
        asm volatile("" : "+v"(F.tid), "+v"(F.lane));
        __syncthreads();
        if (u < 128) {
            const int b = u >> 6, h = (u >> 4) & 3, q0 = (u & 15) * 256;
            for (int i = F.tid; i < 256 * 16; i += NTHR) { const int mrow = i >> 4, c8 = i & 15; const bf16* src = (const bf16*)(ws_ + WS_MEMKV) + ((size_t)l * 512 + b * 256 + mrow) * 1024 + h * 128 + c8 * 8;
                *(LAS v4u*)(Ks + mrow * XA_STR + c8 * 16) = *(const v4u*)src; *(LAS v4u*)(Vs + mrow * XA_STR + c8 * 16) = *(const v4u*)(src + 512); }
            __syncthreads();
#pragma unroll 1
            for (int qt = F.wave; qt < 16; qt += NWAVES) { int ln = F.lane; asm volatile("" : "+v"(ln)); const size_t row = (size_t)b * SEQ + q0 + 16 * qt + (ln & 15);
                xattn_tile(Ks, Vs, XQ + row * XW + h * 128, XO + row * XW + h * 128, true, ln); }
        } else {
            const int su = u - 128, b = su >> 2, h = su & 3;
            for (int i = F.tid; i < 256 * 16; i += NTHR) { const int mrow = i >> 4, c8 = i & 15; const size_t o = (((size_t)l * NBS + b) * NMEM + mrow) * XW + h * 128 + c8 * 8; float fk[8], fv[8];
                const f32x4 a0 = *(const f32x4*)(in_I_CMK + o), a1 = *(const f32x4*)(in_I_CMK + o + 4), b0 = *(const f32x4*)(in_I_CMV + o), b1 = *(const f32x4*)(in_I_CMV + o + 4);
#pragma unroll
                for (int k = 0; k < 4; ++k) { fk[k] = a0[k]; fk[4 + k] = a1[k]; fv[k] = b0[k]; fv[4 + k] = b1[k]; }
                *(LAS v4u*)(Ks + mrow * XA_STR + c8 * 16) = pack8(fk); *(LAS v4u*)(Vs + mrow * XA_STR + c8 * 16) = pack8(fv); }
            __syncthreads();
            if (F.wave == 0) { const int n = F.lane & 15; const size_t row = (size_t)MP + b * TS + (n & 7);
                xattn_tile(Ks, Vs, XQ + row * XW + h * 128, XO + row * XW + h * 128, n < 8, F.lane); }
        }
    }
    __syncthreads();
}

__device__ __forceinline__ void gla_scan16(const bf16* Z, int row0, int lane, int wave, LAS const float* wgs, float (&bb)[16], float (&bend)[16]) {
    float gl[16]; load_glr(Z + (size_t)(row0 + lane) * NINP + ZC_GLR, gl);
#pragma unroll
    for (int dd = 0; dd < 16; ++dd) { float x = gla_lg(gl, wgs, 16 * wave + dd);
#pragma unroll
        for (int off = 1; off < 64; off <<= 1) { const float y = __shfl_up(x, off); if (lane >= off) x += y; }
        bb[dd] = x; bend[dd] = __shfl(x, 63); }
}
__device__ __forceinline__ void load16(const bf16* p, float (&f)[16]) {
    float a[8], b[8]; unpack8(*(const v4u*)p, a); unpack8(*(const v4u*)(p + 8), b);
#pragma unroll
    for (int i = 0; i < 8; ++i) { f[i] = a[i]; f[8 + i] = b[i]; }
}
__device__ __forceinline__ void store16_lds(LAS unsigned char* p, const float (&f)[16]) {
    v4u w0, w1; w0.x = pk2(f[0], f[1]); w0.y = pk2(f[2], f[3]); w0.z = pk2(f[4], f[5]); w0.w = pk2(f[6], f[7]); w1.x = pk2(f[8], f[9]); w1.y = pk2(f[10], f[11]); w1.z = pk2(f[12], f[13]); w1.w = pk2(f[14], f[15]);
    *(LAS v4u*)p = w0; *(LAS v4u*)(p + 16) = w1;
}
constexpr int G1_KSTR = 288, G1_VSTR = 544, G1_WGS = 0, G1_KT = 9216, G1_V = G1_KT + 64 * G1_KSTR;
__device__ __forceinline__ void gla_pass1_prompt_mfma(const Args& A, Frame& F, int l, int u) {
    unsigned char* const ws_ = (unsigned char*)karg64<KA_WS>();
    LAS float* wgs = (LAS float*)(F.lds + G1_WGS); LAS unsigned char* Kt = F.lds + G1_KT; LAS unsigned char* Vb = F.lds + G1_V;
    const bf16* Z = (const bf16*)(ws_ + WS_Z);
    const int bh = u >> 6, c = u & 63, b = bh >> 2, h = bh & 3, row0 = b * SEQ + c * 64, lane = F.lane, w = F.wave;
    gla_stage_wg(A, F, l, h, wgs);
#pragma unroll 2
    for (int i = F.tid; i < 64 * 32; i += NTHR) { const int t = i >> 5, c8 = i & 31; *(LAS v4u*)(Vb + t * G1_VSTR + c8 * 16) = *(const v4u*)(Z + (size_t)(row0 + t) * NINP + ZC_GV + h * 256 + c8 * 8); }
    __syncthreads();
    { float bb[16], bend[16], k[16]; gla_scan16(Z, row0, lane, w, wgs, bb, bend); load16(Z + (size_t)(row0 + lane) * NINP + ZC_GK + h * 128 + 16 * w, k);
#pragma unroll
      for (int dd = 0; dd < 16; ++dd) k[dd] *= __expf(bend[dd] - bb[dd]);
      store16_lds(Kt + lane * G1_KSTR + 32 * w, k);
      if (lane == 0) {
#pragma unroll
          for (int dd = 0; dd < 16; ++dd) ((float*)(ws_ + WS_GLAD))[(size_t)u * 128 + 16 * w + dd] = __expf(bend[dd]); } }
    __syncthreads();
    const int g = lane >> 4, n = lane & 15;
    bf16x8 af[2];
#pragma unroll
    for (int ks = 0; ks < 2; ++ks) af[ks] = frag_tr(Kt, G1_KSTR, 32 * ks + 8 * g, 32 * ks + 8 * g + 4, 16 * w, lane);
    float* U = (float*)(ws_ + WS_GLAU) + (size_t)u * GDK * GDV;
#pragma unroll 4
    for (int nt = 0; nt < 16; ++nt) { f32x4 acc = (f32x4){0.f, 0.f, 0.f, 0.f};
#pragma unroll
        for (int ks = 0; ks < 2; ++ks) acc = MFMA16(af[ks], frag_tr(Vb, G1_VSTR, 32 * ks + 8 * g, 32 * ks + 8 * g + 4, 16 * nt, lane), acc);
#pragma unroll
        for (int i = 0; i < 4; ++i) U[(size_t)(16 * w + 4 * g + i) * 256 + 16 * nt + n] = acc[i]; }
}
constexpr int G3_QSTR = 272, G3_VSTR = 528, G3_PSTR = 160, G3_QD = 0, G3_KD = 64 * G3_QSTR, G3_V = 2 * 64 * G3_QSTR, G3_S = G3_V + 64 * G3_VSTR, G3_PM = G3_S + 128 * G3_VSTR, G3_END = G3_PM + 64 * G3_PSTR;
static_assert(G3_END <= 146944 && 64 * 260 * 4 <= 128 * G3_VSTR && 8704 <= 64 * G3_PSTR, "pass-3 LDS map");
__device__ __forceinline__ void gla_pass3_mfma(const Args& A, Frame& F0, int l) {
    unsigned char* const ws_ = (unsigned char*)karg64<KA_WS>();
    const float* const in_I_GNORM = (const float*)karg64<8 * I_GNORM>();
    Frame F = F0; LAUNDER(F);
    LAS unsigned char* Qd = F.lds + G3_QD; LAS unsigned char* Kd = F.lds + G3_KD; LAS unsigned char* Vb = F.lds + G3_V; LAS unsigned char* Sb = F.lds + G3_S; LAS unsigned char* Pm = F.lds + G3_PM;
    LAS float* wgs = (LAS float*)Pm; LAS float* Of = (LAS float*)Sb;
    const bf16* Z = (const bf16*)(ws_ + WS_Z); bf16* BRA = (bf16*)(ws_ + WS_BR);
#pragma unroll 1
    for (int u = F.vcu; u < 512; u += F.G) {
        asm volatile("" : "+v"(F.tid), "+v"(F.lane));
        const int lane = F.lane, w = F.wave, g = lane >> 4, n = lane & 15;
        __syncthreads();
        const int bh = u >> 6, c = u & 63, b = bh >> 2, h = bh & 3, row0 = b * SEQ + c * 64;
        gla_stage_wg(A, F, l, h, wgs);
#pragma unroll 2
        for (int i = F.tid; i < 64 * 32; i += NTHR) { const int t = i >> 5, c8 = i & 31; *(LAS v4u*)(Vb + t * G3_VSTR + c8 * 16) = *(const v4u*)(Z + (size_t)(row0 + t) * NINP + ZC_GV + h * 256 + c8 * 8); }
        { const float* S = (const float*)(ws_ + WS_GLAU) + (size_t)u * GDK * GDV;
#pragma unroll 2
          for (int i = F.tid; i < 128 * 32; i += NTHR) { const int d = i >> 5, c8 = i & 31; const f32x4 s0 = *(const f32x4*)(S + d * 256 + c8 * 8), s1 = *(const f32x4*)(S + d * 256 + c8 * 8 + 4);
              v4u wv; wv.x = pk2(s0[0], s0[1]); wv.y = pk2(s0[2], s0[3]); wv.z = pk2(s1[0], s1[1]); wv.w = pk2(s1[2], s1[3]); *(LAS v4u*)(Sb + d * G3_VSTR + c8 * 16) = wv; } }
        __syncthreads();
        { float bb[16], bend[16], q[16], k[16]; gla_scan16(Z, row0, lane, w, wgs, bb, bend);
          load16(Z + (size_t)(row0 + lane) * NINP + ZC_GQ + h * 128 + 16 * w, q); load16(Z + (size_t)(row0 + lane) * NINP + ZC_GK + h * 128 + 16 * w, k);
#pragma unroll
          for (int dd = 0; dd < 16; ++dd) { q[dd] *= __expf(bb[dd]); k[dd] *= __expf(-bb[dd]); }
          store16_lds(Qd + lane * G3_QSTR + 32 * w, q); store16_lds(Kd + lane * G3_QSTR + 32 * w, k); }
        __syncthreads();
        {
            const int mt = w >> 1;
#pragma unroll
            for (int j = 0; j < 2; ++j) { const int nt = 2 * (w & 1) + j; f32x4 acc = (f32x4){0.f, 0.f, 0.f, 0.f};
#pragma unroll
                for (int ks = 0; ks < 4; ++ks) acc = MFMA16(frag_row(Qd, G3_QSTR, 16 * mt, 32 * ks, lane), frag_row(Kd, G3_QSTR, 16 * nt, 32 * ks, lane), acc);
#pragma unroll
                for (int i = 0; i < 4; ++i) { const int t = 16 * mt + 4 * g + i, s = 16 * nt + n; *(LAS bf16*)(Pm + t * G3_PSTR + s * 2) = (bf16)(pk2((s <= t) ? acc[i] : 0.f, 0.f) & 0xffffu); } }
        }
        __syncthreads();
        f32x4 o[4][2];
#pragma unroll
        for (int mt = 0; mt < 4; ++mt) { o[mt][0] = (f32x4){0.f, 0.f, 0.f, 0.f}; o[mt][1] = (f32x4){0.f, 0.f, 0.f, 0.f}; }
#pragma unroll
        for (int j = 0; j < 2; ++j) { const int nt = 2 * w + j;
#pragma unroll
            for (int ks = 0; ks < 4; ++ks) { const bf16x8 bf = frag_tr(Sb, G3_VSTR, 32 * ks + 8 * g, 32 * ks + 8 * g + 4, 16 * nt, lane);
#pragma unroll
                for (int mt = 0; mt < 4; ++mt) o[mt][j] = MFMA16(frag_row(Qd, G3_QSTR, 16 * mt, 32 * ks, lane), bf, o[mt][j]); }
#pragma unroll
            for (int ks = 0; ks < 2; ++ks) { const bf16x8 bf = frag_tr(Vb, G3_VSTR, 32 * ks + 8 * g, 32 * ks + 8 * g + 4, 16 * nt, lane);
#pragma unroll
                for (int mt = 0; mt < 4; ++mt) o[mt][j] = MFMA16(frag_row(Pm, G3_PSTR, 16 * mt, 32 * ks, lane), bf, o[mt][j]); } }
        __syncthreads();
#pragma unroll
        for (int mt = 0; mt < 4; ++mt)
#pragma unroll
            for (int j = 0; j < 2; ++j)
#pragma unroll
                for (int i = 0; i < 4; ++i) Of[(16 * mt + 4 * g + i) * 260 + 16 * (2 * w + j) + n] = o[mt][j][i];
        __syncthreads();
        {
            const int tb = F.tid >> 5, vb = F.tid & 31; float gn[8];
#pragma unroll
            for (int j = 0; j < 8; ++j) gn[j] = in_I_GNORM[l * GDV + 8 * vb + j];
#pragma unroll
            for (int i = 0; i < 4; ++i) { const int t = 4 * tb + i; const f32x4 o0 = *(LAS const f32x4*)(Of + t * 260 + 8 * vb), o1 = *(LAS const f32x4*)(Of + t * 260 + 8 * vb + 4);
                float ov[8] = {o0[0], o0[1], o0[2], o0[3], o1[0], o1[1], o1[2], o1[3]}; float ss = 0.f;
#pragma unroll
                for (int j = 0; j < 8; ++j) ss += ov[j] * ov[j];
#pragma unroll
                for (int x = 1; x < 32; x <<= 1) ss += __shfl_xor(ss, x);
                const float rs = rsqrtf(ss * (1.0f / 256.0f) + EPS); const int row = row0 + t; float gv[8], r[8]; unpack8(*(const v4u*)(Z + (size_t)row * NINP + ZC_GR + h * 256 + 8 * vb), gv);
#pragma unroll
                for (int j = 0; j < 8; ++j) r[j] = ov[j] * rs * gn[j] * gv[j] * sigm(gv[j]);
                *(v4u*)(BRA + (size_t)row * MIXW + h * 256 + 8 * vb) = pack8(r); }
        }
    }
    __syncthreads();
}
__device__ __forceinline__ void gla_pass1(const Args& A, Frame& F0, int l) {
    unsigned char* const ws_ = (unsigned char*)karg64<KA_WS>();
    float* const out_ = (float*)karg64<KA_OUT>();
    const float* const in_I_GNORM = (const float*)karg64<8 * I_GNORM>();
    const float* const in_I_SGLA = (const float*)karg64<8 * I_SGLA>();
    Frame F = F0; LAUNDER(F);
    LAS float* bl = (LAS float*)(F.lds); LAS float* kt = (LAS float*)(F.lds + 32768); LAS float* wgs = (LAS float*)(F.lds + 65536);
#pragma unroll 1
    for (int u = F.vcu; u < 512 + 128; u += F.G) {
        asm volatile("" : "+v"(F.tid), "+v"(F.lane));
        __syncthreads();
        if (u < 512) {
            gla_pass1_prompt_mfma(A, F, l, u);
        } else {
            const int su = u - 512, b = su >> 2, h = su & 3, row0 = MP + b * TS;
            LAS float* qs = (LAS float*)(F.lds); LAS float* ks = qs + 1024; LAS float* es = qs + 2048; LAS float* vs = qs + 3072; LAS float* red = qs + 5120;
            gla_stage_wg(A, F, l, h, wgs);
            __syncthreads();
            { const int t = F.tid >> 6, dp = F.tid & 63; float gl[16]; load_glr(((bf16*)(ws_ + WS_Z)) + (size_t)(row0 + t) * NINP + ZC_GLR, gl);
              es[t * 128 + 2 * dp] = __expf(gla_lg(gl, wgs, 2 * dp)); es[t * 128 + 2 * dp + 1] = __expf(gla_lg(gl, wgs, 2 * dp + 1)); }
            for (int i = F.tid; i < 8 * 128; i += NTHR) { const int t = i >> 7, d = i & 127; const bf16* zr = ((bf16*)(ws_ + WS_Z)) + (size_t)(row0 + t) * NINP + h * 128 + d; qs[i] = bf1(zr[ZC_GQ]); ks[i] = bf1(zr[ZC_GK]); }
            for (int i = F.tid; i < 8 * 256; i += NTHR) { const int t = i >> 8, v = i & 255; vs[i] = bf1(((bf16*)(ws_ + WS_Z))[(size_t)(row0 + t) * NINP + ZC_GV + h * 256 + v]); }
            __syncthreads();
            const int v = F.tid & 255, half = F.tid >> 8; const size_t sidx = (((size_t)l * NBS + b) * GH + h) * GDK * GDV;
            const float* S0 = in_I_SGLA + sidx + (size_t)(64 * half) * 256 + v;
            float S[64];
#pragma unroll
            for (int i = 0; i < 64; ++i) S[i] = S0[i * 256];
            for (int t = 0; t < 8; ++t) { const float vv = vs[t * 256 + v]; float part = 0.f;
#pragma unroll
                for (int i = 0; i < 64; ++i) { const int d = 64 * half + i; S[i] = es[t * 128 + d] * S[i] + ks[t * 128 + d] * vv; part += qs[t * 128 + d] * S[i]; }
                red[(t * 2 + half) * 256 + v] = part; }
            float* So = out_ + O_GLAS + sidx + (size_t)(64 * half) * 256 + v;
#pragma unroll
            for (int i = 0; i < 64; ++i) So[i * 256] = S[i];
            __syncthreads();
            { const int t = F.wave, row = row0 + t; float o[4]; float ss = 0.f;
#pragma unroll
              for (int k = 0; k < 4; ++k) { const int vv = F.lane + 64 * k; o[k] = red[(t * 2) * 256 + vv] + red[(t * 2 + 1) * 256 + vv]; ss += o[k] * o[k]; }
              ss = wave_sum(ss); const float rs = rsqrtf(ss * (1.0f / 256.0f) + EPS);
#pragma unroll
              for (int k = 0; k < 4; ++k) { const int vv = F.lane + 64 * k; const float g = bf1(((bf16*)(ws_ + WS_Z))[(size_t)row * NINP + ZC_GR + h * 256 + vv]);
                  ((bf16*)(ws_ + WS_BR))[(size_t)row * MIXW + h * 256 + vv] = (bf16)(pk2(o[k] * rs * in_I_GNORM[l * GDV + vv] * g * sigm(g), 0.f) & 0xffffu); } }
        }
    }
    __syncthreads();
}
__device__ __forceinline__ void gla_pass2(const Args& A, Frame& F0, int l) {
    unsigned char* const ws_ = (unsigned char*)karg64<KA_WS>();
    float* const out_ = (float*)karg64<KA_OUT>();
    Frame F = F0; LAUNDER(F);
    for (int e = F.vcu * NTHR + F.tid; e < 8 * GDK * GDV; e += F.G * NTHR) {
        const int bh = e >> 15, dv = e & 32767, d = dv >> 8;
        float* U = ((float*)(ws_ + WS_GLAU)) + (size_t)bh * 64 * GDK * GDV + dv; const float* D = ((float*)(ws_ + WS_GLAD)) + (size_t)bh * 64 * 128 + d;
        float S = 0.f;
        for (int c0 = 0; c0 < 64; c0 += 8) { float uu[8], dd[8];
#pragma unroll
            for (int k = 0; k < 8; ++k) { uu[k] = U[(size_t)(c0 + k) * GDK * GDV]; dd[k] = D[(c0 + k) * 128]; }
#pragma unroll
            for (int k = 0; k < 8; ++k) { U[(size_t)(c0 + k) * GDK * GDV] = S; S = dd[k] * S + uu[k]; } }
        out_[O_GLAP + ((size_t)l * 8 + bh) * GDK * GDV + dv] = S;
    }
}
__device__ __forceinline__ void gla_pass3(const Args& A, Frame& F0, int l) {
    unsigned char* const ws_ = (unsigned char*)karg64<KA_WS>();
    const float* const in_I_GNORM = (const float*)karg64<8 * I_GNORM>();
    Frame F = F0; LAUNDER(F);
    LAS float* bl = (LAS float*)(F.lds); LAS float* qdT = (LAS float*)(F.lds + 32768); LAS float* kdT = (LAS float*)(F.lds + 67584); LAS float* Am = (LAS float*)(F.lds + 102400); LAS float* wgs = (LAS float*)(F.lds + 119808);
    for (int u = F.vcu; u < 512; u += F.G) {
        __syncthreads();
        const int bh = u >> 6, c = u & 63, b = bh >> 2, h = bh & 3, row0 = b * SEQ + c * 64;
        gla_chunk_b(A, F, l, row0, h, bl, wgs);
        { const int t = F.tid & 63, dg = F.tid >> 6; const bf16* zr = ((bf16*)(ws_ + WS_Z)) + (size_t)(row0 + t) * NINP + h * 128 + dg * 16; float q[16], k[16];
          { float a[8], bb[8]; unpack8(*(const v4u*)(zr + ZC_GQ), a); unpack8(*(const v4u*)(zr + ZC_GQ + 8), bb);
#pragma unroll
            for (int i = 0; i < 8; ++i) { q[i] = a[i]; q[8 + i] = bb[i]; }
            unpack8(*(const v4u*)(zr + ZC_GK), a); unpack8(*(const v4u*)(zr + ZC_GK + 8), bb);
#pragma unroll
            for (int i = 0; i < 8; ++i) { k[i] = a[i]; k[8 + i] = bb[i]; } }
#pragma unroll
          for (int i = 0; i < 16; ++i) { const int d = dg * 16 + i; const float bb = bl[t * 128 + d]; qdT[d * 68 + t] = q[i] * __expf(bb); kdT[d * 68 + t] = k[i] * __expf(-bb); } }
        __syncthreads();
        const int tb = F.tid >> 5, vb = F.tid & 31;
        {
            float a[4][2];
#pragma unroll
            for (int i = 0; i < 4; ++i) { a[i][0] = 0.f; a[i][1] = 0.f; }
            for (int d = 0; d < 128; ++d) { const f32x4 qq = *(LAS const f32x4*)(qdT + d * 68 + 4 * tb); const f32x2 kk = *(LAS const f32x2*)(kdT + d * 68 + 2 * vb);
#pragma unroll
                for (int i = 0; i < 4; ++i) { a[i][0] += qq[i] * kk[0]; a[i][1] += qq[i] * kk[1]; } }
#pragma unroll
            for (int i = 0; i < 4; ++i)
#pragma unroll
                for (int j = 0; j < 2; ++j) { const int t = 4 * tb + i, s = 2 * vb + j; Am[s * 68 + t] = (s <= t) ? a[i][j] : 0.f; }
        }
        float o[4][8];
#pragma unroll
        for (int i = 0; i < 4; ++i)
#pragma unroll
            for (int j = 0; j < 8; ++j) o[i][j] = 0.f;
        { const float* S = ((float*)(ws_ + WS_GLAU)) + (size_t)u * GDK * GDV + 8 * vb;
          for (int d = 0; d < 128; ++d) { const f32x4 qq = *(LAS const f32x4*)(qdT + d * 68 + 4 * tb); const f32x4 s0 = *(const f32x4*)(S + d * 256), s1 = *(const f32x4*)(S + d * 256 + 4);
#pragma unroll
              for (int i = 0; i < 4; ++i)
#pragma unroll
                  for (int j = 0; j < 4; ++j) { o[i][j] += qq[i] * s0[j]; o[i][4 + j] += qq[i] * s1[j]; } } }
        __syncthreads();
        for (int s = 0; s < 64; ++s) { const f32x4 aa = *(LAS const f32x4*)(Am + s * 68 + 4 * tb); float vv[8]; unpack8(*(const v4u*)(((bf16*)(ws_ + WS_Z)) + (size_t)(row0 + s) * NINP + ZC_GV + h * 256 + 8 * vb), vv);
#pragma unroll
            for (int i = 0; i < 4; ++i)
#pragma unroll
                for (int j = 0; j < 8; ++j) o[i][j] += aa[i] * vv[j]; }
        float gn[8];
#pragma unroll
        for (int j = 0; j < 8; ++j) gn[j] = in_I_GNORM[l * GDV + 8 * vb + j];
#pragma unroll
        for (int i = 0; i < 4; ++i) { float ss = 0.f;
#pragma unroll
            for (int j = 0; j < 8; ++j) ss += o[i][j] * o[i][j];
#pragma unroll
            for (int x = 1; x < 32; x <<= 1) ss += __shfl_xor(ss, x);
            const float rs = rsqrtf(ss * (1.0f / 256.0f) + EPS); const int row = row0 + 4 * tb + i; float g[8], r[8]; unpack8(*(const v4u*)(((bf16*)(ws_ + WS_Z)) + (size_t)row * NINP + ZC_GR + h * 256 + 8 * vb), g);
#pragma unroll
            for (int j = 0; j < 8; ++j) r[j] = o[i][j] * rs * gn[j] * g[j] * sigm(g[j]);
            *(v4u*)(((bf16*)(ws_ + WS_BR)) + (size_t)row * MIXW + h * 256 + 8 * vb) = pack8(r); }
    }
    __syncthreads();
}

__device__ __forceinline__ void xattn_phase(const Args& A, Frame& F0, int l) {
    unsigned char* const ws_ = (unsigned char*)karg64<KA_WS>();
    const float* const in_I_CMK = (const float*)karg64<8 * I_CMK>();
    const float* const in_I_CMV = (const float*)karg64<8 * I_CMV>();
    Frame F = F0; LAUNDER(F);
    LAS unsigned char* Ks = F.lds; LAS unsigned char* Vs = F.lds + 65536;
    for (int u = F.vcu; u < 128 + 128; u += F.G) {
        __syncthreads();
        if (u < 128) {
            const int b = u >> 6, h = (u >> 4) & 3, q0 = (u & 15) * 256;
            for (int i = F.tid; i < 256 * 16; i += NTHR) { const int mrow = i >> 4, c8 = i & 15; const bf16* src = ((bf16*)(ws_ + WS_MEMKV)) + ((size_t)l * 512 + b * 256 + mrow) * 1024 + h * 128 + c8 * 8;
                *(LAS v4u*)(Ks + mrow * 256 + c8 * 16) = *(const v4u*)src; *(LAS v4u*)(Vs + mrow * 256 + c8 * 16) = *(const v4u*)(src + 512); }
            __syncthreads();
            const int qi = F.tid >> 1, half = F.tid & 1, row = b * SEQ + q0 + qi;
            float q[64], o[64]; load_q64(((bf16*)(ws_ + WS_XQ)) + (size_t)row * XW + h * 128 + 64 * half, q);
#pragma unroll
            for (int i = 0; i < 64; ++i) o[i] = 0.f;
            float m = -INFINITY, ls = 0.f;
            attn_core<256, true, false>(q, Ks + half * 128, Vs + half * 128, 256, 0, nullptr, m, ls, o);
            store_o64(((bf16*)(ws_ + WS_XO)) + (size_t)row * XW + h * 128 + 64 * half, o, 1.0f / ls);
        } else {
            const int su = u - 128, b = su >> 2, h = su & 3;
            for (int i = F.tid; i < 256 * 16; i += NTHR) { const int mrow = i >> 4, c8 = i & 15; const size_t o = (((size_t)l * NBS + b) * NMEM + mrow) * XW + h * 128 + c8 * 8; float fk[8], fv[8];
                const f32x4 a0 = *(const f32x4*)(in_I_CMK + o), a1 = *(const f32x4*)(in_I_CMK + o + 4), b0 = *(const f32x4*)(in_I_CMV + o), b1 = *(const f32x4*)(in_I_CMV + o + 4);
#pragma unroll
                for (int k = 0; k < 4; ++k) { fk[k] = a0[k]; fk[4 + k] = a1[k]; fv[k] = b0[k]; fv[4 + k] = b1[k]; }
                *(LAS v4u*)(Ks + mrow * 256 + c8 * 16) = pack8(fk); *(LAS v4u*)(Vs + mrow * 256 + c8 * 16) = pack8(fv); }
            __syncthreads();
            if (F.tid < 16) {
                const int qi = F.tid >> 1, half = F.tid & 1, row = MP + b * TS + qi;
                float q[64], o[64]; load_q64(((bf16*)(ws_ + WS_XQ)) + (size_t)row * XW + h * 128 + 64 * half, q);
#pragma unroll
                for (int i = 0; i < 64; ++i) o[i] = 0.f;
                float m = -INFINITY, ls = 0.f;
                attn_core<256, true, false>(q, Ks + half * 128, Vs + half * 128, 256, 0, nullptr, m, ls, o);
                store_o64(((bf16*)(ws_ + WS_XO)) + (size_t)row * XW + h * 128 + 64 * half, o, 1.0f / ls);
            }
        }
    }
    __syncthreads();
}

__device__ __forceinline__ void ffnact_phase(const Args& A, Frame& F0, int l) {
    unsigned char* const ws_ = (unsigned char*)karg64<KA_WS>();
    float* const out_ = (float*)karg64<KA_OUT>();
    const float* const in_I_FCB = (const float*)karg64<8 * I_FCB>();
    const float* const in_I_FCW = (const float*)karg64<8 * I_FCW>();
    const float* const in_I_SFFN = (const float*)karg64<8 * I_SFFN>();
    Frame F = F0; LAUNDER(F);
    const float* cw = in_I_FCW + (size_t)l * 3 * DFF; const float* cbp = in_I_FCB + (size_t)l * DFF; const bf16* UG = (const bf16*)(ws_ + WS_UG); bf16* ACT = (bf16*)(ws_ + WS_ACT);
    constexpr int NG = DFF / 8;
#pragma unroll 1
    for (int idx = F.vcu * NTHR + F.tid; idx < (M / 8) * NG; idx += F.G * NTHR) {
        const int row0 = (idx / NG) * 8, c = (idx % NG) * 8; const bool smp = row0 >= MP; const int b = smp ? (row0 - MP) >> 3 : row0 >> 12, t0 = smp ? 0 : (row0 & (SEQ - 1));
        v4u gg[10], uu[8];
#pragma unroll
        for (int k = 0; k < 10; ++k) { gg[k] = (v4u){0u, 0u, 0u, 0u}; if (k >= 2 || t0 > 0) gg[k] = *(const v4u*)(UG + (size_t)(row0 + k - 2) * 2 * DFF + DFF + c); }
#pragma unroll
        for (int k = 0; k < 8; ++k) uu[k] = *(const v4u*)(UG + (size_t)(row0 + k) * 2 * DFF + c);
        float w0[8], w1[8], w2[8], cb[8];
#pragma unroll
        for (int i = 0; i < 8; ++i) { w0[i] = cw[c + i]; w1[i] = cw[DFF + c + i]; w2[i] = cw[2 * DFF + c + i]; cb[i] = cbp[c + i]; }
        float g2[8], g1[8], g0[8];
        unpack8(gg[0], g2); unpack8(gg[1], g1);
        if (smp) { const float* sp = in_I_SFFN + (((size_t)l * NBS + b) * 2) * DFF + c; const f32x4 a0 = *(const f32x4*)sp, a1 = *(const f32x4*)(sp + 4), b0 = *(const f32x4*)(sp + DFF), b1 = *(const f32x4*)(sp + DFF + 4);
#pragma unroll
            for (int i = 0; i < 4; ++i) { g2[i] = a0[i]; g2[4 + i] = a1[i]; g1[i] = b0[i]; g1[4 + i] = b1[i]; } }
#pragma unroll
        for (int k = 0; k < 8; ++k) { float uf[8], o[8]; unpack8(gg[k + 2], g0); unpack8(uu[k], uf);
#pragma unroll
            for (int i = 0; i < 8; ++i) { const float gc = w0[i] * g2[i] + w1[i] * g1[i] + w2[i] * g0[i] + cb[i]; o[i] = gc * sigm(gc) * uf[i]; }
            *(v4u*)(ACT + (size_t)(row0 + k) * DFF + c) = pack8(o);
            if (k >= 6 && (smp || t0 == SEQ - 8)) { float* dst = out_ + (smp ? O_FFNS + (((size_t)l * NBS + b) * 2 + (k - 6)) * DFF : O_FFNP + (((size_t)l * NBP + b) * 2 + (k - 6)) * DFF) + c;
                *(f32x4*)dst = (f32x4){g0[0], g0[1], g0[2], g0[3]}; *(f32x4*)(dst + 4) = (f32x4){g0[4], g0[5], g0[6], g0[7]}; }
#pragma unroll
            for (int i = 0; i < 8; ++i) { g2[i] = g1[i]; g1[i] = g0[i]; } }
    }
}

__device__ __forceinline__ void final_phase(const Args& A, Frame& F0) {
    unsigned char* const ws_ = (unsigned char*)karg64<KA_WS>();
    float* const out_ = (float*)karg64<KA_OUT>();
    const float* const in_I_NFIN = (const float*)karg64<8 * I_NFIN>();
    Frame F = F0; LAUNDER(F);
    const int gw = F.vcu * NWAVES + F.wave, NGW = F.G * NWAVES, lane = F.lane; const float* g = in_I_NFIN;
    for (int m = gw; m < M; m += NGW) {
        float s = (lane < 32) ? ((float*)(ws_ + WS_SSQ))[(size_t)m * 32 + lane] : 0.f; s = wave_sum(s);
        const float rs = rsqrtf(s * (1.0f / DM) + EPS);
        float* dst = out_ + ((m < MP) ? O_YP + (size_t)m * DM : O_YS + (size_t)(m - MP) * DM);
#pragma unroll
        for (int j = 0; j < 8; ++j) { const f32x4 v = *((const f32x4*)(((float*)(ws_ + WS_X)) + (size_t)m * DM) + lane + 64 * j); const f32x4 gg = *((const f32x4*)g + lane + 64 * j); *((f32x4*)dst + lane + 64 * j) = v * rs * gg; }
    }
}

__device__ __forceinline__ f32x4 sk_tile(const bf16* A, const bf16* Bt, int K, int rb, int cb, LAS float* red, int tid, int lane, int wave) {
    const int n = lane & 15, g = lane >> 4, npairs = K >> 6;
    f32x4 acc[2][4];
#pragma unroll
    for (int mt = 0; mt < 2; ++mt)
#pragma unroll
        for (int nt = 0; nt < 4; ++nt) acc[mt][nt] = (f32x4){0.f, 0.f, 0.f, 0.f};
    const bf16* ap = A + (size_t)(32 * rb + n) * K + 8 * g; const bf16* bp = Bt + (size_t)(64 * cb + n) * K + 8 * g;
#pragma unroll 2
    for (int p = wave; p < npairs; p += NWAVES) {
        bf16x8 af[2][2], bfr[4][2];
#pragma unroll
        for (int ks = 0; ks < 2; ++ks) {
#pragma unroll
            for (int mt = 0; mt < 2; ++mt) af[mt][ks] = *(const bf16x8*)(ap + (size_t)(16 * mt) * K + 64 * p + 32 * ks);
#pragma unroll
            for (int nt = 0; nt < 4; ++nt) bfr[nt][ks] = *(const bf16x8*)(bp + (size_t)(16 * nt) * K + 64 * p + 32 * ks); }
#pragma unroll
        for (int ks = 0; ks < 2; ++ks)
#pragma unroll
            for (int mt = 0; mt < 2; ++mt)
#pragma unroll
                for (int nt = 0; nt < 4; ++nt) acc[mt][nt] = MFMA16(af[mt][ks], bfr[nt][ks], acc[mt][nt]);
    }
    __syncthreads();
#pragma unroll
    for (int mt = 0; mt < 2; ++mt)
#pragma unroll
        for (int nt = 0; nt < 4; ++nt)
#pragma unroll
            for (int i = 0; i < 4; ++i) red[wave * 2048 + (16 * mt + 4 * g + i) * 64 + 16 * nt + n] = acc[mt][nt][i];
    __syncthreads();
    const int r = tid >> 4, cg = tid & 15; f32x4 s = *(LAS const f32x4*)(red + r * 64 + 4 * cg);
#pragma unroll
    for (int w = 1; w < 8; ++w) s += *(LAS const f32x4*)(red + w * 2048 + r * 64 + 4 * cg);
    return s;
}
__device__ __forceinline__ void sk_residual(const bf16* A, const bf16* Bt, int K, Frame& F0) {
    Frame F = F0; LAUNDER(F);
    unsigned char* const ws_ = (unsigned char*)karg64<KA_WS>();
    float* X = (float*)(ws_ + WS_X); bf16* XB = (bf16*)(ws_ + WS_XB); float* SSQ = (float*)(ws_ + WS_SSQ);
    LAS float* red = (LAS float*)F.lds;
#pragma unroll 1
    for (int u = F.vcu; u < 256; u += F.G) {
        asm volatile("" : "+v"(F.tid), "+v"(F.lane));
        const int rb = u >> 5, cb = u & 31;
        const f32x4 s = sk_tile(A, Bt, K, rb, cb, red, F.tid, F.lane, F.wave);
        const int row = MP + 32 * rb + (F.tid >> 4), col = 64 * cb + 4 * (F.tid & 15); const size_t off = (size_t)row * DM + col;
        const f32x4 x = *(const f32x4*)(X + off) + s; *(f32x4*)(X + off) = x;
        v2u w; w.x = pk2(x[0], x[1]); w.y = pk2(x[2], x[3]); *(v2u*)(XB + off) = w;
        float ss = (x[0] * x[0] + x[1] * x[1]) + (x[2] * x[2] + x[3] * x[3]);
        ss += __shfl_xor(ss, 1); ss += __shfl_xor(ss, 2); ss += __shfl_xor(ss, 4); ss += __shfl_xor(ss, 8);
        if ((F.tid & 15) == 0) SSQ[(size_t)row * 32 + cb] = ss;
    }
    __syncthreads();
}
__device__ __forceinline__ void sk_branch(Frame& F0, int l) {
    Frame F = F0; LAUNDER(F);
    unsigned char* const ws_ = (unsigned char*)karg64<KA_WS>();
    const bf16* BR = (const bf16*)(ws_ + WS_BR); const bf16* Wb = (const bf16*)(ws_ + WS_WBR) + (size_t)l * 3 * DM * MIXW; const bf16* Z = (const bf16*)(ws_ + WS_Z); bf16* MG = (bf16*)(ws_ + WS_MG);
    LAS float* red = (LAS float*)F.lds;
#pragma unroll 1
    for (int u = F.vcu; u < 256; u += F.G) {
        asm volatile("" : "+v"(F.tid), "+v"(F.lane));
        const int rb = u >> 5, cb = u & 31; const int row = MP + 32 * rb + (F.tid >> 4), col = 64 * cb + 4 * (F.tid & 15);
        f32x4 mg = (f32x4){0.f, 0.f, 0.f, 0.f};
#pragma unroll 1
        for (int i = 0; i < 3; ++i) {
            const f32x4 s = sk_tile(BR + (size_t)i * M * MIXW + (size_t)MP * MIXW, Wb + (size_t)i * DM * MIXW, MIXW, rb, cb, red, F.tid, F.lane, F.wave);
            const v2u gw = *(const v2u*)(Z + (size_t)row * NINP + ZC_GATE + i * DM + col);
            mg += s * (f32x4){bflo(gw.x), bfhi(gw.x), bflo(gw.y), bfhi(gw.y)};
        }
        v2u w; w.x = pk2(mg[0], mg[1]); w.y = pk2(mg[2], mg[3]); *(v2u*)(MG + (size_t)row * DM + col) = w;
    }
    __syncthreads();
}

#ifndef PH_MASK
#define PH_MASK 0xffffffffu
#endif
#define PON(i) constexpr ((PH_MASK >> (i)) & 1u) for (int rep_ = 0; rep_ <= (int)((PROBE_MASK >> (i)) & 1u); ++rep_)
#ifndef PROBE_MASK
#define PROBE_MASK 0u
#endif
#ifndef USE_MFMA
#define USE_MFMA 7
#endif
#ifndef MK_PER_PHASE
#define MK_PER_PHASE 0
#endif
constexpr int PH_PER_LAYER = 12, N_PHASES = 2 + DEPTH * PH_PER_LAYER + 1;

__global__ void __launch_bounds__(NTHR, 2) fwd(const Args A) {
    extern __shared__ __attribute__((aligned(16))) unsigned char lds[];
    Frame F;
    F.lds = (LAS unsigned char*)lds;
    F.MISC = (volatile LAS unsigned*)(F.lds + MISC_OFF);
    F.wave = __builtin_amdgcn_readfirstlane((int)threadIdx.x >> 6); F.lane = 0; F.tid = 0;
    F.G = gridDim.x; { const int bx = blockIdx.x; F.vcu = (F.G % 8 == 0) ? (bx % 8) * (F.G / 8) + bx / 8 : bx; }
    F.ctl = (gu32*)(((unsigned char*)karg64<KA_WS>()) + WS_CTL);
    for (int u = F.wave * 64 + lane_id(); u < (LDS_BYTES - LDSCTL_OFF) / 4; u += NTHR) ((LAS unsigned*)(F.lds + LDSCTL_OFF))[u] = 0u;
    __syncthreads();
    XcdBarrier bar; bar.bar = (unsigned*)(F.ctl + CW_BAR); bar.x = 0; bar.st = nullptr; bar.wv = (unsigned)F.wave;
    if (!MK_PER_PHASE) bar = xcd_barrier_post((unsigned*)(F.ctl + CW_BAR), F.MISC + 8, (unsigned)F.wave);
    const int lo = karg32<KA_LO>(), hi = karg32<KA_HI>();
#define IN(k) (lo <= (k) && (k) < hi)
#define SEAM(k) do { if (IN(k) && IN((k) + 1)) xcd_barrier(bar); } while (0)
    typedef pg8::StaticOrder SO;
#define BX_ launder_s((int)blockIdx.x)
#define G_ launder_s(F.G)
    LAS unsigned char* ring = F.lds + RING_OFF;

    if (IN(0)) { if PON(0) p0_convert(A, F); }
    SEAM(0);
    if (IN(1)) { if PON(1)
        for (int l = 0; l < DEPTH; ++l) {
            pg8::Gemm g{((bf16*)(((unsigned char*)karg64<KA_WS>()) + WS_MEMB)), ((bf16*)(((unsigned char*)karg64<KA_WS>()) + WS_WXKV)) + (size_t)l * 2 * XW * DM, NBP * NMEM, 2 * XW, DM}; SO S; S.init(NBP * NMEM, 2 * XW, G_, (int)((BX_ + G_ - 8 * l) % G_));
            pg8::EpiMemKV E{((float*)karg64<KA_OUT>()) + O_MKP + (size_t)l * NBP * NMEM * XW, ((float*)karg64<KA_OUT>()) + O_MVP + (size_t)l * NBP * NMEM * XW, ((bf16*)(((unsigned char*)karg64<KA_WS>()) + WS_MEMKV)) + (size_t)l * NBP * NMEM * 2 * XW};
            pg8::gemm_phase<pg8::EpiMemKV, SO, true, true>(ring, g, S, E, F.wave * 64 + lane_id());
        }
    }
    SEAM(1);
    for (int l = 0; l < DEPTH; ++l) {
        const int pb = 2 + l * PH_PER_LAYER;
        if (IN(pb + 0)) { if PON(2) {
            pg8::Gemm g{((bf16*)(((unsigned char*)karg64<KA_WS>()) + WS_XB)), ((bf16*)(((unsigned char*)karg64<KA_WS>()) + WS_WIN)) + (size_t)l * NINP * DM, M, NINP, DM}; SO S; S.init(M, NINP, G_, BX_);
            pg8::EpiScaleBf16 E{((bf16*)(((unsigned char*)karg64<KA_WS>()) + WS_Z)), NINP, ((float*)(((unsigned char*)karg64<KA_WS>()) + WS_SSQ)), ZC_GATE / 256, ZC_GLR / 256};
            pg8::gemm_phase<pg8::EpiScaleBf16, SO, true, true>(ring, g, S, E, F.wave * 64 + lane_id());
        } }
        SEAM(pb + 0);
        if (IN(pb + 1)) { if PON(3) conv_phase(A, F, l); if PON(4) { if (USE_MFMA & 1) swa_phase_mfma(A, F, l); else swa_phase(A, F, l); } if PON(5) gla_pass1(A, F, l); }
        SEAM(pb + 1);
        if (IN(pb + 2)) { if PON(6) gla_pass2(A, F, l); }
        SEAM(pb + 2);
        if (IN(pb + 3)) { if PON(7) { if (USE_MFMA & 2) gla_pass3_mfma(A, F, l); else gla_pass3(A, F, l); } }
        SEAM(pb + 3);
        if (IN(pb + 4)) { if PON(8) {
            for (int i = 0; i < 3; ++i) {
                pg8::Gemm g{((bf16*)(((unsigned char*)karg64<KA_WS>()) + WS_BR)) + (size_t)i * M * MIXW, ((bf16*)(((unsigned char*)karg64<KA_WS>()) + WS_WBR)) + ((size_t)l * 3 + i) * DM * MIXW, MP, DM, MIXW}; SO S; S.init(MP, DM, G_, BX_);
                pg8::EpiBranch E{((bf16*)(((unsigned char*)karg64<KA_WS>()) + WS_MG)), ((bf16*)(((unsigned char*)karg64<KA_WS>()) + WS_Z)) + ZC_GATE + i * DM, NINP, i == 0 ? 1 : 0};
                pg8::gemm_phase<pg8::EpiBranch, SO, true, true>(ring, g, S, E, F.wave * 64 + lane_id());
            }
            sk_branch(F, l);
        } }
        SEAM(pb + 4);
        if (IN(pb + 5)) { if PON(9) {
            pg8::Gemm g{((bf16*)(((unsigned char*)karg64<KA_WS>()) + WS_MG)), ((bf16*)(((unsigned char*)karg64<KA_WS>()) + WS_WOUT)) + (size_t)l * DM * DM, MP, DM, DM}; SO S; S.init(MP, DM, G_, BX_);
            pg8::EpiResidual E{((float*)(((unsigned char*)karg64<KA_WS>()) + WS_X)), ((bf16*)(((unsigned char*)karg64<KA_WS>()) + WS_XB)), ((float*)(((unsigned char*)karg64<KA_WS>()) + WS_SSQ))};
            pg8::gemm_phase<pg8::EpiResidual, SO, true, true>(ring, g, S, E, F.wave * 64 + lane_id());
            sk_residual(((const bf16*)(((unsigned char*)karg64<KA_WS>()) + WS_MG)) + (size_t)MP * DM, ((const bf16*)(((unsigned char*)karg64<KA_WS>()) + WS_WOUT)) + (size_t)l * DM * DM, DM, F);
        } }
        SEAM(pb + 5);
        if (IN(pb + 6)) { if PON(10) {
            pg8::Gemm g{((bf16*)(((unsigned char*)karg64<KA_WS>()) + WS_XB)), ((bf16*)(((unsigned char*)karg64<KA_WS>()) + WS_WXQ)) + (size_t)l * XW * DM, M, XW, DM}; SO S; S.init(M, XW, G_, BX_);
            pg8::EpiScaleBf16 E{((bf16*)(((unsigned char*)karg64<KA_WS>()) + WS_XQ)), XW, ((float*)(((unsigned char*)karg64<KA_WS>()) + WS_SSQ)), 0, 0};
            pg8::gemm_phase<pg8::EpiScaleBf16, SO, true, true>(ring, g, S, E, F.wave * 64 + lane_id());
        } }
        SEAM(pb + 6);
        if (IN(pb + 7)) { if PON(11) { if (USE_MFMA & 4) xattn_phase_mfma(A, F, l); else xattn_phase(A, F, l); } }
        SEAM(pb + 7);
        if (IN(pb + 8)) { if PON(12) {
            pg8::Gemm g{((bf16*)(((unsigned char*)karg64<KA_WS>()) + WS_XO)), ((bf16*)(((unsigned char*)karg64<KA_WS>()) + WS_WXO)) + (size_t)l * DM * XW, MP, DM, XW}; SO S; S.init(MP, DM, G_, BX_);
            pg8::EpiResidual E{((float*)(((unsigned char*)karg64<KA_WS>()) + WS_X)), ((bf16*)(((unsigned char*)karg64<KA_WS>()) + WS_XB)), ((float*)(((unsigned char*)karg64<KA_WS>()) + WS_SSQ))};
            pg8::gemm_phase<pg8::EpiResidual, SO, true, true>(ring, g, S, E, F.wave * 64 + lane_id());
            sk_residual(((const bf16*)(((unsigned char*)karg64<KA_WS>()) + WS_XO)) + (size_t)MP * XW, ((const bf16*)(((unsigned char*)karg64<KA_WS>()) + WS_WXO)) + (size_t)l * DM * XW, XW, F);
        } }
        SEAM(pb + 8);
        if (IN(pb + 9)) { if PON(13) {
            pg8::Gemm g{((bf16*)(((unsigned char*)karg64<KA_WS>()) + WS_XB)), ((bf16*)(((unsigned char*)karg64<KA_WS>()) + WS_WUP)) + (size_t)l * 2 * DFF * DM, M, 2 * DFF, DM}; SO S; S.init(M, 2 * DFF, G_, BX_);
            pg8::EpiScaleBf16 E{((bf16*)(((unsigned char*)karg64<KA_WS>()) + WS_UG)), 2 * DFF, ((float*)(((unsigned char*)karg64<KA_WS>()) + WS_SSQ)), 0, 0};
            pg8::gemm_phase<pg8::EpiScaleBf16, SO, true, true>(ring, g, S, E, F.wave * 64 + lane_id());
        } }
        SEAM(pb + 9);
        if (IN(pb + 10)) { if PON(14) ffnact_phase(A, F, l); }
        SEAM(pb + 10);
        if (IN(pb + 11)) { if PON(15) {
            pg8::Gemm g{((bf16*)(((unsigned char*)karg64<KA_WS>()) + WS_ACT)), ((bf16*)(((unsigned char*)karg64<KA_WS>()) + WS_WDN)) + (size_t)l * DM * DFF, MP, DM, DFF}; SO S; S.init(MP, DM, G_, BX_);
            pg8::EpiResidual E{((float*)(((unsigned char*)karg64<KA_WS>()) + WS_X)), ((bf16*)(((unsigned char*)karg64<KA_WS>()) + WS_XB)), ((float*)(((unsigned char*)karg64<KA_WS>()) + WS_SSQ))};
            pg8::gemm_phase<pg8::EpiResidual, SO, true, true>(ring, g, S, E, F.wave * 64 + lane_id());
            sk_residual(((const bf16*)(((unsigned char*)karg64<KA_WS>()) + WS_ACT)) + (size_t)MP * DFF, ((const bf16*)(((unsigned char*)karg64<KA_WS>()) + WS_WDN)) + (size_t)l * DM * DFF, DFF, F);
        } }
        SEAM(pb + 11);
    }
    if (IN(N_PHASES - 1)) { if PON(16) final_phase(A, F); }
#undef IN
#undef SEAM
}

extern "C" void kernel_launch(void* const* d_in, const int* in_sizes, int n_in, void* d_out, int out_size, void* d_ws, size_t ws_size, hipStream_t stream) {
    static int grid = 0;
    if (grid == 0) {
        if (n_in != N_INPUTS || (size_t)out_size != O_END || ws_size < WS_END) { fprintf(stderr, "kernel_launch: built for %d inputs, %zu outputs, >= %zu bytes of workspace; got n_in %d, out %d, ws %zu; nothing launched\n", N_INPUTS, (size_t)O_END, (size_t)WS_END, n_in, out_size, ws_size); grid = -1; return; }
        int dev = 0, cus = 0, per_cu = 0;
        if (hipGetDevice(&dev) != hipSuccess || hipDeviceGetAttribute(&cus, hipDeviceAttributeMultiprocessorCount, dev) != hipSuccess) { fprintf(stderr, "kernel_launch: device query failed\n"); grid = -1; return; }
        if (hipFuncSetAttribute((const void*)fwd, hipFuncAttributeMaxDynamicSharedMemorySize, LDS_BYTES) != hipSuccess) { fprintf(stderr, "kernel_launch: hipFuncSetAttribute failed\n"); grid = -1; return; }
        if (hipOccupancyMaxActiveBlocksPerMultiprocessor(&per_cu, (const void*)fwd, NTHR, LDS_BYTES) != hipSuccess || per_cu < 1) { fprintf(stderr, "kernel_launch: occupancy query reports %d workgroups per CU\n", per_cu); }
        (void)hipGetLastError();
        grid = cus;
    }
    if (grid < 0) return;
    if (hipMemsetAsync((char*)d_ws + WS_CTL, 0, CTL_ZERO_BYTES, stream) != hipSuccess) { fprintf(stderr, "kernel_launch: memset failed\n"); return; }
    Args a{};
    for (int i = 0; i < N_INPUTS; ++i) a.in[i] = (const float*)d_in[i];
    a.out = (float*)d_out; a.ws = (unsigned char*)d_ws;
#if MK_PER_PHASE
    for (int p = 0; p < N_PHASES; ++p) {
        a.ph_lo = p; a.ph_hi = p + 1;
        hipLaunchKernelGGL(fwd, dim3(grid), dim3(NTHR), LDS_BYTES, stream, a);
    }
#else
    a.ph_lo = 0; a.ph_hi = N_PHASES;
    hipLaunchKernelGGL(fwd, dim3(grid), dim3(NTHR), LDS_BYTES, stream, a);
#endif
    const hipError_t le = hipPeekAtLastError();
    if (le != hipSuccess) fprintf(stderr, "kernel_launch: launch failed: %s\n", hipGetErrorName(le));
}
```

```cpp
#include <hip/hip_runtime.h>
#include <cstdio>
#include <cstdint>
#include <cmath>
#define MK_PER_PHASE 0
namespace pg8 {
#define PG8_LAS __attribute__((address_space(3)))
typedef unsigned short bf16_t;
typedef short bf16x8 __attribute__((ext_vector_type(8)));
typedef float f32x4 __attribute__((ext_vector_type(4)));
typedef unsigned u32x4 __attribute__((ext_vector_type(4)));
constexpr int BM = 256, BK = 64, HALF = 128, HTB = HALF * BK * 2  , STAGE_BYTES = 8 * HTB, NXCD = 8, WGM = 8;

__host__ __device__ __forceinline__ int lds_byte(int r, int c) { const int st = (r >> 4) * 2 + (c >> 5), rr = r & 15, cc = c & 31, ob = rr * 64 + cc * 2; return st * 1024 + (ob ^ (((ob >> 9) & 1) << 5)); }
__host__ __device__ __forceinline__ void stage_rc(int b, int& R, int& C) { const int st = b / 1024, sb = b % 1024, swz = sb ^ (((sb >> 9) & 1) << 5); R = (st >> 1) * 16 + swz / 64; C = (st & 1) * 32 + (swz % 64) / 2; }
__host__ __device__ __forceinline__ int perm32(int rho) { const int n = rho >> 4, i = rho & 15; return 8 * (i >> 2) + 4 * n + (i & 3); }

struct Unit { int pm, pn; };
struct Gemm { const bf16_t* A; const bf16_t* Bt; int M, N, K; };

struct StaticOrder {
    int nM, nN, nwg, G, c;
    __host__ __device__ void init(int M, int N, int G_, int c_) { nM = M / BM; nN = N / BM; nwg = nM * nN; G = G_; c = c_; }
    __host__ __device__ bool next(int i, Unit& u) const {
        const long L = (long)i * G + c; if (L >= nwg) return false;
        int wgid = (int)L; { const int q = nwg / NXCD, r = nwg % NXCD, xcd = wgid % NXCD, off = wgid / NXCD; wgid = (xcd < r ? xcd * (q + 1) : r * (q + 1) + (xcd - r) * q) + off; }
        const int nig = WGM * nN, gid = wgid / nig, fm = gid * WGM, gsz = (nM - fm) < WGM ? (nM - fm) : WGM;
        u.pm = fm + ((wgid % nig) % gsz); u.pn = (wgid % nig) / gsz; return true;
    }
    __device__ __forceinline__ void a_ready(const Unit&) const {}
    __device__ __forceinline__ void done(const Unit&) const {}
};

__device__ __forceinline__ unsigned cvt_pk_bf16(float lo, float hi) { unsigned r; asm volatile("v_cvt_pk_bf16_f32 %0, %1, %2" : "=v"(r) : "v"(lo), "v"(hi)); return r; }
typedef float f32x2 __attribute__((ext_vector_type(2)));
#define PG8_GAS __attribute__((address_space(1)))
typedef unsigned u32x2 __attribute__((ext_vector_type(2)));
__device__ __forceinline__ float bf_lo(unsigned w) { return __uint_as_float(w << 16); }
__device__ __forceinline__ float bf_hi(unsigned w) { return __uint_as_float(w & 0xffff0000u); }
__device__ __forceinline__ float sigmoidf_(float v) { return 1.0f / (1.0f + __expf(-v)); }

struct EpiScaleBf16 {
    static constexpr bool PERM = true, AFTER_DRAIN = false;
    bf16_t* O; int ldc; const float* ssq; int sig_lo, sig_hi;
    __device__ __forceinline__ void operator()(const f32x4 (&acc)[2][2][4][2], const Unit& u, int wr, int wc, int fr, int fq) const {
        const int row0 = u.pm * BM + wr * 64 + fr, col0 = u.pn * BM + wc * 32 + 8 * fq;
        const bool sig = (u.pn >= sig_lo) && (u.pn < sig_hi);
        float rs[2][4];
        if (ssq) {
            f32x4 pr[2][4][2];
#pragma unroll
            for (int ai = 0; ai < 2; ++ai)
#pragma unroll
                for (int m = 0; m < 4; ++m) { const PG8_GAS f32x4* p = (const PG8_GAS f32x4*)(ssq + (size_t)(row0 + ai * HALF + m * 16) * 32 + 8 * fq); pr[ai][m][0] = p[0]; pr[ai][m][1] = p[1]; }
#pragma unroll
            for (int ai = 0; ai < 2; ++ai)
#pragma unroll
                for (int m = 0; m < 4; ++m) { const f32x4 s = pr[ai][m][0] + pr[ai][m][1]; float t = (s[0] + s[1]) + (s[2] + s[3]); t += __shfl_xor(t, 16); t += __shfl_xor(t, 32);
                    rs[ai][m] = rsqrtf(t * (1.0f / 2048.0f) + 1e-6f); }
        } else {
#pragma unroll
            for (int ai = 0; ai < 2; ++ai)
#pragma unroll
                for (int m = 0; m < 4; ++m) rs[ai][m] = 1.0f;
        }
#pragma unroll
        for (int ai = 0; ai < 2; ++ai)
#pragma unroll
            for (int m = 0; m < 4; ++m) {
                PG8_GAS bf16_t* rowp = (PG8_GAS bf16_t*)(O + (size_t)(row0 + ai * HALF + m * 16) * ldc + col0);
#pragma unroll
                for (int bj = 0; bj < 2; ++bj) { f32x4 v0 = acc[ai][bj][m][0] * rs[ai][m], v1 = acc[ai][bj][m][1] * rs[ai][m];
                    if (sig) { v0 = (f32x4){sigmoidf_(v0[0]), sigmoidf_(v0[1]), sigmoidf_(v0[2]), sigmoidf_(v0[3])}; v1 = (f32x4){sigmoidf_(v1[0]), sigmoidf_(v1[1]), sigmoidf_(v1[2]), sigmoidf_(v1[3])}; }
                    u32x4 w; w.x = cvt_pk_bf16(v0[0], v0[1]); w.y = cvt_pk_bf16(v0[2], v0[3]); w.z = cvt_pk_bf16(v1[0], v1[1]); w.w = cvt_pk_bf16(v1[2], v1[3]);
                    *(PG8_GAS u32x4*)(rowp + bj * HALF) = w; }
            }
    }
};

struct EpiResidual {
    static constexpr bool PERM = false, AFTER_DRAIN = false;
    float* X; bf16_t* XB; float* ssq;
    __device__ __forceinline__ void operator()(const f32x4 (&acc)[2][2][4][2], const Unit& u, int wr, int wc, int fr, int fq) const {
        const int row0 = u.pm * BM + wr * 64 + fr, col0 = u.pn * BM + wc * 32 + 4 * fq;
#pragma unroll
        for (int ai = 0; ai < 2; ++ai) {
            f32x4 xo[4][2][2];
#pragma unroll
            for (int m = 0; m < 4; ++m)
#pragma unroll
                for (int bj = 0; bj < 2; ++bj)
#pragma unroll
                    for (int n = 0; n < 2; ++n) xo[m][bj][n] = *(const PG8_GAS f32x4*)(X + (size_t)(row0 + ai * HALF + m * 16) * 2048 + col0 + bj * HALF + n * 16);
            asm volatile("" ::: "memory");
#pragma unroll
            for (int m = 0; m < 4; ++m) { const int row = row0 + ai * HALF + m * 16; float ss = 0.f;
#pragma unroll
                for (int bj = 0; bj < 2; ++bj)
#pragma unroll
                    for (int n = 0; n < 2; ++n) { const size_t off = (size_t)row * 2048 + col0 + bj * HALF + n * 16;
                        const f32x4 x = xo[m][bj][n] + acc[ai][bj][m][n];
                        *(PG8_GAS f32x4*)(X + off) = x;
                        u32x2 w; w.x = cvt_pk_bf16(x[0], x[1]); w.y = cvt_pk_bf16(x[2], x[3]); *(PG8_GAS u32x2*)(XB + off) = w;
                        ss += (x[0] * x[0] + x[1] * x[1]) + (x[2] * x[2] + x[3] * x[3]); }
                ss += __shfl_xor(ss, 16); ss += __shfl_xor(ss, 32);
                if (fq == 0) *(PG8_GAS float*)(ssq + (size_t)row * 32 + u.pn * 4 + wc) = ss; }
            asm volatile("" ::: "memory");
        }
    }
};

struct EpiBranch {
    static constexpr bool PERM = true, AFTER_DRAIN = false;
    bf16_t* MG; const bf16_t* G; int ldg; int first;
    __device__ __forceinline__ void operator()(const f32x4 (&acc)[2][2][4][2], const Unit& u, int wr, int wc, int fr, int fq) const {
        const int row0 = u.pm * BM + wr * 64 + fr, col0 = u.pn * BM + wc * 32 + 8 * fq;
#pragma unroll
        for (int ai = 0; ai < 2; ++ai) {
            u32x4 gt[4][2], od[4][2];
#pragma unroll
            for (int m = 0; m < 4; ++m)
#pragma unroll
                for (int bj = 0; bj < 2; ++bj) { const int row = row0 + ai * HALF + m * 16, col = col0 + bj * HALF;
                    gt[m][bj] = *(const PG8_GAS u32x4*)(G + (size_t)row * ldg + col);
                    od[m][bj] = first ? (u32x4){0u, 0u, 0u, 0u} : *(const PG8_GAS u32x4*)(MG + (size_t)row * 2048 + col); }
            asm volatile("" ::: "memory");
#pragma unroll
            for (int m = 0; m < 4; ++m)
#pragma unroll
                for (int bj = 0; bj < 2; ++bj) { const int row = row0 + ai * HALF + m * 16, col = col0 + bj * HALF; const u32x4 g = gt[m][bj], o = od[m][bj];
                    f32x4 v0 = acc[ai][bj][m][0], v1 = acc[ai][bj][m][1];
                    v0 = v0 * (f32x4){bf_lo(g.x), bf_hi(g.x), bf_lo(g.y), bf_hi(g.y)} + (f32x4){bf_lo(o.x), bf_hi(o.x), bf_lo(o.y), bf_hi(o.y)};
                    v1 = v1 * (f32x4){bf_lo(g.z), bf_hi(g.z), bf_lo(g.w), bf_hi(g.w)} + (f32x4){bf_lo(o.z), bf_hi(o.z), bf_lo(o.w), bf_hi(o.w)};
                    u32x4 w; w.x = cvt_pk_bf16(v0[0], v0[1]); w.y = cvt_pk_bf16(v0[2], v0[3]); w.z = cvt_pk_bf16(v1[0], v1[1]); w.w = cvt_pk_bf16(v1[2], v1[3]);
                    *(PG8_GAS u32x4*)(MG + (size_t)row * 2048 + col) = w; }
            asm volatile("" ::: "memory");
        }
    }
};

struct EpiMemKV {
    static constexpr bool PERM = false, AFTER_DRAIN = false;
    float* outk; float* outv; bf16_t* KV;
    __device__ __forceinline__ void operator()(const f32x4 (&acc)[2][2][4][2], const Unit& u, int wr, int wc, int fr, int fq) const {
        const int row0 = u.pm * BM + wr * 64 + fr, col0 = u.pn * BM + wc * 32 + 4 * fq;
#pragma unroll
        for (int ai = 0; ai < 2; ++ai)
#pragma unroll
            for (int m = 0; m < 4; ++m) {
                const int row = row0 + ai * HALF + m * 16;
#pragma unroll
                for (int bj = 0; bj < 2; ++bj)
#pragma unroll
                    for (int n = 0; n < 2; ++n) { const int col = col0 + bj * HALF + n * 16; const f32x4 a = acc[ai][bj][m][n];
                        float* dst = (col < 512) ? (outk + (size_t)row * 512 + col) : (outv + (size_t)row * 512 + (col - 512));
                        *(PG8_GAS f32x4*)dst = a;
                        u32x2 w; w.x = cvt_pk_bf16(a[0], a[1]); w.y = cvt_pk_bf16(a[2], a[3]); *(PG8_GAS u32x2*)(KV + (size_t)row * 1024 + col) = w; }
            }
    }
};
template <class Epi, class Sched, bool ALIGN_EPI = false, bool SP2 = false>
__device__ __forceinline__ void gemm_phase(PG8_LAS unsigned char* lds, const Gemm g, const Sched& S, const Epi& E, int tid_in) {
    int tid_ = tid_in; asm volatile("" : "+v"(tid_));
    const int tid = tid_, wid = __builtin_amdgcn_readfirstlane(tid >> 6), lane = tid & 63, wr = wid >> 2, wc = wid & 3, fr = lane & 15, fq = lane >> 4;
    const int K = g.K, nt = K / BK;
    unsigned voffA[2], voffB[2];
#pragma unroll
    for (int i = 0; i < 2; ++i) { int R, C; stage_rc(tid * 16 + i * 8192, R, C); const int Rb = Epi::PERM ? ((R & ~31) + perm32(R & 31)) : R;
        voffA[i] = (unsigned)(R * K + C) * 2u; voffB[i] = (unsigned)(Rb * K + C) * 2u; }
    const size_t kstep = (size_t)(BK * 2);
    const size_t hstep = (size_t)HALF * K * 2;
    const size_t tstep = 2 * hstep;
    const unsigned ldsw = (unsigned)wid * 1024u;
    const int aoff = lds_byte(wr * 64 + fr, fq * 8), boff = lds_byte(wc * 32 + fr, fq * 8);
#define PG8_SA(b, h) (((b) * 2 + (h)) * HTB)
#define PG8_SB(b, h) ((4 + (b) * 2 + (h)) * HTB)
#define PG8_STAGE(bufoff, gbase, voff) do { _Pragma("unroll") for (int _i = 0; _i < 2; ++_i) \
        __builtin_amdgcn_global_load_lds((const unsigned*)((const char*)(gbase) + (voff)[_i]), (PG8_LAS unsigned*)(lds + (bufoff) + ldsw + _i * 8192), 16, 0, 0); } while (0)
#define PG8_LDA(dst, b, h) do { _Pragma("unroll") for (int m = 0; m < 4; ++m) _Pragma("unroll") for (int k = 0; k < 2; ++k) dst[m][k] = *(const PG8_LAS bf16x8*)(lds + PG8_SA(b, h) + aoff + m * 2048 + k * 1024); } while (0)
#define PG8_LDB(dst, b, h) do { _Pragma("unroll") for (int n = 0; n < 2; ++n) _Pragma("unroll") for (int k = 0; k < 2; ++k) dst[n][k] = *(const PG8_LAS bf16x8*)(lds + PG8_SB(b, h) + boff + n * 2048 + k * 1024); } while (0)
#define PG8_MMA(ai, bj, At, Bt) do { __builtin_amdgcn_s_setprio(1); _Pragma("unroll") for (int m = 0; m < 4; ++m) _Pragma("unroll") for (int n = 0; n < 2; ++n) _Pragma("unroll") for (int k = 0; k < 2; ++k) \
        acc[ai][bj][m][n] = __builtin_amdgcn_mfma_f32_16x16x32_bf16(Bt[n][k], At[m][k], acc[ai][bj][m][n], 0, 0, 0); __builtin_amdgcn_s_setprio(0); } while (0)
#define PG8_WAIT_V(n) asm volatile("s_waitcnt vmcnt(" #n ")" ::: "memory")
#define PG8_WAIT_L(n) asm volatile("s_waitcnt lgkmcnt(" #n ")" ::: "memory")
#define PG8_BAR __builtin_amdgcn_s_barrier()
#define PG8_SCHED __builtin_amdgcn_sched_barrier(0)
    Unit cur, nxt; int ui = 0;
    if (!S.next(0, cur)) return;
    f32x4 acc[2][2][4][2];
#pragma unroll
    for (int a = 0; a < 2; ++a)
#pragma unroll
        for (int b = 0; b < 2; ++b)
#pragma unroll
            for (int m = 0; m < 4; ++m)
#pragma unroll
                for (int n = 0; n < 2; ++n) acc[a][b][m][n] = (f32x4){0.f, 0.f, 0.f, 0.f};
    bf16x8 At[4][2], B0[2][2], B1[2][2];
    const char* cA = (const char*)g.A + (size_t)cur.pm * tstep; const char* cB = (const char*)g.Bt + (size_t)cur.pn * tstep;
    S.a_ready(cur);
    if constexpr (SP2) {
        PG8_STAGE(PG8_SB(0, 0), cB, voffB); PG8_STAGE(PG8_SB(0, 1), cB + hstep, voffB); PG8_STAGE(PG8_SA(0, 0), cA, voffA); PG8_STAGE(PG8_SA(0, 1), cA + hstep, voffA);
        if (wr == 1) PG8_BAR;
        PG8_WAIT_V(2); PG8_BAR;
        PG8_STAGE(PG8_SB(1, 0), cB + kstep, voffB); PG8_STAGE(PG8_SA(1, 0), cA + kstep, voffA); PG8_STAGE(PG8_SB(1, 1), cB + hstep + kstep, voffB);
        PG8_WAIT_V(6); PG8_BAR;
    } else {
        PG8_STAGE(PG8_SB(0, 0), cB, voffB); PG8_STAGE(PG8_SA(0, 0), cA, voffA); PG8_STAGE(PG8_SB(0, 1), cB + hstep, voffB); PG8_STAGE(PG8_SA(0, 1), cA + hstep, voffA);
        if (wr == 1) PG8_BAR;
        PG8_WAIT_V(4); PG8_BAR;
        PG8_STAGE(PG8_SB(1, 0), cB + kstep, voffB); PG8_STAGE(PG8_SA(1, 0), cA + kstep, voffA); PG8_STAGE(PG8_SB(1, 1), cB + hstep + kstep, voffB);
        PG8_WAIT_V(6); PG8_BAR;
    }
    for (;;) {
        const bool has_next = S.next(ui + 1, nxt);
        const char* nA = has_next ? (const char*)g.A + (size_t)nxt.pm * tstep : cA; const char* nB = has_next ? (const char*)g.Bt + (size_t)nxt.pn * tstep : cB;
        for (int t = 0; t < nt; t += 2) {
            const bool last = (t == nt - 2);
            const char* a1 = cA + (size_t)(t + 1) * kstep;
            const char* a2 = last ? nA : cA + (size_t)(t + 2) * kstep; const char* b2 = last ? nB : cB + (size_t)(t + 2) * kstep;
            const char* a3 = a2 + kstep; const char* b3 = b2 + kstep;
            if (last && has_next) S.a_ready(nxt);
            if constexpr (SP2) {
            PG8_LDB(B0, 0, 0); PG8_LDB(B1, 0, 1); PG8_SCHED; PG8_LDA(At, 0, 0); PG8_STAGE(PG8_SA(1, 1), a1 + hstep, voffA);
            PG8_WAIT_V(8); PG8_WAIT_L(0); PG8_BAR; PG8_MMA(0, 0, At, B0); PG8_MMA(0, 1, At, B1); PG8_BAR; PG8_SCHED;
            PG8_LDA(At, 0, 1); PG8_STAGE(PG8_SB(0, 0), b2, voffB); PG8_STAGE(PG8_SB(0, 1), b2 + hstep, voffB); PG8_STAGE(PG8_SA(0, 0), a2, voffA);
            PG8_WAIT_V(8); PG8_WAIT_L(0); PG8_BAR; PG8_MMA(1, 0, At, B0); PG8_MMA(1, 1, At, B1); PG8_BAR; PG8_SCHED;
            PG8_LDB(B0, 1, 0); PG8_LDB(B1, 1, 1); PG8_SCHED; PG8_LDA(At, 1, 0); PG8_STAGE(PG8_SA(0, 1), a2 + hstep, voffA);
            PG8_WAIT_V(8); PG8_WAIT_L(0); PG8_BAR; PG8_MMA(0, 0, At, B0); PG8_MMA(0, 1, At, B1); PG8_BAR; PG8_SCHED;
            PG8_LDA(At, 1, 1); PG8_STAGE(PG8_SB(1, 0), b3, voffB); PG8_STAGE(PG8_SB(1, 1), b3 + hstep, voffB); PG8_STAGE(PG8_SA(1, 0), a3, voffA);
            PG8_WAIT_V(8); PG8_WAIT_L(0); PG8_BAR; PG8_MMA(1, 0, At, B0); PG8_MMA(1, 1, At, B1); PG8_BAR; PG8_SCHED;
            } else {
            PG8_LDB(B0, 0, 0); PG8_SCHED; PG8_LDA(At, 0, 0); PG8_STAGE(PG8_SA(1, 1), a1 + hstep, voffA);
            PG8_WAIT_L(8); PG8_BAR; PG8_WAIT_L(0); PG8_MMA(0, 0, At, B0); PG8_BAR; PG8_SCHED;
            PG8_LDB(B1, 0, 1); PG8_STAGE(PG8_SB(0, 0), b2, voffB);
            PG8_BAR; PG8_WAIT_L(0); PG8_MMA(0, 1, At, B1); PG8_BAR;
            PG8_LDA(At, 0, 1); PG8_STAGE(PG8_SA(0, 0), a2, voffA);
            PG8_BAR; PG8_WAIT_L(0); PG8_MMA(1, 0, At, B0); PG8_BAR; PG8_SCHED;
            PG8_STAGE(PG8_SB(0, 1), b2 + hstep, voffB);
            PG8_WAIT_V(6); PG8_BAR; PG8_MMA(1, 1, At, B1); PG8_BAR;
            PG8_LDB(B0, 1, 0); PG8_SCHED; PG8_LDA(At, 1, 0); PG8_STAGE(PG8_SA(0, 1), a2 + hstep, voffA);
            PG8_WAIT_L(8); PG8_BAR; PG8_WAIT_L(0); PG8_MMA(0, 0, At, B0); PG8_BAR; PG8_SCHED;
            PG8_LDB(B1, 1, 1); PG8_STAGE(PG8_SB(1, 0), b3, voffB);
            PG8_BAR; PG8_WAIT_L(0); PG8_MMA(0, 1, At, B1); PG8_BAR;
            PG8_LDA(At, 1, 1); PG8_STAGE(PG8_SA(1, 0), a3, voffA);
            PG8_BAR; PG8_WAIT_L(0); PG8_MMA(1, 0, At, B0); PG8_BAR; PG8_SCHED;
            PG8_STAGE(PG8_SB(1, 1), b3 + hstep, voffB);
            PG8_WAIT_V(6); PG8_BAR; PG8_MMA(1, 1, At, B1); PG8_BAR;
            }
        }
        if constexpr (ALIGN_EPI) { if (wr == 0) PG8_BAR; }
        if constexpr (!Epi::AFTER_DRAIN) { E(acc, cur, wr, wc, fr, fq); S.done(cur); }
        if (!has_next) break;
#pragma unroll
        for (int a = 0; a < 2; ++a)
#pragma unroll
            for (int b = 0; b < 2; ++b)
#pragma unroll
                for (int m = 0; m < 4; ++m)
#pragma unroll
                    for (int n = 0; n < 2; ++n) acc[a][b][m][n] = (f32x4){0.f, 0.f, 0.f, 0.f};
        cur = nxt; cA = nA; cB = nB; ++ui;
        if constexpr (ALIGN_EPI) { if (wr == 1) PG8_BAR; }
    }
    PG8_WAIT_V(0);
    if constexpr (!ALIGN_EPI) { if (wr == 0) PG8_BAR; }
    PG8_BAR;
    if constexpr (Epi::AFTER_DRAIN) { E.fused(acc, cur, wr, wc, fr, fq, lds, wid, lane); S.done(cur); }
#undef PG8_SA
#undef PG8_SB
#undef PG8_STAGE
#undef PG8_LDA
#undef PG8_LDB
#undef PG8_MMA
#undef PG8_WAIT_V
#undef PG8_WAIT_L
#undef PG8_BAR
#undef PG8_SCHED
}
}

constexpr int NWAVES = 8, NTHR = 512;
constexpr int DM = 2048, SEQ = 4096, NBP = 2, DEPTH = 4, NBS = 32, TS = 8;
constexpr int MP = NBP * SEQ, MS = NBS * TS, M = MP + MS;
constexpr int MIXW = 1024, GH = 4, GDK = 128, GDV = 256, GRANK = 16;
constexpr int SH = 16, SKV = 2, SHD = 64, WIN = 128;
constexpr int NMEM = 256, XH = 4, XHD = 128, XW = XH * XHD;
constexpr int DFF = 5504, NIN = 13584, NINP = 13824;
constexpr float EPS = 1e-6f;
constexpr int ZC_GQ = 0, ZC_GK = 512, ZC_GV = 1024, ZC_GR = 2048, ZC_SQ = 3072, ZC_SK = 4096, ZC_SV = 4224, ZC_CB = 4352, ZC_CC = 5376, ZC_CH = 6400, ZC_GATE = 7424, ZC_GLR = 13568;
static_assert(ZC_GATE % 256 == 0 && ZC_GLR % 256 == 0 && ZC_GLR + 16 == NIN && NINP % 256 == 0, "z layout");
constexpr size_t O_YP = 0, O_YS = O_YP + (size_t)MP * DM, O_GLAP = O_YS + (size_t)MS * DM, O_GLAS = O_GLAP + (size_t)DEPTH * NBP * GH * GDK * GDV,
                 O_SKP = O_GLAS + (size_t)DEPTH * NBS * GH * GDK * GDV, O_SVP = O_SKP + (size_t)DEPTH * NBP * WIN * SKV * SHD, O_SKS = O_SVP + (size_t)DEPTH * NBP * WIN * SKV * SHD,
                 O_SVS = O_SKS + (size_t)DEPTH * NBS * WIN * SKV * SHD, O_CONVP = O_SVS + (size_t)DEPTH * NBS * WIN * SKV * SHD, O_CONVS = O_CONVP + (size_t)DEPTH * NBP * 2 * MIXW,
                 O_FFNP = O_CONVS + (size_t)DEPTH * NBS * 2 * MIXW, O_FFNS = O_FFNP + (size_t)DEPTH * NBP * 2 * DFF, O_MKP = O_FFNS + (size_t)DEPTH * NBS * 2 * DFF,
                 O_MVP = O_MKP + (size_t)DEPTH * NBP * NMEM * XW, O_END = O_MVP + (size_t)DEPTH * NBP * NMEM * XW;
static_assert(O_END == 43456512, "output size");
enum { I_XP = 0, I_XS, I_SGLA, I_CSK, I_CSV, I_SCONV, I_SFFN, I_CMK, I_CMV, I_MEMP, I_NMIX, I_WIN, I_GUP, I_GB, I_GNORM, I_SINK, I_RELB, I_CONVW, I_WBR, I_WOUT, I_NX, I_WXQ, I_WXK, I_WXV, I_WXO,
       I_NFFN, I_FUP, I_FCW, I_FCB, I_FDN, I_NFIN, N_INPUTS };
static_assert(N_INPUTS == 31, "inputs");

constexpr size_t MiB = 1u << 20;
constexpr size_t al1m(size_t x) { return (x + MiB - 1) / MiB * MiB; }
constexpr size_t WS_CTL = 0, CTL_ZERO_BYTES = 1 * MiB;
constexpr size_t SZ_WIN = (size_t)NINP * DM * 2, SZ_WBR = (size_t)3 * DM * MIXW * 2, SZ_WOUT = (size_t)DM * DM * 2, SZ_WXQ = (size_t)XW * DM * 2, SZ_WXKV = (size_t)2 * XW * DM * 2,
                 SZ_WXO = (size_t)DM * XW * 2, SZ_WUP = (size_t)2 * DFF * DM * 2, SZ_WDN = (size_t)DM * DFF * 2;
constexpr size_t WS_WIN = 2 * MiB, WS_WBR = al1m(WS_WIN + DEPTH * SZ_WIN), WS_WOUT = al1m(WS_WBR + DEPTH * SZ_WBR), WS_WXQ = al1m(WS_WOUT + DEPTH * SZ_WOUT),
                 WS_WXKV = al1m(WS_WXQ + DEPTH * SZ_WXQ), WS_WXO = al1m(WS_WXKV + DEPTH * SZ_WXKV), WS_WUP = al1m(WS_WXO + DEPTH * SZ_WXO), WS_WDN = al1m(WS_WUP + DEPTH * SZ_WUP);
constexpr size_t WS_X = al1m(WS_WDN + DEPTH * SZ_WDN), WS_XB = al1m(WS_X + (size_t)M * DM * 4), WS_SSQ = al1m(WS_XB + (size_t)M * DM * 2), WS_Z = al1m(WS_SSQ + (size_t)M * 32 * 4),
                 WS_BR = al1m(WS_Z + (size_t)M * NINP * 2), WS_MG = al1m(WS_BR + (size_t)3 * M * MIXW * 2), WS_XQ = al1m(WS_MG + (size_t)M * DM * 2), WS_XO = al1m(WS_XQ + (size_t)M * XW * 2),
                 WS_UG = al1m(WS_XO + (size_t)M * XW * 2), WS_ACT = al1m(WS_UG + (size_t)M * 2 * DFF * 2), WS_MEMB = al1m(WS_ACT + (size_t)M * DFF * 2), WS_MEMKV = al1m(WS_MEMB + (size_t)NBP * NMEM * DM * 2),
                 WS_GLAU = al1m(WS_MEMKV + (size_t)DEPTH * NBP * NMEM * 2 * XW * 2), WS_GLAD = al1m(WS_GLAU + (size_t)512 * GDK * GDV * 4), WS_END = al1m(WS_GLAD + (size_t)512 * GDK * 4);
constexpr int CW_TMO = 0, CW_CODE = 1, CW_BAR = 4096;

constexpr int RING_OFF = 0, RING_BYTES = 131072;
constexpr int LDSCTL_OFF = 146944, MISC_OFF = LDSCTL_OFF + 320;
constexpr int LDS_BYTES = 147456;
static_assert(MISC_OFF + 128 <= LDS_BYTES && LDSCTL_OFF >= RING_BYTES, "LDS map");

#define GAS __attribute__((address_space(1)))
#define LAS __attribute__((address_space(3)))
typedef unsigned short bf16;
typedef unsigned v4u __attribute__((ext_vector_type(4)));
typedef unsigned v2u __attribute__((ext_vector_type(2)));
typedef float f32x4 __attribute__((ext_vector_type(4)));
typedef float f32x2 __attribute__((ext_vector_type(2)));
typedef GAS unsigned gu32;
#define RLX_AGENT __ATOMIC_RELAXED, __HIP_MEMORY_SCOPE_AGENT
#define LDS_WAIT() asm volatile("s_waitcnt lgkmcnt(0)" ::: "memory")
#define VM_WAIT() asm volatile("s_waitcnt vmcnt(0)" ::: "memory")
__device__ __forceinline__ float bflo(unsigned w) { return __uint_as_float(w << 16); }
__device__ __forceinline__ float bfhi(unsigned w) { return __uint_as_float(w & 0xffff0000u); }
__device__ __forceinline__ float bf1(bf16 h) { return __uint_as_float(((unsigned)h) << 16); }
__device__ __forceinline__ unsigned pk2(float lo, float hi) { return pg8::cvt_pk_bf16(lo, hi); }
__device__ __forceinline__ void unpack8(const v4u w, float (&f)[8]) { f[0] = bflo(w.x); f[1] = bfhi(w.x); f[2] = bflo(w.y); f[3] = bfhi(w.y); f[4] = bflo(w.z); f[5] = bfhi(w.z); f[6] = bflo(w.w); f[7] = bfhi(w.w); }
__device__ __forceinline__ v4u pack8(const float (&f)[8]) { v4u w; w.x = pk2(f[0], f[1]); w.y = pk2(f[2], f[3]); w.z = pk2(f[4], f[5]); w.w = pk2(f[6], f[7]); return w; }
__device__ __forceinline__ float sigm(float v) { return 1.0f / (1.0f + __expf(-v)); }
__device__ __forceinline__ float wave_sum(float v) {
#pragma unroll
    for (int o = 1; o < 64; o <<= 1) v += __shfl_xor(v, o);
    return v;
}
#define XB_TMO      128
#define XB_XCNT(j)  (256  + 64 * (j))
#define XB_XSUB(j)  (1280 + 64 * (j))
#define XB_XGEN(j)  (2304 + 64 * (j))
#define XB_TOP      3328
#define XB_TOPGEN   3392
#define XCD_BAR_WORDS 3456
#define XB_SPIN_CAP (1u << 18)

__device__ __forceinline__ unsigned xb_ld(unsigned* p)              { return __hip_atomic_load(p, __ATOMIC_RELAXED, __HIP_MEMORY_SCOPE_AGENT); }
__device__ __forceinline__ unsigned xb_add(unsigned* p, unsigned v) { return __hip_atomic_fetch_add(p, v, __ATOMIC_RELAXED, __HIP_MEMORY_SCOPE_AGENT); }
__device__ __forceinline__ unsigned xb_xcc_id() { return (unsigned)__builtin_amdgcn_s_getreg((3 << 11) | 20) & 0xFu; }
#define XB_SPIN(cond, bar) do { unsigned _sp = 0; while (cond) { __builtin_amdgcn_s_sleep(1); \
    if ((++_sp & 255u) == 0u) { if (xb_ld(&(bar)[XB_TMO])) break; if (_sp > XB_SPIN_CAP) { atomicAdd(&(bar)[XB_TMO], 1u); break; } } } } while (0)

struct XcdBarrier {
    unsigned* bar; unsigned x; unsigned wv;
    volatile LAS unsigned* st;
};

__device__ __forceinline__ unsigned xb_lane() { return __builtin_amdgcn_mbcnt_hi(~0u, __builtin_amdgcn_mbcnt_lo(~0u, 0u)); }
__device__ __forceinline__ XcdBarrier xcd_barrier_post(unsigned* bar, volatile LAS unsigned* st, unsigned wv) {
    XcdBarrier b; b.bar = bar; b.x = xb_xcc_id(); b.st = st; b.wv = wv;
    if (wv == 0u && xb_lane() == 0u) (void)xb_add(&bar[XB_XCNT(b.x)], 1u);
    return b;
}
__device__ __forceinline__ void xcd_barrier_complete(unsigned* bar, unsigned x, unsigned& nloc, unsigned& nx) {
    const unsigned G = gridDim.x * gridDim.y * gridDim.z;
    unsigned sum, cnt, mine, sp = 0u;
    for (;;) {
        sum = 0u; cnt = 0u; mine = 0u;
#pragma unroll
        for (unsigned j = 0; j < 16; ++j) { const unsigned c = xb_ld(&bar[XB_XCNT(j)]); sum += c; cnt += (c > 0u) ? 1u : 0u; mine = (j == x) ? c : mine; }
        if (sum == G) break;
        __builtin_amdgcn_s_sleep(1);
        if ((++sp & 255u) == 0u) { if (xb_ld(&bar[XB_TMO])) break; if (sp > XB_SPIN_CAP) { atomicAdd(&bar[XB_TMO], 1u); break; } }
    }
    nloc = mine > 0u ? mine : 1u; nx = cnt > 0u ? cnt : 1u;
}

__device__ __forceinline__ void xcd_barrier(const XcdBarrier& b) {
    asm volatile("s_waitcnt vmcnt(0)" ::: "memory");
    __syncthreads();
    if (b.wv == 0u && xb_lane() == 0u) {
        unsigned* bar = b.bar;
        __builtin_amdgcn_s_waitcnt(0);
        unsigned nloc = b.st[0], nx = b.st[1];
        if (nloc == 0u) { xcd_barrier_complete(bar, b.x, nloc, nx); b.st[0] = nloc; b.st[1] = nx; }
        const unsigned old = xb_add(&bar[XB_XSUB(b.x)], 1u);
        const unsigned gen = old / nloc;
        if (old + 1u == (gen + 1u) * nloc) {
            __builtin_amdgcn_fence(__ATOMIC_RELEASE, "agent");
            asm volatile("s_waitcnt vmcnt(0)" ::: "memory");
            const unsigned og = xb_add(&bar[XB_TOP], 1u);
            const unsigned tg = og / nx;
            if (og + 1u == (tg + 1u) * nx) xb_add(&bar[XB_TOPGEN], 1u);
            else XB_SPIN(xb_ld(&bar[XB_TOPGEN]) == tg, bar);
            __builtin_amdgcn_fence(__ATOMIC_ACQUIRE, "agent");
            xb_add(&bar[XB_XGEN(b.x)], 1u);
            asm volatile("s_waitcnt vmcnt(0)" ::: "memory");
        } else {
            XB_SPIN(xb_ld(&bar[XB_XGEN(b.x)]) == gen, bar);
            __builtin_amdgcn_fence(__ATOMIC_ACQUIRE, "agent");
            asm volatile("s_waitcnt vmcnt(0)" ::: "memory");
        }
    }
    __syncthreads();
}

struct Args { const float* in[N_INPUTS]; float* out; unsigned char* ws; int ph_lo, ph_hi; };
static_assert(sizeof(Args) == N_INPUTS * 8 + 8 + 8 + 8, "Args has no padding");


constexpr int KA_OUT = 8 * N_INPUTS, KA_WS = KA_OUT + 8, KA_LO = KA_WS + 8, KA_HI = KA_LO + 4;
template <int OFF> __device__ __forceinline__ unsigned long long karg64() {
    unsigned long long v; auto kp = __builtin_amdgcn_kernarg_segment_ptr();
    asm volatile("s_load_dwordx2 %0, %1, %2\n\ts_waitcnt lgkmcnt(0)" : "=s"(v) : "s"(kp), "n"(OFF) : "memory"); return v;
}
template <int OFF> __device__ __forceinline__ int karg32() {
    int v; auto kp = __builtin_amdgcn_kernarg_segment_ptr();
    asm volatile("s_load_dword %0, %1, %2\n\ts_waitcnt lgkmcnt(0)" : "=s"(v) : "s"(kp), "n"(OFF) : "memory"); return v;
}
struct Frame {
    LAS unsigned char* lds;
    volatile LAS unsigned* MISC;
    gu32* ctl;
    int tid, lane, wave, vcu, G;
};

__device__ __forceinline__ int lane_id() { int l; asm volatile("v_mbcnt_lo_u32_b32 %0, -1, 0\n\tv_mbcnt_hi_u32_b32 %0, -1, %0" : "=v"(l)); return l; }
__device__ __forceinline__ int launder_s(int v) { asm volatile("" : "+s"(v)); return v; }
#define LAUNDER(F) do { asm volatile("" : "+s"((F).wave), "+s"((F).vcu), "+s"((F).G)); (F).lane = lane_id(); asm volatile("" : "+v"((F).lane)); (F).tid = (F).wave * 64 + (F).lane; } while (0)
__device__ __forceinline__ void tr_item(const float* W, int K, int Nsrc, bf16* WT, int dstrow0, int k0, int srccol, float cscale, const float* gain, LAS float* scr, int lane) {
    const int q = lane & 15, kq = lane >> 4;
    f32x4 v[16];
#pragma unroll
    for (int i = 0; i < 16; ++i) { v[i] = (f32x4){0.f, 0.f, 0.f, 0.f}; if (srccol >= 0) v[i] = *(const f32x4*)(W + (size_t)(k0 + 4 * i + kq) * Nsrc + srccol); }
#pragma unroll
    for (int i = 0; i < 16; ++i) { const int kk = 4 * i + kq; const float s = gain ? gain[k0 + kk] * cscale : cscale; LAS float* d = scr + kk * 65 + 4 * q;
        d[0] = v[i][0] * s; d[1] = v[i][1] * s; d[2] = v[i][2] * s; d[3] = v[i][3] * s; }
    LDS_WAIT(); asm volatile("" ::: "memory");
    const int c = lane & 7;
#pragma unroll
    for (int j = 0; j < 8; ++j) { const int n = (lane >> 3) + 8 * j; const LAS float* s = scr + (8 * c) * 65 + n;
        v4u o; o.x = pk2(s[0 * 65], s[1 * 65]); o.y = pk2(s[2 * 65], s[3 * 65]); o.z = pk2(s[4 * 65], s[5 * 65]); o.w = pk2(s[6 * 65], s[7 * 65]);
        *(v4u*)(WT + (size_t)(dstrow0 + n) * K + k0 + 8 * c) = o; }
    LDS_WAIT(); asm volatile("" ::: "memory");
}
__device__ __forceinline__ void tr_plain(const float* W, int K, int N, bf16* WT, int dst_off, int r, float cscale, const float* gain, LAS float* scr, int lane) {
    const int nblk = N / 64, kb = r / nblk, nb = r % nblk;
    tr_item(W, K, N, WT, dst_off + 64 * nb, 64 * kb, 64 * nb + 4 * (lane & 15), cscale, gain, scr, lane);
}
constexpr int IT_IN = (DM / 64) * (NINP / 64), IT_BR = (MIXW / 64) * (DM / 64), IT_OUT = (DM / 64) * (DM / 64), IT_XQ = (DM / 64) * (XW / 64), IT_XO = (XW / 64) * (DM / 64),
              IT_UP = (DM / 64) * (2 * DFF / 64), IT_DN = (DFF / 64) * (DM / 64), IT_LAYER = IT_IN + 3 * IT_BR + IT_OUT + 3 * IT_XQ + IT_XO + IT_UP + IT_DN;
__device__ __forceinline__ void p0_convert(const Args& A, Frame& F0) {
    unsigned char* const ws_ = (unsigned char*)(GAS unsigned char*)karg64<KA_WS>();
    const float* const in_I_FDN = (const float*)(const GAS float*)karg64<8 * I_FDN>();
    const float* const in_I_FUP = (const float*)(const GAS float*)karg64<8 * I_FUP>();
    const float* const in_I_MEMP = (const float*)(const GAS float*)karg64<8 * I_MEMP>();
    const float* const in_I_NFFN = (const float*)(const GAS float*)karg64<8 * I_NFFN>();
    const float* const in_I_NMIX = (const float*)(const GAS float*)karg64<8 * I_NMIX>();
    const float* const in_I_NX = (const float*)(const GAS float*)karg64<8 * I_NX>();
    const float* const in_I_WBR = (const float*)(const GAS float*)karg64<8 * I_WBR>();
    const float* const in_I_WIN = (const float*)(const GAS float*)karg64<8 * I_WIN>();
    const float* const in_I_WOUT = (const float*)(const GAS float*)karg64<8 * I_WOUT>();
    const float* const in_I_WXK = (const float*)(const GAS float*)karg64<8 * I_WXK>();
    const float* const in_I_WXO = (const float*)(const GAS float*)karg64<8 * I_WXO>();
    const float* const in_I_WXQ = (const float*)(const GAS float*)karg64<8 * I_WXQ>();
    const float* const in_I_WXV = (const float*)(const GAS float*)karg64<8 * I_WXV>();
    const float* const in_I_XP = (const float*)(const GAS float*)karg64<8 * I_XP>();
    const float* const in_I_XS = (const float*)(const GAS float*)karg64<8 * I_XS>();
    Frame F = F0; LAUNDER(F);
    LAS float* scr = (LAS float*)(F.lds + F.wave * 16640);
    const int gw = F.vcu * NWAVES + F.wave, NGW = F.G * NWAVES, lane = F.lane;
#pragma unroll 1
    for (int it = gw; it < DEPTH * IT_LAYER; it += NGW) {
        const int l = it / IT_LAYER; int r = it % IT_LAYER;
        if (r < IT_IN) {
            const int nblk = NINP / 64, kb = r / nblk, nb = r % nblk, n = 64 * nb + 4 * (lane & 15);
            int src; if (n < 3072) src = n; else if (n < ZC_GLR) src = n + 16; else if (n < NIN) src = 3072 + (n - ZC_GLR); else src = -1;
            const float cs = (n < 512) ? 0.08838834764831845f : ((n >= ZC_SQ && n < ZC_SK) ? 0.125f : 1.0f);
            tr_item(in_I_WIN + (size_t)l * DM * NIN, DM, NIN, ((bf16*)(ws_ + WS_WIN)) + (size_t)l * NINP * DM, 64 * nb, 64 * kb, src, cs, in_I_NMIX + l * DM, scr, lane); continue; }
        r -= IT_IN;
        if (r < 3 * IT_BR) { const int i = r / IT_BR; r %= IT_BR;
            tr_plain(in_I_WBR + ((size_t)l * 3 + i) * MIXW * DM, MIXW, DM, ((bf16*)(ws_ + WS_WBR)) + ((size_t)l * 3 + i) * DM * MIXW, 0, r, 1.0f, nullptr, scr, lane); continue; }
        r -= 3 * IT_BR;
        if (r < IT_OUT) { tr_plain(in_I_WOUT + (size_t)l * DM * DM, DM, DM, ((bf16*)(ws_ + WS_WOUT)) + (size_t)l * DM * DM, 0, r, 1.0f, nullptr, scr, lane); continue; }
        r -= IT_OUT;
        if (r < IT_XQ) { tr_plain(in_I_WXQ + (size_t)l * DM * XW, DM, XW, ((bf16*)(ws_ + WS_WXQ)) + (size_t)l * XW * DM, 0, r, 0.08838834764831845f, in_I_NX + l * DM, scr, lane); continue; }
        r -= IT_XQ;
        if (r < IT_XQ) { tr_plain(in_I_WXK + (size_t)l * DM * XW, DM, XW, ((bf16*)(ws_ + WS_WXKV)) + (size_t)l * 2 * XW * DM, 0, r, 1.0f, nullptr, scr, lane); continue; }
        r -= IT_XQ;
        if (r < IT_XQ) { tr_plain(in_I_WXV + (size_t)l * DM * XW, DM, XW, ((bf16*)(ws_ + WS_WXKV)) + (size_t)l * 2 * XW * DM, XW, r, 1.0f, nullptr, scr, lane); continue; }
        r -= IT_XQ;
        if (r < IT_XO) { tr_plain(in_I_WXO + (size_t)l * XW * DM, XW, DM, ((bf16*)(ws_ + WS_WXO)) + (size_t)l * DM * XW, 0, r, 1.0f, nullptr, scr, lane); continue; }
        r -= IT_XO;
        if (r < IT_UP) { tr_plain(in_I_FUP + (size_t)l * DM * 2 * DFF, DM, 2 * DFF, ((bf16*)(ws_ + WS_WUP)) + (size_t)l * 2 * DFF * DM, 0, r, 1.0f, in_I_NFFN + l * DM, scr, lane); continue; }
        r -= IT_UP;
        tr_plain(in_I_FDN + (size_t)l * DFF * DM, DFF, DM, ((bf16*)(ws_ + WS_WDN)) + (size_t)l * DM * DFF, 0, r, 1.0f, nullptr, scr, lane);
    }
    for (int m = gw; m < M + NBP * NMEM; m += NGW) {
        if (m < M) {
            const float* src = (m < MP) ? in_I_XP + (size_t)m * DM : in_I_XS + (size_t)(m - MP) * DM;
            float ss = 0.f;
#pragma unroll
            for (int j = 0; j < 8; ++j) { const f32x4 v = *((const f32x4*)src + lane + 64 * j); *((f32x4*)(((float*)(ws_ + WS_X)) + (size_t)m * DM) + lane + 64 * j) = v;
                v2u w; w.x = pk2(v[0], v[1]); w.y = pk2(v[2], v[3]); *((v2u*)(((bf16*)(ws_ + WS_XB)) + (size_t)m * DM) + lane + 64 * j) = w; ss += (v[0] * v[0] + v[1] * v[1]) + (v[2] * v[2] + v[3] * v[3]); }
            ss = wave_sum(ss);
            if (lane < 32) ((float*)(ws_ + WS_SSQ))[(size_t)m * 32 + lane] = (lane == 0) ? ss : 0.f;
        } else {
            const int r = m - M; const float* src = in_I_MEMP + (size_t)r * DM;
#pragma unroll
            for (int j = 0; j < 8; ++j) { const f32x4 v = *((const f32x4*)src + lane + 64 * j); v2u w; w.x = pk2(v[0], v[1]); w.y = pk2(v[2], v[3]); *((v2u*)(((bf16*)(ws_ + WS_MEMB)) + (size_t)r * DM) + lane + 64 * j) = w; }
        }
    }
}

__device__ __forceinline__ int t5_bucket(int n) {
    if (n < 16) return n;
    const float v = logf((float)n / 16.0f) / logf(8.0f) * 16.0f; const int lg = 16 + (int)v; return lg < 31 ? lg : 31;
}
template <int STRIDE, bool PAIR, bool BIAS>
__device__ __forceinline__ void attn_core(const float (&q)[64], LAS const unsigned char* kp, LAS const unsigned char* vp, int nsteps, int jmin, LAS const float* bp, float& m, float& lsum, float (&o)[64]) {
    for (int j = 0; j < nsteps; ++j) {
        LAS const v4u* kr = (LAS const v4u*)(kp + j * STRIDE);
        float s0 = 0.f, s1 = 0.f;
#pragma unroll
        for (int c = 0; c < 8; ++c) { const v4u kk = kr[c];
            s0 += q[8 * c + 0] * bflo(kk.x) + q[8 * c + 2] * bflo(kk.y) + q[8 * c + 4] * bflo(kk.z) + q[8 * c + 6] * bflo(kk.w);
            s1 += q[8 * c + 1] * bfhi(kk.x) + q[8 * c + 3] * bfhi(kk.y) + q[8 * c + 5] * bfhi(kk.z) + q[8 * c + 7] * bfhi(kk.w); }
        float s = s0 + s1;
        if (PAIR) s += __shfl_xor(s, 1);
        if (BIAS) s += bp[-j];
        s = (j >= jmin) ? s : -INFINITY;
        const float mn = fmaxf(m, s), sc = __expf(m - mn), p = __expf(s - mn);
        lsum = lsum * sc + p; m = mn;
        LAS const v4u* vr = (LAS const v4u*)(vp + j * STRIDE);
#pragma unroll
        for (int c = 0; c < 8; ++c) { const v4u vv = vr[c];
            o[8 * c + 0] = o[8 * c + 0] * sc + p * bflo(vv.x); o[8 * c + 1] = o[8 * c + 1] * sc + p * bfhi(vv.x);
            o[8 * c + 2] = o[8 * c + 2] * sc + p * bflo(vv.y); o[8 * c + 3] = o[8 * c + 3] * sc + p * bfhi(vv.y);
            o[8 * c + 4] = o[8 * c + 4] * sc + p * bflo(vv.z); o[8 * c + 5] = o[8 * c + 5] * sc + p * bfhi(vv.z);
            o[8 * c + 6] = o[8 * c + 6] * sc + p * bflo(vv.w); o[8 * c + 7] = o[8 * c + 7] * sc + p * bfhi(vv.w); }
    }
}
__device__ __forceinline__ void load_q64(const bf16* p, float (&q)[64]) {
#pragma unroll
    for (int c = 0; c < 8; ++c) { const v4u w = *((const v4u*)p + c); float f[8]; unpack8(w, f);
#pragma unroll
        for (int i = 0; i < 8; ++i) q[8 * c + i] = f[i]; }
}
__device__ __forceinline__ void store_o64(bf16* p, const float (&o)[64], float inv) {
#pragma unroll
    for (int c = 0; c < 8; ++c) { float f[8];
#pragma unroll
        for (int i = 0; i < 8; ++i) f[i] = o[8 * c + i] * inv;
        *((v4u*)p + c) = pack8(f); }
}

constexpr int SWA_STR = 144, SWA_K = 0, SWA_V = 192 * SWA_STR, SWA_BT = 2 * 192 * SWA_STR, SWA_BTS = 132;
__device__ __forceinline__ void swa_phase(const Args& A, Frame& F0, int l) {
    unsigned char* const ws_ = (unsigned char*)(GAS unsigned char*)karg64<KA_WS>();
    float* const out_ = (float*)(GAS float*)karg64<KA_OUT>();
    const float* const in_I_CSK = (const float*)(const GAS float*)karg64<8 * I_CSK>();
    const float* const in_I_CSV = (const float*)(const GAS float*)karg64<8 * I_CSV>();
    const float* const in_I_RELB = (const float*)(const GAS float*)karg64<8 * I_RELB>();
    const float* const in_I_SINK = (const float*)(const GAS float*)karg64<8 * I_SINK>();
    Frame F = F0; LAUNDER(F);
    LAS unsigned char* Ks = F.lds + SWA_K; LAS unsigned char* Vs = F.lds + SWA_V; LAS float* BT = (LAS float*)(F.lds + SWA_BT);
    for (int i = F.tid; i < SH * 129; i += NTHR) { const int h = i / 129, d = i % 129; BT[h * SWA_BTS + d] = in_I_RELB[t5_bucket(d) * SH + h]; }
    const float* sinks = in_I_SINK + l * SH;
    for (int u = F.vcu; u < 256 + 64; u += F.G) {
        __syncthreads();
        if (u < 256) {
            const int b = u >> 7, kvh = (u >> 6) & 1, qb = u & 63, q0 = qb * 64;
            for (int i = F.tid; i < 192 * 8; i += NTHR) { const int r = i >> 3, c8 = i & 7, pos = q0 - 128 + r; v4u kv = (v4u){0u, 0u, 0u, 0u}, vv = kv;
                if (pos >= 0) { const bf16* zr = ((bf16*)(ws_ + WS_Z)) + (size_t)(b * SEQ + pos) * NINP + kvh * 64 + c8 * 8; kv = *(const v4u*)(zr + ZC_SK); vv = *(const v4u*)(zr + ZC_SV); }
                *(LAS v4u*)(Ks + r * SWA_STR + c8 * 16) = kv; *(LAS v4u*)(Vs + r * SWA_STR + c8 * 16) = vv;
                if (qb == 63 && r >= 64) { float fk[8], fv[8]; unpack8(kv, fk); unpack8(vv, fv); const size_t o = ((((size_t)l * NBP + b) * WIN + (r - 64)) * SKV + kvh) * SHD + c8 * 8;
                    *(f32x4*)(out_ + O_SKP + o) = (f32x4){fk[0], fk[1], fk[2], fk[3]}; *(f32x4*)(out_ + O_SKP + o + 4) = (f32x4){fk[4], fk[5], fk[6], fk[7]};
                    *(f32x4*)(out_ + O_SVP + o) = (f32x4){fv[0], fv[1], fv[2], fv[3]}; *(f32x4*)(out_ + O_SVP + o + 4) = (f32x4){fv[4], fv[5], fv[6], fv[7]}; }
            }
            __syncthreads();
            const int head = kvh * 8 + F.wave, t = q0 + F.lane, row = b * SEQ + t;
            float q[64], o[64]; load_q64(((bf16*)(ws_ + WS_Z)) + (size_t)row * NINP + ZC_SQ + head * 64, q);
#pragma unroll
            for (int i = 0; i < 64; ++i) o[i] = 0.f;
            float m = sinks[head], ls = 1.0f;
            attn_core<SWA_STR, false, true>(q, Ks + F.lane * SWA_STR, Vs + F.lane * SWA_STR, 129, 128 - t, BT + head * SWA_BTS + 128, m, ls, o);
            store_o64(((bf16*)(ws_ + WS_BR)) + (size_t)1 * M * MIXW + (size_t)row * MIXW + head * 64, o, 1.0f / ls);
        } else {
            const int su = u - 256, b = su >> 1, kvh = su & 1;
            for (int i = F.tid; i < 136 * 8; i += NTHR) { const int r = i >> 3, c8 = i & 7; float fk[8], fv[8];
                if (r < 128) { const size_t o = ((((size_t)l * NBS + b) * WIN + r) * SKV + kvh) * SHD + c8 * 8; const f32x4 a0 = *(const f32x4*)(in_I_CSK + o), a1 = *(const f32x4*)(in_I_CSK + o + 4), b0 = *(const f32x4*)(in_I_CSV + o), b1 = *(const f32x4*)(in_I_CSV + o + 4);
#pragma unroll
                    for (int k = 0; k < 4; ++k) { fk[k] = a0[k]; fk[4 + k] = a1[k]; fv[k] = b0[k]; fv[4 + k] = b1[k]; } }
                else { const bf16* zr = ((bf16*)(ws_ + WS_Z)) + (size_t)(MP + b * TS + (r - 128)) * NINP + kvh * 64 + c8 * 8; unpack8(*(const v4u*)(zr + ZC_SK), fk); unpack8(*(const v4u*)(zr + ZC_SV), fv); }
                *(LAS v4u*)(Ks + r * SWA_STR + c8 * 16) = pack8(fk); *(LAS v4u*)(Vs + r * SWA_STR + c8 * 16) = pack8(fv);
                if (r >= 8) { const size_t o = ((((size_t)l * NBS + b) * WIN + (r - 8)) * SKV + kvh) * SHD + c8 * 8;
                    *(f32x4*)(out_ + O_SKS + o) = (f32x4){fk[0], fk[1], fk[2], fk[3]}; *(f32x4*)(out_ + O_SKS + o + 4) = (f32x4){fk[4], fk[5], fk[6], fk[7]};
                    *(f32x4*)(out_ + O_SVS + o) = (f32x4){fv[0], fv[1], fv[2], fv[3]}; *(f32x4*)(out_ + O_SVS + o + 4) = (f32x4){fv[4], fv[5], fv[6], fv[7]}; }
            }
            __syncthreads();
            if (F.wave == 0) {
                const int t = F.lane & 7, head = kvh * 8 + (F.lane >> 3), row = MP + b * TS + t;
                float q[64], o[64]; load_q64(((bf16*)(ws_ + WS_Z)) + (size_t)row * NINP + ZC_SQ + head * 64, q);
#pragma unroll
                for (int i = 0; i < 64; ++i) o[i] = 0.f;
                float m = sinks[head], ls = 1.0f;
                attn_core<SWA_STR, false, true>(q, Ks + t * SWA_STR, Vs + t * SWA_STR, 129, 0, BT + head * SWA_BTS + 128, m, ls, o);
                store_o64(((bf16*)(ws_ + WS_BR)) + (size_t)1 * M * MIXW + (size_t)row * MIXW + head * 64, o, 1.0f / ls);
            }
        }
    }
    __syncthreads();
}

__device__ __forceinline__ void conv_phase(const Args& A, Frame& F0, int l) {
    unsigned char* const ws_ = (unsigned char*)(GAS unsigned char*)karg64<KA_WS>();
    float* const out_ = (float*)(GAS float*)karg64<KA_OUT>();
    const float* const in_I_CONVW = (const float*)(const GAS float*)karg64<8 * I_CONVW>();
    const float* const in_I_SCONV = (const float*)(const GAS float*)karg64<8 * I_SCONV>();
    Frame F = F0; LAUNDER(F);
    const float* cw = in_I_CONVW + (size_t)l * 3 * MIXW; const bf16* Z = (const bf16*)(ws_ + WS_Z); bf16* BRC = (bf16*)(ws_ + WS_BR) + (size_t)2 * M * MIXW;
#pragma unroll 1
    for (int idx = F.vcu * NTHR + F.tid; idx < (M / 8) * (MIXW / 8); idx += F.G * NTHR) {
        const int row0 = (idx >> 7) * 8, c = (idx & 127) * 8; const bool smp = row0 >= MP; const int b = smp ? (row0 - MP) >> 3 : row0 >> 12, t0 = smp ? 0 : (row0 & (SEQ - 1));
        v4u cc[10], ch[10], cbv[8];
#pragma unroll
        for (int k = 0; k < 10; ++k) { cc[k] = (v4u){0u, 0u, 0u, 0u}; ch[k] = cc[k];
            if (k >= 2 || t0 > 0) { const bf16* zr = Z + (size_t)(row0 + k - 2) * NINP + c; cc[k] = *(const v4u*)(zr + ZC_CC); ch[k] = *(const v4u*)(zr + ZC_CH); } }
#pragma unroll
        for (int k = 0; k < 8; ++k) cbv[k] = *(const v4u*)(Z + (size_t)(row0 + k) * NINP + ZC_CB + c);
        float w0[8], w1[8], w2[8];
#pragma unroll
        for (int i = 0; i < 8; ++i) { w0[i] = cw[c + i]; w1[i] = cw[MIXW + c + i]; w2[i] = cw[2 * MIXW + c + i]; }
        float u2[8], u1[8], u0[8];
        { float a[8], d[8]; unpack8(cc[0], a); unpack8(ch[0], d);
#pragma unroll
          for (int i = 0; i < 8; ++i) u2[i] = a[i] * d[i];
          unpack8(cc[1], a); unpack8(ch[1], d);
#pragma unroll
          for (int i = 0; i < 8; ++i) u1[i] = a[i] * d[i]; }
        if (smp) { const float* sp = in_I_SCONV + (((size_t)l * NBS + b) * 2) * MIXW + c; const f32x4 a0 = *(const f32x4*)sp, a1 = *(const f32x4*)(sp + 4), b0 = *(const f32x4*)(sp + MIXW), b1 = *(const f32x4*)(sp + MIXW + 4);
#pragma unroll
            for (int i = 0; i < 4; ++i) { u2[i] = a0[i]; u2[4 + i] = a1[i]; u1[i] = b0[i]; u1[4 + i] = b1[i]; } }
#pragma unroll
        for (int k = 0; k < 8; ++k) { float a[8], d[8], cbf[8], o[8]; unpack8(cc[k + 2], a); unpack8(ch[k + 2], d); unpack8(cbv[k], cbf);
#pragma unroll
            for (int i = 0; i < 8; ++i) { u0[i] = a[i] * d[i]; o[i] = cbf[i] * (w0[i] * u2[i] + w1[i] * u1[i] + w2[i] * u0[i]); }
            *(v4u*)(BRC + (size_t)(row0 + k) * MIXW + c) = pack8(o);
            if (k >= 6 && (smp || t0 == SEQ - 8)) { float* dst = out_ + (smp ? O_CONVS + (((size_t)l * NBS + b) * 2 + (k - 6)) * MIXW : O_CONVP + (((size_t)l * NBP + b) * 2 + (k - 6)) * MIXW) + c;
                *(f32x4*)dst = (f32x4){u0[0], u0[1], u0[2], u0[3]}; *(f32x4*)(dst + 4) = (f32x4){u0[4], u0[5], u0[6], u0[7]}; }
#pragma unroll
            for (int i = 0; i < 8; ++i) { u2[i] = u1[i]; u1[i] = u0[i]; } }
    }
}

__device__ __forceinline__ void gla_stage_wg(const Args& A, Frame& F, int l, int h, LAS float* wgs) {
    const float* const in_I_GB = (const float*)(const GAS float*)karg64<8 * I_GB>();
    const float* const in_I_GUP = (const float*)(const GAS float*)karg64<8 * I_GUP>();
    for (int i = F.tid; i < 16 * 128; i += NTHR) wgs[i] = in_I_GUP[(size_t)l * GRANK * 512 + (i >> 7) * 512 + h * 128 + (i & 127)];
    if (F.tid < 128) wgs[2048 + F.tid] = in_I_GB[l * 512 + h * 128 + F.tid];
}
__device__ __forceinline__ float gla_lg(const float (&gl)[16], LAS const float* wgs, int d) {
    float zg = wgs[2048 + d];
#pragma unroll
    for (int r = 0; r < 16; ++r) zg += gl[r] * wgs[r * 128 + d];
    return (fminf(zg, 0.f) - log1pf(__expf(-fabsf(zg)))) * (1.0f / 16.0f);
}
__device__ __forceinline__ void load_glr(const bf16* zr, float (&gl)[16]) {
    float a[8], b[8]; unpack8(*(const v4u*)zr, a); unpack8(*(const v4u*)(zr + 8), b);
#pragma unroll
    for (int i = 0; i < 8; ++i) { gl[i] = a[i]; gl[8 + i] = b[i]; }
}
__device__ __forceinline__ void gla_chunk_b(const Args& A, Frame& F, int l, int row0, int h, LAS float* bl, LAS float* wgs) {
    unsigned char* const ws_ = (unsigned char*)(GAS unsigned char*)karg64<KA_WS>();
    gla_stage_wg(A, F, l, h, wgs);
    __syncthreads();
    { const int t = F.tid >> 3, dg = F.tid & 7; float gl[16]; load_glr(((bf16*)(ws_ + WS_Z)) + (size_t)(row0 + t) * NINP + ZC_GLR, gl);
#pragma unroll 4
      for (int dd = 0; dd < 16; ++dd) { const int d = dg * 16 + dd; bl[t * 128 + d] = gla_lg(gl, wgs, d); } }
    __syncthreads();
    if (F.tid < 128) { float a = 0.f; for (int t = 0; t < 64; ++t) { a += bl[t * 128 + F.tid]; bl[t * 128 + F.tid] = a; } }
    __syncthreads();
}

typedef short bf16x8 __attribute__((ext_vector_type(8)));
typedef short v4i16_t __attribute__((ext_vector_type(4)));
#define MFMA16(a, b, c) __builtin_amdgcn_mfma_f32_16x16x32_bf16((a), (b), (c), 0, 0, 0)
__device__ __forceinline__ bf16x8 frag_row(LAS const unsigned char* T, int stride, int r0, int k0, int lane) {
    return *(LAS const bf16x8*)(T + (r0 + (lane & 15)) * stride + (k0 + 8 * (lane >> 4)) * 2);
}
__device__ __forceinline__ bf16x8 frag_tr(LAS const unsigned char* T, int stride, int rlo, int rhi, int n0, int lane) {
    const int q = (lane & 15) >> 2, p = lane & 3;
    const v4i16_t lo = __builtin_amdgcn_ds_read_tr16_b64_v4i16((LAS v4i16_t*)(T + (rlo + q) * stride + n0 * 2 + 8 * p));
    const v4i16_t hi = __builtin_amdgcn_ds_read_tr16_b64_v4i16((LAS v4i16_t*)(T + (rhi + q) * stride + n0 * 2 + 8 * p));
    return (bf16x8){lo[0], lo[1], lo[2], lo[3], hi[0], hi[1], hi[2], hi[3]};
}
__device__ __forceinline__ bf16x8 pack_p(const f32x4 a, const f32x4 b) {
    v4u w; w.x = pk2(a[0], a[1]); w.y = pk2(a[2], a[3]); w.z = pk2(b[0], b[1]); w.w = pk2(b[2], b[3]); return __builtin_bit_cast(bf16x8, w);
}

constexpr int SW_STR = 160, SW_ROWS = 208, SW_K = 0, SW_V = SW_ROWS * SW_STR, SW_BT = 2 * SW_ROWS * SW_STR;
__device__ __forceinline__ void swa_tile(LAS const unsigned char* Ks, LAS const unsigned char* Vs, LAS const float* bt, float sink, const bf16* qrow, bf16* orow, int krow0, int kmin, bool store, int lane) {
    const int n = lane & 15, g = lane >> 4;
    bf16x8 qf[2];
#pragma unroll
    for (int ks = 0; ks < 2; ++ks) qf[ks] = *(const bf16x8*)(qrow + 32 * ks + 8 * g);
    f32x4 s[10];
#pragma unroll
    for (int mt = 0; mt < 10; ++mt) { s[mt] = (f32x4){0.f, 0.f, 0.f, 0.f};
#pragma unroll
        for (int ks = 0; ks < 2; ++ks) s[mt] = MFMA16(frag_row(Ks, SW_STR, krow0 + 16 * mt, 32 * ks, lane), qf[ks], s[mt]); }
    float mx = sink;
#pragma unroll
    for (int mt = 0; mt < 10; ++mt)
#pragma unroll
        for (int i = 0; i < 4; ++i) { const int kcol = 16 * mt + 4 * g + i, dist = n + 128 - kcol; const bool valid = (dist >= 0) && (dist <= 128) && (kcol >= kmin);
            const int di = dist < 0 ? 0 : (dist > 128 ? 128 : dist); const float v = valid ? s[mt][i] + bt[di] : -INFINITY; s[mt][i] = v; mx = fmaxf(mx, v); }
    mx = fmaxf(mx, __shfl_xor(mx, 16)); mx = fmaxf(mx, __shfl_xor(mx, 32));
    float sum = 0.f;
#pragma unroll
    for (int mt = 0; mt < 10; ++mt)
#pragma unroll
        for (int i = 0; i < 4; ++i) { const float p = __expf(s[mt][i] - mx); s[mt][i] = p; sum += p; }
    sum += __shfl_xor(sum, 16); sum += __shfl_xor(sum, 32);
    const float inv = 1.0f / (sum + __expf(sink - mx));
    f32x4 o[4];
#pragma unroll
    for (int mt = 0; mt < 4; ++mt) o[mt] = (f32x4){0.f, 0.f, 0.f, 0.f};
#pragma unroll
    for (int k2 = 0; k2 < 5; ++k2) { const bf16x8 pf = pack_p(s[2 * k2], s[2 * k2 + 1]);
#pragma unroll
        for (int mt = 0; mt < 4; ++mt) o[mt] = MFMA16(frag_tr(Vs, SW_STR, krow0 + 32 * k2 + 4 * g, krow0 + 32 * k2 + 16 + 4 * g, 16 * mt, lane), pf, o[mt]); }
    if (store) {
#pragma unroll
        for (int mt = 0; mt < 4; ++mt) { v2u w; w.x = pk2(o[mt][0] * inv, o[mt][1] * inv); w.y = pk2(o[mt][2] * inv, o[mt][3] * inv); *(v2u*)(orow + 16 * mt + 4 * g) = w; } }
}
__device__ __forceinline__ void swa_phase_mfma(const Args& A, Frame& F0, int l) {
    unsigned char* const ws_ = (unsigned char*)(GAS unsigned char*)karg64<KA_WS>();
    float* const out_ = (float*)(GAS float*)karg64<KA_OUT>();
    const float* const in_I_CSK = (const float*)(const GAS float*)karg64<8 * I_CSK>();
    const float* const in_I_CSV = (const float*)(const GAS float*)karg64<8 * I_CSV>();
    const float* const in_I_RELB = (const float*)(const GAS float*)karg64<8 * I_RELB>();
    const float* const in_I_SINK = (const float*)(const GAS float*)karg64<8 * I_SINK>();
    Frame F = F0; LAUNDER(F);
    LAS unsigned char* Ks = F.lds + SW_K; LAS unsigned char* Vs = F.lds + SW_V; LAS float* BT = (LAS float*)(F.lds + SW_BT);
    const bf16* Z = (const bf16*)(ws_ + WS_Z); bf16* BRB = (bf16*)(ws_ + WS_BR) + (size_t)M * MIXW;
    for (int i = F.tid; i < SH * 129; i += NTHR) { const int h = i / 129, d = i % 129; BT[h * SWA_BTS + d] = in_I_RELB[t5_bucket(d) * SH + h]; }
    const float* sinks = in_I_SINK + l * SH;
#pragma unroll 1
    for (int u = F.vcu; u < 256 + 64; u += F.G) {
        asm volatile("" : "+v"(F.tid), "+v"(F.lane));
        __syncthreads();
        if (u < 256) {
            const int b = u >> 7, kvh = (u >> 6) & 1, qb = u & 63, q0 = qb * 64;
            for (int i = F.tid; i < SW_ROWS * 8; i += NTHR) { const int r = i >> 3, c8 = i & 7, pos = q0 - 128 + r; v4u kv = (v4u){0u, 0u, 0u, 0u}, vv = kv;
                if (pos >= 0 && pos < SEQ) { const bf16* zr = Z + (size_t)(b * SEQ + pos) * NINP + kvh * 64 + c8 * 8; kv = *(const v4u*)(zr + ZC_SK); vv = *(const v4u*)(zr + ZC_SV); }
                *(LAS v4u*)(Ks + r * SW_STR + c8 * 16) = kv; *(LAS v4u*)(Vs + r * SW_STR + c8 * 16) = vv;
                if (qb == 63 && r >= 64 && r < 192) { float fk[8], fv[8]; unpack8(kv, fk); unpack8(vv, fv); const size_t o = ((((size_t)l * NBP + b) * WIN + (r - 64)) * SKV + kvh) * SHD + c8 * 8;
                    *(f32x4*)(out_ + O_SKP + o) = (f32x4){fk[0], fk[1], fk[2], fk[3]}; *(f32x4*)(out_ + O_SKP + o + 4) = (f32x4){fk[4], fk[5], fk[6], fk[7]};
                    *(f32x4*)(out_ + O_SVP + o) = (f32x4){fv[0], fv[1], fv[2], fv[3]}; *(f32x4*)(out_ + O_SVP + o + 4) = (f32x4){fv[4], fv[5], fv[6], fv[7]}; }
            }
            __syncthreads();
            const int head = kvh * 8 + F.wave; const float sink = sinks[head];
#pragma unroll 1
            for (int mq = 0; mq < 4; ++mq) {
                int ln = F.lane; asm volatile("" : "+v"(ln));
                const int t0 = q0 + 16 * mq; const size_t row = (size_t)b * SEQ + t0 + (ln & 15);
                swa_tile(Ks, Vs, BT + head * SWA_BTS, sink, Z + row * NINP + ZC_SQ + head * 64, BRB + row * MIXW + head * 64, 16 * mq, 128 - t0, true, ln);
            }
        } else {
            const int su = u - 256, b = su >> 1, kvh = su & 1;
            for (int i = F.tid; i < 160 * 8; i += NTHR) { const int r = i >> 3, c8 = i & 7; float fk[8], fv[8];
                if (r < 128) { const size_t o = ((((size_t)l * NBS + b) * WIN + r) * SKV + kvh) * SHD + c8 * 8; const f32x4 a0 = *(const f32x4*)(in_I_CSK + o), a1 = *(const f32x4*)(in_I_CSK + o + 4), b0 = *(const f32x4*)(in_I_CSV + o), b1 = *(const f32x4*)(in_I_CSV + o + 4);
#pragma unroll
                    for (int k = 0; k < 4; ++k) { fk[k] = a0[k]; fk[4 + k] = a1[k]; fv[k] = b0[k]; fv[4 + k] = b1[k]; } }
                else if (r < 136) { const bf16* zr = Z + (size_t)(MP + b * TS + (r - 128)) * NINP + kvh * 64 + c8 * 8; unpack8(*(const v4u*)(zr + ZC_SK), fk); unpack8(*(const v4u*)(zr + ZC_SV), fv); }
                else {
#pragma unroll
                    for (int k = 0; k < 8; ++k) { fk[k] = 0.f; fv[k] = 0.f; } }
                *(LAS v4u*)(Ks + r * SW_STR + c8 * 16) = pack8(fk); *(LAS v4u*)(Vs + r * SW_STR + c8 * 16) = pack8(fv);
                if (r >= 8 && r < 136) { const size_t o = ((((size_t)l * NBS + b) * WIN + (r - 8)) * SKV + kvh) * SHD + c8 * 8;
                    *(f32x4*)(out_ + O_SKS + o) = (f32x4){fk[0], fk[1], fk[2], fk[3]}; *(f32x4*)(out_ + O_SKS + o + 4) = (f32x4){fk[4], fk[5], fk[6], fk[7]};
                    *(f32x4*)(out_ + O_SVS + o) = (f32x4){fv[0], fv[1], fv[2], fv[3]}; *(f32x4*)(out_ + O_SVS + o + 4) = (f32x4){fv[4], fv[5], fv[6], fv[7]}; }
            }
            __syncthreads();
            const int head = kvh * 8 + F.wave, n = F.lane & 15; const size_t row = (size_t)MP + b * TS + (n & 7);
            swa_tile(Ks, Vs, BT + head * SWA_BTS, sinks[head], Z + row * NINP + ZC_SQ + head * 64, BRB + row * MIXW + head * 64, 0, 0, n < 8, F.lane);
        }
    }
    __syncthreads();
}

constexpr int XA_STR = 272, XA_K = 0, XA_V = 256 * XA_STR;
__device__ __forceinline__ void xattn_tile(LAS const unsigned char* Ks, LAS const unsigned char* Vs, const bf16* qrow, bf16* orow, bool store, int lane) {
    const int g = lane >> 4;
    bf16x8 qf[4];
#pragma unroll
    for (int ks = 0; ks < 4; ++ks) qf[ks] = *(const bf16x8*)(qrow + 32 * ks + 8 * g);
    f32x4 s[16]; float mx = -INFINITY;
#pragma unroll
    for (int mt = 0; mt < 16; ++mt) { s[mt] = (f32x4){0.f, 0.f, 0.f, 0.f};
#pragma unroll
        for (int ks = 0; ks < 4; ++ks) s[mt] = MFMA16(frag_row(Ks, XA_STR, 16 * mt, 32 * ks, lane), qf[ks], s[mt]);
        mx = fmaxf(mx, fmaxf(fmaxf(s[mt][0], s[mt][1]), fmaxf(s[mt][2], s[mt][3]))); }
    mx = fmaxf(mx, __shfl_xor(mx, 16)); mx = fmaxf(mx, __shfl_xor(mx, 32));
    float sum = 0.f;
#pragma unroll
    for (int mt = 0; mt < 16; ++mt)
#pragma unroll
        for (int i = 0; i < 4; ++i) { const float p = __expf(s[mt][i] - mx); s[mt][i] = p; sum += p; }
    sum += __shfl_xor(sum, 16); sum += __shfl_xor(sum, 32);
    const float inv = 1.0f / sum;
    f32x4 o[8];
#pragma unroll
    for (int mt = 0; mt < 8; ++mt) o[mt] = (f32x4){0.f, 0.f, 0.f, 0.f};
#pragma unroll
    for (int k2 = 0; k2 < 8; ++k2) { const bf16x8 pf = pack_p(s[2 * k2], s[2 * k2 + 1]);
#pragma unroll
        for (int mt = 0; mt < 8; ++mt) o[mt] = MFMA16(frag_tr(Vs, XA_STR, 32 * k2 + 4 * g, 32 * k2 + 16 + 4 * g, 16 * mt, lane), pf, o[mt]); }
    if (store) {
#pragma unroll
        for (int mt = 0; mt < 8; ++mt) { v2u w; w.x = pk2(o[mt][0] * inv, o[mt][1] * inv); w.y = pk2(o[mt][2] * inv, o[mt][3] * inv); *(v2u*)(orow + 16 * mt + 4 * g) = w; } }
}
__device__ __forceinline__ void xattn_phase_mfma(const Args& A, Frame& F0, int l) {
    unsigned char* const ws_ = (unsigned char*)(GAS unsigned char*)karg64<KA_WS>();
    const float* const in_I_CMK = (const float*)(const GAS float*)karg64<8 * I_CMK>();
    const float* const in_I_CMV = (const float*)(const GAS float*)karg64<8 * I_CMV>();
    Frame F = F0; LAUNDER(F);
    LAS unsigned char* Ks = F.lds + XA_K; LAS unsigned char* Vs = F.lds + XA_V;
    const bf16* XQ = (const bf16*)(ws_ + WS_XQ); bf16* XO = (bf16*)(ws_ + WS_XO);
#pragma unroll 1
    for (int u = F.vcu; u < 128 + 128; u += F.G) {
        asm volatile("" : "+v"(F.tid), "+v"(F.lane));
        __syncthreads();
        if (u < 128) {
            const int b = u >> 6, h = (u >> 4) & 3, q0 = (u & 15) * 256;
            for (int i = F.tid; i < 256 * 16; i += NTHR) { const int mrow = i >> 4, c8 = i & 15; const bf16* src = (const bf16*)(ws_ + WS_MEMKV) + ((size_t)l * 512 + b * 256 + mrow) * 1024 + h * 128 + c8 * 8;
                *(LAS v4u*)(Ks + mrow * XA_STR + c8 * 16) = *(const v4u*)src; *(LAS v4u*)(Vs + mrow * XA_STR + c8 * 16) = *(const v4u*)(src + 512); }
            __syncthreads();
#pragma unroll 1
            for (int qt = F.wave; qt < 16; qt += NWAVES) { int ln = F.lane; asm volatile("" : "+v"(ln)); const size_t row = (size_t)b * SEQ + q0 + 16 * qt + (ln & 15);
                xattn_tile(Ks, Vs, XQ + row * XW + h * 128, XO + row * XW + h * 128, true, ln); }
        } else {
            const int su = u - 128, b = su >> 2, h = su & 3;
            for (int i = F.tid; i < 256 * 16; i += NTHR) { const int mrow = i >> 4, c8 = i & 15; const size_t o = (((size_t)l * NBS + b) * NMEM + mrow) * XW + h * 128 + c8 * 8; float fk[8], fv[8];
                const f32x4 a0 = *(const f32x4*)(in_I_CMK + o), a1 = *(const f32x4*)(in_I_CMK + o + 4), b0 = *(const f32x4*)(in_I_CMV + o), b1 = *(const f32x4*)(in_I_CMV + o + 4);
#pragma unroll
                for (int k = 0; k < 4; ++k) { fk[k] = a0[k]; fk[4 + k] = a1[k]; fv[k] = b0[k]; fv[4 + k] = b1[k]; }
                *(LAS v4u*)(Ks + mrow * XA_STR + c8 * 16) = pack8(fk); *(LAS v4u*)(Vs + mrow * XA_STR + c8 * 16) = pack8(fv); }
            __syncthreads();
            if (F.wave == 0) { const int n = F.lane & 15; const size_t row = (size_t)MP + b * TS + (n & 7);
                xattn_tile(Ks, Vs, XQ + row * XW + h * 128, XO + row * XW + h * 128, n < 8, F.lane); }
        }
    }
    __syncthreads();
}

__device__ __forceinline__ void gla_scan16(const bf16* Z, int row0, int lane, int wave, LAS const float* wgs, float (&bb)[16], float (&bend)[16]) {
    float gl[16]; load_glr(Z + (size_t)(row0 + lane) * NINP + ZC_GLR, gl);
#pragma unroll
    for (int dd = 0; dd < 16; ++dd) { float x = gla_lg(gl, wgs, 16 * wave + dd);
#pragma unroll
        for (int off = 1; off < 64; off <<= 1) { const float y = __shfl_up(x, off); if (lane >= off) x += y; }
        bb[dd] = x; bend[dd] = __shfl(x, 63); }
}
__device__ __forceinline__ void load16(const bf16* p, float (&f)[16]) {
    float a[8], b[8]; unpack8(*(const v4u*)p, a); unpack8(*(const v4u*)(p + 8), b);
#pragma unroll
    for (int i = 0; i < 8; ++i) { f[i] = a[i]; f[8 + i] = b[i]; }
}
__device__ __forceinline__ void store16_lds(LAS unsigned char* p, const float (&f)[16]) {
    v4u w0, w1; w0.x = pk2(f[0], f[1]); w0.y = pk2(f[2], f[3]); w0.z = pk2(f[4], f[5]); w0.w = pk2(f[6], f[7]); w1.x = pk2(f[8], f[9]); w1.y = pk2(f[10], f[11]); w1.z = pk2(f[12], f[13]); w1.w = pk2(f[14], f[15]);
    *(LAS v4u*)p = w0; *(LAS v4u*)(p + 16) = w1;
}
constexpr int G1_KSTR = 288, G1_VSTR = 544, G1_WGS = 0, G1_KT = 9216, G1_V = G1_KT + 64 * G1_KSTR;
__device__ __forceinline__ void gla_pass1_prompt_mfma(const Args& A, Frame& F, int l, int u) {
    unsigned char* const ws_ = (unsigned char*)(GAS unsigned char*)karg64<KA_WS>();
    LAS float* wgs = (LAS float*)(F.lds + G1_WGS); LAS unsigned char* Kt = F.lds + G1_KT; LAS unsigned char* Vb = F.lds + G1_V;
    const bf16* Z = (const bf16*)(ws_ + WS_Z);
    const int bh = u >> 6, c = u & 63, b = bh >> 2, h = bh & 3, row0 = b * SEQ + c * 64, lane = F.lane, w = F.wave;
    gla_stage_wg(A, F, l, h, wgs);
#pragma unroll 2
    for (int i = F.tid; i < 64 * 32; i += NTHR) { const int t = i >> 5, c8 = i & 31; *(LAS v4u*)(Vb + t * G1_VSTR + c8 * 16) = *(const v4u*)(Z + (size_t)(row0 + t) * NINP + ZC_GV + h * 256 + c8 * 8); }
    __syncthreads();
    { float bb[16], bend[16], k[16]; gla_scan16(Z, row0, lane, w, wgs, bb, bend); load16(Z + (size_t)(row0 + lane) * NINP + ZC_GK + h * 128 + 16 * w, k);
#pragma unroll
      for (int dd = 0; dd < 16; ++dd) k[dd] *= __expf(bend[dd] - bb[dd]);
      store16_lds(Kt + lane * G1_KSTR + 32 * w, k);
      if (lane == 0) {
#pragma unroll
          for (int dd = 0; dd < 16; ++dd) ((float*)(ws_ + WS_GLAD))[(size_t)u * 128 + 16 * w + dd] = __expf(bend[dd]); } }
    __syncthreads();
    const int g = lane >> 4, n = lane & 15;
    bf16x8 af[2];
#pragma unroll
    for (int ks = 0; ks < 2; ++ks) af[ks] = frag_tr(Kt, G1_KSTR, 32 * ks + 8 * g, 32 * ks + 8 * g + 4, 16 * w, lane);
    float* U = (float*)(ws_ + WS_GLAU) + (size_t)u * GDK * GDV;
#pragma unroll 4
    for (int nt = 0; nt < 16; ++nt) { f32x4 acc = (f32x4){0.f, 0.f, 0.f, 0.f};
#pragma unroll
        for (int ks = 0; ks < 2; ++ks) acc = MFMA16(af[ks], frag_tr(Vb, G1_VSTR, 32 * ks + 8 * g, 32 * ks + 8 * g + 4, 16 * nt, lane), acc);
#pragma unroll
        for (int i = 0; i < 4; ++i) U[(size_t)(16 * w + 4 * g + i) * 256 + 16 * nt + n] = acc[i]; }
}
constexpr int G3_QSTR = 272, G3_VSTR = 528, G3_PSTR = 160, G3_QD = 0, G3_KD = 64 * G3_QSTR, G3_V = 2 * 64 * G3_QSTR, G3_S = G3_V + 64 * G3_VSTR, G3_PM = G3_S + 128 * G3_VSTR, G3_END = G3_PM + 64 * G3_PSTR;
static_assert(G3_END <= 146944 && 64 * 260 * 4 <= 128 * G3_VSTR && 8704 <= 64 * G3_PSTR, "pass-3 LDS map");
__device__ __forceinline__ void gla_pass3_mfma(const Args& A, Frame& F0, int l) {
    unsigned char* const ws_ = (unsigned char*)(GAS unsigned char*)karg64<KA_WS>();
    const float* const in_I_GNORM = (const float*)(const GAS float*)karg64<8 * I_GNORM>();
    Frame F = F0; LAUNDER(F);
    LAS unsigned char* Qd = F.lds + G3_QD; LAS unsigned char* Kd = F.lds + G3_KD; LAS unsigned char* Vb = F.lds + G3_V; LAS unsigned char* Sb = F.lds + G3_S; LAS unsigned char* Pm = F.lds + G3_PM;
    LAS float* wgs = (LAS float*)Pm; LAS float* Of = (LAS float*)Sb;
    const bf16* Z = (const bf16*)(ws_ + WS_Z); bf16* BRA = (bf16*)(ws_ + WS_BR);
#pragma unroll 1
    for (int u = F.vcu; u < 512; u += F.G) {
        asm volatile("" : "+v"(F.tid), "+v"(F.lane));
        const int lane = F.lane, w = F.wave, g = lane >> 4, n = lane & 15;
        __syncthreads();
        const int bh = u >> 6, c = u & 63, b = bh >> 2, h = bh & 3, row0 = b * SEQ + c * 64;
        gla_stage_wg(A, F, l, h, wgs);
#pragma unroll 2
        for (int i = F.tid; i < 64 * 32; i += NTHR) { const int t = i >> 5, c8 = i & 31; *(LAS v4u*)(Vb + t * G3_VSTR + c8 * 16) = *(const v4u*)(Z + (size_t)(row0 + t) * NINP + ZC_GV + h * 256 + c8 * 8); }
        { const float* S = (const float*)(ws_ + WS_GLAU) + (size_t)u * GDK * GDV;
#pragma unroll 2
          for (int i = F.tid; i < 128 * 32; i += NTHR) { const int d = i >> 5, c8 = i & 31; const f32x4 s0 = *(const f32x4*)(S + d * 256 + c8 * 8), s1 = *(const f32x4*)(S + d * 256 + c8 * 8 + 4);
              v4u wv; wv.x = pk2(s0[0], s0[1]); wv.y = pk2(s0[2], s0[3]); wv.z = pk2(s1[0], s1[1]); wv.w = pk2(s1[2], s1[3]); *(LAS v4u*)(Sb + d * G3_VSTR + c8 * 16) = wv; } }
        __syncthreads();
        { float bb[16], bend[16], q[16], k[16]; gla_scan16(Z, row0, lane, w, wgs, bb, bend);
          load16(Z + (size_t)(row0 + lane) * NINP + ZC_GQ + h * 128 + 16 * w, q); load16(Z + (size_t)(row0 + lane) * NINP + ZC_GK + h * 128 + 16 * w, k);
#pragma unroll
          for (int dd = 0; dd < 16; ++dd) { q[dd] *= __expf(bb[dd]); k[dd] *= __expf(-bb[dd]); }
          store16_lds(Qd + lane * G3_QSTR + 32 * w, q); store16_lds(Kd + lane * G3_QSTR + 32 * w, k); }
        __syncthreads();
        {
            const int mt = w >> 1;
#pragma unroll
            for (int j = 0; j < 2; ++j) { const int nt = 2 * (w & 1) + j; f32x4 acc = (f32x4){0.f, 0.f, 0.f, 0.f};
#pragma unroll
                for (int ks = 0; ks < 4; ++ks) acc = MFMA16(frag_row(Qd, G3_QSTR, 16 * mt, 32 * ks, lane), frag_row(Kd, G3_QSTR, 16 * nt, 32 * ks, lane), acc);
#pragma unroll
                for (int i = 0; i < 4; ++i) { const int t = 16 * mt + 4 * g + i, s = 16 * nt + n; *(LAS bf16*)(Pm + t * G3_PSTR + s * 2) = (bf16)(pk2((s <= t) ? acc[i] : 0.f, 0.f) & 0xffffu); } }
        }
        __syncthreads();
        f32x4 o[4][2];
#pragma unroll
        for (int mt = 0; mt < 4; ++mt) { o[mt][0] = (f32x4){0.f, 0.f, 0.f, 0.f}; o[mt][1] = (f32x4){0.f, 0.f, 0.f, 0.f}; }
#pragma unroll
        for (int j = 0; j < 2; ++j) { const int nt = 2 * w + j;
#pragma unroll
            for (int ks = 0; ks < 4; ++ks) { const bf16x8 bf = frag_tr(Sb, G3_VSTR, 32 * ks + 8 * g, 32 * ks + 8 * g + 4, 16 * nt, lane);
#pragma unroll
                for (int mt = 0; mt < 4; ++mt) o[mt][j] = MFMA16(frag_row(Qd, G3_QSTR, 16 * mt, 32 * ks, lane), bf, o[mt][j]); }
#pragma unroll
            for (int ks = 0; ks < 2; ++ks) { const bf16x8 bf = frag_tr(Vb, G3_VSTR, 32 * ks + 8 * g, 32 * ks + 8 * g + 4, 16 * nt, lane);
#pragma unroll
                for (int mt = 0; mt < 4; ++mt) o[mt][j] = MFMA16(frag_row(Pm, G3_PSTR, 16 * mt, 32 * ks, lane), bf, o[mt][j]); } }
        __syncthreads();
#pragma unroll
        for (int mt = 0; mt < 4; ++mt)
#pragma unroll
            for (int j = 0; j < 2; ++j)
#pragma unroll
                for (int i = 0; i < 4; ++i) Of[(16 * mt + 4 * g + i) * 260 + 16 * (2 * w + j) + n] = o[mt][j][i];
        __syncthreads();
        {
            const int tb = F.tid >> 5, vb = F.tid & 31; float gn[8];
#pragma unroll
            for (int j = 0; j < 8; ++j) gn[j] = in_I_GNORM[l * GDV + 8 * vb + j];
#pragma unroll
            for (int i = 0; i < 4; ++i) { const int t = 4 * tb + i; const f32x4 o0 = *(LAS const f32x4*)(Of + t * 260 + 8 * vb), o1 = *(LAS const f32x4*)(Of + t * 260 + 8 * vb + 4);
                float ov[8] = {o0[0], o0[1], o0[2], o0[3], o1[0], o1[1], o1[2], o1[3]}; float ss = 0.f;
#pragma unroll
                for (int j = 0; j < 8; ++j) ss += ov[j] * ov[j];
#pragma unroll
                for (int x = 1; x < 32; x <<= 1) ss += __shfl_xor(ss, x);
                const float rs = rsqrtf(ss * (1.0f / 256.0f) + EPS); const int row = row0 + t; float gv[8], r[8]; unpack8(*(const v4u*)(Z + (size_t)row * NINP + ZC_GR + h * 256 + 8 * vb), gv);
#pragma unroll
                for (int j = 0; j < 8; ++j) r[j] = ov[j] * rs * gn[j] * gv[j] * sigm(gv[j]);
                *(v4u*)(BRA + (size_t)row * MIXW + h * 256 + 8 * vb) = pack8(r); }
        }
    }
    __syncthreads();
}
__device__ __forceinline__ void gla_pass1(const Args& A, Frame& F0, int l) {
    unsigned char* const ws_ = (unsigned char*)(GAS unsigned char*)karg64<KA_WS>();
    float* const out_ = (float*)(GAS float*)karg64<KA_OUT>();
    const float* const in_I_GNORM = (const float*)(const GAS float*)karg64<8 * I_GNORM>();
    const float* const in_I_SGLA = (const float*)(const GAS float*)karg64<8 * I_SGLA>();
    Frame F = F0; LAUNDER(F);
    LAS float* bl = (LAS float*)(F.lds); LAS float* kt = (LAS float*)(F.lds + 32768); LAS float* wgs = (LAS float*)(F.lds + 65536);
#pragma unroll 1
    for (int u = F.vcu; u < 512 + 128; u += F.G) {
        asm volatile("" : "+v"(F.tid), "+v"(F.lane));
        __syncthreads();
        if (u < 512) {
            gla_pass1_prompt_mfma(A, F, l, u);
        } else {
            const int su = u - 512, b = su >> 2, h = su & 3, row0 = MP + b * TS;
            LAS float* qs = (LAS float*)(F.lds); LAS float* ks = qs + 1024; LAS float* es = qs + 2048; LAS float* vs = qs + 3072; LAS float* red = qs + 5120;
            gla_stage_wg(A, F, l, h, wgs);
            __syncthreads();
            { const int t = F.tid >> 6, dp = F.tid & 63; float gl[16]; load_glr(((bf16*)(ws_ + WS_Z)) + (size_t)(row0 + t) * NINP + ZC_GLR, gl);
              es[t * 128 + 2 * dp] = __expf(gla_lg(gl, wgs, 2 * dp)); es[t * 128 + 2 * dp + 1] = __expf(gla_lg(gl, wgs, 2 * dp + 1)); }
            for (int i = F.tid; i < 8 * 128; i += NTHR) { const int t = i >> 7, d = i & 127; const bf16* zr = ((bf16*)(ws_ + WS_Z)) + (size_t)(row0 + t) * NINP + h * 128 + d; qs[i] = bf1(zr[ZC_GQ]); ks[i] = bf1(zr[ZC_GK]); }
            for (int i = F.tid; i < 8 * 256; i += NTHR) { const int t = i >> 8, v = i & 255; vs[i] = bf1(((bf16*)(ws_ + WS_Z))[(size_t)(row0 + t) * NINP + ZC_GV + h * 256 + v]); }
            __syncthreads();
            const int v = F.tid & 255, half = F.tid >> 8; const size_t sidx = (((size_t)l * NBS + b) * GH + h) * GDK * GDV;
            const float* S0 = in_I_SGLA + sidx + (size_t)(64 * half) * 256 + v;
            float S[64];
#pragma unroll
            for (int i = 0; i < 64; ++i) S[i] = S0[i * 256];
            for (int t = 0; t < 8; ++t) { const float vv = vs[t * 256 + v]; float part = 0.f;
#pragma unroll
                for (int i = 0; i < 64; ++i) { const int d = 64 * half + i; S[i] = es[t * 128 + d] * S[i] + ks[t * 128 + d] * vv; part += qs[t * 128 + d] * S[i]; }
                red[(t * 2 + half) * 256 + v] = part; }
            float* So = out_ + O_GLAS + sidx + (size_t)(64 * half) * 256 + v;
#pragma unroll
            for (int i = 0; i < 64; ++i) So[i * 256] = S[i];
            __syncthreads();
            { const int t = F.wave, row = row0 + t; float o[4]; float ss = 0.f;
#pragma unroll
              for (int k = 0; k < 4; ++k) { const int vv = F.lane + 64 * k; o[k] = red[(t * 2) * 256 + vv] + red[(t * 2 + 1) * 256 + vv]; ss += o[k] * o[k]; }
              ss = wave_sum(ss); const float rs = rsqrtf(ss * (1.0f / 256.0f) + EPS);
#pragma unroll
              for (int k = 0; k < 4; ++k) { const int vv = F.lane + 64 * k; const float g = bf1(((bf16*)(ws_ + WS_Z))[(size_t)row * NINP + ZC_GR + h * 256 + vv]);
                  ((bf16*)(ws_ + WS_BR))[(size_t)row * MIXW + h * 256 + vv] = (bf16)(pk2(o[k] * rs * in_I_GNORM[l * GDV + vv] * g * sigm(g), 0.f) & 0xffffu); } }
        }
    }
    __syncthreads();
}
__device__ __forceinline__ void gla_pass2(const Args& A, Frame& F0, int l) {
    unsigned char* const ws_ = (unsigned char*)(GAS unsigned char*)karg64<KA_WS>();
    float* const out_ = (float*)(GAS float*)karg64<KA_OUT>();
    Frame F = F0; LAUNDER(F);
    for (int e = F.vcu * NTHR + F.tid; e < 8 * GDK * GDV; e += F.G * NTHR) {
        const int bh = e >> 15, dv = e & 32767, d = dv >> 8;
        float* U = ((float*)(ws_ + WS_GLAU)) + (size_t)bh * 64 * GDK * GDV + dv; const float* D = ((float*)(ws_ + WS_GLAD)) + (size_t)bh * 64 * 128 + d;
        float S = 0.f;
        for (int c0 = 0; c0 < 64; c0 += 8) { float uu[8], dd[8];
#pragma unroll
            for (int k = 0; k < 8; ++k) { uu[k] = U[(size_t)(c0 + k) * GDK * GDV]; dd[k] = D[(c0 + k) * 128]; }
#pragma unroll
            for (int k = 0; k < 8; ++k) { U[(size_t)(c0 + k) * GDK * GDV] = S; S = dd[k] * S + uu[k]; } }
        out_[O_GLAP + ((size_t)l * 8 + bh) * GDK * GDV + dv] = S;
    }
}
__device__ __forceinline__ void gla_pass3(const Args& A, Frame& F0, int l) {
    unsigned char* const ws_ = (unsigned char*)(GAS unsigned char*)karg64<KA_WS>();
    const float* const in_I_GNORM = (const float*)(const GAS float*)karg64<8 * I_GNORM>();
    Frame F = F0; LAUNDER(F);
    LAS float* bl = (LAS float*)(F.lds); LAS float* qdT = (LAS float*)(F.lds + 32768); LAS float* kdT = (LAS float*)(F.lds + 67584); LAS float* Am = (LAS float*)(F.lds + 102400); LAS float* wgs = (LAS float*)(F.lds + 119808);
    for (int u = F.vcu; u < 512; u += F.G) {
        __syncthreads();
        const int bh = u >> 6, c = u & 63, b = bh >> 2, h = bh & 3, row0 = b * SEQ + c * 64;
        gla_chunk_b(A, F, l, row0, h, bl, wgs);
        { const int t = F.tid & 63, dg = F.tid >> 6; const bf16* zr = ((bf16*)(ws_ + WS_Z)) + (size_t)(row0 + t) * NINP + h * 128 + dg * 16; float q[16], k[16];
          { float a[8], bb[8]; unpack8(*(const v4u*)(zr + ZC_GQ), a); unpack8(*(const v4u*)(zr + ZC_GQ + 8), bb);
#pragma unroll
            for (int i = 0; i < 8; ++i) { q[i] = a[i]; q[8 + i] = bb[i]; }
            unpack8(*(const v4u*)(zr + ZC_GK), a); unpack8(*(const v4u*)(zr + ZC_GK + 8), bb);
#pragma unroll
            for (int i = 0; i < 8; ++i) { k[i] = a[i]; k[8 + i] = bb[i]; } }
#pragma unroll
          for (int i = 0; i < 16; ++i) { const int d = dg * 16 + i; const float bb = bl[t * 128 + d]; qdT[d * 68 + t] = q[i] * __expf(bb); kdT[d * 68 + t] = k[i] * __expf(-bb); } }
        __syncthreads();
        const int tb = F.tid >> 5, vb = F.tid & 31;
        {
            float a[4][2];
#pragma unroll
            for (int i = 0; i < 4; ++i) { a[i][0] = 0.f; a[i][1] = 0.f; }
            for (int d = 0; d < 128; ++d) { const f32x4 qq = *(LAS const f32x4*)(qdT + d * 68 + 4 * tb); const f32x2 kk = *(LAS const f32x2*)(kdT + d * 68 + 2 * vb);
#pragma unroll
                for (int i = 0; i < 4; ++i) { a[i][0] += qq[i] * kk[0]; a[i][1] += qq[i] * kk[1]; } }
#pragma unroll
            for (int i = 0; i < 4; ++i)
#pragma unroll
                for (int j = 0; j < 2; ++j) { const int t = 4 * tb + i, s = 2 * vb + j; Am[s * 68 + t] = (s <= t) ? a[i][j] : 0.f; }
        }
        float o[4][8];
#pragma unroll
        for (int i = 0; i < 4; ++i)
#pragma unroll
            for (int j = 0; j < 8; ++j) o[i][j] = 0.f;
        { const float* S = ((float*)(ws_ + WS_GLAU)) + (size_t)u * GDK * GDV + 8 * vb;
          for (int d = 0; d < 128; ++d) { const f32x4 qq = *(LAS const f32x4*)(qdT + d * 68 + 4 * tb); const f32x4 s0 = *(const f32x4*)(S + d * 256), s1 = *(const f32x4*)(S + d * 256 + 4);
#pragma unroll
              for (int i = 0; i < 4; ++i)
#pragma unroll
                  for (int j = 0; j < 4; ++j) { o[i][j] += qq[i] * s0[j]; o[i][4 + j] += qq[i] * s1[j]; } } }
        __syncthreads();
        for (int s = 0; s < 64; ++s) { const f32x4 aa = *(LAS const f32x4*)(Am + s * 68 + 4 * tb); float vv[8]; unpack8(*(const v4u*)(((bf16*)(ws_ + WS_Z)) + (size_t)(row0 + s) * NINP + ZC_GV + h * 256 + 8 * vb), vv);
#pragma unroll
            for (int i = 0; i < 4; ++i)
#pragma unroll
                for (int j = 0; j < 8; ++j) o[i][j] += aa[i] * vv[j]; }
        float gn[8];
#pragma unroll
        for (int j = 0; j < 8; ++j) gn[j] = in_I_GNORM[l * GDV + 8 * vb + j];
#pragma unroll
        for (int i = 0; i < 4; ++i) { float ss = 0.f;
#pragma unroll
            for (int j = 0; j < 8; ++j) ss += o[i][j] * o[i][j];
#pragma unroll
            for (int x = 1; x < 32; x <<= 1) ss += __shfl_xor(ss, x);
            const float rs = rsqrtf(ss * (1.0f / 256.0f) + EPS); const int row = row0 + 4 * tb + i; float g[8], r[8]; unpack8(*(const v4u*)(((bf16*)(ws_ + WS_Z)) + (size_t)row * NINP + ZC_GR + h * 256 + 8 * vb), g);
#pragma unroll
            for (int j = 0; j < 8; ++j) r[j] = o[i][j] * rs * gn[j] * g[j] * sigm(g[j]);
            *(v4u*)(((bf16*)(ws_ + WS_BR)) + (size_t)row * MIXW + h * 256 + 8 * vb) = pack8(r); }
    }
    __syncthreads();
}

__device__ __forceinline__ void xattn_phase(const Args& A, Frame& F0, int l) {
    unsigned char* const ws_ = (unsigned char*)(GAS unsigned char*)karg64<KA_WS>();
    const float* const in_I_CMK = (const float*)(const GAS float*)karg64<8 * I_CMK>();
    const float* const in_I_CMV = (const float*)(const GAS float*)karg64<8 * I_CMV>();
    Frame F = F0; LAUNDER(F);
    LAS unsigned char* Ks = F.lds; LAS unsigned char* Vs = F.lds + 65536;
    for (int u = F.vcu; u < 128 + 128; u += F.G) {
        __syncthreads();
        if (u < 128) {
            const int b = u >> 6, h = (u >> 4) & 3, q0 = (u & 15) * 256;
            for (int i = F.tid; i < 256 * 16; i += NTHR) { const int mrow = i >> 4, c8 = i & 15; const bf16* src = ((bf16*)(ws_ + WS_MEMKV)) + ((size_t)l * 512 + b * 256 + mrow) * 1024 + h * 128 + c8 * 8;
                *(LAS v4u*)(Ks + mrow * 256 + c8 * 16) = *(const v4u*)src; *(LAS v4u*)(Vs + mrow * 256 + c8 * 16) = *(const v4u*)(src + 512); }
            __syncthreads();
            const int qi = F.tid >> 1, half = F.tid & 1, row = b * SEQ + q0 + qi;
            float q[64], o[64]; load_q64(((bf16*)(ws_ + WS_XQ)) + (size_t)row * XW + h * 128 + 64 * half, q);
#pragma unroll
            for (int i = 0; i < 64; ++i) o[i] = 0.f;
            float m = -INFINITY, ls = 0.f;
            attn_core<256, true, false>(q, Ks + half * 128, Vs + half * 128, 256, 0, nullptr, m, ls, o);
            store_o64(((bf16*)(ws_ + WS_XO)) + (size_t)row * XW + h * 128 + 64 * half, o, 1.0f / ls);
        } else {
            const int su = u - 128, b = su >> 2, h = su & 3;
            for (int i = F.tid; i < 256 * 16; i += NTHR) { const int mrow = i >> 4, c8 = i & 15; const size_t o = (((size_t)l * NBS + b) * NMEM + mrow) * XW + h * 128 + c8 * 8; float fk[8], fv[8];
                const f32x4 a0 = *(const f32x4*)(in_I_CMK + o), a1 = *(const f32x4*)(in_I_CMK + o + 4), b0 = *(const f32x4*)(in_I_CMV + o), b1 = *(const f32x4*)(in_I_CMV + o + 4);
#pragma unroll
                for (int k = 0; k < 4; ++k) { fk[k] = a0[k]; fk[4 + k] = a1[k]; fv[k] = b0[k]; fv[4 + k] = b1[k]; }
                *(LAS v4u*)(Ks + mrow * 256 + c8 * 16) = pack8(fk); *(LAS v4u*)(Vs + mrow * 256 + c8 * 16) = pack8(fv); }
            __syncthreads();
            if (F.tid < 16) {
                const int qi = F.tid >> 1, half = F.tid & 1, row = MP + b * TS + qi;
                float q[64], o[64]; load_q64(((bf16*)(ws_ + WS_XQ)) + (size_t)row * XW + h * 128 + 64 * half, q);
#pragma unroll
                for (int i = 0; i < 64; ++i) o[i] = 0.f;
                float m = -INFINITY, ls = 0.f;
                attn_core<256, true, false>(q, Ks + half * 128, Vs + half * 128, 256, 0, nullptr, m, ls, o);
                store_o64(((bf16*)(ws_ + WS_XO)) + (size_t)row * XW + h * 128 + 64 * half, o, 1.0f / ls);
            }
        }
    }
    __syncthreads();
}

__device__ __forceinline__ void ffnact_phase(const Args& A, Frame& F0, int l) {
    unsigned char* const ws_ = (unsigned char*)(GAS unsigned char*)karg64<KA_WS>();
    float* const out_ = (float*)(GAS float*)karg64<KA_OUT>();
    const float* const in_I_FCB = (const float*)(const GAS float*)karg64<8 * I_FCB>();
    const float* const in_I_FCW = (const float*)(const GAS float*)karg64<8 * I_FCW>();
    const float* const in_I_SFFN = (const float*)(const GAS float*)karg64<8 * I_SFFN>();
    Frame F = F0; LAUNDER(F);
    const float* cw = in_I_FCW + (size_t)l * 3 * DFF; const float* cbp = in_I_FCB + (size_t)l * DFF; const bf16* UG = (const bf16*)(ws_ + WS_UG); bf16* ACT = (bf16*)(ws_ + WS_ACT);
    constexpr int NG = DFF / 8;
#pragma unroll 1
    for (int idx = F.vcu * NTHR + F.tid; idx < (M / 8) * NG; idx += F.G * NTHR) {
        const int row0 = (idx / NG) * 8, c = (idx % NG) * 8; const bool smp = row0 >= MP; const int b = smp ? (row0 - MP) >> 3 : row0 >> 12, t0 = smp ? 0 : (row0 & (SEQ - 1));
        v4u gg[10], uu[8];
#pragma unroll
        for (int k = 0; k < 10; ++k) { gg[k] = (v4u){0u, 0u, 0u, 0u}; if (k >= 2 || t0 > 0) gg[k] = *(const v4u*)(UG + (size_t)(row0 + k - 2) * 2 * DFF + DFF + c); }
#pragma unroll
        for (int k = 0; k < 8; ++k) uu[k] = *(const v4u*)(UG + (size_t)(row0 + k) * 2 * DFF + c);
        float w0[8], w1[8], w2[8], cb[8];
#pragma unroll
        for (int i = 0; i < 8; ++i) { w0[i] = cw[c + i]; w1[i] = cw[DFF + c + i]; w2[i] = cw[2 * DFF + c + i]; cb[i] = cbp[c + i]; }
        float g2[8], g1[8], g0[8];
        unpack8(gg[0], g2); unpack8(gg[1], g1);
        if (smp) { const float* sp = in_I_SFFN + (((size_t)l * NBS + b) * 2) * DFF + c; const f32x4 a0 = *(const f32x4*)sp, a1 = *(const f32x4*)(sp + 4), b0 = *(const f32x4*)(sp + DFF), b1 = *(const f32x4*)(sp + DFF + 4);
#pragma unroll
            for (int i = 0; i < 4; ++i) { g2[i] = a0[i]; g2[4 + i] = a1[i]; g1[i] = b0[i]; g1[4 + i] = b1[i]; } }
#pragma unroll
        for (int k = 0; k < 8; ++k) { float uf[8], o[8]; unpack8(gg[k + 2], g0); unpack8(uu[k], uf);
#pragma unroll
            for (int i = 0; i < 8; ++i) { const float gc = w0[i] * g2[i] + w1[i] * g1[i] + w2[i] * g0[i] + cb[i]; o[i] = gc * sigm(gc) * uf[i]; }
            *(v4u*)(ACT + (size_t)(row0 + k) * DFF + c) = pack8(o);
            if (k >= 6 && (smp || t0 == SEQ - 8)) { float* dst = out_ + (smp ? O_FFNS + (((size_t)l * NBS + b) * 2 + (k - 6)) * DFF : O_FFNP + (((size_t)l * NBP + b) * 2 + (k - 6)) * DFF) + c;
                *(f32x4*)dst = (f32x4){g0[0], g0[1], g0[2], g0[3]}; *(f32x4*)(dst + 4) = (f32x4){g0[4], g0[5], g0[6], g0[7]}; }
#pragma unroll
            for (int i = 0; i < 8; ++i) { g2[i] = g1[i]; g1[i] = g0[i]; } }
    }
}

__device__ __forceinline__ void final_phase(const Args& A, Frame& F0) {
    unsigned char* const ws_ = (unsigned char*)(GAS unsigned char*)karg64<KA_WS>();
    float* const out_ = (float*)(GAS float*)karg64<KA_OUT>();
    const float* const in_I_NFIN = (const float*)(const GAS float*)karg64<8 * I_NFIN>();
    Frame F = F0; LAUNDER(F);
    const int gw = F.vcu * NWAVES + F.wave, NGW = F.G * NWAVES, lane = F.lane; const float* g = in_I_NFIN;
    for (int m = gw; m < M; m += NGW) {
        float s = (lane < 32) ? ((float*)(ws_ + WS_SSQ))[(size_t)m * 32 + lane] : 0.f; s = wave_sum(s);
        const float rs = rsqrtf(s * (1.0f / DM) + EPS);
        float* dst = out_ + ((m < MP) ? O_YP + (size_t)m * DM : O_YS + (size_t)(m - MP) * DM);
#pragma unroll
        for (int j = 0; j < 8; ++j) { const f32x4 v = *((const f32x4*)(((float*)(ws_ + WS_X)) + (size_t)m * DM) + lane + 64 * j); const f32x4 gg = *((const f32x4*)g + lane + 64 * j); *((f32x4*)dst + lane + 64 * j) = v * rs * gg; }
    }
}

__device__ __forceinline__ f32x4 sk_tile(const bf16* A, const bf16* Bt, int K, int rb, int cb, LAS float* red, int tid, int lane, int wave) {
    const int n = lane & 15, g = lane >> 4, npairs = K >> 6;
    f32x4 acc[2][4];
#pragma unroll
    for (int mt = 0; mt < 2; ++mt)
#pragma unroll
        for (int nt = 0; nt < 4; ++nt) acc[mt][nt] = (f32x4){0.f, 0.f, 0.f, 0.f};
    const bf16* ap = A + (size_t)(32 * rb + n) * K + 8 * g; const bf16* bp = Bt + (size_t)(64 * cb + n) * K + 8 * g;
#pragma unroll 2
    for (int p = wave; p < npairs; p += NWAVES) {
        bf16x8 af[2][2], bfr[4][2];
#pragma unroll
        for (int ks = 0; ks < 2; ++ks) {
#pragma unroll
            for (int mt = 0; mt < 2; ++mt) af[mt][ks] = *(const bf16x8*)(ap + (size_t)(16 * mt) * K + 64 * p + 32 * ks);
#pragma unroll
            for (int nt = 0; nt < 4; ++nt) bfr[nt][ks] = *(const bf16x8*)(bp + (size_t)(16 * nt) * K + 64 * p + 32 * ks); }
#pragma unroll
        for (int ks = 0; ks < 2; ++ks)
#pragma unroll
            for (int mt = 0; mt < 2; ++mt)
#pragma unroll
                for (int nt = 0; nt < 4; ++nt) acc[mt][nt] = MFMA16(af[mt][ks], bfr[nt][ks], acc[mt][nt]);
    }
    __syncthreads();
#pragma unroll
    for (int mt = 0; mt < 2; ++mt)
#pragma unroll
        for (int nt = 0; nt < 4; ++nt)
#pragma unroll
            for (int i = 0; i < 4; ++i) red[wave * 2048 + (16 * mt + 4 * g + i) * 64 + 16 * nt + n] = acc[mt][nt][i];
    __syncthreads();
    const int r = tid >> 4, cg = tid & 15; f32x4 s = *(LAS const f32x4*)(red + r * 64 + 4 * cg);
#pragma unroll
    for (int w = 1; w < 8; ++w) s += *(LAS const f32x4*)(red + w * 2048 + r * 64 + 4 * cg);
    return s;
}
__device__ __forceinline__ void sk_residual(const bf16* A, const bf16* Bt, int K, Frame& F0) {
    Frame F = F0; LAUNDER(F);
    unsigned char* const ws_ = (unsigned char*)(GAS unsigned char*)karg64<KA_WS>();
    float* X = (float*)(ws_ + WS_X); bf16* XB = (bf16*)(ws_ + WS_XB); float* SSQ = (float*)(ws_ + WS_SSQ);
    LAS float* red = (LAS float*)F.lds;
#pragma unroll 1
    for (int u = F.vcu; u < 256; u += F.G) {
        asm volatile("" : "+v"(F.tid), "+v"(F.lane));
        const int rb = u >> 5, cb = u & 31;
        const f32x4 s = sk_tile(A, Bt, K, rb, cb, red, F.tid, F.lane, F.wave);
        const int row = MP + 32 * rb + (F.tid >> 4), col = 64 * cb + 4 * (F.tid & 15); const size_t off = (size_t)row * DM + col;
        const f32x4 x = *(const f32x4*)(X + off) + s; *(f32x4*)(X + off) = x;
        v2u w; w.x = pk2(x[0], x[1]); w.y = pk2(x[2], x[3]); *(v2u*)(XB + off) = w;
        float ss = (x[0] * x[0] + x[1] * x[1]) + (x[2] * x[2] + x[3] * x[3]);
        ss += __shfl_xor(ss, 1); ss += __shfl_xor(ss, 2); ss += __shfl_xor(ss, 4); ss += __shfl_xor(ss, 8);
        if ((F.tid & 15) == 0) SSQ[(size_t)row * 32 + cb] = ss;
    }
    __syncthreads();
}
__device__ __forceinline__ void sk_branch(Frame& F0, int l) {
    Frame F = F0; LAUNDER(F);
    unsigned char* const ws_ = (unsigned char*)(GAS unsigned char*)karg64<KA_WS>();
    const bf16* BR = (const bf16*)(ws_ + WS_BR); const bf16* Wb = (const bf16*)(ws_ + WS_WBR) + (size_t)l * 3 * DM * MIXW; const bf16* Z = (const bf16*)(ws_ + WS_Z); bf16* MG = (bf16*)(ws_ + WS_MG);
    LAS float* red = (LAS float*)F.lds;
#pragma unroll 1
    for (int u = F.vcu; u < 256; u += F.G) {
        asm volatile("" : "+v"(F.tid), "+v"(F.lane));
        const int rb = u >> 5, cb = u & 31; const int row = MP + 32 * rb + (F.tid >> 4), col = 64 * cb + 4 * (F.tid & 15);
        f32x4 mg = (f32x4){0.f, 0.f, 0.f, 0.f};
#pragma unroll 1
        for (int i = 0; i < 3; ++i) {
            const f32x4 s = sk_tile(BR + (size_t)i * M * MIXW + (size_t)MP * MIXW, Wb + (size_t)i * DM * MIXW, MIXW, rb, cb, red, F.tid, F.lane, F.wave);
            const v2u gw = *(const v2u*)(Z + (size_t)row * NINP + ZC_GATE + i * DM + col);
            mg += s * (f32x4){bflo(gw.x), bfhi(gw.x), bflo(gw.y), bfhi(gw.y)};
        }
        v2u w; w.x = pk2(mg[0], mg[1]); w.y = pk2(mg[2], mg[3]); *(v2u*)(MG + (size_t)row * DM + col) = w;
    }
    __syncthreads();
}

#ifndef PH_MASK
#define PH_MASK 0xffffffffu
#endif
#define PON(i) constexpr ((PH_MASK >> (i)) & 1u) for (int rep_ = 0; rep_ <= (int)((PROBE_MASK >> (i)) & 1u); ++rep_)
#ifndef PROBE_MASK
#define PROBE_MASK 0u
#endif
#ifndef USE_MFMA
#define USE_MFMA 7
#endif
#ifndef MK_PER_PHASE
#define MK_PER_PHASE 0
#endif
constexpr int PH_PER_LAYER = 12, N_PHASES = 2 + DEPTH * PH_PER_LAYER + 1;

__global__ void __launch_bounds__(NTHR, 2) fwd(const Args A) {
    extern __shared__ __attribute__((aligned(16))) unsigned char lds[];
    Frame F;
    F.lds = (LAS unsigned char*)lds;
    F.MISC = (volatile LAS unsigned*)(F.lds + MISC_OFF);
    F.wave = __builtin_amdgcn_readfirstlane((int)threadIdx.x >> 6); F.lane = 0; F.tid = 0;
    F.G = gridDim.x; { const int bx = blockIdx.x; F.vcu = (F.G % 8 == 0) ? (bx % 8) * (F.G / 8) + bx / 8 : bx; }
    F.ctl = (gu32*)(((unsigned char*)(GAS unsigned char*)karg64<KA_WS>()) + WS_CTL);
    for (int u = F.wave * 64 + lane_id(); u < (LDS_BYTES - LDSCTL_OFF) / 4; u += NTHR) ((LAS unsigned*)(F.lds + LDSCTL_OFF))[u] = 0u;
    __syncthreads();
    XcdBarrier bar; bar.bar = (unsigned*)(F.ctl + CW_BAR); bar.x = 0; bar.st = nullptr; bar.wv = (unsigned)F.wave;
    if (!MK_PER_PHASE) bar = xcd_barrier_post((unsigned*)(F.ctl + CW_BAR), F.MISC + 8, (unsigned)F.wave);
    const int lo = karg32<KA_LO>(), hi = karg32<KA_HI>();
#define IN(k) (lo <= (k) && (k) < hi)
#define SEAM(k) do { if (IN(k) && IN((k) + 1)) xcd_barrier(bar); } while (0)
    typedef pg8::StaticOrder SO;
#define BX_ launder_s((int)blockIdx.x)
#define G_ launder_s(F.G)
    LAS unsigned char* ring = F.lds + RING_OFF;

    if (IN(0)) { if PON(0) p0_convert(A, F); }
    SEAM(0);
    if (IN(1)) { if PON(1)
        for (int l = 0; l < DEPTH; ++l) {
            pg8::Gemm g{((bf16*)(((unsigned char*)(GAS unsigned char*)karg64<KA_WS>()) + WS_MEMB)), ((bf16*)(((unsigned char*)(GAS unsigned char*)karg64<KA_WS>()) + WS_WXKV)) + (size_t)l * 2 * XW * DM, NBP * NMEM, 2 * XW, DM}; SO S; S.init(NBP * NMEM, 2 * XW, G_, (int)((BX_ + G_ - 8 * l) % G_));
            pg8::EpiMemKV E{((float*)(GAS float*)karg64<KA_OUT>()) + O_MKP + (size_t)l * NBP * NMEM * XW, ((float*)(GAS float*)karg64<KA_OUT>()) + O_MVP + (size_t)l * NBP * NMEM * XW, ((bf16*)(((unsigned char*)(GAS unsigned char*)karg64<KA_WS>()) + WS_MEMKV)) + (size_t)l * NBP * NMEM * 2 * XW};
            pg8::gemm_phase<pg8::EpiMemKV, SO, true, true>(ring, g, S, E, F.wave * 64 + lane_id());
        }
    }
    SEAM(1);
    for (int l = 0; l < DEPTH; ++l) {
        const int pb = 2 + l * PH_PER_LAYER;
        if (IN(pb + 0)) { if PON(2) {
            pg8::Gemm g{((bf16*)(((unsigned char*)(GAS unsigned char*)karg64<KA_WS>()) + WS_XB)), ((bf16*)(((unsigned char*)(GAS unsigned char*)karg64<KA_WS>()) + WS_WIN)) + (size_t)l * NINP * DM, M, NINP, DM}; SO S; S.init(M, NINP, G_, BX_);
            pg8::EpiScaleBf16 E{((bf16*)(((unsigned char*)(GAS unsigned char*)karg64<KA_WS>()) + WS_Z)), NINP, ((float*)(((unsigned char*)(GAS unsigned char*)karg64<KA_WS>()) + WS_SSQ)), ZC_GATE / 256, ZC_GLR / 256};
            pg8::gemm_phase<pg8::EpiScaleBf16, SO, true, true>(ring, g, S, E, F.wave * 64 + lane_id());
        } }
        SEAM(pb + 0);
        if (IN(pb + 1)) { if PON(3) conv_phase(A, F, l); if PON(4) { if (USE_MFMA & 1) swa_phase_mfma(A, F, l); else swa_phase(A, F, l); } if PON(5) gla_pass1(A, F, l); }
        SEAM(pb + 1);
        if (IN(pb + 2)) { if PON(6) gla_pass2(A, F, l); }
        SEAM(pb + 2);
        if (IN(pb + 3)) { if PON(7) { if (USE_MFMA & 2) gla_pass3_mfma(A, F, l); else gla_pass3(A, F, l); } }
        SEAM(pb + 3);
        if (IN(pb + 4)) { if PON(8) {
            for (int i = 0; i < 3; ++i) {
                pg8::Gemm g{((bf16*)(((unsigned char*)(GAS unsigned char*)karg64<KA_WS>()) + WS_BR)) + (size_t)i * M * MIXW, ((bf16*)(((unsigned char*)(GAS unsigned char*)karg64<KA_WS>()) + WS_WBR)) + ((size_t)l * 3 + i) * DM * MIXW, MP, DM, MIXW}; SO S; S.init(MP, DM, G_, BX_);
                pg8::EpiBranch E{((bf16*)(((unsigned char*)(GAS unsigned char*)karg64<KA_WS>()) + WS_MG)), ((bf16*)(((unsigned char*)(GAS unsigned char*)karg64<KA_WS>()) + WS_Z)) + ZC_GATE + i * DM, NINP, i == 0 ? 1 : 0};
                pg8::gemm_phase<pg8::EpiBranch, SO, true, true>(ring, g, S, E, F.wave * 64 + lane_id());
            }
            sk_branch(F, l);
        } }
        SEAM(pb + 4);
        if (IN(pb + 5)) { if PON(9) {
            pg8::Gemm g{((bf16*)(((unsigned char*)(GAS unsigned char*)karg64<KA_WS>()) + WS_MG)), ((bf16*)(((unsigned char*)(GAS unsigned char*)karg64<KA_WS>()) + WS_WOUT)) + (size_t)l * DM * DM, MP, DM, DM}; SO S; S.init(MP, DM, G_, BX_);
            pg8::EpiResidual E{((float*)(((unsigned char*)(GAS unsigned char*)karg64<KA_WS>()) + WS_X)), ((bf16*)(((unsigned char*)(GAS unsigned char*)karg64<KA_WS>()) + WS_XB)), ((float*)(((unsigned char*)(GAS unsigned char*)karg64<KA_WS>()) + WS_SSQ))};
            pg8::gemm_phase<pg8::EpiResidual, SO, true, true>(ring, g, S, E, F.wave * 64 + lane_id());
            sk_residual(((const bf16*)(((unsigned char*)(GAS unsigned char*)karg64<KA_WS>()) + WS_MG)) + (size_t)MP * DM, ((const bf16*)(((unsigned char*)(GAS unsigned char*)karg64<KA_WS>()) + WS_WOUT)) + (size_t)l * DM * DM, DM, F);
        } }
        SEAM(pb + 5);
        if (IN(pb + 6)) { if PON(10) {
            pg8::Gemm g{((bf16*)(((unsigned char*)(GAS unsigned char*)karg64<KA_WS>()) + WS_XB)), ((bf16*)(((unsigned char*)(GAS unsigned char*)karg64<KA_WS>()) + WS_WXQ)) + (size_t)l * XW * DM, M, XW, DM}; SO S; S.init(M, XW, G_, BX_);
            pg8::EpiScaleBf16 E{((bf16*)(((unsigned char*)(GAS unsigned char*)karg64<KA_WS>()) + WS_XQ)), XW, ((float*)(((unsigned char*)(GAS unsigned char*)karg64<KA_WS>()) + WS_SSQ)), 0, 0};
            pg8::gemm_phase<pg8::EpiScaleBf16, SO, true, true>(ring, g, S, E, F.wave * 64 + lane_id());
        } }
        SEAM(pb + 6);
        if (IN(pb + 7)) { if PON(11) { if (USE_MFMA & 4) xattn_phase_mfma(A, F, l); else xattn_phase(A, F, l); } }
        SEAM(pb + 7);
        if (IN(pb + 8)) { if PON(12) {
            pg8::Gemm g{((bf16*)(((unsigned char*)(GAS unsigned char*)karg64<KA_WS>()) + WS_XO)), ((bf16*)(((unsigned char*)(GAS unsigned char*)karg64<KA_WS>()) + WS_WXO)) + (size_t)l * DM * XW, MP, DM, XW}; SO S; S.init(MP, DM, G_, BX_);
            pg8::EpiResidual E{((float*)(((unsigned char*)(GAS unsigned char*)karg64<KA_WS>()) + WS_X)), ((bf16*)(((unsigned char*)(GAS unsigned char*)karg64<KA_WS>()) + WS_XB)), ((float*)(((unsigned char*)(GAS unsigned char*)karg64<KA_WS>()) + WS_SSQ))};
            pg8::gemm_phase<pg8::EpiResidual, SO, true, true>(ring, g, S, E, F.wave * 64 + lane_id());
            sk_residual(((const bf16*)(((unsigned char*)(GAS unsigned char*)karg64<KA_WS>()) + WS_XO)) + (size_t)MP * XW, ((const bf16*)(((unsigned char*)(GAS unsigned char*)karg64<KA_WS>()) + WS_WXO)) + (size_t)l * DM * XW, XW, F);
        } }
        SEAM(pb + 8);
        if (IN(pb + 9)) { if PON(13) {
            pg8::Gemm g{((bf16*)(((unsigned char*)(GAS unsigned char*)karg64<KA_WS>()) + WS_XB)), ((bf16*)(((unsigned char*)(GAS unsigned char*)karg64<KA_WS>()) + WS_WUP)) + (size_t)l * 2 * DFF * DM, M, 2 * DFF, DM}; SO S; S.init(M, 2 * DFF, G_, BX_);
            pg8::EpiScaleBf16 E{((bf16*)(((unsigned char*)(GAS unsigned char*)karg64<KA_WS>()) + WS_UG)), 2 * DFF, ((float*)(((unsigned char*)(GAS unsigned char*)karg64<KA_WS>()) + WS_SSQ)), 0, 0};
            pg8::gemm_phase<pg8::EpiScaleBf16, SO, true, true>(ring, g, S, E, F.wave * 64 + lane_id());
        } }
        SEAM(pb + 9);
        if (IN(pb + 10)) { if PON(14) ffnact_phase(A, F, l); }
        SEAM(pb + 10);
        if (IN(pb + 11)) { if PON(15) {
            pg8::Gemm g{((bf16*)(((unsigned char*)(GAS unsigned char*)karg64<KA_WS>()) + WS_ACT)), ((bf16*)(((unsigned char*)(GAS unsigned char*)karg64<KA_WS>()) + WS_WDN)) + (size_t)l * DM * DFF, MP, DM, DFF}; SO S; S.init(MP, DM, G_, BX_);
            pg8::EpiResidual E{((float*)(((unsigned char*)(GAS unsigned char*)karg64<KA_WS>()) + WS_X)), ((bf16*)(((unsigned char*)(GAS unsigned char*)karg64<KA_WS>()) + WS_XB)), ((float*)(((unsigned char*)(GAS unsigned char*)karg64<KA_WS>()) + WS_SSQ))};
            pg8::gemm_phase<pg8::EpiResidual, SO, true, true>(ring, g, S, E, F.wave * 64 + lane_id());
            sk_residual(((const bf16*)(((unsigned char*)(GAS unsigned char*)karg64<KA_WS>()) + WS_ACT)) + (size_t)MP * DFF, ((const bf16*)(((unsigned char*)(GAS unsigned char*)karg64<KA_WS>()) + WS_WDN)) + (size_t)l * DM * DFF, DFF, F);
        } }
        SEAM(pb + 11);
    }
    if (IN(N_PHASES - 1)) { if PON(16) final_phase(A, F); }
#undef IN
#undef SEAM
}

extern "C" void kernel_launch(void* const* d_in, const int* in_sizes, int n_in, void* d_out, int out_size, void* d_ws, size_t ws_size, hipStream_t stream) {
    static int grid = 0;
    if (grid == 0) {
        if (n_in != N_INPUTS || (size_t)out_size != O_END || ws_size < WS_END) { fprintf(stderr, "kernel_launch: built for %d inputs, %zu outputs, >= %zu bytes of workspace; got n_in %d, out %d, ws %zu; nothing launched\n", N_INPUTS, (size_t)O_END, (size_t)WS_END, n_in, out_size, ws_size); grid = -1; return; }
        int dev = 0, cus = 0, per_cu = 0;
        if (hipGetDevice(&dev) != hipSuccess || hipDeviceGetAttribute(&cus, hipDeviceAttributeMultiprocessorCount, dev) != hipSuccess) { fprintf(stderr, "kernel_launch: device query failed\n"); grid = -1; return; }
        if (hipFuncSetAttribute((const void*)fwd, hipFuncAttributeMaxDynamicSharedMemorySize, LDS_BYTES) != hipSuccess) { fprintf(stderr, "kernel_launch: hipFuncSetAttribute failed\n"); grid = -1; return; }
        if (hipOccupancyMaxActiveBlocksPerMultiprocessor(&per_cu, (const void*)fwd, NTHR, LDS_BYTES) != hipSuccess || per_cu < 1) { fprintf(stderr, "kernel_launch: occupancy query reports %d workgroups per CU\n", per_cu); }
        (void)hipGetLastError();
        grid = cus;
    }
    if (grid < 0) return;
    if (hipMemsetAsync((char*)d_ws + WS_CTL, 0, CTL_ZERO_BYTES, stream) != hipSuccess) { fprintf(stderr, "kernel_launch: memset failed\n"); return; }
    Args a{};
    for (int i = 0; i < N_INPUTS; ++i) a.in[i] = (const float*)d_in[i];
    a.out = (float*)d_out; a.ws = (unsigned char*)d_ws;
#if MK_PER_PHASE
    for (int p = 0; p < N_PHASES; ++p) {
        a.ph_lo = p; a.ph_hi = p + 1;
        hipLaunchKernelGGL(fwd, dim3(grid), dim3(NTHR), LDS_BYTES, stream, a);
    }
#else
    a.ph_lo = 0; a.ph_hi = N_PHASES;
    hipLaunchKernelGGL(fwd, dim3(grid), dim3(NTHR), LDS_BYTES, stream, a);
#endif
    const hipError_t le = hipPeekAtLastError();
    if (le != hipSuccess) fprintf(stderr, "kernel_launch: launch failed: %s\n", hipGetErrorName(le));
}
```

```cpp
#include <hip/hip_runtime.h>
#include <cstdio>
#include <cstdint>
#include <cmath>
#define MK_PER_PHASE 0
namespace pg8 {
#define PG8_LAS __attribute__((address_space(3)))
typedef unsigned short bf16_t;
typedef short bf16x8 __attribute__((ext_vector_type(8)));
typedef float f32x4 __attribute__((ext_vector_type(4)));
typedef unsigned u32x4 __attribute__((ext_vector_type(4)));
constexpr int BM = 256, BK = 64, HALF = 128, HTB = HALF * BK * 2  , STAGE_BYTES = 8 * HTB, NXCD = 8, WGM = 8;

__host__ __device__ __forceinline__ int lds_byte(int r, int c) { const int st = (r >> 4) * 2 + (c >> 5), rr = r & 15, cc = c & 31, ob = rr * 64 + cc * 2; return st * 1024 + (ob ^ (((ob >> 9) & 1) << 5)); }
__host__ __device__ __forceinline__ void stage_rc(int b, int& R, int& C) { const int st = b / 1024, sb = b % 1024, swz = sb ^ (((sb >> 9) & 1) << 5); R = (st >> 1) * 16 + swz / 64; C = (st & 1) * 32 + (swz % 64) / 2; }
__host__ __device__ __forceinline__ int perm32(int rho) { const int n = rho >> 4, i = rho & 15; return 8 * (i >> 2) + 4 * n + (i & 3); }

struct Unit { int pm, pn; };
struct Gemm { const bf16_t* A; const bf16_t* Bt; int M, N, K; };

struct StaticOrder {
    int nM, nN, nwg, G, c;
    __host__ __device__ void init(int M, int N, int G_, int c_) { nM = M / BM; nN = N / BM; nwg = nM * nN; G = G_; c = c_; }
    __host__ __device__ bool next(int i, Unit& u) const {
        const long L = (long)i * G + c; if (L >= nwg) return false;
        int wgid = (int)L; { const int q = nwg / NXCD, r = nwg % NXCD, xcd = wgid % NXCD, off = wgid / NXCD; wgid = (xcd < r ? xcd * (q + 1) : r * (q + 1) + (xcd - r) * q) + off; }
        const int nig = WGM * nN, gid = wgid / nig, fm = gid * WGM, gsz = (nM - fm) < WGM ? (nM - fm) : WGM;
        u.pm = fm + ((wgid % nig) % gsz); u.pn = (wgid % nig) / gsz; return true;
    }
    __device__ __forceinline__ void a_ready(const Unit&) const {}
    __device__ __forceinline__ void done(const Unit&) const {}
};

__device__ __forceinline__ unsigned cvt_pk_bf16(float lo, float hi) { unsigned r; asm volatile("v_cvt_pk_bf16_f32 %0, %1, %2" : "=v"(r) : "v"(lo), "v"(hi)); return r; }
typedef float f32x2 __attribute__((ext_vector_type(2)));
#define PG8_GAS __attribute__((address_space(1)))
typedef unsigned u32x2 __attribute__((ext_vector_type(2)));
__device__ __forceinline__ float bf_lo(unsigned w) { return __uint_as_float(w << 16); }
__device__ __forceinline__ float bf_hi(unsigned w) { return __uint_as_float(w & 0xffff0000u); }
__device__ __forceinline__ float sigmoidf_(float v) { return 1.0f / (1.0f + __expf(-v)); }

struct EpiScaleBf16 {
    static constexpr bool PERM = true, AFTER_DRAIN = false;
    bf16_t* O; int ldc; const float* ssq; int sig_lo, sig_hi;
    __device__ __forceinline__ void operator()(const f32x4 (&acc)[2][2][4][2], const Unit& u, int wr, int wc, int fr, int fq) const {
        const int row0 = u.pm * BM + wr * 64 + fr, col0 = u.pn * BM + wc * 32 + 8 * fq;
        const bool sig = (u.pn >= sig_lo) && (u.pn < sig_hi);
        float rs[2][4];
        if (ssq) {
            f32x4 pr[2][4][2];
#pragma unroll
            for (int ai = 0; ai < 2; ++ai)
#pragma unroll
                for (int m = 0; m < 4; ++m) { const PG8_GAS f32x4* p = (const PG8_GAS f32x4*)(ssq + (size_t)(row0 + ai * HALF + m * 16) * 32 + 8 * fq); pr[ai][m][0] = p[0]; pr[ai][m][1] = p[1]; }
#pragma unroll
            for (int ai = 0; ai < 2; ++ai)
#pragma unroll
                for (int m = 0; m < 4; ++m) { const f32x4 s = pr[ai][m][0] + pr[ai][m][1]; float t = (s[0] + s[1]) + (s[2] + s[3]); t += __shfl_xor(t, 16); t += __shfl_xor(t, 32);
                    rs[ai][m] = rsqrtf(t * (1.0f / 2048.0f) + 1e-6f); }
        } else {
#pragma unroll
            for (int ai = 0; ai < 2; ++ai)
#pragma unroll
                for (int m = 0; m < 4; ++m) rs[ai][m] = 1.0f;
        }
#pragma unroll
        for (int ai = 0; ai < 2; ++ai)
#pragma unroll
            for (int m = 0; m < 4; ++m) {
                PG8_GAS bf16_t* rowp = (PG8_GAS bf16_t*)(O + (size_t)(row0 + ai * HALF + m * 16) * ldc + col0);
#pragma unroll
                for (int bj = 0; bj < 2; ++bj) { f32x4 v0 = acc[ai][bj][m][0] * rs[ai][m], v1 = acc[ai][bj][m][1] * rs[ai][m];
                    if (sig) { v0 = (f32x4){sigmoidf_(v0[0]), sigmoidf_(v0[1]), sigmoidf_(v0[2]), sigmoidf_(v0[3])}; v1 = (f32x4){sigmoidf_(v1[0]), sigmoidf_(v1[1]), sigmoidf_(v1[2]), sigmoidf_(v1[3])}; }
                    u32x4 w; w.x = cvt_pk_bf16(v0[0], v0[1]); w.y = cvt_pk_bf16(v0[2], v0[3]); w.z = cvt_pk_bf16(v1[0], v1[1]); w.w = cvt_pk_bf16(v1[2], v1[3]);
                    *(PG8_GAS u32x4*)(rowp + bj * HALF) = w; }
            }
    }
};

struct EpiResidual {
    static constexpr bool PERM = false, AFTER_DRAIN = false;
    float* X; bf16_t* XB; float* ssq;
    __device__ __forceinline__ void operator()(const f32x4 (&acc)[2][2][4][2], const Unit& u, int wr, int wc, int fr, int fq) const {
        const int row0 = u.pm * BM + wr * 64 + fr, col0 = u.pn * BM + wc * 32 + 4 * fq;
#pragma unroll
        for (int ai = 0; ai < 2; ++ai) {
            f32x4 xo[4][2][2];
#pragma unroll
            for (int m = 0; m < 4; ++m)
#pragma unroll
                for (int bj = 0; bj < 2; ++bj)
#pragma unroll
                    for (int n = 0; n < 2; ++n) xo[m][bj][n] = *(const PG8_GAS f32x4*)(X + (size_t)(row0 + ai * HALF + m * 16) * 2048 + col0 + bj * HALF + n * 16);
            asm volatile("" ::: "memory");
#pragma unroll
            for (int m = 0; m < 4; ++m) { const int row = row0 + ai * HALF + m * 16; float ss = 0.f;
#pragma unroll
                for (int bj = 0; bj < 2; ++bj)
#pragma unroll
                    for (int n = 0; n < 2; ++n) { const size_t off = (size_t)row * 2048 + col0 + bj * HALF + n * 16;
                        const f32x4 x = xo[m][bj][n] + acc[ai][bj][m][n];
                        *(PG8_GAS f32x4*)(X + off) = x;
                        u32x2 w; w.x = cvt_pk_bf16(x[0], x[1]); w.y = cvt_pk_bf16(x[2], x[3]); *(PG8_GAS u32x2*)(XB + off) = w;
                        ss += (x[0] * x[0] + x[1] * x[1]) + (x[2] * x[2] + x[3] * x[3]); }
                ss += __shfl_xor(ss, 16); ss += __shfl_xor(ss, 32);
                if (fq == 0) *(PG8_GAS float*)(ssq + (size_t)row * 32 + u.pn * 4 + wc) = ss; }
            asm volatile("" ::: "memory");
        }
    }
};

struct EpiBranch {
    static constexpr bool PERM = true, AFTER_DRAIN = false;
    bf16_t* MG; const bf16_t* G; int ldg; int first;
    __device__ __forceinline__ void operator()(const f32x4 (&acc)[2][2][4][2], const Unit& u, int wr, int wc, int fr, int fq) const {
        const int row0 = u.pm * BM + wr * 64 + fr, col0 = u.pn * BM + wc * 32 + 8 * fq;
#pragma unroll
        for (int ai = 0; ai < 2; ++ai) {
            u32x4 gt[4][2], od[4][2];
#pragma unroll
            for (int m = 0; m < 4; ++m)
#pragma unroll
                for (int bj = 0; bj < 2; ++bj) { const int row = row0 + ai * HALF + m * 16, col = col0 + bj * HALF;
                    gt[m][bj] = *(const PG8_GAS u32x4*)(G + (size_t)row * ldg + col);
                    od[m][bj] = first ? (u32x4){0u, 0u, 0u, 0u} : *(const PG8_GAS u32x4*)(MG + (size_t)row * 2048 + col); }
            asm volatile("" ::: "memory");
#pragma unroll
            for (int m = 0; m < 4; ++m)
#pragma unroll
                for (int bj = 0; bj < 2; ++bj) { const int row = row0 + ai * HALF + m * 16, col = col0 + bj * HALF; const u32x4 g = gt[m][bj], o = od[m][bj];
                    f32x4 v0 = acc[ai][bj][m][0], v1 = acc[ai][bj][m][1];
                    v0 = v0 * (f32x4){bf_lo(g.x), bf_hi(g.x), bf_lo(g.y), bf_hi(g.y)} + (f32x4){bf_lo(o.x), bf_hi(o.x), bf_lo(o.y), bf_hi(o.y)};
                    v1 = v1 * (f32x4){bf_lo(g.z), bf_hi(g.z), bf_lo(g.w), bf_hi(g.w)} + (f32x4){bf_lo(o.z), bf_hi(o.z), bf_lo(o.w), bf_hi(o.w)};
                    u32x4 w; w.x = cvt_pk_bf16(v0[0], v0[1]); w.y = cvt_pk_bf16(v0[2], v0[3]); w.z = cvt_pk_bf16(v1[0], v1[1]); w.w = cvt_pk_bf16(v1[2], v1[3]);
                    *(PG8_GAS u32x4*)(MG + (size_t)row * 2048 + col) = w; }
            asm volatile("" ::: "memory");
        }
    }
};

struct EpiMemKV {
    static constexpr bool PERM = false, AFTER_DRAIN = false;
    float* outk; float* outv; bf16_t* KV;
    __device__ __forceinline__ void operator()(const f32x4 (&acc)[2][2][4][2], const Unit& u, int wr, int wc, int fr, int fq) const {
        const int row0 = u.pm * BM + wr * 64 + fr, col0 = u.pn * BM + wc * 32 + 4 * fq;
#pragma unroll
        for (int ai = 0; ai < 2; ++ai)
#pragma unroll
            for (int m = 0; m < 4; ++m) {
                const int row = row0 + ai * HALF + m * 16;
#pragma unroll
                for (int bj = 0; bj < 2; ++bj)
#pragma unroll
                    for (int n = 0; n < 2; ++n) { const int col = col0 + bj * HALF + n * 16; const f32x4 a = acc[ai][bj][m][n];
                        float* dst = (col < 512) ? (outk + (size_t)row * 512 + col) : (outv + (size_t)row * 512 + (col - 512));
                        *(PG8_GAS f32x4*)dst = a;
                        u32x2 w; w.x = cvt_pk_bf16(a[0], a[1]); w.y = cvt_pk_bf16(a[2], a[3]); *(PG8_GAS u32x2*)(KV + (size_t)row * 1024 + col) = w; }
            }
    }
};
template <class Epi, class Sched, bool ALIGN_EPI = false, bool SP2 = false>
__device__ __forceinline__ void gemm_phase(PG8_LAS unsigned char* lds, const Gemm g, const Sched& S, const Epi& E, int tid_in) {
    int tid_ = tid_in; asm volatile("" : "+v"(tid_));
    const int tid = tid_, wid = __builtin_amdgcn_readfirstlane(tid >> 6), lane = tid & 63, wr = wid >> 2, wc = wid & 3, fr = lane & 15, fq = lane >> 4;
    const int K = g.K, nt = K / BK;
    unsigned voffA[2], voffB[2];
#pragma unroll
    for (int i = 0; i < 2; ++i) { int R, C; stage_rc(tid * 16 + i * 8192, R, C); const int Rb = Epi::PERM ? ((R & ~31) + perm32(R & 31)) : R;
        voffA[i] = (unsigned)(R * K + C) * 2u; voffB[i] = (unsigned)(Rb * K + C) * 2u; }
    const size_t kstep = (size_t)(BK * 2);
    const size_t hstep = (size_t)HALF * K * 2;
    const size_t tstep = 2 * hstep;
    const unsigned ldsw = (unsigned)wid * 1024u;
    const int aoff = lds_byte(wr * 64 + fr, fq * 8), boff = lds_byte(wc * 32 + fr, fq * 8);
#define PG8_SA(b, h) (((b) * 2 + (h)) * HTB)
#define PG8_SB(b, h) ((4 + (b) * 2 + (h)) * HTB)
#define PG8_STAGE(bufoff, gbase, voff) do { _Pragma("unroll") for (int _i = 0; _i < 2; ++_i) \
        __builtin_amdgcn_global_load_lds((const unsigned*)((const char*)(gbase) + (voff)[_i]), (PG8_LAS unsigned*)(lds + (bufoff) + ldsw + _i * 8192), 16, 0, 0); } while (0)
#define PG8_LDA(dst, b, h) do { _Pragma("unroll") for (int m = 0; m < 4; ++m) _Pragma("unroll") for (int k = 0; k < 2; ++k) dst[m][k] = *(const PG8_LAS bf16x8*)(lds + PG8_SA(b, h) + aoff + m * 2048 + k * 1024); } while (0)
#define PG8_LDB(dst, b, h) do { _Pragma("unroll") for (int n = 0; n < 2; ++n) _Pragma("unroll") for (int k = 0; k < 2; ++k) dst[n][k] = *(const PG8_LAS bf16x8*)(lds + PG8_SB(b, h) + boff + n * 2048 + k * 1024); } while (0)
#define PG8_MMA(ai, bj, At, Bt) do { __builtin_amdgcn_s_setprio(1); _Pragma("unroll") for (int m = 0; m < 4; ++m) _Pragma("unroll") for (int n = 0; n < 2; ++n) _Pragma("unroll") for (int k = 0; k < 2; ++k) \
        acc[ai][bj][m][n] = __builtin_amdgcn_mfma_f32_16x16x32_bf16(Bt[n][k], At[m][k], acc[ai][bj][m][n], 0, 0, 0); __builtin_amdgcn_s_setprio(0); } while (0)
#define PG8_WAIT_V(n) asm volatile("s_waitcnt vmcnt(" #n ")" ::: "memory")
#define PG8_WAIT_L(n) asm volatile("s_waitcnt lgkmcnt(" #n ")" ::: "memory")
#define PG8_BAR __builtin_amdgcn_s_barrier()
#define PG8_SCHED __builtin_amdgcn_sched_barrier(0)
    Unit cur, nxt; int ui = 0;
    if (!S.next(0, cur)) return;
    f32x4 acc[2][2][4][2];
#pragma unroll
    for (int a = 0; a < 2; ++a)
#pragma unroll
        for (int b = 0; b < 2; ++b)
#pragma unroll
            for (int m = 0; m < 4; ++m)
#pragma unroll
                for (int n = 0; n < 2; ++n) acc[a][b][m][n] = (f32x4){0.f, 0.f, 0.f, 0.f};
    bf16x8 At[4][2], B0[2][2], B1[2][2];
    const char* cA = (const char*)g.A + (size_t)cur.pm * tstep; const char* cB = (const char*)g.Bt + (size_t)cur.pn * tstep;
    S.a_ready(cur);
    if constexpr (SP2) {
        PG8_STAGE(PG8_SB(0, 0), cB, voffB); PG8_STAGE(PG8_SB(0, 1), cB + hstep, voffB); PG8_STAGE(PG8_SA(0, 0), cA, voffA); PG8_STAGE(PG8_SA(0, 1), cA + hstep, voffA);
        if (wr == 1) PG8_BAR;
        PG8_WAIT_V(2); PG8_BAR;
        PG8_STAGE(PG8_SB(1, 0), cB + kstep, voffB); PG8_STAGE(PG8_SA(1, 0), cA + kstep, voffA); PG8_STAGE(PG8_SB(1, 1), cB + hstep + kstep, voffB);
        PG8_WAIT_V(6); PG8_BAR;
    } else {
        PG8_STAGE(PG8_SB(0, 0), cB, voffB); PG8_STAGE(PG8_SA(0, 0), cA, voffA); PG8_STAGE(PG8_SB(0, 1), cB + hstep, voffB); PG8_STAGE(PG8_SA(0, 1), cA + hstep, voffA);
        if (wr == 1) PG8_BAR;
        PG8_WAIT_V(4); PG8_BAR;
        PG8_STAGE(PG8_SB(1, 0), cB + kstep, voffB); PG8_STAGE(PG8_SA(1, 0), cA + kstep, voffA); PG8_STAGE(PG8_SB(1, 1), cB + hstep + kstep, voffB);
        PG8_WAIT_V(6); PG8_BAR;
    }
    for (;;) {
        const bool has_next = S.next(ui + 1, nxt);
        const char* nA = has_next ? (const char*)g.A + (size_t)nxt.pm * tstep : cA; const char* nB = has_next ? (const char*)g.Bt + (size_t)nxt.pn * tstep : cB;
        for (int t = 0; t < nt; t += 2) {
            const bool last = (t == nt - 2);
            const char* a1 = cA + (size_t)(t + 1) * kstep;
            const char* a2 = last ? nA : cA + (size_t)(t + 2) * kstep; const char* b2 = last ? nB : cB + (size_t)(t + 2) * kstep;
            const char* a3 = a2 + kstep; const char* b3 = b2 + kstep;
            if (last && has_next) S.a_ready(nxt);
            if constexpr (SP2) {
            PG8_LDB(B0, 0, 0); PG8_LDB(B1, 0, 1); PG8_SCHED; PG8_LDA(At, 0, 0); PG8_STAGE(PG8_SA(1, 1), a1 + hstep, voffA);
            PG8_WAIT_V(8); PG8_WAIT_L(0); PG8_BAR; PG8_MMA(0, 0, At, B0); PG8_MMA(0, 1, At, B1); PG8_BAR; PG8_SCHED;
            PG8_LDA(At, 0, 1); PG8_STAGE(PG8_SB(0, 0), b2, voffB); PG8_STAGE(PG8_SB(0, 1), b2 + hstep, voffB); PG8_STAGE(PG8_SA(0, 0), a2, voffA);
            PG8_WAIT_V(8); PG8_WAIT_L(0); PG8_BAR; PG8_MMA(1, 0, At, B0); PG8_MMA(1, 1, At, B1); PG8_BAR; PG8_SCHED;
            PG8_LDB(B0, 1, 0); PG8_LDB(B1, 1, 1); PG8_SCHED; PG8_LDA(At, 1, 0); PG8_STAGE(PG8_SA(0, 1), a2 + hstep, voffA);
            PG8_WAIT_V(8); PG8_WAIT_L(0); PG8_BAR; PG8_MMA(0, 0, At, B0); PG8_MMA(0, 1, At, B1); PG8_BAR; PG8_SCHED;
            PG8_LDA(At, 1, 1); PG8_STAGE(PG8_SB(1, 0), b3, voffB); PG8_STAGE(PG8_SB(1, 1), b3 + hstep, voffB); PG8_STAGE(PG8_SA(1, 0), a3, voffA);
            PG8_WAIT_V(8); PG8_WAIT_L(0); PG8_BAR; PG8_MMA(1, 0, At, B0); PG8_MMA(1, 1, At, B1); PG8_BAR; PG8_SCHED;
            } else {
            PG8_LDB(B0, 0, 0); PG8_SCHED; PG8_LDA(At, 0, 0); PG8_STAGE(PG8_SA(1, 1), a1 + hstep, voffA);
            PG8_WAIT_L(8); PG8_BAR; PG8_WAIT_L(0); PG8_MMA(0, 0, At, B0); PG8_BAR; PG8_SCHED;
            PG8_LDB(B1, 0, 1); PG8_STAGE(PG8_SB(0, 0), b2, voffB);
            PG8_BAR; PG8_WAIT_L(0); PG8_MMA(0, 1, At, B1); PG8_BAR;
            PG8_LDA(At, 0, 1); PG8_STAGE(PG8_SA(0, 0), a2, voffA);
            PG8_BAR; PG8_WAIT_L(0); PG8_MMA(1, 0, At, B0); PG8_BAR; PG8_SCHED;
            PG8_STAGE(PG8_SB(0, 1), b2 + hstep, voffB);
            PG8_WAIT_V(6); PG8_BAR; PG8_MMA(1, 1, At, B1); PG8_BAR;
            PG8_LDB(B0, 1, 0); PG8_SCHED; PG8_LDA(At, 1, 0); PG8_STAGE(PG8_SA(0, 1), a2 + hstep, voffA);
            PG8_WAIT_L(8); PG8_BAR; PG8_WAIT_L(0); PG8_MMA(0, 0, At, B0); PG8_BAR; PG8_SCHED;
            PG8_LDB(B1, 1, 1); PG8_STAGE(PG8_SB(1, 0), b3, voffB);
            PG8_BAR; PG8_WAIT_L(0); PG8_MMA(0, 1, At, B1); PG8_BAR;
            PG8_LDA(At, 1, 1); PG8_STAGE(PG8_SA(1, 0), a3, voffA);
            PG8_BAR; PG8_WAIT_L(0); PG8_MMA(1, 0, At, B0); PG8_BAR; PG8_SCHED;
            PG8_STAGE(PG8_SB(1, 1), b3 + hstep, voffB);
            PG8_WAIT_V(6); PG8_BAR; PG8_MMA(1, 1, At, B1); PG8_BAR;
            }
        }
        if constexpr (ALIGN_EPI) { if (wr == 0) PG8_BAR; }
        if constexpr (!Epi::AFTER_DRAIN) { E(acc, cur, wr, wc, fr, fq); S.done(cur); }
        if (!has_next) break;
#pragma unroll
        for (int a = 0; a < 2; ++a)
#pragma unroll
            for (int b = 0; b < 2; ++b)
#pragma unroll
                for (int m = 0; m < 4; ++m)
#pragma unroll
                    for (int n = 0; n < 2; ++n) acc[a][b][m][n] = (f32x4){0.f, 0.f, 0.f, 0.f};
        cur = nxt; cA = nA; cB = nB; ++ui;
        if constexpr (ALIGN_EPI) { if (wr == 1) PG8_BAR; }
    }
    PG8_WAIT_V(0);
    if constexpr (!ALIGN_EPI) { if (wr == 0) PG8_BAR; }
    PG8_BAR;
    if constexpr (Epi::AFTER_DRAIN) { E.fused(acc, cur, wr, wc, fr, fq, lds, wid, lane); S.done(cur); }
#undef PG8_SA
#undef PG8_SB
#undef PG8_STAGE
#undef PG8_LDA
#undef PG8_LDB
#undef PG8_MMA
#undef PG8_WAIT_V
#undef PG8_WAIT_L
#undef PG8_BAR
#undef PG8_SCHED
}
}

constexpr int NWAVES = 8, NTHR = 512;
constexpr int DM = 2048, SEQ = 4096, NBP = 2, DEPTH = 4, NBS = 32, TS = 8;
constexpr int MP = NBP * SEQ, MS = NBS * TS, M = MP + MS;
constexpr int MIXW = 1024, GH = 4, GDK = 128, GDV = 256, GRANK = 16;
constexpr int SH = 16, SKV = 2, SHD = 64, WIN = 128;
constexpr int NMEM = 256, XH = 4, XHD = 128, XW = XH * XHD;
constexpr int DFF = 5504, NIN = 13584, NINP = 13824;
constexpr float EPS = 1e-6f;
constexpr int ZC_GQ = 0, ZC_GK = 512, ZC_GV = 1024, ZC_GR = 2048, ZC_SQ = 3072, ZC_SK = 4096, ZC_SV = 4224, ZC_CB = 4352, ZC_CC = 5376, ZC_CH = 6400, ZC_GATE = 7424, ZC_GLR = 13568;
static_assert(ZC_GATE % 256 == 0 && ZC_GLR % 256 == 0 && ZC_GLR + 16 == NIN && NINP % 256 == 0, "z layout");
constexpr size_t O_YP = 0, O_YS = O_YP + (size_t)MP * DM, O_GLAP = O_YS + (size_t)MS * DM, O_GLAS = O_GLAP + (size_t)DEPTH * NBP * GH * GDK * GDV,
                 O_SKP = O_GLAS + (size_t)DEPTH * NBS * GH * GDK * GDV, O_SVP = O_SKP + (size_t)DEPTH * NBP * WIN * SKV * SHD, O_SKS = O_SVP + (size_t)DEPTH * NBP * WIN * SKV * SHD,
                 O_SVS = O_SKS + (size_t)DEPTH * NBS * WIN * SKV * SHD, O_CONVP = O_SVS + (size_t)DEPTH * NBS * WIN * SKV * SHD, O_CONVS = O_CONVP + (size_t)DEPTH * NBP * 2 * MIXW,
                 O_FFNP = O_CONVS + (size_t)DEPTH * NBS * 2 * MIXW, O_FFNS = O_FFNP + (size_t)DEPTH * NBP * 2 * DFF, O_MKP = O_FFNS + (size_t)DEPTH * NBS * 2 * DFF,
                 O_MVP = O_MKP + (size_t)DEPTH * NBP * NMEM * XW, O_END = O_MVP + (size_t)DEPTH * NBP * NMEM * XW;
static_assert(O_END == 43456512, "output size");
enum { I_XP = 0, I_XS, I_SGLA, I_CSK, I_CSV, I_SCONV, I_SFFN, I_CMK, I_CMV, I_MEMP, I_NMIX, I_WIN, I_GUP, I_GB, I_GNORM, I_SINK, I_RELB, I_CONVW, I_WBR, I_WOUT, I_NX, I_WXQ, I_WXK, I_WXV, I_WXO,
       I_NFFN, I_FUP, I_FCW, I_FCB, I_FDN, I_NFIN, N_INPUTS };
static_assert(N_INPUTS == 31, "inputs");

constexpr size_t MiB = 1u << 20;
constexpr size_t al1m(size_t x) { return (x + MiB - 1) / MiB * MiB; }
constexpr size_t WS_CTL = 0, CTL_ZERO_BYTES = 1 * MiB;
constexpr size_t SZ_WIN = (size_t)NINP * DM * 2, SZ_WBR = (size_t)3 * DM * MIXW * 2, SZ_WOUT = (size_t)DM * DM * 2, SZ_WXQ = (size_t)XW * DM * 2, SZ_WXKV = (size_t)2 * XW * DM * 2,
                 SZ_WXO = (size_t)DM * XW * 2, SZ_WUP = (size_t)2 * DFF * DM * 2, SZ_WDN = (size_t)DM * DFF * 2;
constexpr size_t WS_WIN = 2 * MiB, WS_WBR = al1m(WS_WIN + DEPTH * SZ_WIN), WS_WOUT = al1m(WS_WBR + DEPTH * SZ_WBR), WS_WXQ = al1m(WS_WOUT + DEPTH * SZ_WOUT),
                 WS_WXKV = al1m(WS_WXQ + DEPTH * SZ_WXQ), WS_WXO = al1m(WS_WXKV + DEPTH * SZ_WXKV), WS_WUP = al1m(WS_WXO + DEPTH * SZ_WXO), WS_WDN = al1m(WS_WUP + DEPTH * SZ_WUP);
constexpr size_t WS_X = al1m(WS_WDN + DEPTH * SZ_WDN), WS_XB = al1m(WS_X + (size_t)M * DM * 4), WS_SSQ = al1m(WS_XB + (size_t)M * DM * 2), WS_Z = al1m(WS_SSQ + (size_t)M * 32 * 4),
                 WS_BR = al1m(WS_Z + (size_t)M * NINP * 2), WS_MG = al1m(WS_BR + (size_t)3 * M * MIXW * 2), WS_XQ = al1m(WS_MG + (size_t)M * DM * 2), WS_XO = al1m(WS_XQ + (size_t)M * XW * 2),
                 WS_UG = al1m(WS_XO + (size_t)M * XW * 2), WS_ACT = al1m(WS_UG + (size_t)M * 2 * DFF * 2), WS_MEMB = al1m(WS_ACT + (size_t)M * DFF * 2), WS_MEMKV = al1m(WS_MEMB + (size_t)NBP * NMEM * DM * 2),
                 WS_GLAU = al1m(WS_MEMKV + (size_t)DEPTH * NBP * NMEM * 2 * XW * 2), WS_GLAD = al1m(WS_GLAU + (size_t)512 * GDK * GDV * 4), WS_END = al1m(WS_GLAD + (size_t)512 * GDK * 4);
constexpr int CW_TMO = 0, CW_CODE = 1, CW_BAR = 4096;

constexpr int RING_OFF = 0, RING_BYTES = 131072;
constexpr int LDSCTL_OFF = 146944, MISC_OFF = LDSCTL_OFF + 320;
constexpr int LDS_BYTES = 147456;
static_assert(MISC_OFF + 128 <= LDS_BYTES && LDSCTL_OFF >= RING_BYTES, "LDS map");

#define GAS __attribute__((address_space(1)))
#define LAS __attribute__((address_space(3)))
typedef unsigned short bf16;
typedef unsigned v4u __attribute__((ext_vector_type(4)));
typedef unsigned v2u __attribute__((ext_vector_type(2)));
typedef float f32x4 __attribute__((ext_vector_type(4)));
typedef float f32x2 __attribute__((ext_vector_type(2)));
typedef GAS unsigned gu32;
#define RLX_AGENT __ATOMIC_RELAXED, __HIP_MEMORY_SCOPE_AGENT
#define LDS_WAIT() asm volatile("s_waitcnt lgkmcnt(0)" ::: "memory")
#define VM_WAIT() asm volatile("s_waitcnt vmcnt(0)" ::: "memory")
__device__ __forceinline__ float bflo(unsigned w) { return __uint_as_float(w << 16); }
__device__ __forceinline__ float bfhi(unsigned w) { return __uint_as_float(w & 0xffff0000u); }
__device__ __forceinline__ float bf1(bf16 h) { return __uint_as_float(((unsigned)h) << 16); }
__device__ __forceinline__ unsigned pk2(float lo, float hi) { return pg8::cvt_pk_bf16(lo, hi); }
__device__ __forceinline__ void unpack8(const v4u w, float (&f)[8]) { f[0] = bflo(w.x); f[1] = bfhi(w.x); f[2] = bflo(w.y); f[3] = bfhi(w.y); f[4] = bflo(w.z); f[5] = bfhi(w.z); f[6] = bflo(w.w); f[7] = bfhi(w.w); }
__device__ __forceinline__ v4u pack8(const float (&f)[8]) { v4u w; w.x = pk2(f[0], f[1]); w.y = pk2(f[2], f[3]); w.z = pk2(f[4], f[5]); w.w = pk2(f[6], f[7]); return w; }
__device__ __forceinline__ float sigm(float v) { return 1.0f / (1.0f + __expf(-v)); }
__device__ __forceinline__ float wave_sum(float v) {
#pragma unroll
    for (int o = 1; o < 64; o <<= 1) v += __shfl_xor(v, o);
    return v;
}
#define XB_TMO      128
#define XB_XCNT(j)  (256  + 64 * (j))
#define XB_XSUB(j)  (1280 + 64 * (j))
#define XB_XGEN(j)  (2304 + 64 * (j))
#define XB_TOP      3328
#define XB_TOPGEN   3392
#define XCD_BAR_WORDS 3456
#define XB_SPIN_CAP (1u << 18)

__device__ __forceinline__ unsigned xb_ld(unsigned* p)              { return __hip_atomic_load(p, __ATOMIC_RELAXED, __HIP_MEMORY_SCOPE_AGENT); }
__device__ __forceinline__ unsigned xb_add(unsigned* p, unsigned v) { return __hip_atomic_fetch_add(p, v, __ATOMIC_RELAXED, __HIP_MEMORY_SCOPE_AGENT); }
__device__ __forceinline__ unsigned xb_xcc_id() { return (unsigned)__builtin_amdgcn_s_getreg((3 << 11) | 20) & 0xFu; }
#define XB_SPIN(cond, bar) do { unsigned _sp = 0; while (cond) { __builtin_amdgcn_s_sleep(1); \
    if ((++_sp & 255u) == 0u) { if (xb_ld(&(bar)[XB_TMO])) break; if (_sp > XB_SPIN_CAP) { atomicAdd(&(bar)[XB_TMO], 1u); break; } } } } while (0)

struct XcdBarrier {
    unsigned* bar; unsigned x; unsigned wv;
    volatile LAS unsigned* st;
};

__device__ __forceinline__ unsigned xb_lane() { return __builtin_amdgcn_mbcnt_hi(~0u, __builtin_amdgcn_mbcnt_lo(~0u, 0u)); }
__device__ __forceinline__ XcdBarrier xcd_barrier_post(unsigned* bar, volatile LAS unsigned* st, unsigned wv) {
    XcdBarrier b; b.bar = bar; b.x = xb_xcc_id(); b.st = st; b.wv = wv;
    if (wv == 0u && xb_lane() == 0u) (void)xb_add(&bar[XB_XCNT(b.x)], 1u);
    return b;
}
__device__ __forceinline__ void xcd_barrier_complete(unsigned* bar, unsigned x, unsigned& nloc, unsigned& nx) {
    const unsigned G = gridDim.x * gridDim.y * gridDim.z;
    unsigned sum, cnt, mine, sp = 0u;
    for (;;) {
        sum = 0u; cnt = 0u; mine = 0u;
#pragma unroll
        for (unsigned j = 0; j < 16; ++j) { const unsigned c = xb_ld(&bar[XB_XCNT(j)]); sum += c; cnt += (c > 0u) ? 1u : 0u; mine = (j == x) ? c : mine; }
        if (sum == G) break;
        __builtin_amdgcn_s_sleep(1);
        if ((++sp & 255u) == 0u) { if (xb_ld(&bar[XB_TMO])) break; if (sp > XB_SPIN_CAP) { atomicAdd(&bar[XB_TMO], 1u); break; } }
    }
    nloc = mine > 0u ? mine : 1u; nx = cnt > 0u ? cnt : 1u;
}

__device__ __forceinline__ void xcd_barrier(const XcdBarrier& b) {
    asm volatile("s_waitcnt vmcnt(0)" ::: "memory");
    __syncthreads();
    if (b.wv == 0u && xb_lane() == 0u) {
        unsigned* bar = b.bar;
        __builtin_amdgcn_s_waitcnt(0);
        unsigned nloc = b.st[0], nx = b.st[1];
        if (nloc == 0u) { xcd_barrier_complete(bar, b.x, nloc, nx); b.st[0] = nloc; b.st[1] = nx; }
        const unsigned old = xb_add(&bar[XB_XSUB(b.x)], 1u);
        const unsigned gen = old / nloc;
        if (old + 1u == (gen + 1u) * nloc) {
            __builtin_amdgcn_fence(__ATOMIC_RELEASE, "agent");
            asm volatile("s_waitcnt vmcnt(0)" ::: "memory");
            const unsigned og = xb_add(&bar[XB_TOP], 1u);
            const unsigned tg = og / nx;
            if (og + 1u == (tg + 1u) * nx) xb_add(&bar[XB_TOPGEN], 1u);
            else XB_SPIN(xb_ld(&bar[XB_TOPGEN]) == tg, bar);
            __builtin_amdgcn_fence(__ATOMIC_ACQUIRE, "agent");
            xb_add(&bar[XB_XGEN(b.x)], 1u);
            asm volatile("s_waitcnt vmcnt(0)" ::: "memory");
        } else {
            XB_SPIN(xb_ld(&bar[XB_XGEN(b.x)]) == gen, bar);
            __builtin_amdgcn_fence(__ATOMIC_ACQUIRE, "agent");
            asm volatile("s_waitcnt vmcnt(0)" ::: "memory");
        }
    }
    __syncthreads();
}

struct Args { const float* in[N_INPUTS]; float* out; unsigned char* ws; int ph_lo, ph_hi; };
static_assert(sizeof(Args) == N_INPUTS * 8 + 8 + 8 + 8, "Args has no padding");


constexpr int KA_OUT = 8 * N_INPUTS, KA_WS = KA_OUT + 8, KA_LO = KA_WS + 8, KA_HI = KA_LO + 4;
template <int OFF> __device__ __forceinline__ unsigned long long karg64() {
    unsigned long long v; auto kp = __builtin_amdgcn_kernarg_segment_ptr();
    asm volatile("s_load_dwordx2 %0, %1, %2\n\ts_waitcnt lgkmcnt(0)" : "=s"(v) : "s"(kp), "n"(OFF) : "memory"); return v;
}
template <int OFF> __device__ __forceinline__ int karg32() {
    int v; auto kp = __builtin_amdgcn_kernarg_segment_ptr();
    asm volatile("s_load_dword %0, %1, %2\n\ts_waitcnt lgkmcnt(0)" : "=s"(v) : "s"(kp), "n"(OFF) : "memory"); return v;
}
struct Frame {
    LAS unsigned char* lds;
    volatile LAS unsigned* MISC;
    gu32* ctl;
    int tid, lane, wave, vcu, G;
};

__device__ __forceinline__ int lane_id() { int l; asm volatile("v_mbcnt_lo_u32_b32 %0, -1, 0\n\tv_mbcnt_hi_u32_b32 %0, -1, %0" : "=v"(l)); return l; }
__device__ __forceinline__ int launder_s(int v) { asm volatile("" : "+s"(v)); return v; }
#define LAUNDER(F) do { asm volatile("" : "+s"((F).wave), "+s"((F).vcu), "+s"((F).G)); (F).lane = lane_id(); asm volatile("" : "+v"((F).lane)); (F).tid = (F).wave * 64 + (F).lane; } while (0)
__device__ __forceinline__ void tr_item(const float* W, int K, int Nsrc, bf16* WT, int dstrow0, int k0, int srccol, float cscale, const float* gain, LAS float* scr, int lane) {
    const int q = lane & 15, kq = lane >> 4;
    f32x4 v[16];
#pragma unroll
    for (int i = 0; i < 16; ++i) { v[i] = (f32x4){0.f, 0.f, 0.f, 0.f}; if (srccol >= 0) v[i] = *(const f32x4*)(W + (size_t)(k0 + 4 * i + kq) * Nsrc + srccol); }
#pragma unroll
    for (int i = 0; i < 16; ++i) { const int kk = 4 * i + kq; const float s = gain ? gain[k0 + kk] * cscale : cscale; LAS float* d = scr + kk * 65 + 4 * q;
        d[0] = v[i][0] * s; d[1] = v[i][1] * s; d[2] = v[i][2] * s; d[3] = v[i][3] * s; }
    LDS_WAIT(); asm volatile("" ::: "memory");
    const int c = lane & 7;
#pragma unroll
    for (int j = 0; j < 8; ++j) { const int n = (lane >> 3) + 8 * j; const LAS float* s = scr + (8 * c) * 65 + n;
        v4u o; o.x = pk2(s[0 * 65], s[1 * 65]); o.y = pk2(s[2 * 65], s[3 * 65]); o.z = pk2(s[4 * 65], s[5 * 65]); o.w = pk2(s[6 * 65], s[7 * 65]);
        *(v4u*)(WT + (size_t)(dstrow0 + n) * K + k0 + 8 * c) = o; }
    LDS_WAIT(); asm volatile("" ::: "memory");
}
__device__ __forceinline__ void tr_plain(const float* W, int K, int N, bf16* WT, int dst_off, int r, float cscale, const float* gain, LAS float* scr, int lane) {
    const int nblk = N / 64, kb = r / nblk, nb = r % nblk;
    tr_item(W, K, N, WT, dst_off + 64 * nb, 64 * kb, 64 * nb + 4 * (lane & 15), cscale, gain, scr, lane);
}
constexpr int IT_IN = (DM / 64) * (NINP / 64), IT_BR = (MIXW / 64) * (DM / 64), IT_OUT = (DM / 64) * (DM / 64), IT_XQ = (DM / 64) * (XW / 64), IT_XO = (XW / 64) * (DM / 64),
              IT_UP = (DM / 64) * (2 * DFF / 64), IT_DN = (DFF / 64) * (DM / 64), IT_LAYER = IT_IN + 3 * IT_BR + IT_OUT + 3 * IT_XQ + IT_XO + IT_UP + IT_DN;
__device__ __forceinline__ void p0_convert(const Args& A, Frame& F0, int l, int part, int nparts, int wk, int nwk, bool rows) {
    unsigned char* const ws_ = (unsigned char*)(GAS unsigned char*)karg64<KA_WS>();
    const float* const in_I_FDN = (const float*)(const GAS float*)karg64<8 * I_FDN>();
    const float* const in_I_FUP = (const float*)(const GAS float*)karg64<8 * I_FUP>();
    const float* const in_I_MEMP = (const float*)(const GAS float*)karg64<8 * I_MEMP>();
    const float* const in_I_NFFN = (const float*)(const GAS float*)karg64<8 * I_NFFN>();
    const float* const in_I_NMIX = (const float*)(const GAS float*)karg64<8 * I_NMIX>();
    const float* const in_I_NX = (const float*)(const GAS float*)karg64<8 * I_NX>();
    const float* const in_I_WBR = (const float*)(const GAS float*)karg64<8 * I_WBR>();
    const float* const in_I_WIN = (const float*)(const GAS float*)karg64<8 * I_WIN>();
    const float* const in_I_WOUT = (const float*)(const GAS float*)karg64<8 * I_WOUT>();
    const float* const in_I_WXK = (const float*)(const GAS float*)karg64<8 * I_WXK>();
    const float* const in_I_WXO = (const float*)(const GAS float*)karg64<8 * I_WXO>();
    const float* const in_I_WXQ = (const float*)(const GAS float*)karg64<8 * I_WXQ>();
    const float* const in_I_WXV = (const float*)(const GAS float*)karg64<8 * I_WXV>();
    const float* const in_I_XP = (const float*)(const GAS float*)karg64<8 * I_XP>();
    const float* const in_I_XS = (const float*)(const GAS float*)karg64<8 * I_XS>();
    Frame F = F0; LAUNDER(F);
    LAS float* scr = (LAS float*)(F.lds + F.wave * 16640);
    const int gw = F.vcu * NWAVES + F.wave, NGW = F.G * NWAVES, lane = F.lane;
    const int it_lo = (int)((long)IT_LAYER * part / nparts), it_hi = (int)((long)IT_LAYER * (part + 1) / nparts);
    if (wk >= 0)
#pragma unroll 1
    for (int it = it_lo + wk * NWAVES + F.wave; it < it_hi; it += nwk * NWAVES) {
        int r = it;
        if (r < IT_IN) {
            const int nblk = NINP / 64, kb = r / nblk, nb = r % nblk, n = 64 * nb + 4 * (lane & 15);
            int src; if (n < 3072) src = n; else if (n < ZC_GLR) src = n + 16; else if (n < NIN) src = 3072 + (n - ZC_GLR); else src = -1;
            const float cs = (n < 512) ? 0.08838834764831845f : ((n >= ZC_SQ && n < ZC_SK) ? 0.125f : 1.0f);
            tr_item(in_I_WIN + (size_t)l * DM * NIN, DM, NIN, ((bf16*)(ws_ + WS_WIN)) + (size_t)l * NINP * DM, 64 * nb, 64 * kb, src, cs, in_I_NMIX + l * DM, scr, lane); continue; }
        r -= IT_IN;
        if (r < 3 * IT_BR) { const int i = r / IT_BR; r %= IT_BR;
            tr_plain(in_I_WBR + ((size_t)l * 3 + i) * MIXW * DM, MIXW, DM, ((bf16*)(ws_ + WS_WBR)) + ((size_t)l * 3 + i) * DM * MIXW, 0, r, 1.0f, nullptr, scr, lane); continue; }
        r -= 3 * IT_BR;
        if (r < IT_OUT) { tr_plain(in_I_WOUT + (size_t)l * DM * DM, DM, DM, ((bf16*)(ws_ + WS_WOUT)) + (size_t)l * DM * DM, 0, r, 1.0f, nullptr, scr, lane); continue; }
        r -= IT_OUT;
        if (r < IT_XQ) { tr_plain(in_I_WXQ + (size_t)l * DM * XW, DM, XW, ((bf16*)(ws_ + WS_WXQ)) + (size_t)l * XW * DM, 0, r, 0.08838834764831845f, in_I_NX + l * DM, scr, lane); continue; }
        r -= IT_XQ;
        if (r < IT_XQ) { tr_plain(in_I_WXK + (size_t)l * DM * XW, DM, XW, ((bf16*)(ws_ + WS_WXKV)) + (size_t)l * 2 * XW * DM, 0, r, 1.0f, nullptr, scr, lane); continue; }
        r -= IT_XQ;
        if (r < IT_XQ) { tr_plain(in_I_WXV + (size_t)l * DM * XW, DM, XW, ((bf16*)(ws_ + WS_WXKV)) + (size_t)l * 2 * XW * DM, XW, r, 1.0f, nullptr, scr, lane); continue; }
        r -= IT_XQ;
        if (r < IT_XO) { tr_plain(in_I_WXO + (size_t)l * XW * DM, XW, DM, ((bf16*)(ws_ + WS_WXO)) + (size_t)l * DM * XW, 0, r, 1.0f, nullptr, scr, lane); continue; }
        r -= IT_XO;
        if (r < IT_UP) { tr_plain(in_I_FUP + (size_t)l * DM * 2 * DFF, DM, 2 * DFF, ((bf16*)(ws_ + WS_WUP)) + (size_t)l * 2 * DFF * DM, 0, r, 1.0f, in_I_NFFN + l * DM, scr, lane); continue; }
        r -= IT_UP;
        tr_plain(in_I_FDN + (size_t)l * DFF * DM, DFF, DM, ((bf16*)(ws_ + WS_WDN)) + (size_t)l * DM * DFF, 0, r, 1.0f, nullptr, scr, lane);
    }
    if (rows)
    for (int m = gw; m < M + NBP * NMEM; m += NGW) {
        if (m < M) {
            const float* src = (m < MP) ? in_I_XP + (size_t)m * DM : in_I_XS + (size_t)(m - MP) * DM;
            float ss = 0.f;
#pragma unroll
            for (int j = 0; j < 8; ++j) { const f32x4 v = *((const f32x4*)src + lane + 64 * j); *((f32x4*)(((float*)(ws_ + WS_X)) + (size_t)m * DM) + lane + 64 * j) = v;
                v2u w; w.x = pk2(v[0], v[1]); w.y = pk2(v[2], v[3]); *((v2u*)(((bf16*)(ws_ + WS_XB)) + (size_t)m * DM) + lane + 64 * j) = w; ss += (v[0] * v[0] + v[1] * v[1]) + (v[2] * v[2] + v[3] * v[3]); }
            ss = wave_sum(ss);
            if (lane < 32) ((float*)(ws_ + WS_SSQ))[(size_t)m * 32 + lane] = (lane == 0) ? ss : 0.f;
        } else {
            const int r = m - M; const float* src = in_I_MEMP + (size_t)r * DM;
#pragma unroll
            for (int j = 0; j < 8; ++j) { const f32x4 v = *((const f32x4*)src + lane + 64 * j); v2u w; w.x = pk2(v[0], v[1]); w.y = pk2(v[2], v[3]); *((v2u*)(((bf16*)(ws_ + WS_MEMB)) + (size_t)r * DM) + lane + 64 * j) = w; }
        }
    }
}

__device__ __forceinline__ int t5_bucket(int n) {
    if (n < 16) return n;
    const float v = logf((float)n / 16.0f) / logf(8.0f) * 16.0f; const int lg = 16 + (int)v; return lg < 31 ? lg : 31;
}
template <int STRIDE, bool PAIR, bool BIAS>
__device__ __forceinline__ void attn_core(const float (&q)[64], LAS const unsigned char* kp, LAS const unsigned char* vp, int nsteps, int jmin, LAS const float* bp, float& m, float& lsum, float (&o)[64]) {
    for (int j = 0; j < nsteps; ++j) {
        LAS const v4u* kr = (LAS const v4u*)(kp + j * STRIDE);
        float s0 = 0.f, s1 = 0.f;
#pragma unroll
        for (int c = 0; c < 8; ++c) { const v4u kk = kr[c];
            s0 += q[8 * c + 0] * bflo(kk.x) + q[8 * c + 2] * bflo(kk.y) + q[8 * c + 4] * bflo(kk.z) + q[8 * c + 6] * bflo(kk.w);
            s1 += q[8 * c + 1] * bfhi(kk.x) + q[8 * c + 3] * bfhi(kk.y) + q[8 * c + 5] * bfhi(kk.z) + q[8 * c + 7] * bfhi(kk.w); }
        float s = s0 + s1;
        if (PAIR) s += __shfl_xor(s, 1);
        if (BIAS) s += bp[-j];
        s = (j >= jmin) ? s : -INFINITY;
        const float mn = fmaxf(m, s), sc = __expf(m - mn), p = __expf(s - mn);
        lsum = lsum * sc + p; m = mn;
        LAS const v4u* vr = (LAS const v4u*)(vp + j * STRIDE);
#pragma unroll
        for (int c = 0; c < 8; ++c) { const v4u vv = vr[c];
            o[8 * c + 0] = o[8 * c + 0] * sc + p * bflo(vv.x); o[8 * c + 1] = o[8 * c + 1] * sc + p * bfhi(vv.x);
            o[8 * c + 2] = o[8 * c + 2] * sc + p * bflo(vv.y); o[8 * c + 3] = o[8 * c + 3] * sc + p * bfhi(vv.y);
            o[8 * c + 4] = o[8 * c + 4] * sc + p * bflo(vv.z); o[8 * c + 5] = o[8 * c + 5] * sc + p * bfhi(vv.z);
            o[8 * c + 6] = o[8 * c + 6] * sc + p * bflo(vv.w); o[8 * c + 7] = o[8 * c + 7] * sc + p * bfhi(vv.w); }
    }
}
__device__ __forceinline__ void load_q64(const bf16* p, float (&q)[64]) {
#pragma unroll
    for (int c = 0; c < 8; ++c) { const v4u w = *((const v4u*)p + c); float f[8]; unpack8(w, f);
#pragma unroll
        for (int i = 0; i < 8; ++i) q[8 * c + i] = f[i]; }
}
__device__ __forceinline__ void store_o64(bf16* p, const float (&o)[64], float inv) {
#pragma unroll
    for (int c = 0; c < 8; ++c) { float f[8];
#pragma unroll
        for (int i = 0; i < 8; ++i) f[i] = o[8 * c + i] * inv;
        *((v4u*)p + c) = pack8(f); }
}

constexpr int SWA_STR = 144, SWA_K = 0, SWA_V = 192 * SWA_STR, SWA_BT = 2 * 192 * SWA_STR, SWA_BTS = 132;
__device__ __forceinline__ void swa_phase(const Args& A, Frame& F0, int l) {
    unsigned char* const ws_ = (unsigned char*)(GAS unsigned char*)karg64<KA_WS>();
    float* const out_ = (float*)(GAS float*)karg64<KA_OUT>();
    const float* const in_I_CSK = (const float*)(const GAS float*)karg64<8 * I_CSK>();
    const float* const in_I_CSV = (const float*)(const GAS float*)karg64<8 * I_CSV>();
    const float* const in_I_RELB = (const float*)(const GAS float*)karg64<8 * I_RELB>();
    const float* const in_I_SINK = (const float*)(const GAS float*)karg64<8 * I_SINK>();
    Frame F = F0; LAUNDER(F);
    LAS unsigned char* Ks = F.lds + SWA_K; LAS unsigned char* Vs = F.lds + SWA_V; LAS float* BT = (LAS float*)(F.lds + SWA_BT);
    for (int i = F.tid; i < SH * 129; i += NTHR) { const int h = i / 129, d = i % 129; BT[h * SWA_BTS + d] = in_I_RELB[t5_bucket(d) * SH + h]; }
    const float* sinks = in_I_SINK + l * SH;
    for (int u = F.vcu; u < 256 + 64; u += F.G) {
        __syncthreads();
        if (u < 256) {
            const int b = u >> 7, kvh = (u >> 6) & 1, qb = u & 63, q0 = qb * 64;
            for (int i = F.tid; i < 192 * 8; i += NTHR) { const int r = i >> 3, c8 = i & 7, pos = q0 - 128 + r; v4u kv = (v4u){0u, 0u, 0u, 0u}, vv = kv;
                if (pos >= 0) { const bf16* zr = ((bf16*)(ws_ + WS_Z)) + (size_t)(b * SEQ + pos) * NINP + kvh * 64 + c8 * 8; kv = *(const v4u*)(zr + ZC_SK); vv = *(const v4u*)(zr + ZC_SV); }
                *(LAS v4u*)(Ks + r * SWA_STR + c8 * 16) = kv; *(LAS v4u*)(Vs + r * SWA_STR + c8 * 16) = vv;
                if (qb == 63 && r >= 64) { float fk[8], fv[8]; unpack8(kv, fk); unpack8(vv, fv); const size_t o = ((((size_t)l * NBP + b) * WIN + (r - 64)) * SKV + kvh) * SHD + c8 * 8;
                    *(f32x4*)(out_ + O_SKP + o) = (f32x4){fk[0], fk[1], fk[2], fk[3]}; *(f32x4*)(out_ + O_SKP + o + 4) = (f32x4){fk[4], fk[5], fk[6], fk[7]};
                    *(f32x4*)(out_ + O_SVP + o) = (f32x4){fv[0], fv[1], fv[2], fv[3]}; *(f32x4*)(out_ + O_SVP + o + 4) = (f32x4){fv[4], fv[5], fv[6], fv[7]}; }
            }
            __syncthreads();
            const int head = kvh * 8 + F.wave, t = q0 + F.lane, row = b * SEQ + t;
            float q[64], o[64]; load_q64(((bf16*)(ws_ + WS_Z)) + (size_t)row * NINP + ZC_SQ + head * 64, q);
#pragma unroll
            for (int i = 0; i < 64; ++i) o[i] = 0.f;
            float m = sinks[head], ls = 1.0f;
            attn_core<SWA_STR, false, true>(q, Ks + F.lane * SWA_STR, Vs + F.lane * SWA_STR, 129, 128 - t, BT + head * SWA_BTS + 128, m, ls, o);
            store_o64(((bf16*)(ws_ + WS_BR)) + (size_t)1 * M * MIXW + (size_t)row * MIXW + head * 64, o, 1.0f / ls);
        } else {
            const int su = u - 256, b = su >> 1, kvh = su & 1;
            for (int i = F.tid; i < 136 * 8; i += NTHR) { const int r = i >> 3, c8 = i & 7; float fk[8], fv[8];
                if (r < 128) { const size_t o = ((((size_t)l * NBS + b) * WIN + r) * SKV + kvh) * SHD + c8 * 8; const f32x4 a0 = *(const f32x4*)(in_I_CSK + o), a1 = *(const f32x4*)(in_I_CSK + o + 4), b0 = *(const f32x4*)(in_I_CSV + o), b1 = *(const f32x4*)(in_I_CSV + o + 4);
#pragma unroll
                    for (int k = 0; k < 4; ++k) { fk[k] = a0[k]; fk[4 + k] = a1[k]; fv[k] = b0[k]; fv[4 + k] = b1[k]; } }
                else { const bf16* zr = ((bf16*)(ws_ + WS_Z)) + (size_t)(MP + b * TS + (r - 128)) * NINP + kvh * 64 + c8 * 8; unpack8(*(const v4u*)(zr + ZC_SK), fk); unpack8(*(const v4u*)(zr + ZC_SV), fv); }
                *(LAS v4u*)(Ks + r * SWA_STR + c8 * 16) = pack8(fk); *(LAS v4u*)(Vs + r * SWA_STR + c8 * 16) = pack8(fv);
                if (r >= 8) { const size_t o = ((((size_t)l * NBS + b) * WIN + (r - 8)) * SKV + kvh) * SHD + c8 * 8;
                    *(f32x4*)(out_ + O_SKS + o) = (f32x4){fk[0], fk[1], fk[2], fk[3]}; *(f32x4*)(out_ + O_SKS + o + 4) = (f32x4){fk[4], fk[5], fk[6], fk[7]};
                    *(f32x4*)(out_ + O_SVS + o) = (f32x4){fv[0], fv[1], fv[2], fv[3]}; *(f32x4*)(out_ + O_SVS + o + 4) = (f32x4){fv[4], fv[5], fv[6], fv[7]}; }
            }
            __syncthreads();
            if (F.wave == 0) {
                const int t = F.lane & 7, head = kvh * 8 + (F.lane >> 3), row = MP + b * TS + t;
                float q[64], o[64]; load_q64(((bf16*)(ws_ + WS_Z)) + (size_t)row * NINP + ZC_SQ + head * 64, q);
#pragma unroll
                for (int i = 0; i < 64; ++i) o[i] = 0.f;
                float m = sinks[head], ls = 1.0f;
                attn_core<SWA_STR, false, true>(q, Ks + t * SWA_STR, Vs + t * SWA_STR, 129, 0, BT + head * SWA_BTS + 128, m, ls, o);
                store_o64(((bf16*)(ws_ + WS_BR)) + (size_t)1 * M * MIXW + (size_t)row * MIXW + head * 64, o, 1.0f / ls);
            }
        }
    }
    __syncthreads();
}

__device__ __forceinline__ void conv_phase(const Args& A, Frame& F0, int l) {
    unsigned char* const ws_ = (unsigned char*)(GAS unsigned char*)karg64<KA_WS>();
    float* const out_ = (float*)(GAS float*)karg64<KA_OUT>();
    const float* const in_I_CONVW = (const float*)(const GAS float*)karg64<8 * I_CONVW>();
    const float* const in_I_SCONV = (const float*)(const GAS float*)karg64<8 * I_SCONV>();
    Frame F = F0; LAUNDER(F);
    const float* cw = in_I_CONVW + (size_t)l * 3 * MIXW; const bf16* Z = (const bf16*)(ws_ + WS_Z); bf16* BRC = (bf16*)(ws_ + WS_BR) + (size_t)2 * M * MIXW;
#pragma unroll 1
    for (int idx = F.vcu * NTHR + F.tid; idx < (M / 8) * (MIXW / 8); idx += F.G * NTHR) {
        const int row0 = (idx >> 7) * 8, c = (idx & 127) * 8; const bool smp = row0 >= MP; const int b = smp ? (row0 - MP) >> 3 : row0 >> 12, t0 = smp ? 0 : (row0 & (SEQ - 1));
        v4u cc[10], ch[10], cbv[8];
#pragma unroll
        for (int k = 0; k < 10; ++k) { cc[k] = (v4u){0u, 0u, 0u, 0u}; ch[k] = cc[k];
            if (k >= 2 || t0 > 0) { const bf16* zr = Z + (size_t)(row0 + k - 2) * NINP + c; cc[k] = *(const v4u*)(zr + ZC_CC); ch[k] = *(const v4u*)(zr + ZC_CH); } }
#pragma unroll
        for (int k = 0; k < 8; ++k) cbv[k] = *(const v4u*)(Z + (size_t)(row0 + k) * NINP + ZC_CB + c);
        float w0[8], w1[8], w2[8];
#pragma unroll
        for (int i = 0; i < 8; ++i) { w0[i] = cw[c + i]; w1[i] = cw[MIXW + c + i]; w2[i] = cw[2 * MIXW + c + i]; }
        float u2[8], u1[8], u0[8];
        { float a[8], d[8]; unpack8(cc[0], a); unpack8(ch[0], d);
#pragma unroll
          for (int i = 0; i < 8; ++i) u2[i] = a[i] * d[i];
          unpack8(cc[1], a); unpack8(ch[1], d);
#pragma unroll
          for (int i = 0; i < 8; ++i) u1[i] = a[i] * d[i]; }
        if (smp) { const float* sp = in_I_SCONV + (((size_t)l * NBS + b) * 2) * MIXW + c; const f32x4 a0 = *(const f32x4*)sp, a1 = *(const f32x4*)(sp + 4), b0 = *(const f32x4*)(sp + MIXW), b1 = *(const f32x4*)(sp + MIXW + 4);
#pragma unroll
            for (int i = 0; i < 4; ++i) { u2[i] = a0[i]; u2[4 + i] = a1[i]; u1[i] = b0[i]; u1[4 + i] = b1[i]; } }
#pragma unroll
        for (int k = 0; k < 8; ++k) { float a[8], d[8], cbf[8], o[8]; unpack8(cc[k + 2], a); unpack8(ch[k + 2], d); unpack8(cbv[k], cbf);
#pragma unroll
            for (int i = 0; i < 8; ++i) { u0[i] = a[i] * d[i]; o[i] = cbf[i] * (w0[i] * u2[i] + w1[i] * u1[i] + w2[i] * u0[i]); }
            *(v4u*)(BRC + (size_t)(row0 + k) * MIXW + c) = pack8(o);
            if (k >= 6 && (smp || t0 == SEQ - 8)) { float* dst = out_ + (smp ? O_CONVS + (((size_t)l * NBS + b) * 2 + (k - 6)) * MIXW : O_CONVP + (((size_t)l * NBP + b) * 2 + (k - 6)) * MIXW) + c;
                *(f32x4*)dst = (f32x4){u0[0], u0[1], u0[2], u0[3]}; *(f32x4*)(dst + 4) = (f32x4){u0[4], u0[5], u0[6], u0[7]}; }
#pragma unroll
            for (int i = 0; i < 8; ++i) { u2[i] = u1[i]; u1[i] = u0[i]; } }
    }
}

__device__ __forceinline__ void gla_stage_wg(const Args& A, Frame& F, int l, int h, LAS float* wgs) {
    const float* const in_I_GB = (const float*)(const GAS float*)karg64<8 * I_GB>();
    const float* const in_I_GUP = (const float*)(const GAS float*)karg64<8 * I_GUP>();
    for (int i = F.tid; i < 16 * 128; i += NTHR) wgs[i] = in_I_GUP[(size_t)l * GRANK * 512 + (i >> 7) * 512 + h * 128 + (i & 127)];
    if (F.tid < 128) wgs[2048 + F.tid] = in_I_GB[l * 512 + h * 128 + F.tid];
}
__device__ __forceinline__ float gla_lg(const float (&gl)[16], LAS const float* wgs, int d) {
    float zg = wgs[2048 + d];
#pragma unroll
    for (int r = 0; r < 16; ++r) zg += gl[r] * wgs[r * 128 + d];
    return (fminf(zg, 0.f) - log1pf(__expf(-fabsf(zg)))) * (1.0f / 16.0f);
}
__device__ __forceinline__ void load_glr(const bf16* zr, float (&gl)[16]) {
    float a[8], b[8]; unpack8(*(const v4u*)zr, a); unpack8(*(const v4u*)(zr + 8), b);
#pragma unroll
    for (int i = 0; i < 8; ++i) { gl[i] = a[i]; gl[8 + i] = b[i]; }
}
__device__ __forceinline__ void gla_chunk_b(const Args& A, Frame& F, int l, int row0, int h, LAS float* bl, LAS float* wgs) {
    unsigned char* const ws_ = (unsigned char*)(GAS unsigned char*)karg64<KA_WS>();
    gla_stage_wg(A, F, l, h, wgs);
    __syncthreads();
    { const int t = F.tid >> 3, dg = F.tid & 7; float gl[16]; load_glr(((bf16*)(ws_ + WS_Z)) + (size_t)(row0 + t) * NINP + ZC_GLR, gl);
#pragma unroll 4
      for (int dd = 0; dd < 16; ++dd) { const int d = dg * 16 + dd; bl[t * 128 + d] = gla_lg(gl, wgs, d); } }
    __syncthreads();
    if (F.tid < 128) { float a = 0.f; for (int t = 0; t < 64; ++t) { a += bl[t * 128 + F.tid]; bl[t * 128 + F.tid] = a; } }
    __syncthreads();
}

typedef short bf16x8 __attribute__((ext_vector_type(8)));
typedef short v4i16_t __attribute__((ext_vector_type(4)));
#define MFMA16(a, b, c) __builtin_amdgcn_mfma_f32_16x16x32_bf16((a), (b), (c), 0, 0, 0)
__device__ __forceinline__ bf16x8 frag_row(LAS const unsigned char* T, int stride, int r0, int k0, int lane) {
    return *(LAS const bf16x8*)(T + (r0 + (lane & 15)) * stride + (k0 + 8 * (lane >> 4)) * 2);
}
__device__ __forceinline__ bf16x8 frag_tr(LAS const unsigned char* T, int stride, int rlo, int rhi, int n0, int lane) {
    const int q = (lane & 15) >> 2, p = lane & 3;
    const v4i16_t lo = __builtin_amdgcn_ds_read_tr16_b64_v4i16((LAS v4i16_t*)(T + (rlo + q) * stride + n0 * 2 + 8 * p));
    const v4i16_t hi = __builtin_amdgcn_ds_read_tr16_b64_v4i16((LAS v4i16_t*)(T + (rhi + q) * stride + n0 * 2 + 8 * p));
    return (bf16x8){lo[0], lo[1], lo[2], lo[3], hi[0], hi[1], hi[2], hi[3]};
}
__device__ __forceinline__ bf16x8 pack_p(const f32x4 a, const f32x4 b) {
    v4u w; w.x = pk2(a[0], a[1]); w.y = pk2(a[2], a[3]); w.z = pk2(b[0], b[1]); w.w = pk2(b[2], b[3]); return __builtin_bit_cast(bf16x8, w);
}

constexpr int SW_STR = 160, SW_ROWS = 208, SW_K = 0, SW_V = SW_ROWS * SW_STR, SW_BT = 2 * SW_ROWS * SW_STR;
__device__ __forceinline__ void swa_tile(LAS const unsigned char* Ks, LAS const unsigned char* Vs, LAS const float* bt, float sink, const bf16* qrow, bf16* orow, int krow0, int kmin, bool store, int lane) {
    const int n = lane & 15, g = lane >> 4;
    bf16x8 qf[2];
#pragma unroll
    for (int ks = 0; ks < 2; ++ks) qf[ks] = *(const bf16x8*)(qrow + 32 * ks + 8 * g);
    f32x4 s[10];
#pragma unroll
    for (int mt = 0; mt < 10; ++mt) { s[mt] = (f32x4){0.f, 0.f, 0.f, 0.f};
#pragma unroll
        for (int ks = 0; ks < 2; ++ks) s[mt] = MFMA16(frag_row(Ks, SW_STR, krow0 + 16 * mt, 32 * ks, lane), qf[ks], s[mt]); }
    float mx = sink;
#pragma unroll
    for (int mt = 0; mt < 10; ++mt)
#pragma unroll
        for (int i = 0; i < 4; ++i) { const int kcol = 16 * mt + 4 * g + i, dist = n + 128 - kcol; const bool valid = (dist >= 0) && (dist <= 128) && (kcol >= kmin);
            const int di = dist < 0 ? 0 : (dist > 128 ? 128 : dist); const float v = valid ? s[mt][i] + bt[di] : -INFINITY; s[mt][i] = v; mx = fmaxf(mx, v); }
    mx = fmaxf(mx, __shfl_xor(mx, 16)); mx = fmaxf(mx, __shfl_xor(mx, 32));
    float sum = 0.f;
#pragma unroll
    for (int mt = 0; mt < 10; ++mt)
#pragma unroll
        for (int i = 0; i < 4; ++i) { const float p = __expf(s[mt][i] - mx); s[mt][i] = p; sum += p; }
    sum += __shfl_xor(sum, 16); sum += __shfl_xor(sum, 32);
    const float inv = 1.0f / (sum + __expf(sink - mx));
    f32x4 o[4];
#pragma unroll
    for (int mt = 0; mt < 4; ++mt) o[mt] = (f32x4){0.f, 0.f, 0.f, 0.f};
#pragma unroll
    for (int k2 = 0; k2 < 5; ++k2) { const bf16x8 pf = pack_p(s[2 * k2], s[2 * k2 + 1]);
#pragma unroll
        for (int mt = 0; mt < 4; ++mt) o[mt] = MFMA16(frag_tr(Vs, SW_STR, krow0 + 32 * k2 + 4 * g, krow0 + 32 * k2 + 16 + 4 * g, 16 * mt, lane), pf, o[mt]); }
    if (store) {
#pragma unroll
        for (int mt = 0; mt < 4; ++mt) { v2u w; w.x = pk2(o[mt][0] * inv, o[mt][1] * inv); w.y = pk2(o[mt][2] * inv, o[mt][3] * inv); *(v2u*)(orow + 16 * mt + 4 * g) = w; } }
}
__device__ __forceinline__ void swa_phase_mfma(const Args& A, Frame& F0, int l) {
    unsigned char* const ws_ = (unsigned char*)(GAS unsigned char*)karg64<KA_WS>();
    float* const out_ = (float*)(GAS float*)karg64<KA_OUT>();
    const float* const in_I_CSK = (const float*)(const GAS float*)karg64<8 * I_CSK>();
    const float* const in_I_CSV = (const float*)(const GAS float*)karg64<8 * I_CSV>();
    const float* const in_I_RELB = (const float*)(const GAS float*)karg64<8 * I_RELB>();
    const float* const in_I_SINK = (const float*)(const GAS float*)karg64<8 * I_SINK>();
    Frame F = F0; LAUNDER(F);
    LAS unsigned char* Ks = F.lds + SW_K; LAS unsigned char* Vs = F.lds + SW_V; LAS float* BT = (LAS float*)(F.lds + SW_BT);
    const bf16* Z = (const bf16*)(ws_ + WS_Z); bf16* BRB = (bf16*)(ws_ + WS_BR) + (size_t)M * MIXW;
    for (int i = F.tid; i < SH * 129; i += NTHR) { const int h = i / 129, d = i % 129; BT[h * SWA_BTS + d] = in_I_RELB[t5_bucket(d) * SH + h]; }
    const float* sinks = in_I_SINK + l * SH;
#pragma unroll 1
    for (int u = F.vcu; u < 256 + 64; u += F.G) {
        asm volatile("" : "+v"(F.tid), "+v"(F.lane));
        __syncthreads();
        if (u < 256) {
            const int b = u >> 7, kvh = (u >> 6) & 1, qb = u & 63, q0 = qb * 64;
            for (int i = F.tid; i < SW_ROWS * 8; i += NTHR) { const int r = i >> 3, c8 = i & 7, pos = q0 - 128 + r; v4u kv = (v4u){0u, 0u, 0u, 0u}, vv = kv;
                if (pos >= 0 && pos < SEQ) { const bf16* zr = Z + (size_t)(b * SEQ + pos) * NINP + kvh * 64 + c8 * 8; kv = *(const v4u*)(zr + ZC_SK); vv = *(const v4u*)(zr + ZC_SV); }
                *(LAS v4u*)(Ks + r * SW_STR + c8 * 16) = kv; *(LAS v4u*)(Vs + r * SW_STR + c8 * 16) = vv;
                if (qb == 63 && r >= 64 && r < 192) { float fk[8], fv[8]; unpack8(kv, fk); unpack8(vv, fv); const size_t o = ((((size_t)l * NBP + b) * WIN + (r - 64)) * SKV + kvh) * SHD + c8 * 8;
                    *(f32x4*)(out_ + O_SKP + o) = (f32x4){fk[0], fk[1], fk[2], fk[3]}; *(f32x4*)(out_ + O_SKP + o + 4) = (f32x4){fk[4], fk[5], fk[6], fk[7]};
                    *(f32x4*)(out_ + O_SVP + o) = (f32x4){fv[0], fv[1], fv[2], fv[3]}; *(f32x4*)(out_ + O_SVP + o + 4) = (f32x4){fv[4], fv[5], fv[6], fv[7]}; }
            }
            __syncthreads();
            const int head = kvh * 8 + F.wave; const float sink = sinks[head];
#pragma unroll 1
            for (int mq = 0; mq < 4; ++mq) {
                int ln = F.lane; asm volatile("" : "+v"(ln));
                const int t0 = q0 + 16 * mq; const size_t row = (size_t)b * SEQ + t0 + (ln & 15);
                swa_tile(Ks, Vs, BT + head * SWA_BTS, sink, Z + row * NINP + ZC_SQ + head * 64, BRB + row * MIXW + head * 64, 16 * mq, 128 - t0, true, ln);
            }
        } else {
            const int su = u - 256, b = su >> 1, kvh = su & 1;
            for (int i = F.tid; i < 160 * 8; i += NTHR) { const int r = i >> 3, c8 = i & 7; float fk[8], fv[8];
                if (r < 128) { const size_t o = ((((size_t)l * NBS + b) * WIN + r) * SKV + kvh) * SHD + c8 * 8; const f32x4 a0 = *(const f32x4*)(in_I_CSK + o), a1 = *(const f32x4*)(in_I_CSK + o + 4), b0 = *(const f32x4*)(in_I_CSV + o), b1 = *(const f32x4*)(in_I_CSV + o + 4);
#pragma unroll
                    for (int k = 0; k < 4; ++k) { fk[k] = a0[k]; fk[4 + k] = a1[k]; fv[k] = b0[k]; fv[4 + k] = b1[k]; } }
                else if (r < 136) { const bf16* zr = Z + (size_t)(MP + b * TS + (r - 128)) * NINP + kvh * 64 + c8 * 8; unpack8(*(const v4u*)(zr + ZC_SK), fk); unpack8(*(const v4u*)(zr + ZC_SV), fv); }
                else {
#pragma unroll
                    for (int k = 0; k < 8; ++k) { fk[k] = 0.f; fv[k] = 0.f; } }
                *(LAS v4u*)(Ks + r * SW_STR + c8 * 16) = pack8(fk); *(LAS v4u*)(Vs + r * SW_STR + c8 * 16) = pack8(fv);
                if (r >= 8 && r < 136) { const size_t o = ((((size_t)l * NBS + b) * WIN + (r - 8)) * SKV + kvh) * SHD + c8 * 8;
                    *(f32x4*)(out_ + O_SKS + o) = (f32x4){fk[0], fk[1], fk[2], fk[3]}; *(f32x4*)(out_ + O_SKS + o + 4) = (f32x4){fk[4], fk[5], fk[6], fk[7]};
                    *(f32x4*)(out_ + O_SVS + o) = (f32x4){fv[0], fv[1], fv[2], fv[3]}; *(f32x4*)(out_ + O_SVS + o + 4) = (f32x4){fv[4], fv[5], fv[6], fv[7]}; }
            }
            __syncthreads();
            const int head = kvh * 8 + F.wave, n = F.lane & 15; const size_t row = (size_t)MP + b * TS + (n & 7);
            swa_tile(Ks, Vs, BT + head * SWA_BTS, sinks[head], Z + row * NINP + ZC_SQ + head * 64, BRB + row * MIXW + head * 64, 0, 0, n < 8, F.lane);
        }
    }
    __syncthreads();
}

constexpr int XA_STR = 272, XA_K = 0, XA_V = 256 * XA_STR;
__device__ __forceinline__ void xattn_tile(LAS const unsigned char* Ks, LAS const unsigned char* Vs, const bf16* qrow, bf16* orow, bool store, int lane) {
    const int g = lane >> 4;
    bf16x8 qf[4];
#pragma unroll
    for (int ks = 0; ks < 4; ++ks) qf[ks] = *(const bf16x8*)(qrow + 32 * ks + 8 * g);
    f32x4 s[16]; float mx = -INFINITY;
#pragma unroll
    for (int mt = 0; mt < 16; ++mt) { s[mt] = (f32x4){0.f, 0.f, 0.f, 0.f};
#pragma unroll
        for (int ks = 0; ks < 4; ++ks) s[mt] = MFMA16(frag_row(Ks, XA_STR, 16 * mt, 32 * ks, lane), qf[ks], s[mt]);
        mx = fmaxf(mx, fmaxf(fmaxf(s[mt][0], s[mt][1]), fmaxf(s[mt][2], s[mt][3]))); }
    mx = fmaxf(mx, __shfl_xor(mx, 16)); mx = fmaxf(mx, __shfl_xor(mx, 32));
    float sum = 0.f;
#pragma unroll
    for (int mt = 0; mt < 16; ++mt)
#pragma unroll
        for (int i = 0; i < 4; ++i) { const float p = __expf(s[mt][i] - mx); s[mt][i] = p; sum += p; }
    sum += __shfl_xor(sum, 16); sum += __shfl_xor(sum, 32);
    const float inv = 1.0f / sum;
    f32x4 o[8];
#pragma unroll
    for (int mt = 0; mt < 8; ++mt) o[mt] = (f32x4){0.f, 0.f, 0.f, 0.f};
#pragma unroll
    for (int k2 = 0; k2 < 8; ++k2) { const bf16x8 pf = pack_p(s[2 * k2], s[2 * k2 + 1]);
#pragma unroll
        for (int mt = 0; mt < 8; ++mt) o[mt] = MFMA16(frag_tr(Vs, XA_STR, 32 * k2 + 4 * g, 32 * k2 + 16 + 4 * g, 16 * mt, lane), pf, o[mt]); }
    if (store) {
#pragma unroll
        for (int mt = 0; mt < 8; ++mt) { v2u w; w.x = pk2(o[mt][0] * inv, o[mt][1] * inv); w.y = pk2(o[mt][2] * inv, o[mt][3] * inv); *(v2u*)(orow + 16 * mt + 4 * g) = w; } }
}
__device__ __forceinline__ void xattn_phase_mfma(const Args& A, Frame& F0, int l) {
    unsigned char* const ws_ = (unsigned char*)(GAS unsigned char*)karg64<KA_WS>();
    const float* const in_I_CMK = (const float*)(const GAS float*)karg64<8 * I_CMK>();
    const float* const in_I_CMV = (const float*)(const GAS float*)karg64<8 * I_CMV>();
    Frame F = F0; LAUNDER(F);
    LAS unsigned char* Ks = F.lds + XA_K; LAS unsigned char* Vs = F.lds + XA_V;
    const bf16* XQ = (const bf16*)(ws_ + WS_XQ); bf16* XO = (bf16*)(ws_ + WS_XO);
#pragma unroll 1
    for (int u = F.vcu; u < 128 + 128; u += F.G) {
        asm volatile("" : "+v"(F.tid), "+v"(F.lane));
        __syncthreads();
        if (u < 128) {
            const int b = u >> 6, h = (u >> 4) & 3, q0 = (u & 15) * 256;
            for (int i = F.tid; i < 256 * 16; i += NTHR) { const int mrow = i >> 4, c8 = i & 15; const bf16* src = (const bf16*)(ws_ + WS_MEMKV) + ((size_t)l * 512 + b * 256 + mrow) * 1024 + h * 128 + c8 * 8;
                *(LAS v4u*)(Ks + mrow * XA_STR + c8 * 16) = *(const v4u*)src; *(LAS v4u*)(Vs + mrow * XA_STR + c8 * 16) = *(const v4u*)(src + 512); }
            __syncthreads();
#pragma unroll 1
            for (int qt = F.wave; qt < 16; qt += NWAVES) { int ln = F.lane; asm volatile("" : "+v"(ln)); const size_t row = (size_t)b * SEQ + q0 + 16 * qt + (ln & 15);
                xattn_tile(Ks, Vs, XQ + row * XW + h * 128, XO + row * XW + h * 128, true, ln); }
        } else {
            const int su = u - 128, b = su >> 2, h = su & 3;
            for (int i = F.tid; i < 256 * 16; i += NTHR) { const int mrow = i >> 4, c8 = i & 15; const size_t o = (((size_t)l * NBS + b) * NMEM + mrow) * XW + h * 128 + c8 * 8; float fk[8], fv[8];
                const f32x4 a0 = *(const f32x4*)(in_I_CMK + o), a1 = *(const f32x4*)(in_I_CMK + o + 4), b0 = *(const f32x4*)(in_I_CMV + o), b1 = *(const f32x4*)(in_I_CMV + o + 4);
#pragma unroll
                for (int k = 0; k < 4; ++k) { fk[k] = a0[k]; fk[4 + k] = a1[k]; fv[k] = b0[k]; fv[4 + k] = b1[k]; }
                *(LAS v4u*)(Ks + mrow * XA_STR + c8 * 16) = pack8(fk); *(LAS v4u*)(Vs + mrow * XA_STR + c8 * 16) = pack8(fv); }
            __syncthreads();
            if (F.wave == 0) { const int n = F.lane & 15; const size_t row = (size_t)MP + b * TS + (n & 7);
                xattn_tile(Ks, Vs, XQ + row * XW + h * 128, XO + row * XW + h * 128, n < 8, F.lane); }
        }
    }
    __syncthreads();
}

__device__ __forceinline__ void gla_scan16(const bf16* Z, int row0, int lane, int wave, LAS const float* wgs, float (&bb)[16], float (&bend)[16]) {
    float gl[16]; load_glr(Z + (size_t)(row0 + lane) * NINP + ZC_GLR, gl);
#pragma unroll
    for (int dd = 0; dd < 16; ++dd) { float x = gla_lg(gl, wgs, 16 * wave + dd);
#pragma unroll
        for (int off = 1; off < 64; off <<= 1) { const float y = __shfl_up(x, off); if (lane >= off) x += y; }
        bb[dd] = x; bend[dd] = __shfl(x, 63); }
}
__device__ __forceinline__ void load16(const bf16* p, float (&f)[16]) {
    float a[8], b[8]; unpack8(*(const v4u*)p, a); unpack8(*(const v4u*)(p + 8), b);
#pragma unroll
    for (int i = 0; i < 8; ++i) { f[i] = a[i]; f[8 + i] = b[i]; }
}
__device__ __forceinline__ void store16_lds(LAS unsigned char* p, const float (&f)[16]) {
    v4u w0, w1; w0.x = pk2(f[0], f[1]); w0.y = pk2(f[2], f[3]); w0.z = pk2(f[4], f[5]); w0.w = pk2(f[6], f[7]); w1.x = pk2(f[8], f[9]); w1.y = pk2(f[10], f[11]); w1.z = pk2(f[12], f[13]); w1.w = pk2(f[14], f[15]);
    *(LAS v4u*)p = w0; *(LAS v4u*)(p + 16) = w1;
}
constexpr int G1_KSTR = 288, G1_VSTR = 544, G1_WGS = 0, G1_KT = 9216, G1_V = G1_KT + 64 * G1_KSTR;
__device__ __forceinline__ void gla_pass1_prompt_mfma(const Args& A, Frame& F, int l, int u) {
    unsigned char* const ws_ = (unsigned char*)(GAS unsigned char*)karg64<KA_WS>();
    LAS float* wgs = (LAS float*)(F.lds + G1_WGS); LAS unsigned char* Kt = F.lds + G1_KT; LAS unsigned char* Vb = F.lds + G1_V;
    const bf16* Z = (const bf16*)(ws_ + WS_Z);
    const int bh = u >> 6, c = u & 63, b = bh >> 2, h = bh & 3, row0 = b * SEQ + c * 64, lane = F.lane, w = F.wave;
    gla_stage_wg(A, F, l, h, wgs);
#pragma unroll 2
    for (int i = F.tid; i < 64 * 32; i += NTHR) { const int t = i >> 5, c8 = i & 31; *(LAS v4u*)(Vb + t * G1_VSTR + c8 * 16) = *(const v4u*)(Z + (size_t)(row0 + t) * NINP + ZC_GV + h * 256 + c8 * 8); }
    __syncthreads();
    { float bb[16], bend[16], k[16]; gla_scan16(Z, row0, lane, w, wgs, bb, bend); load16(Z + (size_t)(row0 + lane) * NINP + ZC_GK + h * 128 + 16 * w, k);
#pragma unroll
      for (int dd = 0; dd < 16; ++dd) k[dd] *= __expf(bend[dd] - bb[dd]);
      store16_lds(Kt + lane * G1_KSTR + 32 * w, k);
      if (lane == 0) {
#pragma unroll
          for (int dd = 0; dd < 16; ++dd) ((float*)(ws_ + WS_GLAD))[(size_t)u * 128 + 16 * w + dd] = __expf(bend[dd]); } }
    __syncthreads();
    const int g = lane >> 4, n = lane & 15;
    bf16x8 af[2];
#pragma unroll
    for (int ks = 0; ks < 2; ++ks) af[ks] = frag_tr(Kt, G1_KSTR, 32 * ks + 8 * g, 32 * ks + 8 * g + 4, 16 * w, lane);
    float* U = (float*)(ws_ + WS_GLAU) + (size_t)u * GDK * GDV;
#pragma unroll 4
    for (int nt = 0; nt < 16; ++nt) { f32x4 acc = (f32x4){0.f, 0.f, 0.f, 0.f};
#pragma unroll
        for (int ks = 0; ks < 2; ++ks) acc = MFMA16(af[ks], frag_tr(Vb, G1_VSTR, 32 * ks + 8 * g, 32 * ks + 8 * g + 4, 16 * nt, lane), acc);
#pragma unroll
        for (int i = 0; i < 4; ++i) U[(size_t)(16 * w + 4 * g + i) * 256 + 16 * nt + n] = acc[i]; }
}
constexpr int G3_QSTR = 272, G3_VSTR = 528, G3_PSTR = 160, G3_QD = 0, G3_KD = 64 * G3_QSTR, G3_V = 2 * 64 * G3_QSTR, G3_S = G3_V + 64 * G3_VSTR, G3_PM = G3_S + 128 * G3_VSTR, G3_END = G3_PM + 64 * G3_PSTR;
static_assert(G3_END <= 146944 && 64 * 260 * 4 <= 128 * G3_VSTR && 8704 <= 64 * G3_PSTR, "pass-3 LDS map");
__device__ __forceinline__ void gla_pass3_mfma(const Args& A, Frame& F0, int l) {
    unsigned char* const ws_ = (unsigned char*)(GAS unsigned char*)karg64<KA_WS>();
    const float* const in_I_GNORM = (const float*)(const GAS float*)karg64<8 * I_GNORM>();
    Frame F = F0; LAUNDER(F);
    LAS unsigned char* Qd = F.lds + G3_QD; LAS unsigned char* Kd = F.lds + G3_KD; LAS unsigned char* Vb = F.lds + G3_V; LAS unsigned char* Sb = F.lds + G3_S; LAS unsigned char* Pm = F.lds + G3_PM;
    LAS float* wgs = (LAS float*)Pm; LAS float* Of = (LAS float*)Sb;
    const bf16* Z = (const bf16*)(ws_ + WS_Z); bf16* BRA = (bf16*)(ws_ + WS_BR);
#pragma unroll 1
    for (int u = F.vcu; u < 512; u += F.G) {
        asm volatile("" : "+v"(F.tid), "+v"(F.lane));
        const int lane = F.lane, w = F.wave, g = lane >> 4, n = lane & 15;
        __syncthreads();
        const int bh = u >> 6, c = u & 63, b = bh >> 2, h = bh & 3, row0 = b * SEQ + c * 64;
        gla_stage_wg(A, F, l, h, wgs);
#pragma unroll 2
        for (int i = F.tid; i < 64 * 32; i += NTHR) { const int t = i >> 5, c8 = i & 31; *(LAS v4u*)(Vb + t * G3_VSTR + c8 * 16) = *(const v4u*)(Z + (size_t)(row0 + t) * NINP + ZC_GV + h * 256 + c8 * 8); }
        { const float* S = (const float*)(ws_ + WS_GLAU) + (size_t)u * GDK * GDV;
#pragma unroll 2
          for (int i = F.tid; i < 128 * 32; i += NTHR) { const int d = i >> 5, c8 = i & 31; const f32x4 s0 = *(const f32x4*)(S + d * 256 + c8 * 8), s1 = *(const f32x4*)(S + d * 256 + c8 * 8 + 4);
              v4u wv; wv.x = pk2(s0[0], s0[1]); wv.y = pk2(s0[2], s0[3]); wv.z = pk2(s1[0], s1[1]); wv.w = pk2(s1[2], s1[3]); *(LAS v4u*)(Sb + d * G3_VSTR + c8 * 16) = wv; } }
        __syncthreads();
        { float bb[16], bend[16], q[16], k[16]; gla_scan16(Z, row0, lane, w, wgs, bb, bend);
          load16(Z + (size_t)(row0 + lane) * NINP + ZC_GQ + h * 128 + 16 * w, q); load16(Z + (size_t)(row0 + lane) * NINP + ZC_GK + h * 128 + 16 * w, k);
#pragma unroll
          for (int dd = 0; dd < 16; ++dd) { q[dd] *= __expf(bb[dd]); k[dd] *= __expf(-bb[dd]); }
          store16_lds(Qd + lane * G3_QSTR + 32 * w, q); store16_lds(Kd + lane * G3_QSTR + 32 * w, k); }
        __syncthreads();
        {
            const int mt = w >> 1;
#pragma unroll
            for (int j = 0; j < 2; ++j) { const int nt = 2 * (w & 1) + j; f32x4 acc = (f32x4){0.f, 0.f, 0.f, 0.f};
#pragma unroll
                for (int ks = 0; ks < 4; ++ks) acc = MFMA16(frag_row(Qd, G3_QSTR, 16 * mt, 32 * ks, lane), frag_row(Kd, G3_QSTR, 16 * nt, 32 * ks, lane), acc);
#pragma unroll
                for (int i = 0; i < 4; ++i) { const int t = 16 * mt + 4 * g + i, s = 16 * nt + n; *(LAS bf16*)(Pm + t * G3_PSTR + s * 2) = (bf16)(pk2((s <= t) ? acc[i] : 0.f, 0.f) & 0xffffu); } }
        }
        __syncthreads();
        f32x4 o[4][2];
#pragma unroll
        for (int mt = 0; mt < 4; ++mt) { o[mt][0] = (f32x4){0.f, 0.f, 0.f, 0.f}; o[mt][1] = (f32x4){0.f, 0.f, 0.f, 0.f}; }
#pragma unroll
        for (int j = 0; j < 2; ++j) { const int nt = 2 * w + j;
#pragma unroll
            for (int ks = 0; ks < 4; ++ks) { const bf16x8 bf = frag_tr(Sb, G3_VSTR, 32 * ks + 8 * g, 32 * ks + 8 * g + 4, 16 * nt, lane);
#pragma unroll
                for (int mt = 0; mt < 4; ++mt) o[mt][j] = MFMA16(frag_row(Qd, G3_QSTR, 16 * mt, 32 * ks, lane), bf, o[mt][j]); }
#pragma unroll
            for (int ks = 0; ks < 2; ++ks) { const bf16x8 bf = frag_tr(Vb, G3_VSTR, 32 * ks + 8 * g, 32 * ks + 8 * g + 4, 16 * nt, lane);
#pragma unroll
                for (int mt = 0; mt < 4; ++mt) o[mt][j] = MFMA16(frag_row(Pm, G3_PSTR, 16 * mt, 32 * ks, lane), bf, o[mt][j]); } }
        __syncthreads();
#pragma unroll
        for (int mt = 0; mt < 4; ++mt)
#pragma unroll
            for (int j = 0; j < 2; ++j)
#pragma unroll
                for (int i = 0; i < 4; ++i) Of[(16 * mt + 4 * g + i) * 260 + 16 * (2 * w + j) + n] = o[mt][j][i];
        __syncthreads();
        {
            const int tb = F.tid >> 5, vb = F.tid & 31; float gn[8];
#pragma unroll
            for (int j = 0; j < 8; ++j) gn[j] = in_I_GNORM[l * GDV + 8 * vb + j];
#pragma unroll
            for (int i = 0; i < 4; ++i) { const int t = 4 * tb + i; const f32x4 o0 = *(LAS const f32x4*)(Of + t * 260 + 8 * vb), o1 = *(LAS const f32x4*)(Of + t * 260 + 8 * vb + 4);
                float ov[8] = {o0[0], o0[1], o0[2], o0[3], o1[0], o1[1], o1[2], o1[3]}; float ss = 0.f;
#pragma unroll
                for (int j = 0; j < 8; ++j) ss += ov[j] * ov[j];
#pragma unroll
                for (int x = 1; x < 32; x <<= 1) ss += __shfl_xor(ss, x);
                const float rs = rsqrtf(ss * (1.0f / 256.0f) + EPS); const int row = row0 + t; float gv[8], r[8]; unpack8(*(const v4u*)(Z + (size_t)row * NINP + ZC_GR + h * 256 + 8 * vb), gv);
#pragma unroll
                for (int j = 0; j < 8; ++j) r[j] = ov[j] * rs * gn[j] * gv[j] * sigm(gv[j]);
                *(v4u*)(BRA + (size_t)row * MIXW + h * 256 + 8 * vb) = pack8(r); }
        }
    }
    __syncthreads();
}
__device__ __forceinline__ void gla_pass1(const Args& A, Frame& F0, int l) {
    unsigned char* const ws_ = (unsigned char*)(GAS unsigned char*)karg64<KA_WS>();
    float* const out_ = (float*)(GAS float*)karg64<KA_OUT>();
    const float* const in_I_GNORM = (const float*)(const GAS float*)karg64<8 * I_GNORM>();
    const float* const in_I_SGLA = (const float*)(const GAS float*)karg64<8 * I_SGLA>();
    Frame F = F0; LAUNDER(F);
    LAS float* bl = (LAS float*)(F.lds); LAS float* kt = (LAS float*)(F.lds + 32768); LAS float* wgs = (LAS float*)(F.lds + 65536);
#pragma unroll 1
    for (int u = F.vcu; u < 512 + 128; u += F.G) {
        asm volatile("" : "+v"(F.tid), "+v"(F.lane));
        __syncthreads();
        if (u < 512) {
            gla_pass1_prompt_mfma(A, F, l, u);
        } else {
            const int su = u - 512, b = su >> 2, h = su & 3, row0 = MP + b * TS;
            LAS float* qs = (LAS float*)(F.lds); LAS float* ks = qs + 1024; LAS float* es = qs + 2048; LAS float* vs = qs + 3072; LAS float* red = qs + 5120;
            gla_stage_wg(A, F, l, h, wgs);
            __syncthreads();
            { const int t = F.tid >> 6, dp = F.tid & 63; float gl[16]; load_glr(((bf16*)(ws_ + WS_Z)) + (size_t)(row0 + t) * NINP + ZC_GLR, gl);
              es[t * 128 + 2 * dp] = __expf(gla_lg(gl, wgs, 2 * dp)); es[t * 128 + 2 * dp + 1] = __expf(gla_lg(gl, wgs, 2 * dp + 1)); }
            for (int i = F.tid; i < 8 * 128; i += NTHR) { const int t = i >> 7, d = i & 127; const bf16* zr = ((bf16*)(ws_ + WS_Z)) + (size_t)(row0 + t) * NINP + h * 128 + d; qs[i] = bf1(zr[ZC_GQ]); ks[i] = bf1(zr[ZC_GK]); }
            for (int i = F.tid; i < 8 * 256; i += NTHR) { const int t = i >> 8, v = i & 255; vs[i] = bf1(((bf16*)(ws_ + WS_Z))[(size_t)(row0 + t) * NINP + ZC_GV + h * 256 + v]); }
            __syncthreads();
            const int v = F.tid & 255, half = F.tid >> 8; const size_t sidx = (((size_t)l * NBS + b) * GH + h) * GDK * GDV;
            const float* S0 = in_I_SGLA + sidx + (size_t)(64 * half) * 256 + v;
            float S[64];
#pragma unroll
            for (int i = 0; i < 64; ++i) S[i] = S0[i * 256];
            for (int t = 0; t < 8; ++t) { const float vv = vs[t * 256 + v]; float part = 0.f;
#pragma unroll
                for (int i = 0; i < 64; ++i) { const int d = 64 * half + i; S[i] = es[t * 128 + d] * S[i] + ks[t * 128 + d] * vv; part += qs[t * 128 + d] * S[i]; }
                red[(t * 2 + half) * 256 + v] = part; }
            float* So = out_ + O_GLAS + sidx + (size_t)(64 * half) * 256 + v;
#pragma unroll
            for (int i = 0; i < 64; ++i) So[i * 256] = S[i];
            __syncthreads();
            { const int t = F.wave, row = row0 + t; float o[4]; float ss = 0.f;
#pragma unroll
              for (int k = 0; k < 4; ++k) { const int vv = F.lane + 64 * k; o[k] = red[(t * 2) * 256 + vv] + red[(t * 2 + 1) * 256 + vv]; ss += o[k] * o[k]; }
              ss = wave_sum(ss); const float rs = rsqrtf(ss * (1.0f / 256.0f) + EPS);
#pragma unroll
              for (int k = 0; k < 4; ++k) { const int vv = F.lane + 64 * k; const float g = bf1(((bf16*)(ws_ + WS_Z))[(size_t)row * NINP + ZC_GR + h * 256 + vv]);
                  ((bf16*)(ws_ + WS_BR))[(size_t)row * MIXW + h * 256 + vv] = (bf16)(pk2(o[k] * rs * in_I_GNORM[l * GDV + vv] * g * sigm(g), 0.f) & 0xffffu); } }
        }
    }
    __syncthreads();
}
__device__ __forceinline__ void gla_pass2(const Args& A, Frame& F0, int l) {
    unsigned char* const ws_ = (unsigned char*)(GAS unsigned char*)karg64<KA_WS>();
    float* const out_ = (float*)(GAS float*)karg64<KA_OUT>();
    Frame F = F0; LAUNDER(F);
    for (int e = F.vcu * NTHR + F.tid; e < 8 * GDK * GDV; e += F.G * NTHR) {
        const int bh = e >> 15, dv = e & 32767, d = dv >> 8;
        float* U = ((float*)(ws_ + WS_GLAU)) + (size_t)bh * 64 * GDK * GDV + dv; const float* D = ((float*)(ws_ + WS_GLAD)) + (size_t)bh * 64 * 128 + d;
        float S = 0.f;
        for (int c0 = 0; c0 < 64; c0 += 8) { float uu[8], dd[8];
#pragma unroll
            for (int k = 0; k < 8; ++k) { uu[k] = U[(size_t)(c0 + k) * GDK * GDV]; dd[k] = D[(c0 + k) * 128]; }
#pragma unroll
            for (int k = 0; k < 8; ++k) { U[(size_t)(c0 + k) * GDK * GDV] = S; S = dd[k] * S + uu[k]; } }
        out_[O_GLAP + ((size_t)l * 8 + bh) * GDK * GDV + dv] = S;
    }
}
__device__ __forceinline__ void gla_pass3(const Args& A, Frame& F0, int l) {
    unsigned char* const ws_ = (unsigned char*)(GAS unsigned char*)karg64<KA_WS>();
    const float* const in_I_GNORM = (const float*)(const GAS float*)karg64<8 * I_GNORM>();
    Frame F = F0; LAUNDER(F);
    LAS float* bl = (LAS float*)(F.lds); LAS float* qdT = (LAS float*)(F.lds + 32768); LAS float* kdT = (LAS float*)(F.lds + 67584); LAS float* Am = (LAS float*)(F.lds + 102400); LAS float* wgs = (LAS float*)(F.lds + 119808);
    for (int u = F.vcu; u < 512; u += F.G) {
        __syncthreads();
        const int bh = u >> 6, c = u & 63, b = bh >> 2, h = bh & 3, row0 = b * SEQ + c * 64;
        gla_chunk_b(A, F, l, row0, h, bl, wgs);
        { const int t = F.tid & 63, dg = F.tid >> 6; const bf16* zr = ((bf16*)(ws_ + WS_Z)) + (size_t)(row0 + t) * NINP + h * 128 + dg * 16; float q[16], k[16];
          { float a[8], bb[8]; unpack8(*(const v4u*)(zr + ZC_GQ), a); unpack8(*(const v4u*)(zr + ZC_GQ + 8), bb);
#pragma unroll
            for (int i = 0; i < 8; ++i) { q[i] = a[i]; q[8 + i] = bb[i]; }
            unpack8(*(const v4u*)(zr + ZC_GK), a); unpack8(*(const v4u*)(zr + ZC_GK + 8), bb);
#pragma unroll
            for (int i = 0; i < 8; ++i) { k[i] = a[i]; k[8 + i] = bb[i]; } }
#pragma unroll
          for (int i = 0; i < 16; ++i) { const int d = dg * 16 + i; const float bb = bl[t * 128 + d]; qdT[d * 68 + t] = q[i] * __expf(bb); kdT[d * 68 + t] = k[i] * __expf(-bb); } }
        __syncthreads();
        const int tb = F.tid >> 5, vb = F.tid & 31;
        {
            float a[4][2];
#pragma unroll
            for (int i = 0; i < 4; ++i) { a[i][0] = 0.f; a[i][1] = 0.f; }
            for (int d = 0; d < 128; ++d) { const f32x4 qq = *(LAS const f32x4*)(qdT + d * 68 + 4 * tb); const f32x2 kk = *(LAS const f32x2*)(kdT + d * 68 + 2 * vb);
#pragma unroll
                for (int i = 0; i < 4; ++i) { a[i][0] += qq[i] * kk[0]; a[i][1] += qq[i] * kk[1]; } }
#pragma unroll
            for (int i = 0; i < 4; ++i)
#pragma unroll
                for (int j = 0; j < 2; ++j) { const int t = 4 * tb + i, s = 2 * vb + j; Am[s * 68 + t] = (s <= t) ? a[i][j] : 0.f; }
        }
        float o[4][8];
#pragma unroll
        for (int i = 0; i < 4; ++i)
#pragma unroll
            for (int j = 0; j < 8; ++j) o[i][j] = 0.f;
        { const float* S = ((float*)(ws_ + WS_GLAU)) + (size_t)u * GDK * GDV + 8 * vb;
          for (int d = 0; d < 128; ++d) { const f32x4 qq = *(LAS const f32x4*)(qdT + d * 68 + 4 * tb); const f32x4 s0 = *(const f32x4*)(S + d * 256), s1 = *(const f32x4*)(S + d * 256 + 4);
#pragma unroll
              for (int i = 0; i < 4; ++i)
#pragma unroll
                  for (int j = 0; j < 4; ++j) { o[i][j] += qq[i] * s0[j]; o[i][4 + j] += qq[i] * s1[j]; } } }
        __syncthreads();
        for (int s = 0; s < 64; ++s) { const f32x4 aa = *(LAS const f32x4*)(Am + s * 68 + 4 * tb); float vv[8]; unpack8(*(const v4u*)(((bf16*)(ws_ + WS_Z)) + (size_t)(row0 + s) * NINP + ZC_GV + h * 256 + 8 * vb), vv);
#pragma unroll
            for (int i = 0; i < 4; ++i)
#pragma unroll
                for (int j = 0; j < 8; ++j) o[i][j] += aa[i] * vv[j]; }
        float gn[8];
#pragma unroll
        for (int j = 0; j < 8; ++j) gn[j] = in_I_GNORM[l * GDV + 8 * vb + j];
#pragma unroll
        for (int i = 0; i < 4; ++i) { float ss = 0.f;
#pragma unroll
            for (int j = 0; j < 8; ++j) ss += o[i][j] * o[i][j];
#pragma unroll
            for (int x = 1; x < 32; x <<= 1) ss += __shfl_xor(ss, x);
            const float rs = rsqrtf(ss * (1.0f / 256.0f) + EPS); const int row = row0 + 4 * tb + i; float g[8], r[8]; unpack8(*(const v4u*)(((bf16*)(ws_ + WS_Z)) + (size_t)row * NINP + ZC_GR + h * 256 + 8 * vb), g);
#pragma unroll
            for (int j = 0; j < 8; ++j) r[j] = o[i][j] * rs * gn[j] * g[j] * sigm(g[j]);
            *(v4u*)(((bf16*)(ws_ + WS_BR)) + (size_t)row * MIXW + h * 256 + 8 * vb) = pack8(r); }
    }
    __syncthreads();
}

__device__ __forceinline__ void xattn_phase(const Args& A, Frame& F0, int l) {
    unsigned char* const ws_ = (unsigned char*)(GAS unsigned char*)karg64<KA_WS>();
    const float* const in_I_CMK = (const float*)(const GAS float*)karg64<8 * I_CMK>();
    const float* const in_I_CMV = (const float*)(const GAS float*)karg64<8 * I_CMV>();
    Frame F = F0; LAUNDER(F);
    LAS unsigned char* Ks = F.lds; LAS unsigned char* Vs = F.lds + 65536;
    for (int u = F.vcu; u < 128 + 128; u += F.G) {
        __syncthreads();
        if (u < 128) {
            const int b = u >> 6, h = (u >> 4) & 3, q0 = (u & 15) * 256;
            for (int i = F.tid; i < 256 * 16; i += NTHR) { const int mrow = i >> 4, c8 = i & 15; const bf16* src = ((bf16*)(ws_ + WS_MEMKV)) + ((size_t)l * 512 + b * 256 + mrow) * 1024 + h * 128 + c8 * 8;
                *(LAS v4u*)(Ks + mrow * 256 + c8 * 16) = *(const v4u*)src; *(LAS v4u*)(Vs + mrow * 256 + c8 * 16) = *(const v4u*)(src + 512); }
            __syncthreads();
            const int qi = F.tid >> 1, half = F.tid & 1, row = b * SEQ + q0 + qi;
            float q[64], o[64]; load_q64(((bf16*)(ws_ + WS_XQ)) + (size_t)row * XW + h * 128 + 64 * half, q);
#pragma unroll
            for (int i = 0; i < 64; ++i) o[i] = 0.f;
            float m = -INFINITY, ls = 0.f;
            attn_core<256, true, false>(q, Ks + half * 128, Vs + half * 128, 256, 0, nullptr, m, ls, o);
            store_o64(((bf16*)(ws_ + WS_XO)) + (size_t)row * XW + h * 128 + 64 * half, o, 1.0f / ls);
        } else {
            const int su = u - 128, b = su >> 2, h = su & 3;
            for (int i = F.tid; i < 256 * 16; i += NTHR) { const int mrow = i >> 4, c8 = i & 15; const size_t o = (((size_t)l * NBS + b) * NMEM + mrow) * XW + h * 128 + c8 * 8; float fk[8], fv[8];
                const f32x4 a0 = *(const f32x4*)(in_I_CMK + o), a1 = *(const f32x4*)(in_I_CMK + o + 4), b0 = *(const f32x4*)(in_I_CMV + o), b1 = *(const f32x4*)(in_I_CMV + o + 4);
#pragma unroll
                for (int k = 0; k < 4; ++k) { fk[k] = a0[k]; fk[4 + k] = a1[k]; fv[k] = b0[k]; fv[4 + k] = b1[k]; }
                *(LAS v4u*)(Ks + mrow * 256 + c8 * 16) = pack8(fk); *(LAS v4u*)(Vs + mrow * 256 + c8 * 16) = pack8(fv); }
            __syncthreads();
            if (F.tid < 16) {
                const int qi = F.tid >> 1, half = F.tid & 1, row = MP + b * TS + qi;
                float q[64], o[64]; load_q64(((bf16*)(ws_ + WS_XQ)) + (size_t)row * XW + h * 128 + 64 * half, q);
#pragma unroll
                for (int i = 0; i < 64; ++i) o[i] = 0.f;
                float m = -INFINITY, ls = 0.f;
                attn_core<256, true, false>(q, Ks + half * 128, Vs + half * 128, 256, 0, nullptr, m, ls, o);
                store_o64(((bf16*)(ws_ + WS_XO)) + (size_t)row * XW + h * 128 + 64 * half, o, 1.0f / ls);
            }
        }
    }
    __syncthreads();
}

__device__ __forceinline__ void ffnact_phase(const Args& A, Frame& F0, int l) {
    unsigned char* const ws_ = (unsigned char*)(GAS unsigned char*)karg64<KA_WS>();
    float* const out_ = (float*)(GAS float*)karg64<KA_OUT>();
    const float* const in_I_FCB = (const float*)(const GAS float*)karg64<8 * I_FCB>();
    const float* const in_I_FCW = (const float*)(const GAS float*)karg64<8 * I_FCW>();
    const float* const in_I_SFFN = (const float*)(const GAS float*)karg64<8 * I_SFFN>();
    Frame F = F0; LAUNDER(F);
    const float* cw = in_I_FCW + (size_t)l * 3 * DFF; const float* cbp = in_I_FCB + (size_t)l * DFF; const bf16* UG = (const bf16*)(ws_ + WS_UG); bf16* ACT = (bf16*)(ws_ + WS_ACT);
    constexpr int NG = DFF / 8;
#pragma unroll 1
    for (int idx = F.vcu * NTHR + F.tid; idx < (M / 8) * NG; idx += F.G * NTHR) {
        const int row0 = (idx / NG) * 8, c = (idx % NG) * 8; const bool smp = row0 >= MP; const int b = smp ? (row0 - MP) >> 3 : row0 >> 12, t0 = smp ? 0 : (row0 & (SEQ - 1));
        v4u gg[10], uu[8];
#pragma unroll
        for (int k = 0; k < 10; ++k) { gg[k] = (v4u){0u, 0u, 0u, 0u}; if (k >= 2 || t0 > 0) gg[k] = *(const v4u*)(UG + (size_t)(row0 + k - 2) * 2 * DFF + DFF + c); }
#pragma unroll
        for (int k = 0; k < 8; ++k) uu[k] = *(const v4u*)(UG + (size_t)(row0 + k) * 2 * DFF + c);
        float w0[8], w1[8], w2[8], cb[8];
#pragma unroll
        for (int i = 0; i < 8; ++i) { w0[i] = cw[c + i]; w1[i] = cw[DFF + c + i]; w2[i] = cw[2 * DFF + c + i]; cb[i] = cbp[c + i]; }
        float g2[8], g1[8], g0[8];
        unpack8(gg[0], g2); unpack8(gg[1], g1);
        if (smp) { const float* sp = in_I_SFFN + (((size_t)l * NBS + b) * 2) * DFF + c; const f32x4 a0 = *(const f32x4*)sp, a1 = *(const f32x4*)(sp + 4), b0 = *(const f32x4*)(sp + DFF), b1 = *(const f32x4*)(sp + DFF + 4);
#pragma unroll
            for (int i = 0; i < 4; ++i) { g2[i] = a0[i]; g2[4 + i] = a1[i]; g1[i] = b0[i]; g1[4 + i] = b1[i]; } }
#pragma unroll
        for (int k = 0; k < 8; ++k) { float uf[8], o[8]; unpack8(gg[k + 2], g0); unpack8(uu[k], uf);
#pragma unroll
            for (int i = 0; i < 8; ++i) { const float gc = w0[i] * g2[i] + w1[i] * g1[i] + w2[i] * g0[i] + cb[i]; o[i] = gc * sigm(gc) * uf[i]; }
            *(v4u*)(ACT + (size_t)(row0 + k) * DFF + c) = pack8(o);
            if (k >= 6 && (smp || t0 == SEQ - 8)) { float* dst = out_ + (smp ? O_FFNS + (((size_t)l * NBS + b) * 2 + (k - 6)) * DFF : O_FFNP + (((size_t)l * NBP + b) * 2 + (k - 6)) * DFF) + c;
                *(f32x4*)dst = (f32x4){g0[0], g0[1], g0[2], g0[3]}; *(f32x4*)(dst + 4) = (f32x4){g0[4], g0[5], g0[6], g0[7]}; }
#pragma unroll
            for (int i = 0; i < 8; ++i) { g2[i] = g1[i]; g1[i] = g0[i]; } }
    }
}

__device__ __forceinline__ void final_phase(const Args& A, Frame& F0) {
    unsigned char* const ws_ = (unsigned char*)(GAS unsigned char*)karg64<KA_WS>();
    float* const out_ = (float*)(GAS float*)karg64<KA_OUT>();
    const float* const in_I_NFIN = (const float*)(const GAS float*)karg64<8 * I_NFIN>();
    Frame F = F0; LAUNDER(F);
    const int gw = F.vcu * NWAVES + F.wave, NGW = F.G * NWAVES, lane = F.lane; const float* g = in_I_NFIN;
    for (int m = gw; m < M; m += NGW) {
        float s = (lane < 32) ? ((float*)(ws_ + WS_SSQ))[(size_t)m * 32 + lane] : 0.f; s = wave_sum(s);
        const float rs = rsqrtf(s * (1.0f / DM) + EPS);
        float* dst = out_ + ((m < MP) ? O_YP + (size_t)m * DM : O_YS + (size_t)(m - MP) * DM);
#pragma unroll
        for (int j = 0; j < 8; ++j) { const f32x4 v = *((const f32x4*)(((float*)(ws_ + WS_X)) + (size_t)m * DM) + lane + 64 * j); const f32x4 gg = *((const f32x4*)g + lane + 64 * j); *((f32x4*)dst + lane + 64 * j) = v * rs * gg; }
    }
}

__device__ __forceinline__ f32x4 sk_tile(const bf16* A, const bf16* Bt, int K, int rb, int cb, LAS float* red, int tid, int lane, int wave) {
    const int n = lane & 15, g = lane >> 4, npairs = K >> 6;
    f32x4 acc[2][4];
#pragma unroll
    for (int mt = 0; mt < 2; ++mt)
#pragma unroll
        for (int nt = 0; nt < 4; ++nt) acc[mt][nt] = (f32x4){0.f, 0.f, 0.f, 0.f};
    const bf16* ap = A + (size_t)(32 * rb + n) * K + 8 * g; const bf16* bp = Bt + (size_t)(64 * cb + n) * K + 8 * g;
#pragma unroll 2
    for (int p = wave; p < npairs; p += NWAVES) {
        bf16x8 af[2][2], bfr[4][2];
#pragma unroll
        for (int ks = 0; ks < 2; ++ks) {
#pragma unroll
            for (int mt = 0; mt < 2; ++mt) af[mt][ks] = *(const bf16x8*)(ap + (size_t)(16 * mt) * K + 64 * p + 32 * ks);
#pragma unroll
            for (int nt = 0; nt < 4; ++nt) bfr[nt][ks] = *(const bf16x8*)(bp + (size_t)(16 * nt) * K + 64 * p + 32 * ks); }
#pragma unroll
        for (int ks = 0; ks < 2; ++ks)
#pragma unroll
            for (int mt = 0; mt < 2; ++mt)
#pragma unroll
                for (int nt = 0; nt < 4; ++nt) acc[mt][nt] = MFMA16(af[mt][ks], bfr[nt][ks], acc[mt][nt]);
    }
    __syncthreads();
#pragma unroll
    for (int mt = 0; mt < 2; ++mt)
#pragma unroll
        for (int nt = 0; nt < 4; ++nt)
#pragma unroll
            for (int i = 0; i < 4; ++i) red[wave * 2048 + (16 * mt + 4 * g + i) * 64 + 16 * nt + n] = acc[mt][nt][i];
    __syncthreads();
    const int r = tid >> 4, cg = tid & 15; f32x4 s = *(LAS const f32x4*)(red + r * 64 + 4 * cg);
#pragma unroll
    for (int w = 1; w < 8; ++w) s += *(LAS const f32x4*)(red + w * 2048 + r * 64 + 4 * cg);
    return s;
}
__device__ __forceinline__ void sk_residual(const bf16* A, const bf16* Bt, int K, Frame& F0) {
    Frame F = F0; LAUNDER(F);
    unsigned char* const ws_ = (unsigned char*)(GAS unsigned char*)karg64<KA_WS>();
    float* X = (float*)(ws_ + WS_X); bf16* XB = (bf16*)(ws_ + WS_XB); float* SSQ = (float*)(ws_ + WS_SSQ);
    LAS float* red = (LAS float*)F.lds;
#pragma unroll 1
    for (int u = F.vcu; u < 256; u += F.G) {
        asm volatile("" : "+v"(F.tid), "+v"(F.lane));
        const int rb = u >> 5, cb = u & 31;
        const f32x4 s = sk_tile(A, Bt, K, rb, cb, red, F.tid, F.lane, F.wave);
        const int row = MP + 32 * rb + (F.tid >> 4), col = 64 * cb + 4 * (F.tid & 15); const size_t off = (size_t)row * DM + col;
        const f32x4 x = *(const f32x4*)(X + off) + s; *(f32x4*)(X + off) = x;
        v2u w; w.x = pk2(x[0], x[1]); w.y = pk2(x[2], x[3]); *(v2u*)(XB + off) = w;
        float ss = (x[0] * x[0] + x[1] * x[1]) + (x[2] * x[2] + x[3] * x[3]);
        ss += __shfl_xor(ss, 1); ss += __shfl_xor(ss, 2); ss += __shfl_xor(ss, 4); ss += __shfl_xor(ss, 8);
        if ((F.tid & 15) == 0) SSQ[(size_t)row * 32 + cb] = ss;
    }
    __syncthreads();
}
__device__ __forceinline__ void sk_branch(Frame& F0, int l) {
    Frame F = F0; LAUNDER(F);
    unsigned char* const ws_ = (unsigned char*)(GAS unsigned char*)karg64<KA_WS>();
    const bf16* BR = (const bf16*)(ws_ + WS_BR); const bf16* Wb = (const bf16*)(ws_ + WS_WBR) + (size_t)l * 3 * DM * MIXW; const bf16* Z = (const bf16*)(ws_ + WS_Z); bf16* MG = (bf16*)(ws_ + WS_MG);
    LAS float* red = (LAS float*)F.lds;
#pragma unroll 1
    for (int u = F.vcu; u < 256; u += F.G) {
        asm volatile("" : "+v"(F.tid), "+v"(F.lane));
        const int rb = u >> 5, cb = u & 31; const int row = MP + 32 * rb + (F.tid >> 4), col = 64 * cb + 4 * (F.tid & 15);
        f32x4 mg = (f32x4){0.f, 0.f, 0.f, 0.f};
#pragma unroll 1
        for (int i = 0; i < 3; ++i) {
            const f32x4 s = sk_tile(BR + (size_t)i * M * MIXW + (size_t)MP * MIXW, Wb + (size_t)i * DM * MIXW, MIXW, rb, cb, red, F.tid, F.lane, F.wave);
            const v2u gw = *(const v2u*)(Z + (size_t)row * NINP + ZC_GATE + i * DM + col);
            mg += s * (f32x4){bflo(gw.x), bfhi(gw.x), bflo(gw.y), bfhi(gw.y)};
        }
        v2u w; w.x = pk2(mg[0], mg[1]); w.y = pk2(mg[2], mg[3]); *(v2u*)(MG + (size_t)row * DM + col) = w;
    }
    __syncthreads();
}

#ifndef PH_MASK
#define PH_MASK 0xffffffffu
#endif
#define PON(i) constexpr ((PH_MASK >> (i)) & 1u) for (int rep_ = 0; rep_ <= (int)((PROBE_MASK >> (i)) & 1u); ++rep_)
#ifndef PROBE_MASK
#define PROBE_MASK 0u
#endif
#ifndef USE_MFMA
#define USE_MFMA 7
#endif
#ifndef MK_PER_PHASE
#define MK_PER_PHASE 0
#endif
constexpr int PH_PER_LAYER = 12, N_PHASES = 1 + DEPTH * PH_PER_LAYER + 1;

__global__ void __launch_bounds__(NTHR, 2) fwd(const Args A) {
    extern __shared__ __attribute__((aligned(16))) unsigned char lds[];
    Frame F;
    F.lds = (LAS unsigned char*)lds;
    F.MISC = (volatile LAS unsigned*)(F.lds + MISC_OFF);
    F.wave = __builtin_amdgcn_readfirstlane((int)threadIdx.x >> 6); F.lane = 0; F.tid = 0;
    F.G = gridDim.x; { const int bx = blockIdx.x; F.vcu = (F.G % 8 == 0) ? (bx % 8) * (F.G / 8) + bx / 8 : bx; }
    F.ctl = (gu32*)(((unsigned char*)(GAS unsigned char*)karg64<KA_WS>()) + WS_CTL);
    for (int u = F.wave * 64 + lane_id(); u < (LDS_BYTES - LDSCTL_OFF) / 4; u += NTHR) ((LAS unsigned*)(F.lds + LDSCTL_OFF))[u] = 0u;
    __syncthreads();
    XcdBarrier bar; bar.bar = (unsigned*)(F.ctl + CW_BAR); bar.x = 0; bar.st = nullptr; bar.wv = (unsigned)F.wave;
    if (!MK_PER_PHASE) bar = xcd_barrier_post((unsigned*)(F.ctl + CW_BAR), F.MISC + 8, (unsigned)F.wave);
    const int lo = karg32<KA_LO>(), hi = karg32<KA_HI>();
#define IN(k) (lo <= (k) && (k) < hi)
#define SEAM(k) do { if (IN(k) && IN((k) + 1)) xcd_barrier(bar); } while (0)
    typedef pg8::StaticOrder SO;
#define BX_ launder_s((int)blockIdx.x)
#define G_ launder_s(F.G)
    LAS unsigned char* ring = F.lds + RING_OFF;

    if (IN(0)) { if PON(0) p0_convert(A, F, 0, 0, 1, F.vcu, G_, true); }
    SEAM(0);
    for (int l = 0; l < DEPTH; ++l) {
        const int pb = 1 + l * PH_PER_LAYER;
        if (IN(pb + 0)) { if PON(2) {
            pg8::Gemm g{((bf16*)(((unsigned char*)(GAS unsigned char*)karg64<KA_WS>()) + WS_XB)), ((bf16*)(((unsigned char*)(GAS unsigned char*)karg64<KA_WS>()) + WS_WIN)) + (size_t)l * NINP * DM, M, NINP, DM}; SO S; S.init(M, NINP, G_, BX_);
            pg8::EpiScaleBf16 E{((bf16*)(((unsigned char*)(GAS unsigned char*)karg64<KA_WS>()) + WS_Z)), NINP, ((float*)(((unsigned char*)(GAS unsigned char*)karg64<KA_WS>()) + WS_SSQ)), ZC_GATE / 256, ZC_GLR / 256};
            pg8::gemm_phase<pg8::EpiScaleBf16, SO, true, true>(ring, g, S, E, F.wave * 64 + lane_id());
            {
                const int bx = BX_, cc = (bx >= 246 && G_ == 256) ? bx - 246 : ((G_ == 256) ? 256 : bx);
                pg8::Gemm g2{((bf16*)(((unsigned char*)(GAS unsigned char*)karg64<KA_WS>()) + WS_MEMB)), ((bf16*)(((unsigned char*)(GAS unsigned char*)karg64<KA_WS>()) + WS_WXKV)) + (size_t)l * 2 * XW * DM, NBP * NMEM, 2 * XW, DM}; SO S2; S2.init(NBP * NMEM, 2 * XW, G_, cc);
                pg8::EpiMemKV E2{((float*)(GAS float*)karg64<KA_OUT>()) + O_MKP + (size_t)l * NBP * NMEM * XW, ((float*)(GAS float*)karg64<KA_OUT>()) + O_MVP + (size_t)l * NBP * NMEM * XW, ((bf16*)(((unsigned char*)(GAS unsigned char*)karg64<KA_WS>()) + WS_MEMKV)) + (size_t)l * NBP * NMEM * 2 * XW};
                pg8::gemm_phase<pg8::EpiMemKV, SO, true, true>(ring, g2, S2, E2, F.wave * 64 + lane_id());
            }
        } }
        SEAM(pb + 0);
        if (IN(pb + 1)) { if PON(3) conv_phase(A, F, l); if PON(4) { if (USE_MFMA & 1) swa_phase_mfma(A, F, l); else swa_phase(A, F, l); } if PON(5) gla_pass1(A, F, l); }
        SEAM(pb + 1);
        if (IN(pb + 2)) { if PON(6) gla_pass2(A, F, l); }
        SEAM(pb + 2);
        if (IN(pb + 3)) { if PON(7) { if (USE_MFMA & 2) gla_pass3_mfma(A, F, l); else gla_pass3(A, F, l); } }
        SEAM(pb + 3);
        if (IN(pb + 4)) { if PON(8) {
            for (int i = 0; i < 3; ++i) {
                pg8::Gemm g{((bf16*)(((unsigned char*)(GAS unsigned char*)karg64<KA_WS>()) + WS_BR)) + (size_t)i * M * MIXW, ((bf16*)(((unsigned char*)(GAS unsigned char*)karg64<KA_WS>()) + WS_WBR)) + ((size_t)l * 3 + i) * DM * MIXW, MP, DM, MIXW}; SO S; S.init(MP, DM, G_, BX_);
                pg8::EpiBranch E{((bf16*)(((unsigned char*)(GAS unsigned char*)karg64<KA_WS>()) + WS_MG)), ((bf16*)(((unsigned char*)(GAS unsigned char*)karg64<KA_WS>()) + WS_Z)) + ZC_GATE + i * DM, NINP, i == 0 ? 1 : 0};
                pg8::gemm_phase<pg8::EpiBranch, SO, true, true>(ring, g, S, E, F.wave * 64 + lane_id());
            }
            sk_branch(F, l);
        } }
        SEAM(pb + 4);
        if (IN(pb + 5)) { if PON(9) {
            pg8::Gemm g{((bf16*)(((unsigned char*)(GAS unsigned char*)karg64<KA_WS>()) + WS_MG)), ((bf16*)(((unsigned char*)(GAS unsigned char*)karg64<KA_WS>()) + WS_WOUT)) + (size_t)l * DM * DM, MP, DM, DM}; SO S; S.init(MP, DM, G_, BX_);
            pg8::EpiResidual E{((float*)(((unsigned char*)(GAS unsigned char*)karg64<KA_WS>()) + WS_X)), ((bf16*)(((unsigned char*)(GAS unsigned char*)karg64<KA_WS>()) + WS_XB)), ((float*)(((unsigned char*)(GAS unsigned char*)karg64<KA_WS>()) + WS_SSQ))};
            pg8::gemm_phase<pg8::EpiResidual, SO, true, true>(ring, g, S, E, F.wave * 64 + lane_id());
            sk_residual(((const bf16*)(((unsigned char*)(GAS unsigned char*)karg64<KA_WS>()) + WS_MG)) + (size_t)MP * DM, ((const bf16*)(((unsigned char*)(GAS unsigned char*)karg64<KA_WS>()) + WS_WOUT)) + (size_t)l * DM * DM, DM, F);
        } }
        SEAM(pb + 5);
        if (IN(pb + 6)) { if PON(10) {
            pg8::Gemm g{((bf16*)(((unsigned char*)(GAS unsigned char*)karg64<KA_WS>()) + WS_XB)), ((bf16*)(((unsigned char*)(GAS unsigned char*)karg64<KA_WS>()) + WS_WXQ)) + (size_t)l * XW * DM, M, XW, DM}; SO S; S.init(M, XW, G_, BX_);
            pg8::EpiScaleBf16 E{((bf16*)(((unsigned char*)(GAS unsigned char*)karg64<KA_WS>()) + WS_XQ)), XW, ((float*)(((unsigned char*)(GAS unsigned char*)karg64<KA_WS>()) + WS_SSQ)), 0, 0};
            pg8::gemm_phase<pg8::EpiScaleBf16, SO, true, true>(ring, g, S, E, F.wave * 64 + lane_id());
            if (l + 1 < DEPTH) { const int bx = BX_; const bool std_ = (G_ == 256); p0_convert(A, F, l + 1, 0, 2, std_ ? ((bx >= 66) ? bx - 66 : -1) : bx, std_ ? 190 : G_, false); }
        } }
        SEAM(pb + 6);
        if (IN(pb + 7)) { if PON(11) { if (USE_MFMA & 4) xattn_phase_mfma(A, F, l); else xattn_phase(A, F, l); } }
        SEAM(pb + 7);
        if (IN(pb + 8)) { if PON(12) {
            pg8::Gemm g{((bf16*)(((unsigned char*)(GAS unsigned char*)karg64<KA_WS>()) + WS_XO)), ((bf16*)(((unsigned char*)(GAS unsigned char*)karg64<KA_WS>()) + WS_WXO)) + (size_t)l * DM * XW, MP, DM, XW}; SO S; S.init(MP, DM, G_, BX_);
            pg8::EpiResidual E{((float*)(((unsigned char*)(GAS unsigned char*)karg64<KA_WS>()) + WS_X)), ((bf16*)(((unsigned char*)(GAS unsigned char*)karg64<KA_WS>()) + WS_XB)), ((float*)(((unsigned char*)(GAS unsigned char*)karg64<KA_WS>()) + WS_SSQ))};
            pg8::gemm_phase<pg8::EpiResidual, SO, true, true>(ring, g, S, E, F.wave * 64 + lane_id());
            sk_residual(((const bf16*)(((unsigned char*)(GAS unsigned char*)karg64<KA_WS>()) + WS_XO)) + (size_t)MP * XW, ((const bf16*)(((unsigned char*)(GAS unsigned char*)karg64<KA_WS>()) + WS_WXO)) + (size_t)l * DM * XW, XW, F);
        } }
        SEAM(pb + 8);
        if (IN(pb + 9)) { if PON(13) {
            pg8::Gemm g{((bf16*)(((unsigned char*)(GAS unsigned char*)karg64<KA_WS>()) + WS_XB)), ((bf16*)(((unsigned char*)(GAS unsigned char*)karg64<KA_WS>()) + WS_WUP)) + (size_t)l * 2 * DFF * DM, M, 2 * DFF, DM}; SO S; S.init(M, 2 * DFF, G_, BX_);
            pg8::EpiScaleBf16 E{((bf16*)(((unsigned char*)(GAS unsigned char*)karg64<KA_WS>()) + WS_UG)), 2 * DFF, ((float*)(((unsigned char*)(GAS unsigned char*)karg64<KA_WS>()) + WS_SSQ)), 0, 0};
            pg8::gemm_phase<pg8::EpiScaleBf16, SO, true, true>(ring, g, S, E, F.wave * 64 + lane_id());
            if (l + 1 < DEPTH) { const int bx = BX_; const bool std_ = (G_ == 256); p0_convert(A, F, l + 1, 1, 2, std_ ? ((bx >= 139) ? bx - 139 : -1) : bx, std_ ? 117 : G_, false); }
        } }
        SEAM(pb + 9);
        if (IN(pb + 10)) { if PON(14) ffnact_phase(A, F, l); }
        SEAM(pb + 10);
        if (IN(pb + 11)) { if PON(15) {
            pg8::Gemm g{((bf16*)(((unsigned char*)(GAS unsigned char*)karg64<KA_WS>()) + WS_ACT)), ((bf16*)(((unsigned char*)(GAS unsigned char*)karg64<KA_WS>()) + WS_WDN)) + (size_t)l * DM * DFF, MP, DM, DFF}; SO S; S.init(MP, DM, G_, BX_);
            pg8::EpiResidual E{((float*)(((unsigned char*)(GAS unsigned char*)karg64<KA_WS>()) + WS_X)), ((bf16*)(((unsigned char*)(GAS unsigned char*)karg64<KA_WS>()) + WS_XB)), ((float*)(((unsigned char*)(GAS unsigned char*)karg64<KA_WS>()) + WS_SSQ))};
            pg8::gemm_phase<pg8::EpiResidual, SO, true, true>(ring, g, S, E, F.wave * 64 + lane_id());
            sk_residual(((const bf16*)(((unsigned char*)(GAS unsigned char*)karg64<KA_WS>()) + WS_ACT)) + (size_t)MP * DFF, ((const bf16*)(((unsigned char*)(GAS unsigned char*)karg64<KA_WS>()) + WS_WDN)) + (size_t)l * DM * DFF, DFF, F);
        } }
        SEAM(pb + 11);
    }
    if (IN(N_PHASES - 1)) { if PON(16) final_phase(A, F); }
#undef IN
#undef SEAM
}

extern "C" void kernel_launch(void* const* d_in, const int* in_sizes, int n_in, void* d_out, int out_size, void* d_ws, size_t ws_size, hipStream_t stream) {
    static int grid = 0;
    if (grid == 0) {
        if (n_in != N_INPUTS || (size_t)out_size != O_END || ws_size < WS_END) { fprintf(stderr, "kernel_launch: built for %d inputs, %zu outputs, >= %zu bytes of workspace; got n_in %d, out %d, ws %zu; nothing launched\n", N_INPUTS, (size_t)O_END, (size_t)WS_END, n_in, out_size, ws_size); grid = -1; return; }
        int dev = 0, cus = 0, per_cu = 0;
        if (hipGetDevice(&dev) != hipSuccess || hipDeviceGetAttribute(&cus, hipDeviceAttributeMultiprocessorCount, dev) != hipSuccess) { fprintf(stderr, "kernel_launch: device query failed\n"); grid = -1; return; }
        if (hipFuncSetAttribute((const void*)fwd, hipFuncAttributeMaxDynamicSharedMemorySize, LDS_BYTES) != hipSuccess) { fprintf(stderr, "kernel_launch: hipFuncSetAttribute failed\n"); grid = -1; return; }
        if (hipOccupancyMaxActiveBlocksPerMultiprocessor(&per_cu, (const void*)fwd, NTHR, LDS_BYTES) != hipSuccess || per_cu < 1) { fprintf(stderr, "kernel_launch: occupancy query reports %d workgroups per CU\n", per_cu); }
        (void)hipGetLastError();
        grid = cus;
    }
    if (grid < 0) return;
    if (hipMemsetAsync((char*)d_ws + WS_CTL, 0, CTL_ZERO_BYTES, stream) != hipSuccess) { fprintf(stderr, "kernel_launch: memset failed\n"); return; }
    Args a{};
    for (int i = 0; i < N_INPUTS; ++i) a.in[i] = (const float*)d_in[i];
    a.out = (float*)d_out; a.ws = (unsigned char*)d_ws;
#if MK_PER_PHASE
    for (int p = 0; p < N_PHASES; ++p) {
        a.ph_lo = p; a.ph_hi = p + 1;
        hipLaunchKernelGGL(fwd, dim3(grid), dim3(NTHR), LDS_BYTES, stream, a);
    }
#else
    a.ph_lo = 0; a.ph_hi = N_PHASES;
    hipLaunchKernelGGL(fwd, dim3(grid), dim3(NTHR), LDS_BYTES, stream, a);
#endif
    const hipError_t le = hipPeekAtLastError();
    if (le != hipSuccess) fprintf(stderr, "kernel_launch: launch failed: %s\n", hipGetErrorName(le));
}
```

```cpp
#include <hip/hip_runtime.h>
#include <cstdio>
#include <cstdint>
#include <cmath>
#define MK_PER_PHASE 0
namespace pg8 {
#define PG8_LAS __attribute__((address_space(3)))
typedef unsigned short bf16_t;
typedef short bf16x8 __attribute__((ext_vector_type(8)));
typedef float f32x4 __attribute__((ext_vector_type(4)));
typedef unsigned u32x4 __attribute__((ext_vector_type(4)));
constexpr int BM = 256, BK = 64, HALF = 128, HTB = HALF * BK * 2  , STAGE_BYTES = 8 * HTB, NXCD = 8, WGM = 8;

__host__ __device__ __forceinline__ int lds_byte(int r, int c) { const int st = (r >> 4) * 2 + (c >> 5), rr = r & 15, cc = c & 31, ob = rr * 64 + cc * 2; return st * 1024 + (ob ^ (((ob >> 9) & 1) << 5)); }
__host__ __device__ __forceinline__ void stage_rc(int b, int& R, int& C) { const int st = b / 1024, sb = b % 1024, swz = sb ^ (((sb >> 9) & 1) << 5); R = (st >> 1) * 16 + swz / 64; C = (st & 1) * 32 + (swz % 64) / 2; }
__host__ __device__ __forceinline__ int perm32(int rho) { const int n = rho >> 4, i = rho & 15; return 8 * (i >> 2) + 4 * n + (i & 3); }

struct Unit { int pm, pn; };
struct Gemm { const bf16_t* A; const bf16_t* Bt; int M, N, K; };

struct StaticOrder {
    int nM, nN, nwg, G, c;
    __host__ __device__ void init(int M, int N, int G_, int c_) { nM = M / BM; nN = N / BM; nwg = nM * nN; G = G_; c = c_; }
    __host__ __device__ bool next(int i, Unit& u) const {
        const long L = (long)i * G + c; if (L >= nwg) return false;
        int wgid = (int)L; { const int q = nwg / NXCD, r = nwg % NXCD, xcd = wgid % NXCD, off = wgid / NXCD; wgid = (xcd < r ? xcd * (q + 1) : r * (q + 1) + (xcd - r) * q) + off; }
        const int nig = WGM * nN, gid = wgid / nig, fm = gid * WGM, gsz = (nM - fm) < WGM ? (nM - fm) : WGM;
        u.pm = fm + ((wgid % nig) % gsz); u.pn = (wgid % nig) / gsz; return true;
    }
    __device__ __forceinline__ void a_ready(const Unit&) const {}
    __device__ __forceinline__ void done(const Unit&) const {}
};

__device__ __forceinline__ unsigned cvt_pk_bf16(float lo, float hi) { unsigned r; asm volatile("v_cvt_pk_bf16_f32 %0, %1, %2" : "=v"(r) : "v"(lo), "v"(hi)); return r; }
typedef float f32x2 __attribute__((ext_vector_type(2)));
#define PG8_GAS __attribute__((address_space(1)))
typedef unsigned u32x2 __attribute__((ext_vector_type(2)));
__device__ __forceinline__ float bf_lo(unsigned w) { return __uint_as_float(w << 16); }
__device__ __forceinline__ float bf_hi(unsigned w) { return __uint_as_float(w & 0xffff0000u); }
__device__ __forceinline__ float sigmoidf_(float v) { return 1.0f / (1.0f + __expf(-v)); }

struct EpiScaleBf16 {
    static constexpr bool PERM = true, AFTER_DRAIN = false;
    bf16_t* O; int ldc; const float* ssq; int sig_lo, sig_hi;
    __device__ __forceinline__ void operator()(const f32x4 (&acc)[2][2][4][2], const Unit& u, int wr, int wc, int fr, int fq) const {
        const int row0 = u.pm * BM + wr * 64 + fr, col0 = u.pn * BM + wc * 32 + 8 * fq;
        const bool sig = (u.pn >= sig_lo) && (u.pn < sig_hi);
        float rs[2][4];
        if (ssq) {
            f32x4 pr[2][4][2];
#pragma unroll
            for (int ai = 0; ai < 2; ++ai)
#pragma unroll
                for (int m = 0; m < 4; ++m) { const PG8_GAS f32x4* p = (const PG8_GAS f32x4*)(ssq + (size_t)(row0 + ai * HALF + m * 16) * 32 + 8 * fq); pr[ai][m][0] = p[0]; pr[ai][m][1] = p[1]; }
#pragma unroll
            for (int ai = 0; ai < 2; ++ai)
#pragma unroll
                for (int m = 0; m < 4; ++m) { const f32x4 s = pr[ai][m][0] + pr[ai][m][1]; float t = (s[0] + s[1]) + (s[2] + s[3]); t += __shfl_xor(t, 16); t += __shfl_xor(t, 32);
                    rs[ai][m] = rsqrtf(t * (1.0f / 2048.0f) + 1e-6f); }
        } else {
#pragma unroll
            for (int ai = 0; ai < 2; ++ai)
#pragma unroll
                for (int m = 0; m < 4; ++m) rs[ai][m] = 1.0f;
        }
#pragma unroll
        for (int ai = 0; ai < 2; ++ai)
#pragma unroll
            for (int m = 0; m < 4; ++m) {
                PG8_GAS bf16_t* rowp = (PG8_GAS bf16_t*)(O + (size_t)(row0 + ai * HALF + m * 16) * ldc + col0);
#pragma unroll
                for (int bj = 0; bj < 2; ++bj) { f32x4 v0 = acc[ai][bj][m][0] * rs[ai][m], v1 = acc[ai][bj][m][1] * rs[ai][m];
                    if (sig) { v0 = (f32x4){sigmoidf_(v0[0]), sigmoidf_(v0[1]), sigmoidf_(v0[2]), sigmoidf_(v0[3])}; v1 = (f32x4){sigmoidf_(v1[0]), sigmoidf_(v1[1]), sigmoidf_(v1[2]), sigmoidf_(v1[3])}; }
                    u32x4 w; w.x = cvt_pk_bf16(v0[0], v0[1]); w.y = cvt_pk_bf16(v0[2], v0[3]); w.z = cvt_pk_bf16(v1[0], v1[1]); w.w = cvt_pk_bf16(v1[2], v1[3]);
                    *(PG8_GAS u32x4*)(rowp + bj * HALF) = w; }
            }
    }
};

struct EpiResidual {
    static constexpr bool PERM = false, AFTER_DRAIN = false;
    const bf16_t* XB; bf16_t* XBo; float* ssq;
    __device__ __forceinline__ void operator()(const f32x4 (&acc)[2][2][4][2], const Unit& u, int wr, int wc, int fr, int fq) const {
        const int row0 = u.pm * BM + wr * 64 + fr, col0 = u.pn * BM + wc * 32 + 4 * fq;
        u32x2 xo[2][4][2][2];
#pragma unroll
        for (int ai = 0; ai < 2; ++ai)
#pragma unroll
            for (int m = 0; m < 4; ++m)
#pragma unroll
                for (int bj = 0; bj < 2; ++bj)
#pragma unroll
                    for (int n = 0; n < 2; ++n) xo[ai][m][bj][n] = *(const PG8_GAS u32x2*)(XB + (size_t)(row0 + ai * HALF + m * 16) * 2048 + col0 + bj * HALF + n * 16);
        asm volatile("" ::: "memory");
#pragma unroll
        for (int ai = 0; ai < 2; ++ai)
#pragma unroll
            for (int m = 0; m < 4; ++m) { const int row = row0 + ai * HALF + m * 16; float ss = 0.f;
#pragma unroll
                for (int bj = 0; bj < 2; ++bj)
#pragma unroll
                    for (int n = 0; n < 2; ++n) { const size_t off = (size_t)row * 2048 + col0 + bj * HALF + n * 16; const u32x2 o = xo[ai][m][bj][n];
                        const f32x4 x = (f32x4){bf_lo(o.x), bf_hi(o.x), bf_lo(o.y), bf_hi(o.y)} + acc[ai][bj][m][n];
                        u32x2 w; w.x = cvt_pk_bf16(x[0], x[1]); w.y = cvt_pk_bf16(x[2], x[3]); *(PG8_GAS u32x2*)(XBo + off) = w;
                        ss += (x[0] * x[0] + x[1] * x[1]) + (x[2] * x[2] + x[3] * x[3]); }
                ss += __shfl_xor(ss, 16); ss += __shfl_xor(ss, 32);
                if (fq == 0) *(PG8_GAS float*)(ssq + (size_t)row * 32 + u.pn * 4 + wc) = ss; }
    }
};

struct EpiBranch {
    static constexpr bool PERM = true, AFTER_DRAIN = false;
    bf16_t* MG; const bf16_t* G; int ldg; int first;
    __device__ __forceinline__ void operator()(const f32x4 (&acc)[2][2][4][2], const Unit& u, int wr, int wc, int fr, int fq) const {
        const int row0 = u.pm * BM + wr * 64 + fr, col0 = u.pn * BM + wc * 32 + 8 * fq;
#pragma unroll
        for (int ai = 0; ai < 2; ++ai) {
            u32x4 gt[4][2], od[4][2];
#pragma unroll
            for (int m = 0; m < 4; ++m)
#pragma unroll
                for (int bj = 0; bj < 2; ++bj) { const int row = row0 + ai * HALF + m * 16, col = col0 + bj * HALF;
                    gt[m][bj] = *(const PG8_GAS u32x4*)(G + (size_t)row * ldg + col);
                    od[m][bj] = first ? (u32x4){0u, 0u, 0u, 0u} : *(const PG8_GAS u32x4*)(MG + (size_t)row * 2048 + col); }
            asm volatile("" ::: "memory");
#pragma unroll
            for (int m = 0; m < 4; ++m)
#pragma unroll
                for (int bj = 0; bj < 2; ++bj) { const int row = row0 + ai * HALF + m * 16, col = col0 + bj * HALF; const u32x4 g = gt[m][bj], o = od[m][bj];
                    f32x4 v0 = acc[ai][bj][m][0], v1 = acc[ai][bj][m][1];
                    v0 = v0 * (f32x4){bf_lo(g.x), bf_hi(g.x), bf_lo(g.y), bf_hi(g.y)} + (f32x4){bf_lo(o.x), bf_hi(o.x), bf_lo(o.y), bf_hi(o.y)};
                    v1 = v1 * (f32x4){bf_lo(g.z), bf_hi(g.z), bf_lo(g.w), bf_hi(g.w)} + (f32x4){bf_lo(o.z), bf_hi(o.z), bf_lo(o.w), bf_hi(o.w)};
                    u32x4 w; w.x = cvt_pk_bf16(v0[0], v0[1]); w.y = cvt_pk_bf16(v0[2], v0[3]); w.z = cvt_pk_bf16(v1[0], v1[1]); w.w = cvt_pk_bf16(v1[2], v1[3]);
                    *(PG8_GAS u32x4*)(MG + (size_t)row * 2048 + col) = w; }
            asm volatile("" ::: "memory");
        }
    }
};

struct EpiMemKV {
    static constexpr bool PERM = false, AFTER_DRAIN = false;
    float* outk; float* outv; bf16_t* KV;
    __device__ __forceinline__ void operator()(const f32x4 (&acc)[2][2][4][2], const Unit& u, int wr, int wc, int fr, int fq) const {
        const int row0 = u.pm * BM + wr * 64 + fr, col0 = u.pn * BM + wc * 32 + 4 * fq;
#pragma unroll
        for (int ai = 0; ai < 2; ++ai)
#pragma unroll
            for (int m = 0; m < 4; ++m) {
                const int row = row0 + ai * HALF + m * 16;
#pragma unroll
                for (int bj = 0; bj < 2; ++bj)
#pragma unroll
                    for (int n = 0; n < 2; ++n) { const int col = col0 + bj * HALF + n * 16; const f32x4 a = acc[ai][bj][m][n];
                        float* dst = (col < 512) ? (outk + (size_t)row * 512 + col) : (outv + (size_t)row * 512 + (col - 512));
                        *(PG8_GAS f32x4*)dst = a;
                        u32x2 w; w.x = cvt_pk_bf16(a[0], a[1]); w.y = cvt_pk_bf16(a[2], a[3]); *(PG8_GAS u32x2*)(KV + (size_t)row * 1024 + col) = w; }
            }
    }
};
template <class Epi, class Sched, bool ALIGN_EPI = false, bool SP2 = false>
__device__ __forceinline__ void gemm_phase(PG8_LAS unsigned char* lds, const Gemm g, const Sched& S, const Epi& E, int tid_in) {
    int tid_ = tid_in; asm volatile("" : "+v"(tid_));
    const int tid = tid_, wid = __builtin_amdgcn_readfirstlane(tid >> 6), lane = tid & 63, wr = wid >> 2, wc = wid & 3, fr = lane & 15, fq = lane >> 4;
    const int K = g.K, nt = K / BK;
    unsigned voffA[2], voffB[2];
#pragma unroll
    for (int i = 0; i < 2; ++i) { int R, C; stage_rc(tid * 16 + i * 8192, R, C); const int Rb = Epi::PERM ? ((R & ~31) + perm32(R & 31)) : R;
        voffA[i] = (unsigned)(R * K + C) * 2u; voffB[i] = (unsigned)(Rb * K + C) * 2u; }
    const size_t kstep = (size_t)(BK * 2);
    const size_t hstep = (size_t)HALF * K * 2;
    const size_t tstep = 2 * hstep;
    const unsigned ldsw = (unsigned)wid * 1024u;
    const int aoff = lds_byte(wr * 64 + fr, fq * 8), boff = lds_byte(wc * 32 + fr, fq * 8);
#define PG8_SA(b, h) (((b) * 2 + (h)) * HTB)
#define PG8_SB(b, h) ((4 + (b) * 2 + (h)) * HTB)
#define PG8_STAGE(bufoff, gbase, voff) do { _Pragma("unroll") for (int _i = 0; _i < 2; ++_i) \
        __builtin_amdgcn_global_load_lds((const unsigned*)((const char*)(gbase) + (voff)[_i]), (PG8_LAS unsigned*)(lds + (bufoff) + ldsw + _i * 8192), 16, 0, 0); } while (0)
#define PG8_LDA(dst, b, h) do { _Pragma("unroll") for (int m = 0; m < 4; ++m) _Pragma("unroll") for (int k = 0; k < 2; ++k) dst[m][k] = *(const PG8_LAS bf16x8*)(lds + PG8_SA(b, h) + aoff + m * 2048 + k * 1024); } while (0)
#define PG8_LDB(dst, b, h) do { _Pragma("unroll") for (int n = 0; n < 2; ++n) _Pragma("unroll") for (int k = 0; k < 2; ++k) dst[n][k] = *(const PG8_LAS bf16x8*)(lds + PG8_SB(b, h) + boff + n * 2048 + k * 1024); } while (0)
#define PG8_MMA(ai, bj, At, Bt) do { __builtin_amdgcn_s_setprio(1); _Pragma("unroll") for (int m = 0; m < 4; ++m) _Pragma("unroll") for (int n = 0; n < 2; ++n) _Pragma("unroll") for (int k = 0; k < 2; ++k) \
        acc[ai][bj][m][n] = __builtin_amdgcn_mfma_f32_16x16x32_bf16(Bt[n][k], At[m][k], acc[ai][bj][m][n], 0, 0, 0); __builtin_amdgcn_s_setprio(0); } while (0)
#define PG8_WAIT_V(n) asm volatile("s_waitcnt vmcnt(" #n ")" ::: "memory")
#define PG8_WAIT_L(n) asm volatile("s_waitcnt lgkmcnt(" #n ")" ::: "memory")
#define PG8_BAR __builtin_amdgcn_s_barrier()
#define PG8_SCHED __builtin_amdgcn_sched_barrier(0)
    Unit cur, nxt; int ui = 0;
    if (!S.next(0, cur)) return;
    f32x4 acc[2][2][4][2];
#pragma unroll
    for (int a = 0; a < 2; ++a)
#pragma unroll
        for (int b = 0; b < 2; ++b)
#pragma unroll
            for (int m = 0; m < 4; ++m)
#pragma unroll
                for (int n = 0; n < 2; ++n) acc[a][b][m][n] = (f32x4){0.f, 0.f, 0.f, 0.f};
    bf16x8 At[4][2], B0[2][2], B1[2][2];
    const char* cA = (const char*)g.A + (size_t)cur.pm * tstep; const char* cB = (const char*)g.Bt + (size_t)cur.pn * tstep;
    S.a_ready(cur);
    if constexpr (SP2) {
        PG8_STAGE(PG8_SB(0, 0), cB, voffB); PG8_STAGE(PG8_SB(0, 1), cB + hstep, voffB); PG8_STAGE(PG8_SA(0, 0), cA, voffA); PG8_STAGE(PG8_SA(0, 1), cA + hstep, voffA);
        if (wr == 1) PG8_BAR;
        PG8_WAIT_V(2); PG8_BAR;
        PG8_STAGE(PG8_SB(1, 0), cB + kstep, voffB); PG8_STAGE(PG8_SA(1, 0), cA + kstep, voffA); PG8_STAGE(PG8_SB(1, 1), cB + hstep + kstep, voffB);
        PG8_WAIT_V(6); PG8_BAR;
    } else {
        PG8_STAGE(PG8_SB(0, 0), cB, voffB); PG8_STAGE(PG8_SA(0, 0), cA, voffA); PG8_STAGE(PG8_SB(0, 1), cB + hstep, voffB); PG8_STAGE(PG8_SA(0, 1), cA + hstep, voffA);
        if (wr == 1) PG8_BAR;
        PG8_WAIT_V(4); PG8_BAR;
        PG8_STAGE(PG8_SB(1, 0), cB + kstep, voffB); PG8_STAGE(PG8_SA(1, 0), cA + kstep, voffA); PG8_STAGE(PG8_SB(1, 1), cB + hstep + kstep, voffB);
        PG8_WAIT_V(6); PG8_BAR;
    }
    for (;;) {
        const bool has_next = S.next(ui + 1, nxt);
        const char* nA = has_next ? (const char*)g.A + (size_t)nxt.pm * tstep : cA; const char* nB = has_next ? (const char*)g.Bt + (size_t)nxt.pn * tstep : cB;
        for (int t = 0; t < nt; t += 2) {
            const bool last = (t == nt - 2);
            const char* a1 = cA + (size_t)(t + 1) * kstep;
            const char* a2 = last ? nA : cA + (size_t)(t + 2) * kstep; const char* b2 = last ? nB : cB + (size_t)(t + 2) * kstep;
            const char* a3 = a2 + kstep; const char* b3 = b2 + kstep;
            if (last && has_next) S.a_ready(nxt);
            if constexpr (SP2) {
            PG8_LDB(B0, 0, 0); PG8_LDB(B1, 0, 1); PG8_SCHED; PG8_LDA(At, 0, 0); PG8_STAGE(PG8_SA(1, 1), a1 + hstep, voffA);
            PG8_WAIT_V(8); PG8_WAIT_L(0); PG8_BAR; PG8_MMA(0, 0, At, B0); PG8_MMA(0, 1, At, B1); PG8_BAR; PG8_SCHED;
            PG8_LDA(At, 0, 1); PG8_STAGE(PG8_SB(0, 0), b2, voffB); PG8_STAGE(PG8_SB(0, 1), b2 + hstep, voffB); PG8_STAGE(PG8_SA(0, 0), a2, voffA);
            PG8_WAIT_V(8); PG8_WAIT_L(0); PG8_BAR; PG8_MMA(1, 0, At, B0); PG8_MMA(1, 1, At, B1); PG8_BAR; PG8_SCHED;
            PG8_LDB(B0, 1, 0); PG8_LDB(B1, 1, 1); PG8_SCHED; PG8_LDA(At, 1, 0); PG8_STAGE(PG8_SA(0, 1), a2 + hstep, voffA);
            PG8_WAIT_V(8); PG8_WAIT_L(0); PG8_BAR; PG8_MMA(0, 0, At, B0); PG8_MMA(0, 1, At, B1); PG8_BAR; PG8_SCHED;
            PG8_LDA(At, 1, 1); PG8_STAGE(PG8_SB(1, 0), b3, voffB); PG8_STAGE(PG8_SB(1, 1), b3 + hstep, voffB); PG8_STAGE(PG8_SA(1, 0), a3, voffA);
            PG8_WAIT_V(8); PG8_WAIT_L(0); PG8_BAR; PG8_MMA(1, 0, At, B0); PG8_MMA(1, 1, At, B1); PG8_BAR; PG8_SCHED;
            } else {
            PG8_LDB(B0, 0, 0); PG8_SCHED; PG8_LDA(At, 0, 0); PG8_STAGE(PG8_SA(1, 1), a1 + hstep, voffA);
            PG8_WAIT_L(8); PG8_BAR; PG8_WAIT_L(0); PG8_MMA(0, 0, At, B0); PG8_BAR; PG8_SCHED;
            PG8_LDB(B1, 0, 1); PG8_STAGE(PG8_SB(0, 0), b2, voffB);
            PG8_BAR; PG8_WAIT_L(0); PG8_MMA(0, 1, At, B1); PG8_BAR;
            PG8_LDA(At, 0, 1); PG8_STAGE(PG8_SA(0, 0), a2, voffA);
            PG8_BAR; PG8_WAIT_L(0); PG8_MMA(1, 0, At, B0); PG8_BAR; PG8_SCHED;
            PG8_STAGE(PG8_SB(0, 1), b2 + hstep, voffB);
            PG8_WAIT_V(6); PG8_BAR; PG8_MMA(1, 1, At, B1); PG8_BAR;
            PG8_LDB(B0, 1, 0); PG8_SCHED; PG8_LDA(At, 1, 0); PG8_STAGE(PG8_SA(0, 1), a2 + hstep, voffA);
            PG8_WAIT_L(8); PG8_BAR; PG8_WAIT_L(0); PG8_MMA(0, 0, At, B0); PG8_BAR; PG8_SCHED;
            PG8_LDB(B1, 1, 1); PG8_STAGE(PG8_SB(1, 0), b3, voffB);
            PG8_BAR; PG8_WAIT_L(0); PG8_MMA(0, 1, At, B1); PG8_BAR;
            PG8_LDA(At, 1, 1); PG8_STAGE(PG8_SA(1, 0), a3, voffA);
            PG8_BAR; PG8_WAIT_L(0); PG8_MMA(1, 0, At, B0); PG8_BAR; PG8_SCHED;
            PG8_STAGE(PG8_SB(1, 1), b3 + hstep, voffB);
            PG8_WAIT_V(6); PG8_BAR; PG8_MMA(1, 1, At, B1); PG8_BAR;
            }
        }
        if constexpr (ALIGN_EPI) { if (wr == 0) PG8_BAR; }
        if constexpr (!Epi::AFTER_DRAIN) { E(acc, cur, wr, wc, fr, fq); S.done(cur); }
        if (!has_next) break;
#pragma unroll
        for (int a = 0; a < 2; ++a)
#pragma unroll
            for (int b = 0; b < 2; ++b)
#pragma unroll
                for (int m = 0; m < 4; ++m)
#pragma unroll
                    for (int n = 0; n < 2; ++n) acc[a][b][m][n] = (f32x4){0.f, 0.f, 0.f, 0.f};
        cur = nxt; cA = nA; cB = nB; ++ui;
        if constexpr (ALIGN_EPI) { if (wr == 1) PG8_BAR; }
    }
    PG8_WAIT_V(0);
    if constexpr (!ALIGN_EPI) { if (wr == 0) PG8_BAR; }
    PG8_BAR;
    if constexpr (Epi::AFTER_DRAIN) { E.fused(acc, cur, wr, wc, fr, fq, lds, wid, lane); S.done(cur); }
#undef PG8_SA
#undef PG8_SB
#undef PG8_STAGE
#undef PG8_LDA
#undef PG8_LDB
#undef PG8_MMA
#undef PG8_WAIT_V
#undef PG8_WAIT_L
#undef PG8_BAR
#undef PG8_SCHED
}
}

constexpr int NWAVES = 8, NTHR = 512;
constexpr int DM = 2048, SEQ = 4096, NBP = 2, DEPTH = 4, NBS = 32, TS = 8;
constexpr int MP = NBP * SEQ, MS = NBS * TS, M = MP + MS;
constexpr int MIXW = 1024, GH = 4, GDK = 128, GDV = 256, GRANK = 16;
constexpr int SH = 16, SKV = 2, SHD = 64, WIN = 128;
constexpr int NMEM = 256, XH = 4, XHD = 128, XW = XH * XHD;
constexpr int DFF = 5504, NIN = 13584, NINP = 13824;
constexpr float EPS = 1e-6f;
constexpr int ZC_GQ = 0, ZC_GK = 512, ZC_GV = 1024, ZC_GR = 2048, ZC_SQ = 3072, ZC_SK = 4096, ZC_SV = 4224, ZC_CB = 4352, ZC_CC = 5376, ZC_CH = 6400, ZC_GATE = 7424, ZC_GLR = 13568;
static_assert(ZC_GATE % 256 == 0 && ZC_GLR % 256 == 0 && ZC_GLR + 16 == NIN && NINP % 256 == 0, "z layout");
constexpr size_t O_YP = 0, O_YS = O_YP + (size_t)MP * DM, O_GLAP = O_YS + (size_t)MS * DM, O_GLAS = O_GLAP + (size_t)DEPTH * NBP * GH * GDK * GDV,
                 O_SKP = O_GLAS + (size_t)DEPTH * NBS * GH * GDK * GDV, O_SVP = O_SKP + (size_t)DEPTH * NBP * WIN * SKV * SHD, O_SKS = O_SVP + (size_t)DEPTH * NBP * WIN * SKV * SHD,
                 O_SVS = O_SKS + (size_t)DEPTH * NBS * WIN * SKV * SHD, O_CONVP = O_SVS + (size_t)DEPTH * NBS * WIN * SKV * SHD, O_CONVS = O_CONVP + (size_t)DEPTH * NBP * 2 * MIXW,
                 O_FFNP = O_CONVS + (size_t)DEPTH * NBS * 2 * MIXW, O_FFNS = O_FFNP + (size_t)DEPTH * NBP * 2 * DFF, O_MKP = O_FFNS + (size_t)DEPTH * NBS * 2 * DFF,
                 O_MVP = O_MKP + (size_t)DEPTH * NBP * NMEM * XW, O_END = O_MVP + (size_t)DEPTH * NBP * NMEM * XW;
static_assert(O_END == 43456512, "output size");
enum { I_XP = 0, I_XS, I_SGLA, I_CSK, I_CSV, I_SCONV, I_SFFN, I_CMK, I_CMV, I_MEMP, I_NMIX, I_WIN, I_GUP, I_GB, I_GNORM, I_SINK, I_RELB, I_CONVW, I_WBR, I_WOUT, I_NX, I_WXQ, I_WXK, I_WXV, I_WXO,
       I_NFFN, I_FUP, I_FCW, I_FCB, I_FDN, I_NFIN, N_INPUTS };
static_assert(N_INPUTS == 31, "inputs");

constexpr size_t MiB = 1u << 20;
constexpr size_t al1m(size_t x) { return (x + MiB - 1) / MiB * MiB; }
constexpr size_t WS_CTL = 0, CTL_ZERO_BYTES = 1 * MiB;
constexpr size_t SZ_WIN = (size_t)NINP * DM * 2, SZ_WBR = (size_t)3 * DM * MIXW * 2, SZ_WOUT = (size_t)DM * DM * 2, SZ_WXQ = (size_t)XW * DM * 2, SZ_WXKV = (size_t)2 * XW * DM * 2,
                 SZ_WXO = (size_t)DM * XW * 2, SZ_WUP = (size_t)2 * DFF * DM * 2, SZ_WDN = (size_t)DM * DFF * 2;
constexpr size_t WS_WIN = 2 * MiB, WS_WBR = al1m(WS_WIN + DEPTH * SZ_WIN), WS_WOUT = al1m(WS_WBR + DEPTH * SZ_WBR), WS_WXQ = al1m(WS_WOUT + DEPTH * SZ_WOUT),
                 WS_WXKV = al1m(WS_WXQ + DEPTH * SZ_WXQ), WS_WXO = al1m(WS_WXKV + DEPTH * SZ_WXKV), WS_WUP = al1m(WS_WXO + DEPTH * SZ_WXO), WS_WDN = al1m(WS_WUP + DEPTH * SZ_WUP);
constexpr size_t WS_X = al1m(WS_WDN + DEPTH * SZ_WDN), WS_XB = al1m(WS_X + (size_t)M * DM * 4), WS_SSQ = al1m(WS_XB + (size_t)M * DM * 2), WS_Z = al1m(WS_SSQ + (size_t)M * 32 * 4),
                 WS_BR = al1m(WS_Z + (size_t)M * NINP * 2), WS_MG = al1m(WS_BR + (size_t)3 * M * MIXW * 2), WS_XQ = al1m(WS_MG + (size_t)M * DM * 2), WS_XO = al1m(WS_XQ + (size_t)M * XW * 2),
                 WS_UG = al1m(WS_XO + (size_t)M * XW * 2), WS_ACT = al1m(WS_UG + (size_t)M * 2 * DFF * 2), WS_MEMB = al1m(WS_ACT + (size_t)M * DFF * 2), WS_MEMKV = al1m(WS_MEMB + (size_t)NBP * NMEM * DM * 2),
                 WS_GLAU = al1m(WS_MEMKV + (size_t)DEPTH * NBP * NMEM * 2 * XW * 2), WS_GLAD = al1m(WS_GLAU + (size_t)512 * GDK * GDV * 4), WS_END = al1m(WS_GLAD + (size_t)512 * GDK * 4);
constexpr size_t PROBE_OFF = WS_END - WS_X, WS_END2 = WS_END + (WS_Z - WS_X);
constexpr int CW_TMO = 0, CW_CODE = 1, CW_BAR = 4096;

constexpr int RING_OFF = 0, RING_BYTES = 131072;
constexpr int LDSCTL_OFF = 146944, MISC_OFF = LDSCTL_OFF + 320;
constexpr int LDS_BYTES = 147456;
static_assert(MISC_OFF + 128 <= LDS_BYTES && LDSCTL_OFF >= RING_BYTES, "LDS map");

#define GAS __attribute__((address_space(1)))
#define LAS __attribute__((address_space(3)))
typedef unsigned short bf16;
typedef unsigned v4u __attribute__((ext_vector_type(4)));
typedef unsigned v2u __attribute__((ext_vector_type(2)));
typedef float f32x4 __attribute__((ext_vector_type(4)));
typedef float f32x2 __attribute__((ext_vector_type(2)));
typedef GAS unsigned gu32;
#define RLX_AGENT __ATOMIC_RELAXED, __HIP_MEMORY_SCOPE_AGENT
#define LDS_WAIT() asm volatile("s_waitcnt lgkmcnt(0)" ::: "memory")
#define VM_WAIT() asm volatile("s_waitcnt vmcnt(0)" ::: "memory")
__device__ __forceinline__ float bflo(unsigned w) { return __uint_as_float(w << 16); }
__device__ __forceinline__ float bfhi(unsigned w) { return __uint_as_float(w & 0xffff0000u); }
__device__ __forceinline__ float bf1(bf16 h) { return __uint_as_float(((unsigned)h) << 16); }
__device__ __forceinline__ unsigned pk2(float lo, float hi) { return pg8::cvt_pk_bf16(lo, hi); }
__device__ __forceinline__ void unpack8(const v4u w, float (&f)[8]) { f[0] = bflo(w.x); f[1] = bfhi(w.x); f[2] = bflo(w.y); f[3] = bfhi(w.y); f[4] = bflo(w.z); f[5] = bfhi(w.z); f[6] = bflo(w.w); f[7] = bfhi(w.w); }
__device__ __forceinline__ v4u pack8(const float (&f)[8]) { v4u w; w.x = pk2(f[0], f[1]); w.y = pk2(f[2], f[3]); w.z = pk2(f[4], f[5]); w.w = pk2(f[6], f[7]); return w; }
__device__ __forceinline__ float sigm(float v) { return 1.0f / (1.0f + __expf(-v)); }
__device__ __forceinline__ float wave_sum(float v) {
#pragma unroll
    for (int o = 1; o < 64; o <<= 1) v += __shfl_xor(v, o);
    return v;
}
#define XB_TMO      128
#define XB_XCNT(j)  (256  + 64 * (j))
#define XB_XSUB(j)  (1280 + 64 * (j))
#define XB_XGEN(j)  (2304 + 64 * (j))
#define XB_TOP      3328
#define XB_TOPGEN   3392
#define XCD_BAR_WORDS 3456
#define XB_SPIN_CAP (1u << 18)

__device__ __forceinline__ unsigned xb_ld(unsigned* p)              { return __hip_atomic_load(p, __ATOMIC_RELAXED, __HIP_MEMORY_SCOPE_AGENT); }
__device__ __forceinline__ unsigned xb_add(unsigned* p, unsigned v) { return __hip_atomic_fetch_add(p, v, __ATOMIC_RELAXED, __HIP_MEMORY_SCOPE_AGENT); }
__device__ __forceinline__ unsigned xb_xcc_id() { return (unsigned)__builtin_amdgcn_s_getreg((3 << 11) | 20) & 0xFu; }
#define XB_SPIN(cond, bar) do { unsigned _sp = 0; while (cond) { __builtin_amdgcn_s_sleep(1); \
    if ((++_sp & 255u) == 0u) { if (xb_ld(&(bar)[XB_TMO])) break; if (_sp > XB_SPIN_CAP) { atomicAdd(&(bar)[XB_TMO], 1u); break; } } } } while (0)

struct XcdBarrier {
    unsigned* bar; unsigned x; unsigned wv;
    volatile LAS unsigned* st;
};

__device__ __forceinline__ unsigned xb_lane() { return __builtin_amdgcn_mbcnt_hi(~0u, __builtin_amdgcn_mbcnt_lo(~0u, 0u)); }
__device__ __forceinline__ XcdBarrier xcd_barrier_post(unsigned* bar, volatile LAS unsigned* st, unsigned wv) {
    XcdBarrier b; b.bar = bar; b.x = xb_xcc_id(); b.st = st; b.wv = wv;
    if (wv == 0u && xb_lane() == 0u) (void)xb_add(&bar[XB_XCNT(b.x)], 1u);
    return b;
}
__device__ __forceinline__ void xcd_barrier_complete(unsigned* bar, unsigned x, unsigned& nloc, unsigned& nx) {
    const unsigned G = gridDim.x * gridDim.y * gridDim.z;
    unsigned sum, cnt, mine, sp = 0u;
    for (;;) {
        sum = 0u; cnt = 0u; mine = 0u;
#pragma unroll
        for (unsigned j = 0; j < 16; ++j) { const unsigned c = xb_ld(&bar[XB_XCNT(j)]); sum += c; cnt += (c > 0u) ? 1u : 0u; mine = (j == x) ? c : mine; }
        if (sum == G) break;
        __builtin_amdgcn_s_sleep(1);
        if ((++sp & 255u) == 0u) { if (xb_ld(&bar[XB_TMO])) break; if (sp > XB_SPIN_CAP) { atomicAdd(&bar[XB_TMO], 1u); break; } }
    }
    nloc = mine > 0u ? mine : 1u; nx = cnt > 0u ? cnt : 1u;
}

__device__ __forceinline__ void xcd_barrier(const XcdBarrier& b) {
    asm volatile("s_waitcnt vmcnt(0)" ::: "memory");
    __syncthreads();
    if (b.wv == 0u && xb_lane() == 0u) {
        unsigned* bar = b.bar;
        __builtin_amdgcn_s_waitcnt(0);
        unsigned nloc = b.st[0], nx = b.st[1];
        if (nloc == 0u) { xcd_barrier_complete(bar, b.x, nloc, nx); b.st[0] = nloc; b.st[1] = nx; }
        const unsigned old = xb_add(&bar[XB_XSUB(b.x)], 1u);
        const unsigned gen = old / nloc;
        if (old + 1u == (gen + 1u) * nloc) {
            __builtin_amdgcn_fence(__ATOMIC_RELEASE, "agent");
            asm volatile("s_waitcnt vmcnt(0)" ::: "memory");
            const unsigned og = xb_add(&bar[XB_TOP], 1u);
            const unsigned tg = og / nx;
            if (og + 1u == (tg + 1u) * nx) xb_add(&bar[XB_TOPGEN], 1u);
            else XB_SPIN(xb_ld(&bar[XB_TOPGEN]) == tg, bar);
            __builtin_amdgcn_fence(__ATOMIC_ACQUIRE, "agent");
            xb_add(&bar[XB_XGEN(b.x)], 1u);
            asm volatile("s_waitcnt vmcnt(0)" ::: "memory");
        } else {
            XB_SPIN(xb_ld(&bar[XB_XGEN(b.x)]) == gen, bar);
            __builtin_amdgcn_fence(__ATOMIC_ACQUIRE, "agent");
            asm volatile("s_waitcnt vmcnt(0)" ::: "memory");
        }
    }
    __syncthreads();
}

struct Args { const float* in[N_INPUTS]; float* out; unsigned char* ws; int ph_lo, ph_hi; };
static_assert(sizeof(Args) == N_INPUTS * 8 + 8 + 8 + 8, "Args has no padding");


constexpr int KA_OUT = 8 * N_INPUTS, KA_WS = KA_OUT + 8, KA_LO = KA_WS + 8, KA_HI = KA_LO + 4;
template <int OFF> __device__ __forceinline__ unsigned long long karg64() {
    unsigned long long v; auto kp = __builtin_amdgcn_kernarg_segment_ptr();
    asm volatile("s_load_dwordx2 %0, %1, %2\n\ts_waitcnt lgkmcnt(0)" : "=s"(v) : "s"(kp), "n"(OFF) : "memory"); return v;
}
template <int OFF> __device__ __forceinline__ int karg32() {
    int v; auto kp = __builtin_amdgcn_kernarg_segment_ptr();
    asm volatile("s_load_dword %0, %1, %2\n\ts_waitcnt lgkmcnt(0)" : "=s"(v) : "s"(kp), "n"(OFF) : "memory"); return v;
}
struct Frame {
    LAS unsigned char* lds;
    volatile LAS unsigned* MISC;
    gu32* ctl;
    int tid, lane, wave, vcu, G;
};

__device__ __forceinline__ int lane_id() { int l; asm volatile("v_mbcnt_lo_u32_b32 %0, -1, 0\n\tv_mbcnt_hi_u32_b32 %0, -1, %0" : "=v"(l)); return l; }
__device__ __forceinline__ int launder_s(int v) { asm volatile("" : "+s"(v)); return v; }
#define LAUNDER(F) do { asm volatile("" : "+s"((F).wave), "+s"((F).vcu), "+s"((F).G)); (F).lane = lane_id(); asm volatile("" : "+v"((F).lane)); (F).tid = (F).wave * 64 + (F).lane; } while (0)
__device__ __forceinline__ void tr_item(const float* W, int K, int Nsrc, bf16* WT, int dstrow0, int k0, int srccol, float cscale, const float* gain, LAS float* scr, int lane) {
    const int q = lane & 15, kq = lane >> 4;
    f32x4 v[16];
#pragma unroll
    for (int i = 0; i < 16; ++i) { v[i] = (f32x4){0.f, 0.f, 0.f, 0.f}; if (srccol >= 0) v[i] = *(const f32x4*)(W + (size_t)(k0 + 4 * i + kq) * Nsrc + srccol); }
#pragma unroll
    for (int i = 0; i < 16; ++i) { const int kk = 4 * i + kq; const float s = gain ? gain[k0 + kk] * cscale : cscale; LAS float* d = scr + kk * 65 + 4 * q;
        d[0] = v[i][0] * s; d[1] = v[i][1] * s; d[2] = v[i][2] * s; d[3] = v[i][3] * s; }
    LDS_WAIT(); asm volatile("" ::: "memory");
    const int c = lane & 7;
#pragma unroll
    for (int j = 0; j < 8; ++j) { const int n = (lane >> 3) + 8 * j; const LAS float* s = scr + (8 * c) * 65 + n;
        v4u o; o.x = pk2(s[0 * 65], s[1 * 65]); o.y = pk2(s[2 * 65], s[3 * 65]); o.z = pk2(s[4 * 65], s[5 * 65]); o.w = pk2(s[6 * 65], s[7 * 65]);
        *(v4u*)(WT + (size_t)(dstrow0 + n) * K + k0 + 8 * c) = o; }
    LDS_WAIT(); asm volatile("" ::: "memory");
}
__device__ __forceinline__ void tr_plain(const float* W, int K, int N, bf16* WT, int dst_off, int r, float cscale, const float* gain, LAS float* scr, int lane) {
    const int nblk = N / 64, kb = r / nblk, nb = r % nblk;
    tr_item(W, K, N, WT, dst_off + 64 * nb, 64 * kb, 64 * nb + 4 * (lane & 15), cscale, gain, scr, lane);
}
constexpr int IT_IN = (DM / 64) * (NINP / 64), IT_BR = (MIXW / 64) * (DM / 64), IT_OUT = (DM / 64) * (DM / 64), IT_XQ = (DM / 64) * (XW / 64), IT_XO = (XW / 64) * (DM / 64),
              IT_UP = (DM / 64) * (2 * DFF / 64), IT_DN = (DFF / 64) * (DM / 64), IT_LAYER = IT_IN + 3 * IT_BR + IT_OUT + 3 * IT_XQ + IT_XO + IT_UP + IT_DN;
__device__ __forceinline__ void p0_convert(const Args& A, Frame& F0, int l, int part, int nparts, int wk, int nwk, bool rows) {
    unsigned char* const ws_ = (unsigned char*)(GAS unsigned char*)karg64<KA_WS>();
    const float* const in_I_FDN = (const float*)(const GAS float*)karg64<8 * I_FDN>();
    const float* const in_I_FUP = (const float*)(const GAS float*)karg64<8 * I_FUP>();
    const float* const in_I_MEMP = (const float*)(const GAS float*)karg64<8 * I_MEMP>();
    const float* const in_I_NFFN = (const float*)(const GAS float*)karg64<8 * I_NFFN>();
    const float* const in_I_NMIX = (const float*)(const GAS float*)karg64<8 * I_NMIX>();
    const float* const in_I_NX = (const float*)(const GAS float*)karg64<8 * I_NX>();
    const float* const in_I_WBR = (const float*)(const GAS float*)karg64<8 * I_WBR>();
    const float* const in_I_WIN = (const float*)(const GAS float*)karg64<8 * I_WIN>();
    const float* const in_I_WOUT = (const float*)(const GAS float*)karg64<8 * I_WOUT>();
    const float* const in_I_WXK = (const float*)(const GAS float*)karg64<8 * I_WXK>();
    const float* const in_I_WXO = (const float*)(const GAS float*)karg64<8 * I_WXO>();
    const float* const in_I_WXQ = (const float*)(const GAS float*)karg64<8 * I_WXQ>();
    const float* const in_I_WXV = (const float*)(const GAS float*)karg64<8 * I_WXV>();
    const float* const in_I_XP = (const float*)(const GAS float*)karg64<8 * I_XP>();
    const float* const in_I_XS = (const float*)(const GAS float*)karg64<8 * I_XS>();
    Frame F = F0; LAUNDER(F);
    LAS float* scr = (LAS float*)(F.lds + F.wave * 16640);
    const int gw = F.vcu * NWAVES + F.wave, NGW = F.G * NWAVES, lane = F.lane;
    const int it_lo = (int)((long)IT_LAYER * part / nparts), it_hi = (int)((long)IT_LAYER * (part + 1) / nparts);
    if (wk >= 0)
#pragma unroll 1
    for (int it = it_lo + wk * NWAVES + F.wave; it < it_hi; it += nwk * NWAVES) {
        int r = it;
        if (r < IT_IN) {
            const int nblk = NINP / 64, kb = r / nblk, nb = r % nblk, n = 64 * nb + 4 * (lane & 15);
            int src; if (n < 3072) src = n; else if (n < ZC_GLR) src = n + 16; else if (n < NIN) src = 3072 + (n - ZC_GLR); else src = -1;
            const float cs = (n < 512) ? 0.08838834764831845f : ((n >= ZC_SQ && n < ZC_SK) ? 0.125f : 1.0f);
            tr_item(in_I_WIN + (size_t)l * DM * NIN, DM, NIN, ((bf16*)(ws_ + WS_WIN)) + (size_t)l * NINP * DM, 64 * nb, 64 * kb, src, cs, in_I_NMIX + l * DM, scr, lane); continue; }
        r -= IT_IN;
        if (r < 3 * IT_BR) { const int i = r / IT_BR; r %= IT_BR;
            tr_plain(in_I_WBR + ((size_t)l * 3 + i) * MIXW * DM, MIXW, DM, ((bf16*)(ws_ + WS_WBR)) + ((size_t)l * 3 + i) * DM * MIXW, 0, r, 1.0f, nullptr, scr, lane); continue; }
        r -= 3 * IT_BR;
        if (r < IT_OUT) { tr_plain(in_I_WOUT + (size_t)l * DM * DM, DM, DM, ((bf16*)(ws_ + WS_WOUT)) + (size_t)l * DM * DM, 0, r, 1.0f, nullptr, scr, lane); continue; }
        r -= IT_OUT;
        if (r < IT_XQ) { tr_plain(in_I_WXQ + (size_t)l * DM * XW, DM, XW, ((bf16*)(ws_ + WS_WXQ)) + (size_t)l * XW * DM, 0, r, 0.08838834764831845f, in_I_NX + l * DM, scr, lane); continue; }
        r -= IT_XQ;
        if (r < IT_XQ) { tr_plain(in_I_WXK + (size_t)l * DM * XW, DM, XW, ((bf16*)(ws_ + WS_WXKV)) + (size_t)l * 2 * XW * DM, 0, r, 1.0f, nullptr, scr, lane); continue; }
        r -= IT_XQ;
        if (r < IT_XQ) { tr_plain(in_I_WXV + (size_t)l * DM * XW, DM, XW, ((bf16*)(ws_ + WS_WXKV)) + (size_t)l * 2 * XW * DM, XW, r, 1.0f, nullptr, scr, lane); continue; }
        r -= IT_XQ;
        if (r < IT_XO) { tr_plain(in_I_WXO + (size_t)l * XW * DM, XW, DM, ((bf16*)(ws_ + WS_WXO)) + (size_t)l * DM * XW, 0, r, 1.0f, nullptr, scr, lane); continue; }
        r -= IT_XO;
        if (r < IT_UP) { tr_plain(in_I_FUP + (size_t)l * DM * 2 * DFF, DM, 2 * DFF, ((bf16*)(ws_ + WS_WUP)) + (size_t)l * 2 * DFF * DM, 0, r, 1.0f, in_I_NFFN + l * DM, scr, lane); continue; }
        r -= IT_UP;
        tr_plain(in_I_FDN + (size_t)l * DFF * DM, DFF, DM, ((bf16*)(ws_ + WS_WDN)) + (size_t)l * DM * DFF, 0, r, 1.0f, nullptr, scr, lane);
    }
    if (rows)
    for (int m = gw; m < M + NBP * NMEM; m += NGW) {
        if (m < M) {
            const float* src = (m < MP) ? in_I_XP + (size_t)m * DM : in_I_XS + (size_t)(m - MP) * DM;
            float ss = 0.f;
#pragma unroll
            for (int j = 0; j < 8; ++j) { const f32x4 v = *((const f32x4*)src + lane + 64 * j);
                v2u w; w.x = pk2(v[0], v[1]); w.y = pk2(v[2], v[3]); *((v2u*)(((bf16*)(ws_ + WS_XB)) + (size_t)m * DM) + lane + 64 * j) = w; ss += (v[0] * v[0] + v[1] * v[1]) + (v[2] * v[2] + v[3] * v[3]); }
            ss = wave_sum(ss);
            if (lane < 32) ((float*)(ws_ + WS_SSQ))[(size_t)m * 32 + lane] = (lane == 0) ? ss : 0.f;
        } else {
            const int r = m - M; const float* src = in_I_MEMP + (size_t)r * DM;
#pragma unroll
            for (int j = 0; j < 8; ++j) { const f32x4 v = *((const f32x4*)src + lane + 64 * j); v2u w; w.x = pk2(v[0], v[1]); w.y = pk2(v[2], v[3]); *((v2u*)(((bf16*)(ws_ + WS_MEMB)) + (size_t)r * DM) + lane + 64 * j) = w; }
        }
    }
}

__device__ __forceinline__ int t5_bucket(int n) {
    if (n < 16) return n;
    const float v = logf((float)n / 16.0f) / logf(8.0f) * 16.0f; const int lg = 16 + (int)v; return lg < 31 ? lg : 31;
}
template <int STRIDE, bool PAIR, bool BIAS>
__device__ __forceinline__ void attn_core(const float (&q)[64], LAS const unsigned char* kp, LAS const unsigned char* vp, int nsteps, int jmin, LAS const float* bp, float& m, float& lsum, float (&o)[64]) {
    for (int j = 0; j < nsteps; ++j) {
        LAS const v4u* kr = (LAS const v4u*)(kp + j * STRIDE);
        float s0 = 0.f, s1 = 0.f;
#pragma unroll
        for (int c = 0; c < 8; ++c) { const v4u kk = kr[c];
            s0 += q[8 * c + 0] * bflo(kk.x) + q[8 * c + 2] * bflo(kk.y) + q[8 * c + 4] * bflo(kk.z) + q[8 * c + 6] * bflo(kk.w);
            s1 += q[8 * c + 1] * bfhi(kk.x) + q[8 * c + 3] * bfhi(kk.y) + q[8 * c + 5] * bfhi(kk.z) + q[8 * c + 7] * bfhi(kk.w); }
        float s = s0 + s1;
        if (PAIR) s += __shfl_xor(s, 1);
        if (BIAS) s += bp[-j];
        s = (j >= jmin) ? s : -INFINITY;
        const float mn = fmaxf(m, s), sc = __expf(m - mn), p = __expf(s - mn);
        lsum = lsum * sc + p; m = mn;
        LAS const v4u* vr = (LAS const v4u*)(vp + j * STRIDE);
#pragma unroll
        for (int c = 0; c < 8; ++c) { const v4u vv = vr[c];
            o[8 * c + 0] = o[8 * c + 0] * sc + p * bflo(vv.x); o[8 * c + 1] = o[8 * c + 1] * sc + p * bfhi(vv.x);
            o[8 * c + 2] = o[8 * c + 2] * sc + p * bflo(vv.y); o[8 * c + 3] = o[8 * c + 3] * sc + p * bfhi(vv.y);
            o[8 * c + 4] = o[8 * c + 4] * sc + p * bflo(vv.z); o[8 * c + 5] = o[8 * c + 5] * sc + p * bfhi(vv.z);
            o[8 * c + 6] = o[8 * c + 6] * sc + p * bflo(vv.w); o[8 * c + 7] = o[8 * c + 7] * sc + p * bfhi(vv.w); }
    }
}
__device__ __forceinline__ void load_q64(const bf16* p, float (&q)[64]) {
#pragma unroll
    for (int c = 0; c < 8; ++c) { const v4u w = *((const v4u*)p + c); float f[8]; unpack8(w, f);
#pragma unroll
        for (int i = 0; i < 8; ++i) q[8 * c + i] = f[i]; }
}
__device__ __forceinline__ void store_o64(bf16* p, const float (&o)[64], float inv) {
#pragma unroll
    for (int c = 0; c < 8; ++c) { float f[8];
#pragma unroll
        for (int i = 0; i < 8; ++i) f[i] = o[8 * c + i] * inv;
        *((v4u*)p + c) = pack8(f); }
}

constexpr int SWA_STR = 144, SWA_K = 0, SWA_V = 192 * SWA_STR, SWA_BT = 2 * 192 * SWA_STR, SWA_BTS = 132;
__device__ __forceinline__ void swa_phase(const Args& A, Frame& F0, int l) {
    unsigned char* const ws_ = (unsigned char*)(GAS unsigned char*)karg64<KA_WS>();
    float* const out_ = (float*)(GAS float*)karg64<KA_OUT>();
    const float* const in_I_CSK = (const float*)(const GAS float*)karg64<8 * I_CSK>();
    const float* const in_I_CSV = (const float*)(const GAS float*)karg64<8 * I_CSV>();
    const float* const in_I_RELB = (const float*)(const GAS float*)karg64<8 * I_RELB>();
    const float* const in_I_SINK = (const float*)(const GAS float*)karg64<8 * I_SINK>();
    Frame F = F0; LAUNDER(F);
    LAS unsigned char* Ks = F.lds + SWA_K; LAS unsigned char* Vs = F.lds + SWA_V; LAS float* BT = (LAS float*)(F.lds + SWA_BT);
    for (int i = F.tid; i < SH * 129; i += NTHR) { const int h = i / 129, d = i % 129; BT[h * SWA_BTS + d] = in_I_RELB[t5_bucket(d) * SH + h]; }
    const float* sinks = in_I_SINK + l * SH;
    for (int u = F.vcu; u < 256 + 64; u += F.G) {
        __syncthreads();
        if (u < 256) {
            const int b = u >> 7, kvh = (u >> 6) & 1, qb = u & 63, q0 = qb * 64;
            for (int i = F.tid; i < 192 * 8; i += NTHR) { const int r = i >> 3, c8 = i & 7, pos = q0 - 128 + r; v4u kv = (v4u){0u, 0u, 0u, 0u}, vv = kv;
                if (pos >= 0) { const bf16* zr = ((bf16*)(ws_ + WS_Z)) + (size_t)(b * SEQ + pos) * NINP + kvh * 64 + c8 * 8; kv = *(const v4u*)(zr + ZC_SK); vv = *(const v4u*)(zr + ZC_SV); }
                *(LAS v4u*)(Ks + r * SWA_STR + c8 * 16) = kv; *(LAS v4u*)(Vs + r * SWA_STR + c8 * 16) = vv;
                if (qb == 63 && r >= 64) { float fk[8], fv[8]; unpack8(kv, fk); unpack8(vv, fv); const size_t o = ((((size_t)l * NBP + b) * WIN + (r - 64)) * SKV + kvh) * SHD + c8 * 8;
                    *(f32x4*)(out_ + O_SKP + o) = (f32x4){fk[0], fk[1], fk[2], fk[3]}; *(f32x4*)(out_ + O_SKP + o + 4) = (f32x4){fk[4], fk[5], fk[6], fk[7]};
                    *(f32x4*)(out_ + O_SVP + o) = (f32x4){fv[0], fv[1], fv[2], fv[3]}; *(f32x4*)(out_ + O_SVP + o + 4) = (f32x4){fv[4], fv[5], fv[6], fv[7]}; }
            }
            __syncthreads();
            const int head = kvh * 8 + F.wave, t = q0 + F.lane, row = b * SEQ + t;
            float q[64], o[64]; load_q64(((bf16*)(ws_ + WS_Z)) + (size_t)row * NINP + ZC_SQ + head * 64, q);
#pragma unroll
            for (int i = 0; i < 64; ++i) o[i] = 0.f;
            float m = sinks[head], ls = 1.0f;
            attn_core<SWA_STR, false, true>(q, Ks + F.lane * SWA_STR, Vs + F.lane * SWA_STR, 129, 128 - t, BT + head * SWA_BTS + 128, m, ls, o);
            store_o64(((bf16*)(ws_ + WS_BR)) + (size_t)1 * M * MIXW + (size_t)row * MIXW + head * 64, o, 1.0f / ls);
        } else {
            const int su = u - 256, b = su >> 1, kvh = su & 1;
            for (int i = F.tid; i < 136 * 8; i += NTHR) { const int r = i >> 3, c8 = i & 7; float fk[8], fv[8];
                if (r < 128) { const size_t o = ((((size_t)l * NBS + b) * WIN + r) * SKV + kvh) * SHD + c8 * 8; const f32x4 a0 = *(const f32x4*)(in_I_CSK + o), a1 = *(const f32x4*)(in_I_CSK + o + 4), b0 = *(const f32x4*)(in_I_CSV + o), b1 = *(const f32x4*)(in_I_CSV + o + 4);
#pragma unroll
                    for (int k = 0; k < 4; ++k) { fk[k] = a0[k]; fk[4 + k] = a1[k]; fv[k] = b0[k]; fv[4 + k] = b1[k]; } }
                else { const bf16* zr = ((bf16*)(ws_ + WS_Z)) + (size_t)(MP + b * TS + (r - 128)) * NINP + kvh * 64 + c8 * 8; unpack8(*(const v4u*)(zr + ZC_SK), fk); unpack8(*(const v4u*)(zr + ZC_SV), fv); }
                *(LAS v4u*)(Ks + r * SWA_STR + c8 * 16) = pack8(fk); *(LAS v4u*)(Vs + r * SWA_STR + c8 * 16) = pack8(fv);
                if (r >= 8) { const size_t o = ((((size_t)l * NBS + b) * WIN + (r - 8)) * SKV + kvh) * SHD + c8 * 8;
                    *(f32x4*)(out_ + O_SKS + o) = (f32x4){fk[0], fk[1], fk[2], fk[3]}; *(f32x4*)(out_ + O_SKS + o + 4) = (f32x4){fk[4], fk[5], fk[6], fk[7]};
                    *(f32x4*)(out_ + O_SVS + o) = (f32x4){fv[0], fv[1], fv[2], fv[3]}; *(f32x4*)(out_ + O_SVS + o + 4) = (f32x4){fv[4], fv[5], fv[6], fv[7]}; }
            }
            __syncthreads();
            if (F.wave == 0) {
                const int t = F.lane & 7, head = kvh * 8 + (F.lane >> 3), row = MP + b * TS + t;
                float q[64], o[64]; load_q64(((bf16*)(ws_ + WS_Z)) + (size_t)row * NINP + ZC_SQ + head * 64, q);
#pragma unroll
                for (int i = 0; i < 64; ++i) o[i] = 0.f;
                float m = sinks[head], ls = 1.0f;
                attn_core<SWA_STR, false, true>(q, Ks + t * SWA_STR, Vs + t * SWA_STR, 129, 0, BT + head * SWA_BTS + 128, m, ls, o);
                store_o64(((bf16*)(ws_ + WS_BR)) + (size_t)1 * M * MIXW + (size_t)row * MIXW + head * 64, o, 1.0f / ls);
            }
        }
    }
    __syncthreads();
}

__device__ __forceinline__ void conv_phase(const Args& A, Frame& F0, int l) {
    unsigned char* const ws_ = (unsigned char*)(GAS unsigned char*)karg64<KA_WS>();
    float* const out_ = (float*)(GAS float*)karg64<KA_OUT>();
    const float* const in_I_CONVW = (const float*)(const GAS float*)karg64<8 * I_CONVW>();
    const float* const in_I_SCONV = (const float*)(const GAS float*)karg64<8 * I_SCONV>();
    Frame F = F0; LAUNDER(F);
    const float* cw = in_I_CONVW + (size_t)l * 3 * MIXW; const bf16* Z = (const bf16*)(ws_ + WS_Z); bf16* BRC = (bf16*)(ws_ + WS_BR) + (size_t)2 * M * MIXW;
#pragma unroll 1
    for (int idx = F.vcu * NTHR + F.tid; idx < (M / 8) * (MIXW / 8); idx += F.G * NTHR) {
        const int row0 = (idx >> 7) * 8, c = (idx & 127) * 8; const bool smp = row0 >= MP; const int b = smp ? (row0 - MP) >> 3 : row0 >> 12, t0 = smp ? 0 : (row0 & (SEQ - 1));
        v4u cc[10], ch[10], cbv[8];
#pragma unroll
        for (int k = 0; k < 10; ++k) { cc[k] = (v4u){0u, 0u, 0u, 0u}; ch[k] = cc[k];
            if (k >= 2 || t0 > 0) { const bf16* zr = Z + (size_t)(row0 + k - 2) * NINP + c; cc[k] = *(const v4u*)(zr + ZC_CC); ch[k] = *(const v4u*)(zr + ZC_CH); } }
#pragma unroll
        for (int k = 0; k < 8; ++k) cbv[k] = *(const v4u*)(Z + (size_t)(row0 + k) * NINP + ZC_CB + c);
        float w0[8], w1[8], w2[8];
#pragma unroll
        for (int i = 0; i < 8; ++i) { w0[i] = cw[c + i]; w1[i] = cw[MIXW + c + i]; w2[i] = cw[2 * MIXW + c + i]; }
        float u2[8], u1[8], u0[8];
        { float a[8], d[8]; unpack8(cc[0], a); unpack8(ch[0], d);
#pragma unroll
          for (int i = 0; i < 8; ++i) u2[i] = a[i] * d[i];
          unpack8(cc[1], a); unpack8(ch[1], d);
#pragma unroll
          for (int i = 0; i < 8; ++i) u1[i] = a[i] * d[i]; }
        if (smp) { const float* sp = in_I_SCONV + (((size_t)l * NBS + b) * 2) * MIXW + c; const f32x4 a0 = *(const f32x4*)sp, a1 = *(const f32x4*)(sp + 4), b0 = *(const f32x4*)(sp + MIXW), b1 = *(const f32x4*)(sp + MIXW + 4);
#pragma unroll
            for (int i = 0; i < 4; ++i) { u2[i] = a0[i]; u2[4 + i] = a1[i]; u1[i] = b0[i]; u1[4 + i] = b1[i]; } }
#pragma unroll
        for (int k = 0; k < 8; ++k) { float a[8], d[8], cbf[8], o[8]; unpack8(cc[k + 2], a); unpack8(ch[k + 2], d); unpack8(cbv[k], cbf);
#pragma unroll
            for (int i = 0; i < 8; ++i) { u0[i] = a[i] * d[i]; o[i] = cbf[i] * (w0[i] * u2[i] + w1[i] * u1[i] + w2[i] * u0[i]); }
            *(v4u*)(BRC + (size_t)(row0 + k) * MIXW + c) = pack8(o);
            if (k >= 6 && (smp || t0 == SEQ - 8)) { float* dst = out_ + (smp ? O_CONVS + (((size_t)l * NBS + b) * 2 + (k - 6)) * MIXW : O_CONVP + (((size_t)l * NBP + b) * 2 + (k - 6)) * MIXW) + c;
                *(f32x4*)dst = (f32x4){u0[0], u0[1], u0[2], u0[3]}; *(f32x4*)(dst + 4) = (f32x4){u0[4], u0[5], u0[6], u0[7]}; }
#pragma unroll
            for (int i = 0; i < 8; ++i) { u2[i] = u1[i]; u1[i] = u0[i]; } }
    }
}

__device__ __forceinline__ void gla_stage_wg(const Args& A, Frame& F, int l, int h, LAS float* wgs) {
    const float* const in_I_GB = (const float*)(const GAS float*)karg64<8 * I_GB>();
    const float* const in_I_GUP = (const float*)(const GAS float*)karg64<8 * I_GUP>();
    for (int i = F.tid; i < 16 * 128; i += NTHR) wgs[i] = in_I_GUP[(size_t)l * GRANK * 512 + (i >> 7) * 512 + h * 128 + (i & 127)];
    if (F.tid < 128) wgs[2048 + F.tid] = in_I_GB[l * 512 + h * 128 + F.tid];
}
__device__ __forceinline__ float gla_lg(const float (&gl)[16], LAS const float* wgs, int d) {
    float zg = wgs[2048 + d];
#pragma unroll
    for (int r = 0; r < 16; ++r) zg += gl[r] * wgs[r * 128 + d];
    return (fminf(zg, 0.f) - log1pf(__expf(-fabsf(zg)))) * (1.0f / 16.0f);
}
__device__ __forceinline__ void load_glr(const bf16* zr, float (&gl)[16]) {
    float a[8], b[8]; unpack8(*(const v4u*)zr, a); unpack8(*(const v4u*)(zr + 8), b);
#pragma unroll
    for (int i = 0; i < 8; ++i) { gl[i] = a[i]; gl[8 + i] = b[i]; }
}
__device__ __forceinline__ void gla_chunk_b(const Args& A, Frame& F, int l, int row0, int h, LAS float* bl, LAS float* wgs) {
    unsigned char* const ws_ = (unsigned char*)(GAS unsigned char*)karg64<KA_WS>();
    gla_stage_wg(A, F, l, h, wgs);
    __syncthreads();
    { const int t = F.tid >> 3, dg = F.tid & 7; float gl[16]; load_glr(((bf16*)(ws_ + WS_Z)) + (size_t)(row0 + t) * NINP + ZC_GLR, gl);
#pragma unroll 4
      for (int dd = 0; dd < 16; ++dd) { const int d = dg * 16 + dd; bl[t * 128 + d] = gla_lg(gl, wgs, d); } }
    __syncthreads();
    if (F.tid < 128) { float a = 0.f; for (int t = 0; t < 64; ++t) { a += bl[t * 128 + F.tid]; bl[t * 128 + F.tid] = a; } }
    __syncthreads();
}

typedef short bf16x8 __attribute__((ext_vector_type(8)));
typedef short v4i16_t __attribute__((ext_vector_type(4)));
#define MFMA16(a, b, c) __builtin_amdgcn_mfma_f32_16x16x32_bf16((a), (b), (c), 0, 0, 0)
__device__ __forceinline__ bf16x8 frag_row(LAS const unsigned char* T, int stride, int r0, int k0, int lane) {
    return *(LAS const bf16x8*)(T + (r0 + (lane & 15)) * stride + (k0 + 8 * (lane >> 4)) * 2);
}
__device__ __forceinline__ bf16x8 frag_tr(LAS const unsigned char* T, int stride, int rlo, int rhi, int n0, int lane) {
    const int q = (lane & 15) >> 2, p = lane & 3;
    const v4i16_t lo = __builtin_amdgcn_ds_read_tr16_b64_v4i16((LAS v4i16_t*)(T + (rlo + q) * stride + n0 * 2 + 8 * p));
    const v4i16_t hi = __builtin_amdgcn_ds_read_tr16_b64_v4i16((LAS v4i16_t*)(T + (rhi + q) * stride + n0 * 2 + 8 * p));
    return (bf16x8){lo[0], lo[1], lo[2], lo[3], hi[0], hi[1], hi[2], hi[3]};
}
__device__ __forceinline__ bf16x8 pack_p(const f32x4 a, const f32x4 b) {
    v4u w; w.x = pk2(a[0], a[1]); w.y = pk2(a[2], a[3]); w.z = pk2(b[0], b[1]); w.w = pk2(b[2], b[3]); return __builtin_bit_cast(bf16x8, w);
}

constexpr int SW_STR = 160, SW_ROWS = 208, SW_K = 0, SW_V = SW_ROWS * SW_STR, SW_BT = 2 * SW_ROWS * SW_STR;
__device__ __forceinline__ void swa_tile(LAS const unsigned char* Ks, LAS const unsigned char* Vs, LAS const float* bt, float sink, const bf16* qrow, bf16* orow, int krow0, int kmin, bool store, int lane) {
    const int n = lane & 15, g = lane >> 4;
    bf16x8 qf[2];
#pragma unroll
    for (int ks = 0; ks < 2; ++ks) qf[ks] = *(const bf16x8*)(qrow + 32 * ks + 8 * g);
    f32x4 s[10];
#pragma unroll
    for (int mt = 0; mt < 10; ++mt) { s[mt] = (f32x4){0.f, 0.f, 0.f, 0.f};
#pragma unroll
        for (int ks = 0; ks < 2; ++ks) s[mt] = MFMA16(frag_row(Ks, SW_STR, krow0 + 16 * mt, 32 * ks, lane), qf[ks], s[mt]); }
    float mx = sink;
#pragma unroll
    for (int mt = 0; mt < 10; ++mt)
#pragma unroll
        for (int i = 0; i < 4; ++i) { const int kcol = 16 * mt + 4 * g + i, dist = n + 128 - kcol; const bool valid = (dist >= 0) && (dist <= 128) && (kcol >= kmin);
            const int di = dist < 0 ? 0 : (dist > 128 ? 128 : dist); const float v = valid ? s[mt][i] + bt[di] : -INFINITY; s[mt][i] = v; mx = fmaxf(mx, v); }
    mx = fmaxf(mx, __shfl_xor(mx, 16)); mx = fmaxf(mx, __shfl_xor(mx, 32));
    float sum = 0.f;
#pragma unroll
    for (int mt = 0; mt < 10; ++mt)
#pragma unroll
        for (int i = 0; i < 4; ++i) { const float p = __expf(s[mt][i] - mx); s[mt][i] = p; sum += p; }
    sum += __shfl_xor(sum, 16); sum += __shfl_xor(sum, 32);
    const float inv = 1.0f / (sum + __expf(sink - mx));
    f32x4 o[4];
#pragma unroll
    for (int mt = 0; mt < 4; ++mt) o[mt] = (f32x4){0.f, 0.f, 0.f, 0.f};
#pragma unroll
    for (int k2 = 0; k2 < 5; ++k2) { const bf16x8 pf = pack_p(s[2 * k2], s[2 * k2 + 1]);
#pragma unroll
        for (int mt = 0; mt < 4; ++mt) o[mt] = MFMA16(frag_tr(Vs, SW_STR, krow0 + 32 * k2 + 4 * g, krow0 + 32 * k2 + 16 + 4 * g, 16 * mt, lane), pf, o[mt]); }
    if (store) {
#pragma unroll
        for (int mt = 0; mt < 4; ++mt) { v2u w; w.x = pk2(o[mt][0] * inv, o[mt][1] * inv); w.y = pk2(o[mt][2] * inv, o[mt][3] * inv); *(v2u*)(orow + 16 * mt + 4 * g) = w; } }
}
__device__ __forceinline__ void swa_phase_mfma(const Args& A, Frame& F0, int l) {
    unsigned char* const ws_ = (unsigned char*)(GAS unsigned char*)karg64<KA_WS>();
    float* const out_ = (float*)(GAS float*)karg64<KA_OUT>();
    const float* const in_I_CSK = (const float*)(const GAS float*)karg64<8 * I_CSK>();
    const float* const in_I_CSV = (const float*)(const GAS float*)karg64<8 * I_CSV>();
    const float* const in_I_RELB = (const float*)(const GAS float*)karg64<8 * I_RELB>();
    const float* const in_I_SINK = (const float*)(const GAS float*)karg64<8 * I_SINK>();
    Frame F = F0; LAUNDER(F);
    LAS unsigned char* Ks = F.lds + SW_K; LAS unsigned char* Vs = F.lds + SW_V; LAS float* BT = (LAS float*)(F.lds + SW_BT);
    const bf16* Z = (const bf16*)(ws_ + WS_Z); bf16* BRB = (bf16*)(ws_ + WS_BR) + (size_t)M * MIXW;
    for (int i = F.tid; i < SH * 129; i += NTHR) { const int h = i / 129, d = i % 129; BT[h * SWA_BTS + d] = in_I_RELB[t5_bucket(d) * SH + h]; }
    const float* sinks = in_I_SINK + l * SH;
#pragma unroll 1
    for (int u = F.vcu; u < 256 + 64; u += F.G) {
        asm volatile("" : "+v"(F.tid), "+v"(F.lane));
        __syncthreads();
        if (u < 256) {
            const int b = u >> 7, kvh = (u >> 6) & 1, qb = u & 63, q0 = qb * 64;
            for (int i = F.tid; i < SW_ROWS * 8; i += NTHR) { const int r = i >> 3, c8 = i & 7, pos = q0 - 128 + r; v4u kv = (v4u){0u, 0u, 0u, 0u}, vv = kv;
                if (pos >= 0 && pos < SEQ) { const bf16* zr = Z + (size_t)(b * SEQ + pos) * NINP + kvh * 64 + c8 * 8; kv = *(const v4u*)(zr + ZC_SK); vv = *(const v4u*)(zr + ZC_SV); }
                *(LAS v4u*)(Ks + r * SW_STR + c8 * 16) = kv; *(LAS v4u*)(Vs + r * SW_STR + c8 * 16) = vv;
                if (qb == 63 && r >= 64 && r < 192) { float fk[8], fv[8]; unpack8(kv, fk); unpack8(vv, fv); const size_t o = ((((size_t)l * NBP + b) * WIN + (r - 64)) * SKV + kvh) * SHD + c8 * 8;
                    *(f32x4*)(out_ + O_SKP + o) = (f32x4){fk[0], fk[1], fk[2], fk[3]}; *(f32x4*)(out_ + O_SKP + o + 4) = (f32x4){fk[4], fk[5], fk[6], fk[7]};
                    *(f32x4*)(out_ + O_SVP + o) = (f32x4){fv[0], fv[1], fv[2], fv[3]}; *(f32x4*)(out_ + O_SVP + o + 4) = (f32x4){fv[4], fv[5], fv[6], fv[7]}; }
            }
            __syncthreads();
            const int head = kvh * 8 + F.wave; const float sink = sinks[head];
#pragma unroll 1
            for (int mq = 0; mq < 4; ++mq) {
                int ln = F.lane; asm volatile("" : "+v"(ln));
                const int t0 = q0 + 16 * mq; const size_t row = (size_t)b * SEQ + t0 + (ln & 15);
                swa_tile(Ks, Vs, BT + head * SWA_BTS, sink, Z + row * NINP + ZC_SQ + head * 64, BRB + row * MIXW + head * 64, 16 * mq, 128 - t0, true, ln);
            }
        } else {
            const int su = u - 256, b = su >> 1, kvh = su & 1;
            for (int i = F.tid; i < 160 * 8; i += NTHR) { const int r = i >> 3, c8 = i & 7; float fk[8], fv[8];
                if (r < 128) { const size_t o = ((((size_t)l * NBS + b) * WIN + r) * SKV + kvh) * SHD + c8 * 8; const f32x4 a0 = *(const f32x4*)(in_I_CSK + o), a1 = *(const f32x4*)(in_I_CSK + o + 4), b0 = *(const f32x4*)(in_I_CSV + o), b1 = *(const f32x4*)(in_I_CSV + o + 4);
#pragma unroll
                    for (int k = 0; k < 4; ++k) { fk[k] = a0[k]; fk[4 + k] = a1[k]; fv[k] = b0[k]; fv[4 + k] = b1[k]; } }
                else if (r < 136) { const bf16* zr = Z + (size_t)(MP + b * TS + (r - 128)) * NINP + kvh * 64 + c8 * 8; unpack8(*(const v4u*)(zr + ZC_SK), fk); unpack8(*(const v4u*)(zr + ZC_SV), fv); }
                else {
#pragma unroll
                    for (int k = 0; k < 8; ++k) { fk[k] = 0.f; fv[k] = 0.f; } }
                *(LAS v4u*)(Ks + r * SW_STR + c8 * 16) = pack8(fk); *(LAS v4u*)(Vs + r * SW_STR + c8 * 16) = pack8(fv);
                if (r >= 8 && r < 136) { const size_t o = ((((size_t)l * NBS + b) * WIN + (r - 8)) * SKV + kvh) * SHD + c8 * 8;
                    *(f32x4*)(out_ + O_SKS + o) = (f32x4){fk[0], fk[1], fk[2], fk[3]}; *(f32x4*)(out_ + O_SKS + o + 4) = (f32x4){fk[4], fk[5], fk[6], fk[7]};
                    *(f32x4*)(out_ + O_SVS + o) = (f32x4){fv[0], fv[1], fv[2], fv[3]}; *(f32x4*)(out_ + O_SVS + o + 4) = (f32x4){fv[4], fv[5], fv[6], fv[7]}; }
            }
            __syncthreads();
            const int head = kvh * 8 + F.wave, n = F.lane & 15; const size_t row = (size_t)MP + b * TS + (n & 7);
            swa_tile(Ks, Vs, BT + head * SWA_BTS, sinks[head], Z + row * NINP + ZC_SQ + head * 64, BRB + row * MIXW + head * 64, 0, 0, n < 8, F.lane);
        }
    }
    __syncthreads();
}

constexpr int XA_STR = 272, XA_K = 0, XA_V = 256 * XA_STR;
__device__ __forceinline__ void xattn_tile(LAS const unsigned char* Ks, LAS const unsigned char* Vs, const bf16* qrow, bf16* orow, bool store, int lane) {
    const int g = lane >> 4;
    bf16x8 qf[4];
#pragma unroll
    for (int ks = 0; ks < 4; ++ks) qf[ks] = *(const bf16x8*)(qrow + 32 * ks + 8 * g);
    f32x4 s[16]; float mx = -INFINITY;
#pragma unroll
    for (int mt = 0; mt < 16; ++mt) { s[mt] = (f32x4){0.f, 0.f, 0.f, 0.f};
#pragma unroll
        for (int ks = 0; ks < 4; ++ks) s[mt] = MFMA16(frag_row(Ks, XA_STR, 16 * mt, 32 * ks, lane), qf[ks], s[mt]);
        mx = fmaxf(mx, fmaxf(fmaxf(s[mt][0], s[mt][1]), fmaxf(s[mt][2], s[mt][3]))); }
    mx = fmaxf(mx, __shfl_xor(mx, 16)); mx = fmaxf(mx, __shfl_xor(mx, 32));
    float sum = 0.f;
#pragma unroll
    for (int mt = 0; mt < 16; ++mt)
#pragma unroll
        for (int i = 0; i < 4; ++i) { const float p = __expf(s[mt][i] - mx); s[mt][i] = p; sum += p; }
    sum += __shfl_xor(sum, 16); sum += __shfl_xor(sum, 32);
    const float inv = 1.0f / sum;
    f32x4 o[8];
#pragma unroll
    for (int mt = 0; mt < 8; ++mt) o[mt] = (f32x4){0.f, 0.f, 0.f, 0.f};
#pragma unroll
    for (int k2 = 0; k2 < 8; ++k2) { const bf16x8 pf = pack_p(s[2 * k2], s[2 * k2 + 1]);
#pragma unroll
        for (int mt = 0; mt < 8; ++mt) o[mt] = MFMA16(frag_tr(Vs, XA_STR, 32 * k2 + 4 * g, 32 * k2 + 16 + 4 * g, 16 * mt, lane), pf, o[mt]); }
    if (store) {
#pragma unroll
        for (int mt = 0; mt < 8; ++mt) { v2u w; w.x = pk2(o[mt][0] * inv, o[mt][1] * inv); w.y = pk2(o[mt][2] * inv, o[mt][3] * inv); *(v2u*)(orow + 16 * mt + 4 * g) = w; } }
}
__device__ __forceinline__ void xattn_phase_mfma(const Args& A, Frame& F0, int l) {
    unsigned char* const ws_ = (unsigned char*)(GAS unsigned char*)karg64<KA_WS>();
    const float* const in_I_CMK = (const float*)(const GAS float*)karg64<8 * I_CMK>();
    const float* const in_I_CMV = (const float*)(const GAS float*)karg64<8 * I_CMV>();
    Frame F = F0; LAUNDER(F);
    LAS unsigned char* Ks = F.lds + XA_K; LAS unsigned char* Vs = F.lds + XA_V;
    const bf16* XQ = (const bf16*)(ws_ + WS_XQ); bf16* XO = (bf16*)(ws_ + WS_XO);
#pragma unroll 1
    for (int u = F.vcu; u < 128 + 128; u += F.G) {
        asm volatile("" : "+v"(F.tid), "+v"(F.lane));
        __syncthreads();
        if (u < 128) {
            const int b = u >> 6, h = (u >> 4) & 3, q0 = (u & 15) * 256;
            for (int i = F.tid; i < 256 * 16; i += NTHR) { const int mrow = i >> 4, c8 = i & 15; const bf16* src = (const bf16*)(ws_ + WS_MEMKV) + ((size_t)l * 512 + b * 256 + mrow) * 1024 + h * 128 + c8 * 8;
                *(LAS v4u*)(Ks + mrow * XA_STR + c8 * 16) = *(const v4u*)src; *(LAS v4u*)(Vs + mrow * XA_STR + c8 * 16) = *(const v4u*)(src + 512); }
            __syncthreads();
#pragma unroll 1
            for (int qt = F.wave; qt < 16; qt += NWAVES) { int ln = F.lane; asm volatile("" : "+v"(ln)); const size_t row = (size_t)b * SEQ + q0 + 16 * qt + (ln & 15);
                xattn_tile(Ks, Vs, XQ + row * XW + h * 128, XO + row * XW + h * 128, true, ln); }
        } else {
            const int su = u - 128, b = su >> 2, h = su & 3;
            for (int i = F.tid; i < 256 * 16; i += NTHR) { const int mrow = i >> 4, c8 = i & 15; const size_t o = (((size_t)l * NBS + b) * NMEM + mrow) * XW + h * 128 + c8 * 8; float fk[8], fv[8];
                const f32x4 a0 = *(const f32x4*)(in_I_CMK + o), a1 = *(const f32x4*)(in_I_CMK + o + 4), b0 = *(const f32x4*)(in_I_CMV + o), b1 = *(const f32x4*)(in_I_CMV + o + 4);
#pragma unroll
                for (int k = 0; k < 4; ++k) { fk[k] = a0[k]; fk[4 + k] = a1[k]; fv[k] = b0[k]; fv[4 + k] = b1[k]; }
                *(LAS v4u*)(Ks + mrow * XA_STR + c8 * 16) = pack8(fk); *(LAS v4u*)(Vs + mrow * XA_STR + c8 * 16) = pack8(fv); }
            __syncthreads();
            if (F.wave == 0) { const int n = F.lane & 15; const size_t row = (size_t)MP + b * TS + (n & 7);
                xattn_tile(Ks, Vs, XQ + row * XW + h * 128, XO + row * XW + h * 128, n < 8, F.lane); }
        }
    }
    __syncthreads();
}

__device__ __forceinline__ void gla_scan16(const bf16* Z, int row0, int lane, int wave, LAS const float* wgs, float (&bb)[16], float (&bend)[16]) {
    float gl[16]; load_glr(Z + (size_t)(row0 + lane) * NINP + ZC_GLR, gl);
#pragma unroll
    for (int dd = 0; dd < 16; ++dd) { float x = gla_lg(gl, wgs, 16 * wave + dd);
#pragma unroll
        for (int off = 1; off < 64; off <<= 1) { const float y = __shfl_up(x, off); if (lane >= off) x += y; }
        bb[dd] = x; bend[dd] = __shfl(x, 63); }
}
__device__ __forceinline__ void load16(const bf16* p, float (&f)[16]) {
    float a[8], b[8]; unpack8(*(const v4u*)p, a); unpack8(*(const v4u*)(p + 8), b);
#pragma unroll
    for (int i = 0; i < 8; ++i) { f[i] = a[i]; f[8 + i] = b[i]; }
}
__device__ __forceinline__ void store16_lds(LAS unsigned char* p, const float (&f)[16]) {
    v4u w0, w1; w0.x = pk2(f[0], f[1]); w0.y = pk2(f[2], f[3]); w0.z = pk2(f[4], f[5]); w0.w = pk2(f[6], f[7]); w1.x = pk2(f[8], f[9]); w1.y = pk2(f[10], f[11]); w1.z = pk2(f[12], f[13]); w1.w = pk2(f[14], f[15]);
    *(LAS v4u*)p = w0; *(LAS v4u*)(p + 16) = w1;
}
constexpr int G1_KSTR = 288, G1_VSTR = 544, G1_WGS = 0, G1_KT = 9216, G1_V = G1_KT + 64 * G1_KSTR;
__device__ __forceinline__ void gla_pass1_prompt_mfma(const Args& A, Frame& F, int l, int u) {
    unsigned char* const ws_ = (unsigned char*)(GAS unsigned char*)karg64<KA_WS>();
    LAS float* wgs = (LAS float*)(F.lds + G1_WGS); LAS unsigned char* Kt = F.lds + G1_KT; LAS unsigned char* Vb = F.lds + G1_V;
    const bf16* Z = (const bf16*)(ws_ + WS_Z);
    const int bh = u >> 6, c = u & 63, b = bh >> 2, h = bh & 3, row0 = b * SEQ + c * 64, lane = F.lane, w = F.wave;
    gla_stage_wg(A, F, l, h, wgs);
#pragma unroll 2
    for (int i = F.tid; i < 64 * 32; i += NTHR) { const int t = i >> 5, c8 = i & 31; *(LAS v4u*)(Vb + t * G1_VSTR + c8 * 16) = *(const v4u*)(Z + (size_t)(row0 + t) * NINP + ZC_GV + h * 256 + c8 * 8); }
    __syncthreads();
    { float bb[16], bend[16], k[16]; gla_scan16(Z, row0, lane, w, wgs, bb, bend); load16(Z + (size_t)(row0 + lane) * NINP + ZC_GK + h * 128 + 16 * w, k);
#pragma unroll
      for (int dd = 0; dd < 16; ++dd) k[dd] *= __expf(bend[dd] - bb[dd]);
      store16_lds(Kt + lane * G1_KSTR + 32 * w, k);
      if (lane == 0) {
#pragma unroll
          for (int dd = 0; dd < 16; ++dd) ((float*)(ws_ + WS_GLAD))[(size_t)u * 128 + 16 * w + dd] = __expf(bend[dd]); } }
    __syncthreads();
    const int g = lane >> 4, n = lane & 15;
    bf16x8 af[2];
#pragma unroll
    for (int ks = 0; ks < 2; ++ks) af[ks] = frag_tr(Kt, G1_KSTR, 32 * ks + 8 * g, 32 * ks + 8 * g + 4, 16 * w, lane);
    float* U = (float*)(ws_ + WS_GLAU) + (size_t)u * GDK * GDV;
#pragma unroll 4
    for (int nt = 0; nt < 16; ++nt) { f32x4 acc = (f32x4){0.f, 0.f, 0.f, 0.f};
#pragma unroll
        for (int ks = 0; ks < 2; ++ks) acc = MFMA16(af[ks], frag_tr(Vb, G1_VSTR, 32 * ks + 8 * g, 32 * ks + 8 * g + 4, 16 * nt, lane), acc);
#pragma unroll
        for (int i = 0; i < 4; ++i) U[(size_t)(16 * w + 4 * g + i) * 256 + 16 * nt + n] = acc[i]; }
}
constexpr int G3_QSTR = 272, G3_VSTR = 528, G3_PSTR = 160, G3_QD = 0, G3_KD = 64 * G3_QSTR, G3_V = 2 * 64 * G3_QSTR, G3_S = G3_V + 64 * G3_VSTR, G3_PM = G3_S + 128 * G3_VSTR, G3_END = G3_PM + 64 * G3_PSTR;
static_assert(G3_END <= 146944 && 64 * 260 * 4 <= 128 * G3_VSTR && 8704 <= 64 * G3_PSTR, "pass-3 LDS map");
__device__ __forceinline__ void gla_pass3_mfma(const Args& A, Frame& F0, int l) {
    unsigned char* const ws_ = (unsigned char*)(GAS unsigned char*)karg64<KA_WS>();
    const float* const in_I_GNORM = (const float*)(const GAS float*)karg64<8 * I_GNORM>();
    Frame F = F0; LAUNDER(F);
    LAS unsigned char* Qd = F.lds + G3_QD; LAS unsigned char* Kd = F.lds + G3_KD; LAS unsigned char* Vb = F.lds + G3_V; LAS unsigned char* Sb = F.lds + G3_S; LAS unsigned char* Pm = F.lds + G3_PM;
    LAS float* wgs = (LAS float*)Pm; LAS float* Of = (LAS float*)Sb;
    const bf16* Z = (const bf16*)(ws_ + WS_Z); bf16* BRA = (bf16*)(ws_ + WS_BR);
#pragma unroll 1
    for (int u = F.vcu; u < 512; u += F.G) {
        asm volatile("" : "+v"(F.tid), "+v"(F.lane));
        const int lane = F.lane, w = F.wave, g = lane >> 4, n = lane & 15;
        __syncthreads();
        const int bh = u >> 6, c = u & 63, b = bh >> 2, h = bh & 3, row0 = b * SEQ + c * 64;
        gla_stage_wg(A, F, l, h, wgs);
#pragma unroll 2
        for (int i = F.tid; i < 64 * 32; i += NTHR) { const int t = i >> 5, c8 = i & 31; *(LAS v4u*)(Vb + t * G3_VSTR + c8 * 16) = *(const v4u*)(Z + (size_t)(row0 + t) * NINP + ZC_GV + h * 256 + c8 * 8); }
        { const float* S = (const float*)(ws_ + WS_GLAU) + (size_t)u * GDK * GDV;
#pragma unroll 2
          for (int i = F.tid; i < 128 * 32; i += NTHR) { const int d = i >> 5, c8 = i & 31; const f32x4 s0 = *(const f32x4*)(S + d * 256 + c8 * 8), s1 = *(const f32x4*)(S + d * 256 + c8 * 8 + 4);
              v4u wv; wv.x = pk2(s0[0], s0[1]); wv.y = pk2(s0[2], s0[3]); wv.z = pk2(s1[0], s1[1]); wv.w = pk2(s1[2], s1[3]); *(LAS v4u*)(Sb + d * G3_VSTR + c8 * 16) = wv; } }
        __syncthreads();
        { float bb[16], bend[16], q[16], k[16]; gla_scan16(Z, row0, lane, w, wgs, bb, bend);
          load16(Z + (size_t)(row0 + lane) * NINP + ZC_GQ + h * 128 + 16 * w, q); load16(Z + (size_t)(row0 + lane) * NINP + ZC_GK + h * 128 + 16 * w, k);
#pragma unroll
          for (int dd = 0; dd < 16; ++dd) { q[dd] *= __expf(bb[dd]); k[dd] *= __expf(-bb[dd]); }
          store16_lds(Qd + lane * G3_QSTR + 32 * w, q); store16_lds(Kd + lane * G3_QSTR + 32 * w, k); }
        __syncthreads();
        {
            const int mt = w >> 1;
#pragma unroll
            for (int j = 0; j < 2; ++j) { const int nt = 2 * (w & 1) + j; f32x4 acc = (f32x4){0.f, 0.f, 0.f, 0.f};
#pragma unroll
                for (int ks = 0; ks < 4; ++ks) acc = MFMA16(frag_row(Qd, G3_QSTR, 16 * mt, 32 * ks, lane), frag_row(Kd, G3_QSTR, 16 * nt, 32 * ks, lane), acc);
#pragma unroll
                for (int i = 0; i < 4; ++i) { const int t = 16 * mt + 4 * g + i, s = 16 * nt + n; *(LAS bf16*)(Pm + t * G3_PSTR + s * 2) = (bf16)(pk2((s <= t) ? acc[i] : 0.f, 0.f) & 0xffffu); } }
        }
        __syncthreads();
        f32x4 o[4][2];
#pragma unroll
        for (int mt = 0; mt < 4; ++mt) { o[mt][0] = (f32x4){0.f, 0.f, 0.f, 0.f}; o[mt][1] = (f32x4){0.f, 0.f, 0.f, 0.f}; }
#pragma unroll
        for (int j = 0; j < 2; ++j) { const int nt = 2 * w + j;
#pragma unroll
            for (int ks = 0; ks < 4; ++ks) { const bf16x8 bf = frag_tr(Sb, G3_VSTR, 32 * ks + 8 * g, 32 * ks + 8 * g + 4, 16 * nt, lane);
#pragma unroll
                for (int mt = 0; mt < 4; ++mt) o[mt][j] = MFMA16(frag_row(Qd, G3_QSTR, 16 * mt, 32 * ks, lane), bf, o[mt][j]); }
#pragma unroll
            for (int ks = 0; ks < 2; ++ks) { const bf16x8 bf = frag_tr(Vb, G3_VSTR, 32 * ks + 8 * g, 32 * ks + 8 * g + 4, 16 * nt, lane);
#pragma unroll
                for (int mt = 0; mt < 4; ++mt) o[mt][j] = MFMA16(frag_row(Pm, G3_PSTR, 16 * mt, 32 * ks, lane), bf, o[mt][j]); } }
        __syncthreads();
#pragma unroll
        for (int mt = 0; mt < 4; ++mt)
#pragma unroll
            for (int j = 0; j < 2; ++j)
#pragma unroll
                for (int i = 0; i < 4; ++i) Of[(16 * mt + 4 * g + i) * 260 + 16 * (2 * w + j) + n] = o[mt][j][i];
        __syncthreads();
        {
            const int tb = F.tid >> 5, vb = F.tid & 31; float gn[8];
#pragma unroll
            for (int j = 0; j < 8; ++j) gn[j] = in_I_GNORM[l * GDV + 8 * vb + j];
#pragma unroll
            for (int i = 0; i < 4; ++i) { const int t = 4 * tb + i; const f32x4 o0 = *(LAS const f32x4*)(Of + t * 260 + 8 * vb), o1 = *(LAS const f32x4*)(Of + t * 260 + 8 * vb + 4);
                float ov[8] = {o0[0], o0[1], o0[2], o0[3], o1[0], o1[1], o1[2], o1[3]}; float ss = 0.f;
#pragma unroll
                for (int j = 0; j < 8; ++j) ss += ov[j] * ov[j];
#pragma unroll
                for (int x = 1; x < 32; x <<= 1) ss += __shfl_xor(ss, x);
                const float rs = rsqrtf(ss * (1.0f / 256.0f) + EPS); const int row = row0 + t; float gv[8], r[8]; unpack8(*(const v4u*)(Z + (size_t)row * NINP + ZC_GR + h * 256 + 8 * vb), gv);
#pragma unroll
                for (int j = 0; j < 8; ++j) r[j] = ov[j] * rs * gn[j] * gv[j] * sigm(gv[j]);
                *(v4u*)(BRA + (size_t)row * MIXW + h * 256 + 8 * vb) = pack8(r); }
        }
    }
    __syncthreads();
}
__device__ __forceinline__ void gla_pass1(const Args& A, Frame& F0, int l) {
    unsigned char* const ws_ = (unsigned char*)(GAS unsigned char*)karg64<KA_WS>();
    float* const out_ = (float*)(GAS float*)karg64<KA_OUT>();
    const float* const in_I_GNORM = (const float*)(const GAS float*)karg64<8 * I_GNORM>();
    const float* const in_I_SGLA = (const float*)(const GAS float*)karg64<8 * I_SGLA>();
    Frame F = F0; LAUNDER(F);
    LAS float* bl = (LAS float*)(F.lds); LAS float* kt = (LAS float*)(F.lds + 32768); LAS float* wgs = (LAS float*)(F.lds + 65536);
#pragma unroll 1
    for (int u = F.vcu; u < 512 + 128; u += F.G) {
        asm volatile("" : "+v"(F.tid), "+v"(F.lane));
        __syncthreads();
        if (u < 512) {
            gla_pass1_prompt_mfma(A, F, l, u);
        } else {
            const int su = u - 512, b = su >> 2, h = su & 3, row0 = MP + b * TS;
            LAS float* qs = (LAS float*)(F.lds); LAS float* ks = qs + 1024; LAS float* es = qs + 2048; LAS float* vs = qs + 3072; LAS float* red = qs + 5120;
            gla_stage_wg(A, F, l, h, wgs);
            __syncthreads();
            { const int t = F.tid >> 6, dp = F.tid & 63; float gl[16]; load_glr(((bf16*)(ws_ + WS_Z)) + (size_t)(row0 + t) * NINP + ZC_GLR, gl);
              es[t * 128 + 2 * dp] = __expf(gla_lg(gl, wgs, 2 * dp)); es[t * 128 + 2 * dp + 1] = __expf(gla_lg(gl, wgs, 2 * dp + 1)); }
            for (int i = F.tid; i < 8 * 128; i += NTHR) { const int t = i >> 7, d = i & 127; const bf16* zr = ((bf16*)(ws_ + WS_Z)) + (size_t)(row0 + t) * NINP + h * 128 + d; qs[i] = bf1(zr[ZC_GQ]); ks[i] = bf1(zr[ZC_GK]); }
            for (int i = F.tid; i < 8 * 256; i += NTHR) { const int t = i >> 8, v = i & 255; vs[i] = bf1(((bf16*)(ws_ + WS_Z))[(size_t)(row0 + t) * NINP + ZC_GV + h * 256 + v]); }
            __syncthreads();
            const int v = F.tid & 255, half = F.tid >> 8; const size_t sidx = (((size_t)l * NBS + b) * GH + h) * GDK * GDV;
            const float* S0 = in_I_SGLA + sidx + (size_t)(64 * half) * 256 + v;
            float S[64];
#pragma unroll
            for (int i = 0; i < 64; ++i) S[i] = S0[i * 256];
            for (int t = 0; t < 8; ++t) { const float vv = vs[t * 256 + v]; float part = 0.f;
#pragma unroll
                for (int i = 0; i < 64; ++i) { const int d = 64 * half + i; S[i] = es[t * 128 + d] * S[i] + ks[t * 128 + d] * vv; part += qs[t * 128 + d] * S[i]; }
                red[(t * 2 + half) * 256 + v] = part; }
            float* So = out_ + O_GLAS + sidx + (size_t)(64 * half) * 256 + v;
#pragma unroll
            for (int i = 0; i < 64; ++i) So[i * 256] = S[i];
            __syncthreads();
            { const int t = F.wave, row = row0 + t; float o[4]; float ss = 0.f;
#pragma unroll
              for (int k = 0; k < 4; ++k) { const int vv = F.lane + 64 * k; o[k] = red[(t * 2) * 256 + vv] + red[(t * 2 + 1) * 256 + vv]; ss += o[k] * o[k]; }
              ss = wave_sum(ss); const float rs = rsqrtf(ss * (1.0f / 256.0f) + EPS);
#pragma unroll
              for (int k = 0; k < 4; ++k) { const int vv = F.lane + 64 * k; const float g = bf1(((bf16*)(ws_ + WS_Z))[(size_t)row * NINP + ZC_GR + h * 256 + vv]);
                  ((bf16*)(ws_ + WS_BR))[(size_t)row * MIXW + h * 256 + vv] = (bf16)(pk2(o[k] * rs * in_I_GNORM[l * GDV + vv] * g * sigm(g), 0.f) & 0xffffu); } }
        }
    }
    __syncthreads();
}
__device__ __forceinline__ void gla_pass2(const Args& A, Frame& F0, int l) {
    unsigned char* const ws_ = (unsigned char*)(GAS unsigned char*)karg64<KA_WS>();
    float* const out_ = (float*)(GAS float*)karg64<KA_OUT>();
    Frame F = F0; LAUNDER(F);
    for (int e = F.vcu * NTHR + F.tid; e < 8 * GDK * GDV; e += F.G * NTHR) {
        const int bh = e >> 15, dv = e & 32767, d = dv >> 8;
        float* U = ((float*)(ws_ + WS_GLAU)) + (size_t)bh * 64 * GDK * GDV + dv; const float* D = ((float*)(ws_ + WS_GLAD)) + (size_t)bh * 64 * 128 + d;
        float S = 0.f;
        for (int c0 = 0; c0 < 64; c0 += 8) { float uu[8], dd[8];
#pragma unroll
            for (int k = 0; k < 8; ++k) { uu[k] = U[(size_t)(c0 + k) * GDK * GDV]; dd[k] = D[(c0 + k) * 128]; }
#pragma unroll
            for (int k = 0; k < 8; ++k) { U[(size_t)(c0 + k) * GDK * GDV] = S; S = dd[k] * S + uu[k]; } }
        out_[O_GLAP + ((size_t)l * 8 + bh) * GDK * GDV + dv] = S;
    }
}
__device__ __forceinline__ void gla_pass3(const Args& A, Frame& F0, int l) {
    unsigned char* const ws_ = (unsigned char*)(GAS unsigned char*)karg64<KA_WS>();
    const float* const in_I_GNORM = (const float*)(const GAS float*)karg64<8 * I_GNORM>();
    Frame F = F0; LAUNDER(F);
    LAS float* bl = (LAS float*)(F.lds); LAS float* qdT = (LAS float*)(F.lds + 32768); LAS float* kdT = (LAS float*)(F.lds + 67584); LAS float* Am = (LAS float*)(F.lds + 102400); LAS float* wgs = (LAS float*)(F.lds + 119808);
    for (int u = F.vcu; u < 512; u += F.G) {
        __syncthreads();
        const int bh = u >> 6, c = u & 63, b = bh >> 2, h = bh & 3, row0 = b * SEQ + c * 64;
        gla_chunk_b(A, F, l, row0, h, bl, wgs);
        { const int t = F.tid & 63, dg = F.tid >> 6; const bf16* zr = ((bf16*)(ws_ + WS_Z)) + (size_t)(row0 + t) * NINP + h * 128 + dg * 16; float q[16], k[16];
          { float a[8], bb[8]; unpack8(*(const v4u*)(zr + ZC_GQ), a); unpack8(*(const v4u*)(zr + ZC_GQ + 8), bb);
#pragma unroll
            for (int i = 0; i < 8; ++i) { q[i] = a[i]; q[8 + i] = bb[i]; }
            unpack8(*(const v4u*)(zr + ZC_GK), a); unpack8(*(const v4u*)(zr + ZC_GK + 8), bb);
#pragma unroll
            for (int i = 0; i < 8; ++i) { k[i] = a[i]; k[8 + i] = bb[i]; } }
#pragma unroll
          for (int i = 0; i < 16; ++i) { const int d = dg * 16 + i; const float bb = bl[t * 128 + d]; qdT[d * 68 + t] = q[i] * __expf(bb); kdT[d * 68 + t] = k[i] * __expf(-bb); } }
        __syncthreads();
        const int tb = F.tid >> 5, vb = F.tid & 31;
        {
            float a[4][2];
#pragma unroll
            for (int i = 0; i < 4; ++i) { a[i][0] = 0.f; a[i][1] = 0.f; }
            for (int d = 0; d < 128; ++d) { const f32x4 qq = *(LAS const f32x4*)(qdT + d * 68 + 4 * tb); const f32x2 kk = *(LAS const f32x2*)(kdT + d * 68 + 2 * vb);
#pragma unroll
                for (int i = 0; i < 4; ++i) { a[i][0] += qq[i] * kk[0]; a[i][1] += qq[i] * kk[1]; } }
#pragma unroll
            for (int i = 0; i < 4; ++i)
#pragma unroll
                for (int j = 0; j < 2; ++j) { const int t = 4 * tb + i, s = 2 * vb + j; Am[s * 68 + t] = (s <= t) ? a[i][j] : 0.f; }
        }
        float o[4][8];
#pragma unroll
        for (int i = 0; i < 4; ++i)
#pragma unroll
            for (int j = 0; j < 8; ++j) o[i][j] = 0.f;
        { const float* S = ((float*)(ws_ + WS_GLAU)) + (size_t)u * GDK * GDV + 8 * vb;
          for (int d = 0; d < 128; ++d) { const f32x4 qq = *(LAS const f32x4*)(qdT + d * 68 + 4 * tb); const f32x4 s0 = *(const f32x4*)(S + d * 256), s1 = *(const f32x4*)(S + d * 256 + 4);
#pragma unroll
              for (int i = 0; i < 4; ++i)
#pragma unroll
                  for (int j = 0; j < 4; ++j) { o[i][j] += qq[i] * s0[j]; o[i][4 + j] += qq[i] * s1[j]; } } }
        __syncthreads();
        for (int s = 0; s < 64; ++s) { const f32x4 aa = *(LAS const f32x4*)(Am + s * 68 + 4 * tb); float vv[8]; unpack8(*(const v4u*)(((bf16*)(ws_ + WS_Z)) + (size_t)(row0 + s) * NINP + ZC_GV + h * 256 + 8 * vb), vv);
#pragma unroll
            for (int i = 0; i < 4; ++i)
#pragma unroll
                for (int j = 0; j < 8; ++j) o[i][j] += aa[i] * vv[j]; }
        float gn[8];
#pragma unroll
        for (int j = 0; j < 8; ++j) gn[j] = in_I_GNORM[l * GDV + 8 * vb + j];
#pragma unroll
        for (int i = 0; i < 4; ++i) { float ss = 0.f;
#pragma unroll
            for (int j = 0; j < 8; ++j) ss += o[i][j] * o[i][j];
#pragma unroll
            for (int x = 1; x < 32; x <<= 1) ss += __shfl_xor(ss, x);
            const float rs = rsqrtf(ss * (1.0f / 256.0f) + EPS); const int row = row0 + 4 * tb + i; float g[8], r[8]; unpack8(*(const v4u*)(((bf16*)(ws_ + WS_Z)) + (size_t)row * NINP + ZC_GR + h * 256 + 8 * vb), g);
#pragma unroll
            for (int j = 0; j < 8; ++j) r[j] = o[i][j] * rs * gn[j] * g[j] * sigm(g[j]);
            *(v4u*)(((bf16*)(ws_ + WS_BR)) + (size_t)row * MIXW + h * 256 + 8 * vb) = pack8(r); }
    }
    __syncthreads();
}

__device__ __forceinline__ void xattn_phase(const Args& A, Frame& F0, int l) {
    unsigned char* const ws_ = (unsigned char*)(GAS unsigned char*)karg64<KA_WS>();
    const float* const in_I_CMK = (const float*)(const GAS float*)karg64<8 * I_CMK>();
    const float* const in_I_CMV = (const float*)(const GAS float*)karg64<8 * I_CMV>();
    Frame F = F0; LAUNDER(F);
    LAS unsigned char* Ks = F.lds; LAS unsigned char* Vs = F.lds + 65536;
    for (int u = F.vcu; u < 128 + 128; u += F.G) {
        __syncthreads();
        if (u < 128) {
            const int b = u >> 6, h = (u >> 4) & 3, q0 = (u & 15) * 256;
            for (int i = F.tid; i < 256 * 16; i += NTHR) { const int mrow = i >> 4, c8 = i & 15; const bf16* src = ((bf16*)(ws_ + WS_MEMKV)) + ((size_t)l * 512 + b * 256 + mrow) * 1024 + h * 128 + c8 * 8;
                *(LAS v4u*)(Ks + mrow * 256 + c8 * 16) = *(const v4u*)src; *(LAS v4u*)(Vs + mrow * 256 + c8 * 16) = *(const v4u*)(src + 512); }
            __syncthreads();
            const int qi = F.tid >> 1, half = F.tid & 1, row = b * SEQ + q0 + qi;
            float q[64], o[64]; load_q64(((bf16*)(ws_ + WS_XQ)) + (size_t)row * XW + h * 128 + 64 * half, q);
#pragma unroll
            for (int i = 0; i < 64; ++i) o[i] = 0.f;
            float m = -INFINITY, ls = 0.f;
            attn_core<256, true, false>(q, Ks + half * 128, Vs + half * 128, 256, 0, nullptr, m, ls, o);
            store_o64(((bf16*)(ws_ + WS_XO)) + (size_t)row * XW + h * 128 + 64 * half, o, 1.0f / ls);
        } else {
            const int su = u - 128, b = su >> 2, h = su & 3;
            for (int i = F.tid; i < 256 * 16; i += NTHR) { const int mrow = i >> 4, c8 = i & 15; const size_t o = (((size_t)l * NBS + b) * NMEM + mrow) * XW + h * 128 + c8 * 8; float fk[8], fv[8];
                const f32x4 a0 = *(const f32x4*)(in_I_CMK + o), a1 = *(const f32x4*)(in_I_CMK + o + 4), b0 = *(const f32x4*)(in_I_CMV + o), b1 = *(const f32x4*)(in_I_CMV + o + 4);
#pragma unroll
                for (int k = 0; k < 4; ++k) { fk[k] = a0[k]; fk[4 + k] = a1[k]; fv[k] = b0[k]; fv[4 + k] = b1[k]; }
                *(LAS v4u*)(Ks + mrow * 256 + c8 * 16) = pack8(fk); *(LAS v4u*)(Vs + mrow * 256 + c8 * 16) = pack8(fv); }
            __syncthreads();
            if (F.tid < 16) {
                const int qi = F.tid >> 1, half = F.tid & 1, row = MP + b * TS + qi;
                float q[64], o[64]; load_q64(((bf16*)(ws_ + WS_XQ)) + (size_t)row * XW + h * 128 + 64 * half, q);
#pragma unroll
                for (int i = 0; i < 64; ++i) o[i] = 0.f;
                float m = -INFINITY, ls = 0.f;
                attn_core<256, true, false>(q, Ks + half * 128, Vs + half * 128, 256, 0, nullptr, m, ls, o);
                store_o64(((bf16*)(ws_ + WS_XO)) + (size_t)row * XW + h * 128 + 64 * half, o, 1.0f / ls);
            }
        }
    }
    __syncthreads();
}

__device__ __forceinline__ void ffnact_phase(const Args& A, Frame& F0, int l) {
    unsigned char* const ws_ = (unsigned char*)(GAS unsigned char*)karg64<KA_WS>();
    float* const out_ = (float*)(GAS float*)karg64<KA_OUT>();
    const float* const in_I_FCB = (const float*)(const GAS float*)karg64<8 * I_FCB>();
    const float* const in_I_FCW = (const float*)(const GAS float*)karg64<8 * I_FCW>();
    const float* const in_I_SFFN = (const float*)(const GAS float*)karg64<8 * I_SFFN>();
    Frame F = F0; LAUNDER(F);
    const float* cw = in_I_FCW + (size_t)l * 3 * DFF; const float* cbp = in_I_FCB + (size_t)l * DFF; const bf16* UG = (const bf16*)(ws_ + WS_UG); bf16* ACT = (bf16*)(ws_ + WS_ACT);
    constexpr int NG = DFF / 8;
#pragma unroll 1
    for (int idx = F.vcu * NTHR + F.tid; idx < (M / 8) * NG; idx += F.G * NTHR) {
        const int row0 = (idx / NG) * 8, c = (idx % NG) * 8; const bool smp = row0 >= MP; const int b = smp ? (row0 - MP) >> 3 : row0 >> 12, t0 = smp ? 0 : (row0 & (SEQ - 1));
        v4u gg[10], uu[8];
#pragma unroll
        for (int k = 0; k < 10; ++k) { gg[k] = (v4u){0u, 0u, 0u, 0u}; if (k >= 2 || t0 > 0) gg[k] = *(const v4u*)(UG + (size_t)(row0 + k - 2) * 2 * DFF + DFF + c); }
#pragma unroll
        for (int k = 0; k < 8; ++k) uu[k] = *(const v4u*)(UG + (size_t)(row0 + k) * 2 * DFF + c);
        float w0[8], w1[8], w2[8], cb[8];
#pragma unroll
        for (int i = 0; i < 8; ++i) { w0[i] = cw[c + i]; w1[i] = cw[DFF + c + i]; w2[i] = cw[2 * DFF + c + i]; cb[i] = cbp[c + i]; }
        float g2[8], g1[8], g0[8];
        unpack8(gg[0], g2); unpack8(gg[1], g1);
        if (smp) { const float* sp = in_I_SFFN + (((size_t)l * NBS + b) * 2) * DFF + c; const f32x4 a0 = *(const f32x4*)sp, a1 = *(const f32x4*)(sp + 4), b0 = *(const f32x4*)(sp + DFF), b1 = *(const f32x4*)(sp + DFF + 4);
#pragma unroll
            for (int i = 0; i < 4; ++i) { g2[i] = a0[i]; g2[4 + i] = a1[i]; g1[i] = b0[i]; g1[4 + i] = b1[i]; } }
#pragma unroll
        for (int k = 0; k < 8; ++k) { float uf[8], o[8]; unpack8(gg[k + 2], g0); unpack8(uu[k], uf);
#pragma unroll
            for (int i = 0; i < 8; ++i) { const float gc = w0[i] * g2[i] + w1[i] * g1[i] + w2[i] * g0[i] + cb[i]; o[i] = gc * sigm(gc) * uf[i]; }
            *(v4u*)(ACT + (size_t)(row0 + k) * DFF + c) = pack8(o);
            if (k >= 6 && (smp || t0 == SEQ - 8)) { float* dst = out_ + (smp ? O_FFNS + (((size_t)l * NBS + b) * 2 + (k - 6)) * DFF : O_FFNP + (((size_t)l * NBP + b) * 2 + (k - 6)) * DFF) + c;
                *(f32x4*)dst = (f32x4){g0[0], g0[1], g0[2], g0[3]}; *(f32x4*)(dst + 4) = (f32x4){g0[4], g0[5], g0[6], g0[7]}; }
#pragma unroll
            for (int i = 0; i < 8; ++i) { g2[i] = g1[i]; g1[i] = g0[i]; } }
    }
}

__device__ __forceinline__ void final_phase(const Args& A, Frame& F0) {
    unsigned char* const ws_ = (unsigned char*)(GAS unsigned char*)karg64<KA_WS>();
    float* const out_ = (float*)(GAS float*)karg64<KA_OUT>();
    const float* const in_I_NFIN = (const float*)(const GAS float*)karg64<8 * I_NFIN>();
    Frame F = F0; LAUNDER(F);
    const int gw = F.vcu * NWAVES + F.wave, NGW = F.G * NWAVES, lane = F.lane; const float* g = in_I_NFIN;
    for (int m = gw; m < M; m += NGW) {
        float s = (lane < 32) ? ((float*)(ws_ + WS_SSQ))[(size_t)m * 32 + lane] : 0.f; s = wave_sum(s);
        const float rs = rsqrtf(s * (1.0f / DM) + EPS);
        float* dst = out_ + ((m < MP) ? O_YP + (size_t)m * DM : O_YS + (size_t)(m - MP) * DM);
#pragma unroll
        for (int j = 0; j < 8; ++j) { const v2u o = *((const v2u*)(((const bf16*)(ws_ + WS_XB)) + (size_t)m * DM) + lane + 64 * j); const f32x4 v = (f32x4){bflo(o.x), bfhi(o.x), bflo(o.y), bfhi(o.y)};
            const f32x4 gg = *((const f32x4*)g + lane + 64 * j); *((f32x4*)dst + lane + 64 * j) = v * rs * gg; }
    }
}

__device__ __forceinline__ f32x4 sk_tile(const bf16* A, const bf16* Bt, int K, int rb, int cb, LAS float* red, int tid, int lane, int wave) {
    const int n = lane & 15, g = lane >> 4, npairs = K >> 6;
    f32x4 acc[2][4];
#pragma unroll
    for (int mt = 0; mt < 2; ++mt)
#pragma unroll
        for (int nt = 0; nt < 4; ++nt) acc[mt][nt] = (f32x4){0.f, 0.f, 0.f, 0.f};
    const bf16* ap = A + (size_t)(32 * rb + n) * K + 8 * g; const bf16* bp = Bt + (size_t)(64 * cb + n) * K + 8 * g;
#pragma unroll 2
    for (int p = wave; p < npairs; p += NWAVES) {
        bf16x8 af[2][2], bfr[4][2];
#pragma unroll
        for (int ks = 0; ks < 2; ++ks) {
#pragma unroll
            for (int mt = 0; mt < 2; ++mt) af[mt][ks] = *(const bf16x8*)(ap + (size_t)(16 * mt) * K + 64 * p + 32 * ks);
#pragma unroll
            for (int nt = 0; nt < 4; ++nt) bfr[nt][ks] = *(const bf16x8*)(bp + (size_t)(16 * nt) * K + 64 * p + 32 * ks); }
#pragma unroll
        for (int ks = 0; ks < 2; ++ks)
#pragma unroll
            for (int mt = 0; mt < 2; ++mt)
#pragma unroll
                for (int nt = 0; nt < 4; ++nt) acc[mt][nt] = MFMA16(af[mt][ks], bfr[nt][ks], acc[mt][nt]);
    }
    __syncthreads();
#pragma unroll
    for (int mt = 0; mt < 2; ++mt)
#pragma unroll
        for (int nt = 0; nt < 4; ++nt)
#pragma unroll
            for (int i = 0; i < 4; ++i) red[wave * 2048 + (16 * mt + 4 * g + i) * 64 + 16 * nt + n] = acc[mt][nt][i];
    __syncthreads();
    const int r = tid >> 4, cg = tid & 15; f32x4 s = *(LAS const f32x4*)(red + r * 64 + 4 * cg);
#pragma unroll
    for (int w = 1; w < 8; ++w) s += *(LAS const f32x4*)(red + w * 2048 + r * 64 + 4 * cg);
    return s;
}
__device__ __forceinline__ void sk_residual(const bf16* A, const bf16* Bt, int K, Frame& F0, size_t probe_off) {
    Frame F = F0; LAUNDER(F);
    unsigned char* const ws_ = (unsigned char*)(GAS unsigned char*)karg64<KA_WS>();
    const bf16* XB = (const bf16*)(ws_ + WS_XB); bf16* XBo = (bf16*)(ws_ + WS_XB + probe_off); float* SSQ = (float*)(ws_ + WS_SSQ + probe_off);
    LAS float* red = (LAS float*)F.lds;
#pragma unroll 1
    for (int u = F.vcu; u < 256; u += F.G) {
        asm volatile("" : "+v"(F.tid), "+v"(F.lane));
        const int rb = u >> 5, cb = u & 31;
        const f32x4 s = sk_tile(A, Bt, K, rb, cb, red, F.tid, F.lane, F.wave);
        const int row = MP + 32 * rb + (F.tid >> 4), col = 64 * cb + 4 * (F.tid & 15); const size_t off = (size_t)row * DM + col;
        const v2u o = *(const v2u*)(XB + off); const f32x4 x = (f32x4){bflo(o.x), bfhi(o.x), bflo(o.y), bfhi(o.y)} + s;
        v2u w; w.x = pk2(x[0], x[1]); w.y = pk2(x[2], x[3]); *(v2u*)(XBo + off) = w;
        float ss = (x[0] * x[0] + x[1] * x[1]) + (x[2] * x[2] + x[3] * x[3]);
        ss += __shfl_xor(ss, 1); ss += __shfl_xor(ss, 2); ss += __shfl_xor(ss, 4); ss += __shfl_xor(ss, 8);
        if ((F.tid & 15) == 0) SSQ[(size_t)row * 32 + cb] = ss;
    }
    __syncthreads();
}
__device__ __forceinline__ void sk_branch(Frame& F0, int l) {
    Frame F = F0; LAUNDER(F);
    unsigned char* const ws_ = (unsigned char*)(GAS unsigned char*)karg64<KA_WS>();
    const bf16* BR = (const bf16*)(ws_ + WS_BR); const bf16* Wb = (const bf16*)(ws_ + WS_WBR) + (size_t)l * 3 * DM * MIXW; const bf16* Z = (const bf16*)(ws_ + WS_Z); bf16* MG = (bf16*)(ws_ + WS_MG);
    LAS float* red = (LAS float*)F.lds;
#pragma unroll 1
    for (int u = F.vcu; u < 256; u += F.G) {
        asm volatile("" : "+v"(F.tid), "+v"(F.lane));
        const int rb = u >> 5, cb = u & 31; const int row = MP + 32 * rb + (F.tid >> 4), col = 64 * cb + 4 * (F.tid & 15);
        f32x4 mg = (f32x4){0.f, 0.f, 0.f, 0.f};
#pragma unroll 1
        for (int i = 0; i < 3; ++i) {
            const f32x4 s = sk_tile(BR + (size_t)i * M * MIXW + (size_t)MP * MIXW, Wb + (size_t)i * DM * MIXW, MIXW, rb, cb, red, F.tid, F.lane, F.wave);
            const v2u gw = *(const v2u*)(Z + (size_t)row * NINP + ZC_GATE + i * DM + col);
            mg += s * (f32x4){bflo(gw.x), bfhi(gw.x), bflo(gw.y), bfhi(gw.y)};
        }
        v2u w; w.x = pk2(mg[0], mg[1]); w.y = pk2(mg[2], mg[3]); *(v2u*)(MG + (size_t)row * DM + col) = w;
    }
    __syncthreads();
}

#ifndef PH_MASK
#define PH_MASK 0xffffffffu
#endif
#define PON(i) constexpr ((PH_MASK >> (i)) & 1u) for (int rep_ = 0; rep_ <= (int)((PROBE_MASK >> (i)) & 1u); ++rep_)
#ifndef PROBE_MASK
#define PROBE_MASK 0u
#endif
#ifndef USE_MFMA
#define USE_MFMA 7
#endif
#ifndef MK_PER_PHASE
#define MK_PER_PHASE 0
#endif
constexpr int PH_PER_LAYER = 12, N_PHASES = 1 + DEPTH * PH_PER_LAYER + 1;

__global__ void __launch_bounds__(NTHR, 2) fwd(const Args A) {
    extern __shared__ __attribute__((aligned(16))) unsigned char lds[];
    Frame F;
    F.lds = (LAS unsigned char*)lds;
    F.MISC = (volatile LAS unsigned*)(F.lds + MISC_OFF);
    F.wave = __builtin_amdgcn_readfirstlane((int)threadIdx.x >> 6); F.lane = 0; F.tid = 0;
    F.G = gridDim.x; { const int bx = blockIdx.x; F.vcu = (F.G % 8 == 0) ? (bx % 8) * (F.G / 8) + bx / 8 : bx; }
    F.ctl = (gu32*)(((unsigned char*)(GAS unsigned char*)karg64<KA_WS>()) + WS_CTL);
    for (int u = F.wave * 64 + lane_id(); u < (LDS_BYTES - LDSCTL_OFF) / 4; u += NTHR) ((LAS unsigned*)(F.lds + LDSCTL_OFF))[u] = 0u;
    __syncthreads();
    XcdBarrier bar; bar.bar = (unsigned*)(F.ctl + CW_BAR); bar.x = 0; bar.st = nullptr; bar.wv = (unsigned)F.wave;
    if (!MK_PER_PHASE) bar = xcd_barrier_post((unsigned*)(F.ctl + CW_BAR), F.MISC + 8, (unsigned)F.wave);
    const int lo = karg32<KA_LO>(), hi = karg32<KA_HI>();
#define IN(k) (lo <= (k) && (k) < hi)
#define SEAM(k) do { if (IN(k) && IN((k) + 1)) xcd_barrier(bar); } while (0)
    typedef pg8::StaticOrder SO;
#define BX_ launder_s((int)blockIdx.x)
#define G_ launder_s(F.G)
    LAS unsigned char* ring = F.lds + RING_OFF;

    if (IN(0)) { if PON(0) p0_convert(A, F, 0, 0, 1, F.vcu, G_, true); }
    SEAM(0);
    for (int l = 0; l < DEPTH; ++l) {
        const int pb = 1 + l * PH_PER_LAYER;
        if (IN(pb + 0)) { if PON(2) {
            pg8::Gemm g{((bf16*)(((unsigned char*)(GAS unsigned char*)karg64<KA_WS>()) + WS_XB)), ((bf16*)(((unsigned char*)(GAS unsigned char*)karg64<KA_WS>()) + WS_WIN)) + (size_t)l * NINP * DM, M, NINP, DM}; SO S; S.init(M, NINP, G_, BX_);
            pg8::EpiScaleBf16 E{((bf16*)(((unsigned char*)(GAS unsigned char*)karg64<KA_WS>()) + WS_Z)), NINP, ((float*)(((unsigned char*)(GAS unsigned char*)karg64<KA_WS>()) + WS_SSQ)), ZC_GATE / 256, ZC_GLR / 256};
            pg8::gemm_phase<pg8::EpiScaleBf16, SO, true, true>(ring, g, S, E, F.wave * 64 + lane_id());
            {
                const int bx = BX_, cc = (bx >= 246 && G_ == 256) ? bx - 246 : ((G_ == 256) ? 256 : bx);
                pg8::Gemm g2{((bf16*)(((unsigned char*)(GAS unsigned char*)karg64<KA_WS>()) + WS_MEMB)), ((bf16*)(((unsigned char*)(GAS unsigned char*)karg64<KA_WS>()) + WS_WXKV)) + (size_t)l * 2 * XW * DM, NBP * NMEM, 2 * XW, DM}; SO S2; S2.init(NBP * NMEM, 2 * XW, G_, cc);
                pg8::EpiMemKV E2{((float*)(GAS float*)karg64<KA_OUT>()) + O_MKP + (size_t)l * NBP * NMEM * XW, ((float*)(GAS float*)karg64<KA_OUT>()) + O_MVP + (size_t)l * NBP * NMEM * XW, ((bf16*)(((unsigned char*)(GAS unsigned char*)karg64<KA_WS>()) + WS_MEMKV)) + (size_t)l * NBP * NMEM * 2 * XW};
                pg8::gemm_phase<pg8::EpiMemKV, SO, true, true>(ring, g2, S2, E2, F.wave * 64 + lane_id());
            }
        } }
        SEAM(pb + 0);
        if (IN(pb + 1)) { if PON(3) conv_phase(A, F, l); if PON(4) { if (USE_MFMA & 1) swa_phase_mfma(A, F, l); else swa_phase(A, F, l); } if PON(5) gla_pass1(A, F, l); }
        SEAM(pb + 1);
        if (IN(pb + 2)) { if PON(6) gla_pass2(A, F, l); }
        SEAM(pb + 2);
        if (IN(pb + 3)) { if PON(7) { if (USE_MFMA & 2) gla_pass3_mfma(A, F, l); else gla_pass3(A, F, l); } }
        SEAM(pb + 3);
        if (IN(pb + 4)) { if PON(8) {
            for (int i = 0; i < 3; ++i) {
                pg8::Gemm g{((bf16*)(((unsigned char*)(GAS unsigned char*)karg64<KA_WS>()) + WS_BR)) + (size_t)i * M * MIXW, ((bf16*)(((unsigned char*)(GAS unsigned char*)karg64<KA_WS>()) + WS_WBR)) + ((size_t)l * 3 + i) * DM * MIXW, MP, DM, MIXW}; SO S; S.init(MP, DM, G_, BX_);
                pg8::EpiBranch E{((bf16*)(((unsigned char*)(GAS unsigned char*)karg64<KA_WS>()) + WS_MG)), ((bf16*)(((unsigned char*)(GAS unsigned char*)karg64<KA_WS>()) + WS_Z)) + ZC_GATE + i * DM, NINP, i == 0 ? 1 : 0};
                pg8::gemm_phase<pg8::EpiBranch, SO, true, true>(ring, g, S, E, F.wave * 64 + lane_id());
            }
            sk_branch(F, l);
        } }
        SEAM(pb + 4);
        if (IN(pb + 5)) { if PON(9) {
            constexpr int PID_ = 9;
            pg8::Gemm g{((bf16*)(((unsigned char*)(GAS unsigned char*)karg64<KA_WS>()) + WS_MG)), ((bf16*)(((unsigned char*)(GAS unsigned char*)karg64<KA_WS>()) + WS_WOUT)) + (size_t)l * DM * DM, MP, DM, DM}; SO S; S.init(MP, DM, G_, BX_);
            const size_t po_ = (rep_ < (int)((PROBE_MASK >> PID_) & 1u)) ? PROBE_OFF : 0; unsigned char* wsb_ = (unsigned char*)(GAS unsigned char*)karg64<KA_WS>();
            pg8::EpiResidual E{(const bf16*)(wsb_ + WS_XB), (bf16*)(wsb_ + WS_XB + po_), (float*)(wsb_ + WS_SSQ + po_)};
            pg8::gemm_phase<pg8::EpiResidual, SO, true, true>(ring, g, S, E, F.wave * 64 + lane_id());
            sk_residual(((const bf16*)(((unsigned char*)(GAS unsigned char*)karg64<KA_WS>()) + WS_MG)) + (size_t)MP * DM, ((const bf16*)(((unsigned char*)(GAS unsigned char*)karg64<KA_WS>()) + WS_WOUT)) + (size_t)l * DM * DM, DM, F, po_);
        } }
        SEAM(pb + 5);
        if (IN(pb + 6)) { if PON(10) {
            pg8::Gemm g{((bf16*)(((unsigned char*)(GAS unsigned char*)karg64<KA_WS>()) + WS_XB)), ((bf16*)(((unsigned char*)(GAS unsigned char*)karg64<KA_WS>()) + WS_WXQ)) + (size_t)l * XW * DM, M, XW, DM}; SO S; S.init(M, XW, G_, BX_);
            pg8::EpiScaleBf16 E{((bf16*)(((unsigned char*)(GAS unsigned char*)karg64<KA_WS>()) + WS_XQ)), XW, ((float*)(((unsigned char*)(GAS unsigned char*)karg64<KA_WS>()) + WS_SSQ)), 0, 0};
            pg8::gemm_phase<pg8::EpiScaleBf16, SO, true, true>(ring, g, S, E, F.wave * 64 + lane_id());
            if (l + 1 < DEPTH) { const int bx = BX_; const bool std_ = (G_ == 256); p0_convert(A, F, l + 1, 0, 2, std_ ? ((bx >= 66) ? bx - 66 : -1) : bx, std_ ? 190 : G_, false); }
        } }
        SEAM(pb + 6);
        if (IN(pb + 7)) { if PON(11) { if (USE_MFMA & 4) xattn_phase_mfma(A, F, l); else xattn_phase(A, F, l); } }
        SEAM(pb + 7);
        if (IN(pb + 8)) { if PON(12) {
            constexpr int PID_ = 12;
            pg8::Gemm g{((bf16*)(((unsigned char*)(GAS unsigned char*)karg64<KA_WS>()) + WS_XO)), ((bf16*)(((unsigned char*)(GAS unsigned char*)karg64<KA_WS>()) + WS_WXO)) + (size_t)l * DM * XW, MP, DM, XW}; SO S; S.init(MP, DM, G_, BX_);
            const size_t po_ = (rep_ < (int)((PROBE_MASK >> PID_) & 1u)) ? PROBE_OFF : 0; unsigned char* wsb_ = (unsigned char*)(GAS unsigned char*)karg64<KA_WS>();
            pg8::EpiResidual E{(const bf16*)(wsb_ + WS_XB), (bf16*)(wsb_ + WS_XB + po_), (float*)(wsb_ + WS_SSQ + po_)};
            pg8::gemm_phase<pg8::EpiResidual, SO, true, true>(ring, g, S, E, F.wave * 64 + lane_id());
            sk_residual(((const bf16*)(((unsigned char*)(GAS unsigned char*)karg64<KA_WS>()) + WS_XO)) + (size_t)MP * XW, ((const bf16*)(((unsigned char*)(GAS unsigned char*)karg64<KA_WS>()) + WS_WXO)) + (size_t)l * DM * XW, XW, F, po_);
        } }
        SEAM(pb + 8);
        if (IN(pb + 9)) { if PON(13) {
            pg8::Gemm g{((bf16*)(((unsigned char*)(GAS unsigned char*)karg64<KA_WS>()) + WS_XB)), ((bf16*)(((unsigned char*)(GAS unsigned char*)karg64<KA_WS>()) + WS_WUP)) + (size_t)l * 2 * DFF * DM, M, 2 * DFF, DM}; SO S; S.init(M, 2 * DFF, G_, BX_);
            pg8::EpiScaleBf16 E{((bf16*)(((unsigned char*)(GAS unsigned char*)karg64<KA_WS>()) + WS_UG)), 2 * DFF, ((float*)(((unsigned char*)(GAS unsigned char*)karg64<KA_WS>()) + WS_SSQ)), 0, 0};
            pg8::gemm_phase<pg8::EpiScaleBf16, SO, true, true>(ring, g, S, E, F.wave * 64 + lane_id());
            if (l + 1 < DEPTH) { const int bx = BX_; const bool std_ = (G_ == 256); p0_convert(A, F, l + 1, 1, 2, std_ ? ((bx >= 139) ? bx - 139 : -1) : bx, std_ ? 117 : G_, false); }
        } }
        SEAM(pb + 9);
        if (IN(pb + 10)) { if PON(14) ffnact_phase(A, F, l); }
        SEAM(pb + 10);
        if (IN(pb + 11)) { if PON(15) {
            constexpr int PID_ = 15;
            pg8::Gemm g{((bf16*)(((unsigned char*)(GAS unsigned char*)karg64<KA_WS>()) + WS_ACT)), ((bf16*)(((unsigned char*)(GAS unsigned char*)karg64<KA_WS>()) + WS_WDN)) + (size_t)l * DM * DFF, MP, DM, DFF}; SO S; S.init(MP, DM, G_, BX_);
            const size_t po_ = (rep_ < (int)((PROBE_MASK >> PID_) & 1u)) ? PROBE_OFF : 0; unsigned char* wsb_ = (unsigned char*)(GAS unsigned char*)karg64<KA_WS>();
            pg8::EpiResidual E{(const bf16*)(wsb_ + WS_XB), (bf16*)(wsb_ + WS_XB + po_), (float*)(wsb_ + WS_SSQ + po_)};
            pg8::gemm_phase<pg8::EpiResidual, SO, true, true>(ring, g, S, E, F.wave * 64 + lane_id());
            sk_residual(((const bf16*)(((unsigned char*)(GAS unsigned char*)karg64<KA_WS>()) + WS_ACT)) + (size_t)MP * DFF, ((const bf16*)(((unsigned char*)(GAS unsigned char*)karg64<KA_WS>()) + WS_WDN)) + (size_t)l * DM * DFF, DFF, F, po_);
        } }
        SEAM(pb + 11);
    }
    if (IN(N_PHASES - 1)) { if PON(16) final_phase(A, F); }
#undef IN
#undef SEAM
}

extern "C" void kernel_launch(void* const* d_in, const int* in_sizes, int n_in, void* d_out, int out_size, void* d_ws, size_t ws_size, hipStream_t stream) {
    static int grid = 0;
    if (grid == 0) {
        if (n_in != N_INPUTS || (size_t)out_size != O_END || ws_size < WS_END2) { fprintf(stderr, "kernel_launch: built for %d inputs, %zu outputs, >= %zu bytes of workspace; got n_in %d, out %d, ws %zu; nothing launched\n", N_INPUTS, (size_t)O_END, (size_t)WS_END, n_in, out_size, ws_size); grid = -1; return; }
        int dev = 0, cus = 0, per_cu = 0;
        if (hipGetDevice(&dev) != hipSuccess || hipDeviceGetAttribute(&cus, hipDeviceAttributeMultiprocessorCount, dev) != hipSuccess) { fprintf(stderr, "kernel_launch: device query failed\n"); grid = -1; return; }
        if (hipFuncSetAttribute((const void*)fwd, hipFuncAttributeMaxDynamicSharedMemorySize, LDS_BYTES) != hipSuccess) { fprintf(stderr, "kernel_launch: hipFuncSetAttribute failed\n"); grid = -1; return; }
        if (hipOccupancyMaxActiveBlocksPerMultiprocessor(&per_cu, (const void*)fwd, NTHR, LDS_BYTES) != hipSuccess || per_cu < 1) { fprintf(stderr, "kernel_launch: occupancy query reports %d workgroups per CU\n", per_cu); }
        (void)hipGetLastError();
        grid = cus;
    }
    if (grid < 0) return;
    if (hipMemsetAsync((char*)d_ws + WS_CTL, 0, CTL_ZERO_BYTES, stream) != hipSuccess) { fprintf(stderr, "kernel_launch: memset failed\n"); return; }
    Args a{};
    for (int i = 0; i < N_INPUTS; ++i) a.in[i] = (const float*)d_in[i];
    a.out = (float*)d_out; a.ws = (unsigned char*)d_ws;
#if MK_PER_PHASE
    for (int p = 0; p < N_PHASES; ++p) {
        a.ph_lo = p; a.ph_hi = p + 1;
        hipLaunchKernelGGL(fwd, dim3(grid), dim3(NTHR), LDS_BYTES, stream, a);
    }
#else
    a.ph_lo = 0; a.ph_hi = N_PHASES;
    hipLaunchKernelGGL(fwd, dim3(grid), dim3(NTHR), LDS_BYTES, stream, a);
#endif
    const hipError_t le = hipPeekAtLastError();
    if (le != hipSuccess) fprintf(stderr, "kernel_launch: launch failed: %s\n", hipGetErrorName(le));
}
```

```cpp
#include <hip/hip_runtime.h>
#include <cstdio>
#include <cstdint>
#include <cmath>
#define MK_PER_PHASE 0
namespace pg8 {
#define PG8_LAS __attribute__((address_space(3)))
typedef unsigned short bf16_t;
typedef short bf16x8 __attribute__((ext_vector_type(8)));
typedef float f32x4 __attribute__((ext_vector_type(4)));
typedef unsigned u32x4 __attribute__((ext_vector_type(4)));
constexpr int BM = 256, BK = 64, HALF = 128, HTB = HALF * BK * 2  , STAGE_BYTES = 8 * HTB, NXCD = 8, WGM = 8;

__host__ __device__ __forceinline__ int lds_byte(int r, int c) { const int st = (r >> 4) * 2 + (c >> 5), rr = r & 15, cc = c & 31, ob = rr * 64 + cc * 2; return st * 1024 + (ob ^ (((ob >> 9) & 1) << 5)); }
__host__ __device__ __forceinline__ void stage_rc(int b, int& R, int& C) { const int st = b / 1024, sb = b % 1024, swz = sb ^ (((sb >> 9) & 1) << 5); R = (st >> 1) * 16 + swz / 64; C = (st & 1) * 32 + (swz % 64) / 2; }
__host__ __device__ __forceinline__ int perm32(int rho) { const int n = rho >> 4, i = rho & 15; return 8 * (i >> 2) + 4 * n + (i & 3); }

struct Unit { int pm, pn; };
struct Gemm { const bf16_t* A; const bf16_t* Bt; int M, N, K; };

struct StaticOrder {
    int nM, nN, nwg, G, c;
    __host__ __device__ void init(int M, int N, int G_, int c_) { nM = M / BM; nN = N / BM; nwg = nM * nN; G = G_; c = c_; }
    __host__ __device__ bool next(int i, Unit& u) const {
        const long L = (long)i * G + c; if (L >= nwg) return false;
        int wgid = (int)L; { const int q = nwg / NXCD, r = nwg % NXCD, xcd = wgid % NXCD, off = wgid / NXCD; wgid = (xcd < r ? xcd * (q + 1) : r * (q + 1) + (xcd - r) * q) + off; }
        const int nig = WGM * nN, gid = wgid / nig, fm = gid * WGM, gsz = (nM - fm) < WGM ? (nM - fm) : WGM;
        u.pm = fm + ((wgid % nig) % gsz); u.pn = (wgid % nig) / gsz; return true;
    }
    __device__ __forceinline__ void a_ready(const Unit&) const {}
    __device__ __forceinline__ void done(const Unit&) const {}
};

__device__ __forceinline__ unsigned cvt_pk_bf16(float lo, float hi) { unsigned r; asm volatile("v_cvt_pk_bf16_f32 %0, %1, %2" : "=v"(r) : "v"(lo), "v"(hi)); return r; }
typedef float f32x2 __attribute__((ext_vector_type(2)));
#define PG8_GAS __attribute__((address_space(1)))
typedef unsigned u32x2 __attribute__((ext_vector_type(2)));
__device__ __forceinline__ float bf_lo(unsigned w) { return __uint_as_float(w << 16); }
__device__ __forceinline__ float bf_hi(unsigned w) { return __uint_as_float(w & 0xffff0000u); }
__device__ __forceinline__ float sigmoidf_(float v) { return 1.0f / (1.0f + __expf(-v)); }

struct EpiScaleBf16 {
    static constexpr bool PERM = true, AFTER_DRAIN = false;
    bf16_t* O; int ldc; const float* ssq; int sig_lo, sig_hi;
    __device__ __forceinline__ void operator()(const f32x4 (&acc)[2][2][4][2], const Unit& u, int wr, int wc, int fr, int fq) const {
        const int row0 = u.pm * BM + wr * 64 + fr, col0 = u.pn * BM + wc * 32 + 8 * fq;
        const bool sig = (u.pn >= sig_lo) && (u.pn < sig_hi);
        float rs[2][4];
        if (ssq) {
            f32x4 pr[2][4][2];
#pragma unroll
            for (int ai = 0; ai < 2; ++ai)
#pragma unroll
                for (int m = 0; m < 4; ++m) { const PG8_GAS f32x4* p = (const PG8_GAS f32x4*)(ssq + (size_t)(row0 + ai * HALF + m * 16) * 32 + 8 * fq); pr[ai][m][0] = p[0]; pr[ai][m][1] = p[1]; }
#pragma unroll
            for (int ai = 0; ai < 2; ++ai)
#pragma unroll
                for (int m = 0; m < 4; ++m) { const f32x4 s = pr[ai][m][0] + pr[ai][m][1]; float t = (s[0] + s[1]) + (s[2] + s[3]); t += __shfl_xor(t, 16); t += __shfl_xor(t, 32);
                    rs[ai][m] = rsqrtf(t * (1.0f / 2048.0f) + 1e-6f); }
        } else {
#pragma unroll
            for (int ai = 0; ai < 2; ++ai)
#pragma unroll
                for (int m = 0; m < 4; ++m) rs[ai][m] = 1.0f;
        }
#pragma unroll
        for (int ai = 0; ai < 2; ++ai)
#pragma unroll
            for (int m = 0; m < 4; ++m) {
                PG8_GAS bf16_t* rowp = (PG8_GAS bf16_t*)(O + (size_t)(row0 + ai * HALF + m * 16) * ldc + col0);
#pragma unroll
                for (int bj = 0; bj < 2; ++bj) { f32x4 v0 = acc[ai][bj][m][0] * rs[ai][m], v1 = acc[ai][bj][m][1] * rs[ai][m];
                    if (sig) { v0 = (f32x4){sigmoidf_(v0[0]), sigmoidf_(v0[1]), sigmoidf_(v0[2]), sigmoidf_(v0[3])}; v1 = (f32x4){sigmoidf_(v1[0]), sigmoidf_(v1[1]), sigmoidf_(v1[2]), sigmoidf_(v1[3])}; }
                    u32x4 w; w.x = cvt_pk_bf16(v0[0], v0[1]); w.y = cvt_pk_bf16(v0[2], v0[3]); w.z = cvt_pk_bf16(v1[0], v1[1]); w.w = cvt_pk_bf16(v1[2], v1[3]);
                    *(PG8_GAS u32x4*)(rowp + bj * HALF) = w; }
            }
    }
};

struct EpiResidual {
    static constexpr bool PERM = false, AFTER_DRAIN = false;
    const bf16_t* XB; bf16_t* XBo; float* ssq;
    __device__ __forceinline__ void operator()(const f32x4 (&acc)[2][2][4][2], const Unit& u, int wr, int wc, int fr, int fq) const {
        const int row0 = u.pm * BM + wr * 64 + fr, col0 = u.pn * BM + wc * 32 + 4 * fq;
        u32x2 xo[2][4][2][2];
#pragma unroll
        for (int ai = 0; ai < 2; ++ai)
#pragma unroll
            for (int m = 0; m < 4; ++m)
#pragma unroll
                for (int bj = 0; bj < 2; ++bj)
#pragma unroll
                    for (int n = 0; n < 2; ++n) xo[ai][m][bj][n] = *(const PG8_GAS u32x2*)(XB + (size_t)(row0 + ai * HALF + m * 16) * 2048 + col0 + bj * HALF + n * 16);
        asm volatile("" ::: "memory");
#pragma unroll
        for (int ai = 0; ai < 2; ++ai)
#pragma unroll
            for (int m = 0; m < 4; ++m) { const int row = row0 + ai * HALF + m * 16; float ss = 0.f;
#pragma unroll
                for (int bj = 0; bj < 2; ++bj)
#pragma unroll
                    for (int n = 0; n < 2; ++n) { const size_t off = (size_t)row * 2048 + col0 + bj * HALF + n * 16; const u32x2 o = xo[ai][m][bj][n];
                        const f32x4 x = (f32x4){bf_lo(o.x), bf_hi(o.x), bf_lo(o.y), bf_hi(o.y)} + acc[ai][bj][m][n];
                        u32x2 w; w.x = cvt_pk_bf16(x[0], x[1]); w.y = cvt_pk_bf16(x[2], x[3]); *(PG8_GAS u32x2*)(XBo + off) = w;
                        ss += (x[0] * x[0] + x[1] * x[1]) + (x[2] * x[2] + x[3] * x[3]); }
                ss += __shfl_xor(ss, 16); ss += __shfl_xor(ss, 32);
                if (fq == 0) *(PG8_GAS float*)(ssq + (size_t)row * 32 + u.pn * 4 + wc) = ss; }
    }
};

struct EpiBranch {
    static constexpr bool PERM = true, AFTER_DRAIN = false;
    bf16_t* MG; const bf16_t* G; int ldg; int first;
    __device__ __forceinline__ void operator()(const f32x4 (&acc)[2][2][4][2], const Unit& u, int wr, int wc, int fr, int fq) const {
        const int row0 = u.pm * BM + wr * 64 + fr, col0 = u.pn * BM + wc * 32 + 8 * fq;
#pragma unroll
        for (int ai = 0; ai < 2; ++ai) {
            u32x4 gt[4][2], od[4][2];
#pragma unroll
            for (int m = 0; m < 4; ++m)
#pragma unroll
                for (int bj = 0; bj < 2; ++bj) { const int row = row0 + ai * HALF + m * 16, col = col0 + bj * HALF;
                    gt[m][bj] = *(const PG8_GAS u32x4*)(G + (size_t)row * ldg + col);
                    od[m][bj] = first ? (u32x4){0u, 0u, 0u, 0u} : *(const PG8_GAS u32x4*)(MG + (size_t)row * 2048 + col); }
            asm volatile("" ::: "memory");
#pragma unroll
            for (int m = 0; m < 4; ++m)
#pragma unroll
                for (int bj = 0; bj < 2; ++bj) { const int row = row0 + ai * HALF + m * 16, col = col0 + bj * HALF; const u32x4 g = gt[m][bj], o = od[m][bj];
                    f32x4 v0 = acc[ai][bj][m][0], v1 = acc[ai][bj][m][1];
                    v0 = v0 * (f32x4){bf_lo(g.x), bf_hi(g.x), bf_lo(g.y), bf_hi(g.y)} + (f32x4){bf_lo(o.x), bf_hi(o.x), bf_lo(o.y), bf_hi(o.y)};
                    v1 = v1 * (f32x4){bf_lo(g.z), bf_hi(g.z), bf_lo(g.w), bf_hi(g.w)} + (f32x4){bf_lo(o.z), bf_hi(o.z), bf_lo(o.w), bf_hi(o.w)};
                    u32x4 w; w.x = cvt_pk_bf16(v0[0], v0[1]); w.y = cvt_pk_bf16(v0[2], v0[3]); w.z = cvt_pk_bf16(v1[0], v1[1]); w.w = cvt_pk_bf16(v1[2], v1[3]);
                    *(PG8_GAS u32x4*)(MG + (size_t)row * 2048 + col) = w; }
            asm volatile("" ::: "memory");
        }
    }
};

struct EpiMemKV {
    static constexpr bool PERM = false, AFTER_DRAIN = false;
    float* outk; float* outv; bf16_t* KV;
    __device__ __forceinline__ void operator()(const f32x4 (&acc)[2][2][4][2], const Unit& u, int wr, int wc, int fr, int fq) const {
        const int row0 = u.pm * BM + wr * 64 + fr, col0 = u.pn * BM + wc * 32 + 4 * fq;
#pragma unroll
        for (int ai = 0; ai < 2; ++ai)
#pragma unroll
            for (int m = 0; m < 4; ++m) {
                const int row = row0 + ai * HALF + m * 16;
#pragma unroll
                for (int bj = 0; bj < 2; ++bj)
#pragma unroll
                    for (int n = 0; n < 2; ++n) { const int col = col0 + bj * HALF + n * 16; const f32x4 a = acc[ai][bj][m][n];
                        float* dst = (col < 512) ? (outk + (size_t)row * 512 + col) : (outv + (size_t)row * 512 + (col - 512));
                        *(PG8_GAS f32x4*)dst = a;
                        u32x2 w; w.x = cvt_pk_bf16(a[0], a[1]); w.y = cvt_pk_bf16(a[2], a[3]); *(PG8_GAS u32x2*)(KV + (size_t)row * 1024 + col) = w; }
            }
    }
};
template <class Epi, class Sched, bool ALIGN_EPI = false, bool SP2 = false>
__device__ __forceinline__ void gemm_phase(PG8_LAS unsigned char* lds, const Gemm g, const Sched& S, const Epi& E, int tid_in) {
    int tid_ = tid_in; asm volatile("" : "+v"(tid_));
    const int tid = tid_, wid = __builtin_amdgcn_readfirstlane(tid >> 6), lane = tid & 63, wr = wid >> 2, wc = wid & 3, fr = lane & 15, fq = lane >> 4;
    const int K = g.K, nt = K / BK;
    unsigned voffA[2], voffB[2];
#pragma unroll
    for (int i = 0; i < 2; ++i) { int R, C; stage_rc(tid * 16 + i * 8192, R, C); const int Rb = Epi::PERM ? ((R & ~31) + perm32(R & 31)) : R;
        voffA[i] = (unsigned)(R * K + C) * 2u; voffB[i] = (unsigned)(Rb * K + C) * 2u; }
    const size_t kstep = (size_t)(BK * 2);
    const size_t hstep = (size_t)HALF * K * 2;
    const size_t tstep = 2 * hstep;
    const unsigned ldsw = (unsigned)wid * 1024u;
    const int aoff = lds_byte(wr * 64 + fr, fq * 8), boff = lds_byte(wc * 32 + fr, fq * 8);
#define PG8_SA(b, h) (((b) * 2 + (h)) * HTB)
#define PG8_SB(b, h) ((4 + (b) * 2 + (h)) * HTB)
#define PG8_STAGE(bufoff, gbase, voff) do { _Pragma("unroll") for (int _i = 0; _i < 2; ++_i) \
        __builtin_amdgcn_global_load_lds((const unsigned*)((const char*)(gbase) + (voff)[_i]), (PG8_LAS unsigned*)(lds + (bufoff) + ldsw + _i * 8192), 16, 0, 0); } while (0)
#define PG8_LDA(dst, b, h) do { _Pragma("unroll") for (int m = 0; m < 4; ++m) _Pragma("unroll") for (int k = 0; k < 2; ++k) dst[m][k] = *(const PG8_LAS bf16x8*)(lds + PG8_SA(b, h) + aoff + m * 2048 + k * 1024); } while (0)
#define PG8_LDB(dst, b, h) do { _Pragma("unroll") for (int n = 0; n < 2; ++n) _Pragma("unroll") for (int k = 0; k < 2; ++k) dst[n][k] = *(const PG8_LAS bf16x8*)(lds + PG8_SB(b, h) + boff + n * 2048 + k * 1024); } while (0)
#define PG8_MMA(ai, bj, At, Bt) do { __builtin_amdgcn_s_setprio(1); _Pragma("unroll") for (int m = 0; m < 4; ++m) _Pragma("unroll") for (int n = 0; n < 2; ++n) _Pragma("unroll") for (int k = 0; k < 2; ++k) \
        acc[ai][bj][m][n] = __builtin_amdgcn_mfma_f32_16x16x32_bf16(Bt[n][k], At[m][k], acc[ai][bj][m][n], 0, 0, 0); __builtin_amdgcn_s_setprio(0); } while (0)
#define PG8_WAIT_V(n) asm volatile("s_waitcnt vmcnt(" #n ")" ::: "memory")
#define PG8_WAIT_L(n) asm volatile("s_waitcnt lgkmcnt(" #n ")" ::: "memory")
#define PG8_BAR __builtin_amdgcn_s_barrier()
#define PG8_SCHED __builtin_amdgcn_sched_barrier(0)
    Unit cur, nxt; int ui = 0;
    if (!S.next(0, cur)) return;
    f32x4 acc[2][2][4][2];
#pragma unroll
    for (int a = 0; a < 2; ++a)
#pragma unroll
        for (int b = 0; b < 2; ++b)
#pragma unroll
            for (int m = 0; m < 4; ++m)
#pragma unroll
                for (int n = 0; n < 2; ++n) acc[a][b][m][n] = (f32x4){0.f, 0.f, 0.f, 0.f};
    bf16x8 At[4][2], B0[2][2], B1[2][2];
    const char* cA = (const char*)g.A + (size_t)cur.pm * tstep; const char* cB = (const char*)g.Bt + (size_t)cur.pn * tstep;
    S.a_ready(cur);
    if constexpr (SP2) {
        PG8_STAGE(PG8_SB(0, 0), cB, voffB); PG8_STAGE(PG8_SB(0, 1), cB + hstep, voffB); PG8_STAGE(PG8_SA(0, 0), cA, voffA); PG8_STAGE(PG8_SA(0, 1), cA + hstep, voffA);
        if (wr == 1) PG8_BAR;
        PG8_WAIT_V(2); PG8_BAR;
        PG8_STAGE(PG8_SB(1, 0), cB + kstep, voffB); PG8_STAGE(PG8_SA(1, 0), cA + kstep, voffA); PG8_STAGE(PG8_SB(1, 1), cB + hstep + kstep, voffB);
        PG8_WAIT_V(6); PG8_BAR;
    } else {
        PG8_STAGE(PG8_SB(0, 0), cB, voffB); PG8_STAGE(PG8_SA(0, 0), cA, voffA); PG8_STAGE(PG8_SB(0, 1), cB + hstep, voffB); PG8_STAGE(PG8_SA(0, 1), cA + hstep, voffA);
        if (wr == 1) PG8_BAR;
        PG8_WAIT_V(4); PG8_BAR;
        PG8_STAGE(PG8_SB(1, 0), cB + kstep, voffB); PG8_STAGE(PG8_SA(1, 0), cA + kstep, voffA); PG8_STAGE(PG8_SB(1, 1), cB + hstep + kstep, voffB);
        PG8_WAIT_V(6); PG8_BAR;
    }
    for (;;) {
        const bool has_next = S.next(ui + 1, nxt);
        const char* nA = has_next ? (const char*)g.A + (size_t)nxt.pm * tstep : cA; const char* nB = has_next ? (const char*)g.Bt + (size_t)nxt.pn * tstep : cB;
        for (int t = 0; t < nt; t += 2) {
            const bool last = (t == nt - 2);
            const char* a1 = cA + (size_t)(t + 1) * kstep;
            const char* a2 = last ? nA : cA + (size_t)(t + 2) * kstep; const char* b2 = last ? nB : cB + (size_t)(t + 2) * kstep;
            const char* a3 = a2 + kstep; const char* b3 = b2 + kstep;
            if (last && has_next) S.a_ready(nxt);
            if constexpr (SP2) {
            PG8_LDB(B0, 0, 0); PG8_LDB(B1, 0, 1); PG8_SCHED; PG8_LDA(At, 0, 0); PG8_STAGE(PG8_SA(1, 1), a1 + hstep, voffA);
            PG8_WAIT_V(8); PG8_WAIT_L(0); PG8_BAR; PG8_MMA(0, 0, At, B0); PG8_MMA(0, 1, At, B1); PG8_BAR; PG8_SCHED;
            PG8_LDA(At, 0, 1); PG8_STAGE(PG8_SB(0, 0), b2, voffB); PG8_STAGE(PG8_SB(0, 1), b2 + hstep, voffB); PG8_STAGE(PG8_SA(0, 0), a2, voffA);
            PG8_WAIT_V(8); PG8_WAIT_L(0); PG8_BAR; PG8_MMA(1, 0, At, B0); PG8_MMA(1, 1, At, B1); PG8_BAR; PG8_SCHED;
            PG8_LDB(B0, 1, 0); PG8_LDB(B1, 1, 1); PG8_SCHED; PG8_LDA(At, 1, 0); PG8_STAGE(PG8_SA(0, 1), a2 + hstep, voffA);
            PG8_WAIT_V(8); PG8_WAIT_L(0); PG8_BAR; PG8_MMA(0, 0, At, B0); PG8_MMA(0, 1, At, B1); PG8_BAR; PG8_SCHED;
            PG8_LDA(At, 1, 1); PG8_STAGE(PG8_SB(1, 0), b3, voffB); PG8_STAGE(PG8_SB(1, 1), b3 + hstep, voffB); PG8_STAGE(PG8_SA(1, 0), a3, voffA);
            PG8_WAIT_V(8); PG8_WAIT_L(0); PG8_BAR; PG8_MMA(1, 0, At, B0); PG8_MMA(1, 1, At, B1); PG8_BAR; PG8_SCHED;
            } else {
            PG8_LDB(B0, 0, 0); PG8_SCHED; PG8_LDA(At, 0, 0); PG8_STAGE(PG8_SA(1, 1), a1 + hstep, voffA);
            PG8_WAIT_L(8); PG8_BAR; PG8_WAIT_L(0); PG8_MMA(0, 0, At, B0); PG8_BAR; PG8_SCHED;
            PG8_LDB(B1, 0, 1); PG8_STAGE(PG8_SB(0, 0), b2, voffB);
            PG8_BAR; PG8_WAIT_L(0); PG8_MMA(0, 1, At, B1); PG8_BAR;
            PG8_LDA(At, 0, 1); PG8_STAGE(PG8_SA(0, 0), a2, voffA);
            PG8_BAR; PG8_WAIT_L(0); PG8_MMA(1, 0, At, B0); PG8_BAR; PG8_SCHED;
            PG8_STAGE(PG8_SB(0, 1), b2 + hstep, voffB);
            PG8_WAIT_V(6); PG8_BAR; PG8_MMA(1, 1, At, B1); PG8_BAR;
            PG8_LDB(B0, 1, 0); PG8_SCHED; PG8_LDA(At, 1, 0); PG8_STAGE(PG8_SA(0, 1), a2 + hstep, voffA);
            PG8_WAIT_L(8); PG8_BAR; PG8_WAIT_L(0); PG8_MMA(0, 0, At, B0); PG8_BAR; PG8_SCHED;
            PG8_LDB(B1, 1, 1); PG8_STAGE(PG8_SB(1, 0), b3, voffB);
            PG8_BAR; PG8_WAIT_L(0); PG8_MMA(0, 1, At, B1); PG8_BAR;
            PG8_LDA(At, 1, 1); PG8_STAGE(PG8_SA(1, 0), a3, voffA);
            PG8_BAR; PG8_WAIT_L(0); PG8_MMA(1, 0, At, B0); PG8_BAR; PG8_SCHED;
            PG8_STAGE(PG8_SB(1, 1), b3 + hstep, voffB);
            PG8_WAIT_V(6); PG8_BAR; PG8_MMA(1, 1, At, B1); PG8_BAR;
            }
        }
        if constexpr (ALIGN_EPI) { if (wr == 0) PG8_BAR; }
        if constexpr (!Epi::AFTER_DRAIN) { E(acc, cur, wr, wc, fr, fq); S.done(cur); }
        if (!has_next) break;
#pragma unroll
        for (int a = 0; a < 2; ++a)
#pragma unroll
            for (int b = 0; b < 2; ++b)
#pragma unroll
                for (int m = 0; m < 4; ++m)
#pragma unroll
                    for (int n = 0; n < 2; ++n) acc[a][b][m][n] = (f32x4){0.f, 0.f, 0.f, 0.f};
        cur = nxt; cA = nA; cB = nB; ++ui;
        if constexpr (ALIGN_EPI) { if (wr == 1) PG8_BAR; }
    }
    PG8_WAIT_V(0);
    if constexpr (!ALIGN_EPI) { if (wr == 0) PG8_BAR; }
    PG8_BAR;
    if constexpr (Epi::AFTER_DRAIN) { E.fused(acc, cur, wr, wc, fr, fq, lds, wid, lane); S.done(cur); }
#undef PG8_SA
#undef PG8_SB
#undef PG8_STAGE
#undef PG8_LDA
#undef PG8_LDB
#undef PG8_MMA
#undef PG8_WAIT_V
#undef PG8_WAIT_L
#undef PG8_BAR
#undef PG8_SCHED
}
}

constexpr int NWAVES = 8, NTHR = 512;
constexpr int DM = 2048, SEQ = 4096, NBP = 2, DEPTH = 4, NBS = 32, TS = 8;
constexpr int MP = NBP * SEQ, MS = NBS * TS, M = MP + MS;
constexpr int MIXW = 1024, GH = 4, GDK = 128, GDV = 256, GRANK = 16;
constexpr int SH = 16, SKV = 2, SHD = 64, WIN = 128;
constexpr int NMEM = 256, XH = 4, XHD = 128, XW = XH * XHD;
constexpr int DFF = 5504, NIN = 13584, NINP = 13824;
constexpr float EPS = 1e-6f;
constexpr int ZC_GQ = 0, ZC_GK = 512, ZC_GV = 1024, ZC_GR = 2048, ZC_SQ = 3072, ZC_SK = 4096, ZC_SV = 4224, ZC_CB = 4352, ZC_CC = 5376, ZC_CH = 6400, ZC_GATE = 7424, ZC_GLR = 13568;
static_assert(ZC_GATE % 256 == 0 && ZC_GLR % 256 == 0 && ZC_GLR + 16 == NIN && NINP % 256 == 0, "z layout");
constexpr size_t O_YP = 0, O_YS = O_YP + (size_t)MP * DM, O_GLAP = O_YS + (size_t)MS * DM, O_GLAS = O_GLAP + (size_t)DEPTH * NBP * GH * GDK * GDV,
                 O_SKP = O_GLAS + (size_t)DEPTH * NBS * GH * GDK * GDV, O_SVP = O_SKP + (size_t)DEPTH * NBP * WIN * SKV * SHD, O_SKS = O_SVP + (size_t)DEPTH * NBP * WIN * SKV * SHD,
                 O_SVS = O_SKS + (size_t)DEPTH * NBS * WIN * SKV * SHD, O_CONVP = O_SVS + (size_t)DEPTH * NBS * WIN * SKV * SHD, O_CONVS = O_CONVP + (size_t)DEPTH * NBP * 2 * MIXW,
                 O_FFNP = O_CONVS + (size_t)DEPTH * NBS * 2 * MIXW, O_FFNS = O_FFNP + (size_t)DEPTH * NBP * 2 * DFF, O_MKP = O_FFNS + (size_t)DEPTH * NBS * 2 * DFF,
                 O_MVP = O_MKP + (size_t)DEPTH * NBP * NMEM * XW, O_END = O_MVP + (size_t)DEPTH * NBP * NMEM * XW;
static_assert(O_END == 43456512, "output size");
enum { I_XP = 0, I_XS, I_SGLA, I_CSK, I_CSV, I_SCONV, I_SFFN, I_CMK, I_CMV, I_MEMP, I_NMIX, I_WIN, I_GUP, I_GB, I_GNORM, I_SINK, I_RELB, I_CONVW, I_WBR, I_WOUT, I_NX, I_WXQ, I_WXK, I_WXV, I_WXO,
       I_NFFN, I_FUP, I_FCW, I_FCB, I_FDN, I_NFIN, N_INPUTS };
static_assert(N_INPUTS == 31, "inputs");

constexpr size_t MiB = 1u << 20;
constexpr size_t al1m(size_t x) { return (x + MiB - 1) / MiB * MiB; }
constexpr size_t WS_CTL = 0, CTL_ZERO_BYTES = 1 * MiB;
constexpr size_t SZ_WIN = (size_t)NINP * DM * 2, SZ_WBR = (size_t)3 * DM * MIXW * 2, SZ_WOUT = (size_t)DM * DM * 2, SZ_WXQ = (size_t)XW * DM * 2, SZ_WXKV = (size_t)2 * XW * DM * 2,
                 SZ_WXO = (size_t)DM * XW * 2, SZ_WUP = (size_t)2 * DFF * DM * 2, SZ_WDN = (size_t)DM * DFF * 2;
constexpr size_t WS_WIN = 2 * MiB, WS_WBR = al1m(WS_WIN + DEPTH * SZ_WIN), WS_WOUT = al1m(WS_WBR + DEPTH * SZ_WBR), WS_WXQ = al1m(WS_WOUT + DEPTH * SZ_WOUT),
                 WS_WXKV = al1m(WS_WXQ + DEPTH * SZ_WXQ), WS_WXO = al1m(WS_WXKV + DEPTH * SZ_WXKV), WS_WUP = al1m(WS_WXO + DEPTH * SZ_WXO), WS_WDN = al1m(WS_WUP + DEPTH * SZ_WUP);
constexpr size_t WS_X = al1m(WS_WDN + DEPTH * SZ_WDN), WS_XB = al1m(WS_X + (size_t)M * DM * 4), WS_SSQ = al1m(WS_XB + (size_t)M * DM * 2), WS_Z = al1m(WS_SSQ + (size_t)M * 32 * 4),
                 WS_BR = al1m(WS_Z + (size_t)M * NINP * 2), WS_MG = al1m(WS_BR + (size_t)3 * M * MIXW * 2), WS_XQ = al1m(WS_MG + (size_t)M * DM * 2), WS_XO = al1m(WS_XQ + (size_t)M * XW * 2),
                 WS_UG = al1m(WS_XO + (size_t)M * XW * 2), WS_ACT = al1m(WS_UG + (size_t)M * 2 * DFF * 2), WS_MEMB = al1m(WS_ACT + (size_t)M * DFF * 2), WS_MEMKV = al1m(WS_MEMB + (size_t)NBP * NMEM * DM * 2),
                 WS_GLAU = al1m(WS_MEMKV + (size_t)DEPTH * NBP * NMEM * 2 * XW * 2), WS_GLAD = al1m(WS_GLAU + (size_t)512 * GDK * GDV * 4), WS_GLAS = al1m(WS_GLAD + (size_t)512 * GDK * 4), WS_GLAB = al1m(WS_GLAS + (size_t)512 * GDK * GDV * 2), WS_END = al1m(WS_GLAB + (size_t)512 * 64 * GDK * 4);
constexpr size_t PROBE_OFF = WS_END - WS_X, WS_END2 = WS_END + (WS_Z - WS_X);
constexpr int CW_TMO = 0, CW_CODE = 1, CW_BAR = 4096;

constexpr int RING_OFF = 0, RING_BYTES = 131072;
constexpr int LDSCTL_OFF = 146944, MISC_OFF = LDSCTL_OFF + 320;
constexpr int LDS_BYTES = 147456;
static_assert(MISC_OFF + 128 <= LDS_BYTES && LDSCTL_OFF >= RING_BYTES, "LDS map");

#define GAS __attribute__((address_space(1)))
#define LAS __attribute__((address_space(3)))
typedef unsigned short bf16;
typedef unsigned v4u __attribute__((ext_vector_type(4)));
typedef unsigned v2u __attribute__((ext_vector_type(2)));
typedef float f32x4 __attribute__((ext_vector_type(4)));
typedef float f32x2 __attribute__((ext_vector_type(2)));
typedef GAS unsigned gu32;
#define RLX_AGENT __ATOMIC_RELAXED, __HIP_MEMORY_SCOPE_AGENT
#define LDS_WAIT() asm volatile("s_waitcnt lgkmcnt(0)" ::: "memory")
#define VM_WAIT() asm volatile("s_waitcnt vmcnt(0)" ::: "memory")
__device__ __forceinline__ float bflo(unsigned w) { return __uint_as_float(w << 16); }
__device__ __forceinline__ float bfhi(unsigned w) { return __uint_as_float(w & 0xffff0000u); }
__device__ __forceinline__ float bf1(bf16 h) { return __uint_as_float(((unsigned)h) << 16); }
__device__ __forceinline__ unsigned pk2(float lo, float hi) { return pg8::cvt_pk_bf16(lo, hi); }
__device__ __forceinline__ void unpack8(const v4u w, float (&f)[8]) { f[0] = bflo(w.x); f[1] = bfhi(w.x); f[2] = bflo(w.y); f[3] = bfhi(w.y); f[4] = bflo(w.z); f[5] = bfhi(w.z); f[6] = bflo(w.w); f[7] = bfhi(w.w); }
__device__ __forceinline__ v4u pack8(const float (&f)[8]) { v4u w; w.x = pk2(f[0], f[1]); w.y = pk2(f[2], f[3]); w.z = pk2(f[4], f[5]); w.w = pk2(f[6], f[7]); return w; }
__device__ __forceinline__ float sigm(float v) { return 1.0f / (1.0f + __expf(-v)); }
__device__ __forceinline__ float wave_sum(float v) {
#pragma unroll
    for (int o = 1; o < 64; o <<= 1) v += __shfl_xor(v, o);
    return v;
}
#define XB_TMO      128
#define XB_XCNT(j)  (256  + 64 * (j))
#define XB_XSUB(j)  (1280 + 64 * (j))
#define XB_XGEN(j)  (2304 + 64 * (j))
#define XB_TOP      3328
#define XB_TOPGEN   3392
#define XCD_BAR_WORDS 3456
#define XB_SPIN_CAP (1u << 18)

__device__ __forceinline__ unsigned xb_ld(unsigned* p)              { return __hip_atomic_load(p, __ATOMIC_RELAXED, __HIP_MEMORY_SCOPE_AGENT); }
__device__ __forceinline__ unsigned xb_add(unsigned* p, unsigned v) { return __hip_atomic_fetch_add(p, v, __ATOMIC_RELAXED, __HIP_MEMORY_SCOPE_AGENT); }
__device__ __forceinline__ unsigned xb_xcc_id() { return (unsigned)__builtin_amdgcn_s_getreg((3 << 11) | 20) & 0xFu; }
#define XB_SPIN(cond, bar) do { unsigned _sp = 0; while (cond) { __builtin_amdgcn_s_sleep(1); \
    if ((++_sp & 255u) == 0u) { if (xb_ld(&(bar)[XB_TMO])) break; if (_sp > XB_SPIN_CAP) { atomicAdd(&(bar)[XB_TMO], 1u); break; } } } } while (0)

struct XcdBarrier {
    unsigned* bar; unsigned x; unsigned wv;
    volatile LAS unsigned* st;
};

__device__ __forceinline__ unsigned xb_lane() { return __builtin_amdgcn_mbcnt_hi(~0u, __builtin_amdgcn_mbcnt_lo(~0u, 0u)); }
__device__ __forceinline__ XcdBarrier xcd_barrier_post(unsigned* bar, volatile LAS unsigned* st, unsigned wv) {
    XcdBarrier b; b.bar = bar; b.x = xb_xcc_id(); b.st = st; b.wv = wv;
    if (wv == 0u && xb_lane() == 0u) (void)xb_add(&bar[XB_XCNT(b.x)], 1u);
    return b;
}
__device__ __forceinline__ void xcd_barrier_complete(unsigned* bar, unsigned x, unsigned& nloc, unsigned& nx) {
    const unsigned G = gridDim.x * gridDim.y * gridDim.z;
    unsigned sum, cnt, mine, sp = 0u;
    for (;;) {
        sum = 0u; cnt = 0u; mine = 0u;
#pragma unroll
        for (unsigned j = 0; j < 16; ++j) { const unsigned c = xb_ld(&bar[XB_XCNT(j)]); sum += c; cnt += (c > 0u) ? 1u : 0u; mine = (j == x) ? c : mine; }
        if (sum == G) break;
        __builtin_amdgcn_s_sleep(1);
        if ((++sp & 255u) == 0u) { if (xb_ld(&bar[XB_TMO])) break; if (sp > XB_SPIN_CAP) { atomicAdd(&bar[XB_TMO], 1u); break; } }
    }
    nloc = mine > 0u ? mine : 1u; nx = cnt > 0u ? cnt : 1u;
}

__device__ __forceinline__ void xcd_barrier(const XcdBarrier& b) {
    asm volatile("s_waitcnt vmcnt(0)" ::: "memory");
    __syncthreads();
    if (b.wv == 0u && xb_lane() == 0u) {
        unsigned* bar = b.bar;
        __builtin_amdgcn_s_waitcnt(0);
        unsigned nloc = b.st[0], nx = b.st[1];
        if (nloc == 0u) { xcd_barrier_complete(bar, b.x, nloc, nx); b.st[0] = nloc; b.st[1] = nx; }
        const unsigned old = xb_add(&bar[XB_XSUB(b.x)], 1u);
        const unsigned gen = old / nloc;
        if (old + 1u == (gen + 1u) * nloc) {
            __builtin_amdgcn_fence(__ATOMIC_RELEASE, "agent");
            asm volatile("s_waitcnt vmcnt(0)" ::: "memory");
            const unsigned og = xb_add(&bar[XB_TOP], 1u);
            const unsigned tg = og / nx;
            if (og + 1u == (tg + 1u) * nx) xb_add(&bar[XB_TOPGEN], 1u);
            else XB_SPIN(xb_ld(&bar[XB_TOPGEN]) == tg, bar);
            __builtin_amdgcn_fence(__ATOMIC_ACQUIRE, "agent");
            xb_add(&bar[XB_XGEN(b.x)], 1u);
            asm volatile("s_waitcnt vmcnt(0)" ::: "memory");
        } else {
            XB_SPIN(xb_ld(&bar[XB_XGEN(b.x)]) == gen, bar);
            __builtin_amdgcn_fence(__ATOMIC_ACQUIRE, "agent");
            asm volatile("s_waitcnt vmcnt(0)" ::: "memory");
        }
    }
    __syncthreads();
}

struct Args { const float* in[N_INPUTS]; float* out; unsigned char* ws; int ph_lo, ph_hi; };
static_assert(sizeof(Args) == N_INPUTS * 8 + 8 + 8 + 8, "Args has no padding");


constexpr int KA_OUT = 8 * N_INPUTS, KA_WS = KA_OUT + 8, KA_LO = KA_WS + 8, KA_HI = KA_LO + 4;
template <int OFF> __device__ __forceinline__ unsigned long long karg64() {
    unsigned long long v; auto kp = __builtin_amdgcn_kernarg_segment_ptr();
    asm volatile("s_load_dwordx2 %0, %1, %2\n\ts_waitcnt lgkmcnt(0)" : "=s"(v) : "s"(kp), "n"(OFF) : "memory"); return v;
}
template <int OFF> __device__ __forceinline__ int karg32() {
    int v; auto kp = __builtin_amdgcn_kernarg_segment_ptr();
    asm volatile("s_load_dword %0, %1, %2\n\ts_waitcnt lgkmcnt(0)" : "=s"(v) : "s"(kp), "n"(OFF) : "memory"); return v;
}
struct Frame {
    LAS unsigned char* lds;
    volatile LAS unsigned* MISC;
    gu32* ctl;
    int tid, lane, wave, vcu, G;
};

__device__ __forceinline__ int lane_id() { int l; asm volatile("v_mbcnt_lo_u32_b32 %0, -1, 0\n\tv_mbcnt_hi_u32_b32 %0, -1, %0" : "=v"(l)); return l; }
__device__ __forceinline__ int launder_s(int v) { asm volatile("" : "+s"(v)); return v; }
#define LAUNDER(F) do { asm volatile("" : "+s"((F).wave), "+s"((F).vcu), "+s"((F).G)); (F).lane = lane_id(); asm volatile("" : "+v"((F).lane)); (F).tid = (F).wave * 64 + (F).lane; } while (0)
__device__ __forceinline__ void tr_item(const float* W, int K, int Nsrc, bf16* WT, int dstrow0, int k0, int srccol, float cscale, const float* gain, LAS float* scr, int lane) {
    const int q = lane & 15, kq = lane >> 4;
    f32x4 v[16];
#pragma unroll
    for (int i = 0; i < 16; ++i) { v[i] = (f32x4){0.f, 0.f, 0.f, 0.f}; if (srccol >= 0) v[i] = *(const f32x4*)(W + (size_t)(k0 + 4 * i + kq) * Nsrc + srccol); }
#pragma unroll
    for (int i = 0; i < 16; ++i) { const int kk = 4 * i + kq; const float s = gain ? gain[k0 + kk] * cscale : cscale; LAS float* d = scr + kk * 65 + 4 * q;
        d[0] = v[i][0] * s; d[1] = v[i][1] * s; d[2] = v[i][2] * s; d[3] = v[i][3] * s; }
    LDS_WAIT(); asm volatile("" ::: "memory");
    const int c = lane & 7;
#pragma unroll
    for (int j = 0; j < 8; ++j) { const int n = (lane >> 3) + 8 * j; const LAS float* s = scr + (8 * c) * 65 + n;
        v4u o; o.x = pk2(s[0 * 65], s[1 * 65]); o.y = pk2(s[2 * 65], s[3 * 65]); o.z = pk2(s[4 * 65], s[5 * 65]); o.w = pk2(s[6 * 65], s[7 * 65]);
        *(v4u*)(WT + (size_t)(dstrow0 + n) * K + k0 + 8 * c) = o; }
    LDS_WAIT(); asm volatile("" ::: "memory");
}
__device__ __forceinline__ void tr_plain(const float* W, int K, int N, bf16* WT, int dst_off, int r, float cscale, const float* gain, LAS float* scr, int lane) {
    const int nblk = N / 64, kb = r / nblk, nb = r % nblk;
    tr_item(W, K, N, WT, dst_off + 64 * nb, 64 * kb, 64 * nb + 4 * (lane & 15), cscale, gain, scr, lane);
}
constexpr int IT_IN = (DM / 64) * (NINP / 64), IT_BR = (MIXW / 64) * (DM / 64), IT_OUT = (DM / 64) * (DM / 64), IT_XQ = (DM / 64) * (XW / 64), IT_XO = (XW / 64) * (DM / 64),
              IT_UP = (DM / 64) * (2 * DFF / 64), IT_DN = (DFF / 64) * (DM / 64), IT_LAYER = IT_IN + 3 * IT_BR + IT_OUT + 3 * IT_XQ + IT_XO + IT_UP + IT_DN;
__device__ __forceinline__ void p0_convert(const Args& A, Frame& F0, int l, int part, int nparts, int wk, int nwk, bool rows) {
    unsigned char* const ws_ = (unsigned char*)(GAS unsigned char*)karg64<KA_WS>();
    const float* const in_I_FDN = (const float*)(const GAS float*)karg64<8 * I_FDN>();
    const float* const in_I_FUP = (const float*)(const GAS float*)karg64<8 * I_FUP>();
    const float* const in_I_MEMP = (const float*)(const GAS float*)karg64<8 * I_MEMP>();
    const float* const in_I_NFFN = (const float*)(const GAS float*)karg64<8 * I_NFFN>();
    const float* const in_I_NMIX = (const float*)(const GAS float*)karg64<8 * I_NMIX>();
    const float* const in_I_NX = (const float*)(const GAS float*)karg64<8 * I_NX>();
    const float* const in_I_WBR = (const float*)(const GAS float*)karg64<8 * I_WBR>();
    const float* const in_I_WIN = (const float*)(const GAS float*)karg64<8 * I_WIN>();
    const float* const in_I_WOUT = (const float*)(const GAS float*)karg64<8 * I_WOUT>();
    const float* const in_I_WXK = (const float*)(const GAS float*)karg64<8 * I_WXK>();
    const float* const in_I_WXO = (const float*)(const GAS float*)karg64<8 * I_WXO>();
    const float* const in_I_WXQ = (const float*)(const GAS float*)karg64<8 * I_WXQ>();
    const float* const in_I_WXV = (const float*)(const GAS float*)karg64<8 * I_WXV>();
    const float* const in_I_XP = (const float*)(const GAS float*)karg64<8 * I_XP>();
    const float* const in_I_XS = (const float*)(const GAS float*)karg64<8 * I_XS>();
    Frame F = F0; LAUNDER(F);
    LAS float* scr = (LAS float*)(F.lds + F.wave * 16640);
    const int gw = F.vcu * NWAVES + F.wave, NGW = F.G * NWAVES, lane = F.lane;
    const int it_lo = (int)((long)IT_LAYER * part / nparts), it_hi = (int)((long)IT_LAYER * (part + 1) / nparts);
    if (wk >= 0)
#pragma unroll 1
    for (int it = it_lo + wk * NWAVES + F.wave; it < it_hi; it += nwk * NWAVES) {
        int r = it;
        if (r < IT_IN) {
            const int nblk = NINP / 64, kb = r / nblk, nb = r % nblk, n = 64 * nb + 4 * (lane & 15);
            int src; if (n < 3072) src = n; else if (n < ZC_GLR) src = n + 16; else if (n < NIN) src = 3072 + (n - ZC_GLR); else src = -1;
            const float cs = (n < 512) ? 0.08838834764831845f : ((n >= ZC_SQ && n < ZC_SK) ? 0.125f : 1.0f);
            tr_item(in_I_WIN + (size_t)l * DM * NIN, DM, NIN, ((bf16*)(ws_ + WS_WIN)) + (size_t)l * NINP * DM, 64 * nb, 64 * kb, src, cs, in_I_NMIX + l * DM, scr, lane); continue; }
        r -= IT_IN;
        if (r < 3 * IT_BR) { const int i = r / IT_BR; r %= IT_BR;
            tr_plain(in_I_WBR + ((size_t)l * 3 + i) * MIXW * DM, MIXW, DM, ((bf16*)(ws_ + WS_WBR)) + ((size_t)l * 3 + i) * DM * MIXW, 0, r, 1.0f, nullptr, scr, lane); continue; }
        r -= 3 * IT_BR;
        if (r < IT_OUT) { tr_plain(in_I_WOUT + (size_t)l * DM * DM, DM, DM, ((bf16*)(ws_ + WS_WOUT)) + (size_t)l * DM * DM, 0, r, 1.0f, nullptr, scr, lane); continue; }
        r -= IT_OUT;
        if (r < IT_XQ) { tr_plain(in_I_WXQ + (size_t)l * DM * XW, DM, XW, ((bf16*)(ws_ + WS_WXQ)) + (size_t)l * XW * DM, 0, r, 0.08838834764831845f, in_I_NX + l * DM, scr, lane); continue; }
        r -= IT_XQ;
        if (r < IT_XQ) { tr_plain(in_I_WXK + (size_t)l * DM * XW, DM, XW, ((bf16*)(ws_ + WS_WXKV)) + (size_t)l * 2 * XW * DM, 0, r, 1.0f, nullptr, scr, lane); continue; }
        r -= IT_XQ;
        if (r < IT_XQ) { tr_plain(in_I_WXV + (size_t)l * DM * XW, DM, XW, ((bf16*)(ws_ + WS_WXKV)) + (size_t)l * 2 * XW * DM, XW, r, 1.0f, nullptr, scr, lane); continue; }
        r -= IT_XQ;
        if (r < IT_XO) { tr_plain(in_I_WXO + (size_t)l * XW * DM, XW, DM, ((bf16*)(ws_ + WS_WXO)) + (size_t)l * DM * XW, 0, r, 1.0f, nullptr, scr, lane); continue; }
        r -= IT_XO;
        if (r < IT_UP) { tr_plain(in_I_FUP + (size_t)l * DM * 2 * DFF, DM, 2 * DFF, ((bf16*)(ws_ + WS_WUP)) + (size_t)l * 2 * DFF * DM, 0, r, 1.0f, in_I_NFFN + l * DM, scr, lane); continue; }
        r -= IT_UP;
        tr_plain(in_I_FDN + (size_t)l * DFF * DM, DFF, DM, ((bf16*)(ws_ + WS_WDN)) + (size_t)l * DM * DFF, 0, r, 1.0f, nullptr, scr, lane);
    }
    if (rows)
    for (int m = gw; m < M + NBP * NMEM; m += NGW) {
        if (m < M) {
            const float* src = (m < MP) ? in_I_XP + (size_t)m * DM : in_I_XS + (size_t)(m - MP) * DM;
            float ss = 0.f;
#pragma unroll
            for (int j = 0; j < 8; ++j) { const f32x4 v = *((const f32x4*)src + lane + 64 * j);
                v2u w; w.x = pk2(v[0], v[1]); w.y = pk2(v[2], v[3]); *((v2u*)(((bf16*)(ws_ + WS_XB)) + (size_t)m * DM) + lane + 64 * j) = w; ss += (v[0] * v[0] + v[1] * v[1]) + (v[2] * v[2] + v[3] * v[3]); }
            ss = wave_sum(ss);
            if (lane < 32) ((float*)(ws_ + WS_SSQ))[(size_t)m * 32 + lane] = (lane == 0) ? ss : 0.f;
        } else {
            const int r = m - M; const float* src = in_I_MEMP + (size_t)r * DM;
#pragma unroll
            for (int j = 0; j < 8; ++j) { const f32x4 v = *((const f32x4*)src + lane + 64 * j); v2u w; w.x = pk2(v[0], v[1]); w.y = pk2(v[2], v[3]); *((v2u*)(((bf16*)(ws_ + WS_MEMB)) + (size_t)r * DM) + lane + 64 * j) = w; }
        }
    }
}

__device__ __forceinline__ int t5_bucket(int n) {
    if (n < 16) return n;
    const float v = logf((float)n / 16.0f) / logf(8.0f) * 16.0f; const int lg = 16 + (int)v; return lg < 31 ? lg : 31;
}
template <int STRIDE, bool PAIR, bool BIAS>
__device__ __forceinline__ void attn_core(const float (&q)[64], LAS const unsigned char* kp, LAS const unsigned char* vp, int nsteps, int jmin, LAS const float* bp, float& m, float& lsum, float (&o)[64]) {
    for (int j = 0; j < nsteps; ++j) {
        LAS const v4u* kr = (LAS const v4u*)(kp + j * STRIDE);
        float s0 = 0.f, s1 = 0.f;
#pragma unroll
        for (int c = 0; c < 8; ++c) { const v4u kk = kr[c];
            s0 += q[8 * c + 0] * bflo(kk.x) + q[8 * c + 2] * bflo(kk.y) + q[8 * c + 4] * bflo(kk.z) + q[8 * c + 6] * bflo(kk.w);
            s1 += q[8 * c + 1] * bfhi(kk.x) + q[8 * c + 3] * bfhi(kk.y) + q[8 * c + 5] * bfhi(kk.z) + q[8 * c + 7] * bfhi(kk.w); }
        float s = s0 + s1;
        if (PAIR) s += __shfl_xor(s, 1);
        if (BIAS) s += bp[-j];
        s = (j >= jmin) ? s : -INFINITY;
        const float mn = fmaxf(m, s), sc = __expf(m - mn), p = __expf(s - mn);
        lsum = lsum * sc + p; m = mn;
        LAS const v4u* vr = (LAS const v4u*)(vp + j * STRIDE);
#pragma unroll
        for (int c = 0; c < 8; ++c) { const v4u vv = vr[c];
            o[8 * c + 0] = o[8 * c + 0] * sc + p * bflo(vv.x); o[8 * c + 1] = o[8 * c + 1] * sc + p * bfhi(vv.x);
            o[8 * c + 2] = o[8 * c + 2] * sc + p * bflo(vv.y); o[8 * c + 3] = o[8 * c + 3] * sc + p * bfhi(vv.y);
            o[8 * c + 4] = o[8 * c + 4] * sc + p * bflo(vv.z); o[8 * c + 5] = o[8 * c + 5] * sc + p * bfhi(vv.z);
            o[8 * c + 6] = o[8 * c + 6] * sc + p * bflo(vv.w); o[8 * c + 7] = o[8 * c + 7] * sc + p * bfhi(vv.w); }
    }
}
__device__ __forceinline__ void load_q64(const bf16* p, float (&q)[64]) {
#pragma unroll
    for (int c = 0; c < 8; ++c) { const v4u w = *((const v4u*)p + c); float f[8]; unpack8(w, f);
#pragma unroll
        for (int i = 0; i < 8; ++i) q[8 * c + i] = f[i]; }
}
__device__ __forceinline__ void store_o64(bf16* p, const float (&o)[64], float inv) {
#pragma unroll
    for (int c = 0; c < 8; ++c) { float f[8];
#pragma unroll
        for (int i = 0; i < 8; ++i) f[i] = o[8 * c + i] * inv;
        *((v4u*)p + c) = pack8(f); }
}

constexpr int SWA_STR = 144, SWA_K = 0, SWA_V = 192 * SWA_STR, SWA_BT = 2 * 192 * SWA_STR, SWA_BTS = 132;
__device__ __forceinline__ void swa_phase(const Args& A, Frame& F0, int l) {
    unsigned char* const ws_ = (unsigned char*)(GAS unsigned char*)karg64<KA_WS>();
    float* const out_ = (float*)(GAS float*)karg64<KA_OUT>();
    const float* const in_I_CSK = (const float*)(const GAS float*)karg64<8 * I_CSK>();
    const float* const in_I_CSV = (const float*)(const GAS float*)karg64<8 * I_CSV>();
    const float* const in_I_RELB = (const float*)(const GAS float*)karg64<8 * I_RELB>();
    const float* const in_I_SINK = (const float*)(const GAS float*)karg64<8 * I_SINK>();
    Frame F = F0; LAUNDER(F);
    LAS unsigned char* Ks = F.lds + SWA_K; LAS unsigned char* Vs = F.lds + SWA_V; LAS float* BT = (LAS float*)(F.lds + SWA_BT);
    for (int i = F.tid; i < SH * 129; i += NTHR) { const int h = i / 129, d = i % 129; BT[h * SWA_BTS + d] = in_I_RELB[t5_bucket(d) * SH + h]; }
    const float* sinks = in_I_SINK + l * SH;
    for (int u = F.vcu; u < 256 + 64; u += F.G) {
        __syncthreads();
        if (u < 256) {
            const int b = u >> 7, kvh = (u >> 6) & 1, qb = u & 63, q0 = qb * 64;
            for (int i = F.tid; i < 192 * 8; i += NTHR) { const int r = i >> 3, c8 = i & 7, pos = q0 - 128 + r; v4u kv = (v4u){0u, 0u, 0u, 0u}, vv = kv;
                if (pos >= 0) { const bf16* zr = ((bf16*)(ws_ + WS_Z)) + (size_t)(b * SEQ + pos) * NINP + kvh * 64 + c8 * 8; kv = *(const v4u*)(zr + ZC_SK); vv = *(const v4u*)(zr + ZC_SV); }
                *(LAS v4u*)(Ks + r * SWA_STR + c8 * 16) = kv; *(LAS v4u*)(Vs + r * SWA_STR + c8 * 16) = vv;
                if (qb == 63 && r >= 64) { float fk[8], fv[8]; unpack8(kv, fk); unpack8(vv, fv); const size_t o = ((((size_t)l * NBP + b) * WIN + (r - 64)) * SKV + kvh) * SHD + c8 * 8;
                    *(f32x4*)(out_ + O_SKP + o) = (f32x4){fk[0], fk[1], fk[2], fk[3]}; *(f32x4*)(out_ + O_SKP + o + 4) = (f32x4){fk[4], fk[5], fk[6], fk[7]};
                    *(f32x4*)(out_ + O_SVP + o) = (f32x4){fv[0], fv[1], fv[2], fv[3]}; *(f32x4*)(out_ + O_SVP + o + 4) = (f32x4){fv[4], fv[5], fv[6], fv[7]}; }
            }
            __syncthreads();
            const int head = kvh * 8 + F.wave, t = q0 + F.lane, row = b * SEQ + t;
            float q[64], o[64]; load_q64(((bf16*)(ws_ + WS_Z)) + (size_t)row * NINP + ZC_SQ + head * 64, q);
#pragma unroll
            for (int i = 0; i < 64; ++i) o[i] = 0.f;
            float m = sinks[head], ls = 1.0f;
            attn_core<SWA_STR, false, true>(q, Ks + F.lane * SWA_STR, Vs + F.lane * SWA_STR, 129, 128 - t, BT + head * SWA_BTS + 128, m, ls, o);
            store_o64(((bf16*)(ws_ + WS_BR)) + (size_t)1 * M * MIXW + (size_t)row * MIXW + head * 64, o, 1.0f / ls);
        } else {
            const int su = u - 256, b = su >> 1, kvh = su & 1;
            for (int i = F.tid; i < 136 * 8; i += NTHR) { const int r = i >> 3, c8 = i & 7; float fk[8], fv[8];
                if (r < 128) { const size_t o = ((((size_t)l * NBS + b) * WIN + r) * SKV + kvh) * SHD + c8 * 8; const f32x4 a0 = *(const f32x4*)(in_I_CSK + o), a1 = *(const f32x4*)(in_I_CSK + o + 4), b0 = *(const f32x4*)(in_I_CSV + o), b1 = *(const f32x4*)(in_I_CSV + o + 4);
#pragma unroll
                    for (int k = 0; k < 4; ++k) { fk[k] = a0[k]; fk[4 + k] = a1[k]; fv[k] = b0[k]; fv[4 + k] = b1[k]; } }
                else { const bf16* zr = ((bf16*)(ws_ + WS_Z)) + (size_t)(MP + b * TS + (r - 128)) * NINP + kvh * 64 + c8 * 8; unpack8(*(const v4u*)(zr + ZC_SK), fk); unpack8(*(const v4u*)(zr + ZC_SV), fv); }
                *(LAS v4u*)(Ks + r * SWA_STR + c8 * 16) = pack8(fk); *(LAS v4u*)(Vs + r * SWA_STR + c8 * 16) = pack8(fv);
                if (r >= 8) { const size_t o = ((((size_t)l * NBS + b) * WIN + (r - 8)) * SKV + kvh) * SHD + c8 * 8;
                    *(f32x4*)(out_ + O_SKS + o) = (f32x4){fk[0], fk[1], fk[2], fk[3]}; *(f32x4*)(out_ + O_SKS + o + 4) = (f32x4){fk[4], fk[5], fk[6], fk[7]};
                    *(f32x4*)(out_ + O_SVS + o) = (f32x4){fv[0], fv[1], fv[2], fv[3]}; *(f32x4*)(out_ + O_SVS + o + 4) = (f32x4){fv[4], fv[5], fv[6], fv[7]}; }
            }
            __syncthreads();
            if (F.wave == 0) {
                const int t = F.lane & 7, head = kvh * 8 + (F.lane >> 3), row = MP + b * TS + t;
                float q[64], o[64]; load_q64(((bf16*)(ws_ + WS_Z)) + (size_t)row * NINP + ZC_SQ + head * 64, q);
#pragma unroll
                for (int i = 0; i < 64; ++i) o[i] = 0.f;
                float m = sinks[head], ls = 1.0f;
                attn_core<SWA_STR, false, true>(q, Ks + t * SWA_STR, Vs + t * SWA_STR, 129, 0, BT + head * SWA_BTS + 128, m, ls, o);
                store_o64(((bf16*)(ws_ + WS_BR)) + (size_t)1 * M * MIXW + (size_t)row * MIXW + head * 64, o, 1.0f / ls);
            }
        }
    }
    __syncthreads();
}

__device__ __forceinline__ void conv_phase(const Args& A, Frame& F0, int l) {
    unsigned char* const ws_ = (unsigned char*)(GAS unsigned char*)karg64<KA_WS>();
    float* const out_ = (float*)(GAS float*)karg64<KA_OUT>();
    const float* const in_I_CONVW = (const float*)(const GAS float*)karg64<8 * I_CONVW>();
    const float* const in_I_SCONV = (const float*)(const GAS float*)karg64<8 * I_SCONV>();
    Frame F = F0; LAUNDER(F);
    const float* cw = in_I_CONVW + (size_t)l * 3 * MIXW; const bf16* Z = (const bf16*)(ws_ + WS_Z); bf16* BRC = (bf16*)(ws_ + WS_BR) + (size_t)2 * M * MIXW;
#pragma unroll 1
    for (int idx = F.vcu * NTHR + F.tid; idx < (M / 8) * (MIXW / 8); idx += F.G * NTHR) {
        const int row0 = (idx >> 7) * 8, c = (idx & 127) * 8; const bool smp = row0 >= MP; const int b = smp ? (row0 - MP) >> 3 : row0 >> 12, t0 = smp ? 0 : (row0 & (SEQ - 1));
        v4u cc[10], ch[10], cbv[8];
#pragma unroll
        for (int k = 0; k < 10; ++k) { cc[k] = (v4u){0u, 0u, 0u, 0u}; ch[k] = cc[k];
            if (k >= 2 || t0 > 0) { const bf16* zr = Z + (size_t)(row0 + k - 2) * NINP + c; cc[k] = *(const v4u*)(zr + ZC_CC); ch[k] = *(const v4u*)(zr + ZC_CH); } }
#pragma unroll
        for (int k = 0; k < 8; ++k) cbv[k] = *(const v4u*)(Z + (size_t)(row0 + k) * NINP + ZC_CB + c);
        float w0[8], w1[8], w2[8];
#pragma unroll
        for (int i = 0; i < 8; ++i) { w0[i] = cw[c + i]; w1[i] = cw[MIXW + c + i]; w2[i] = cw[2 * MIXW + c + i]; }
        float u2[8], u1[8], u0[8];
        { float a[8], d[8]; unpack8(cc[0], a); unpack8(ch[0], d);
#pragma unroll
          for (int i = 0; i < 8; ++i) u2[i] = a[i] * d[i];
          unpack8(cc[1], a); unpack8(ch[1], d);
#pragma unroll
          for (int i = 0; i < 8; ++i) u1[i] = a[i] * d[i]; }
        if (smp) { const float* sp = in_I_SCONV + (((size_t)l * NBS + b) * 2) * MIXW + c; const f32x4 a0 = *(const f32x4*)sp, a1 = *(const f32x4*)(sp + 4), b0 = *(const f32x4*)(sp + MIXW), b1 = *(const f32x4*)(sp + MIXW + 4);
#pragma unroll
            for (int i = 0; i < 4; ++i) { u2[i] = a0[i]; u2[4 + i] = a1[i]; u1[i] = b0[i]; u1[4 + i] = b1[i]; } }
#pragma unroll
        for (int k = 0; k < 8; ++k) { float a[8], d[8], cbf[8], o[8]; unpack8(cc[k + 2], a); unpack8(ch[k + 2], d); unpack8(cbv[k], cbf);
#pragma unroll
            for (int i = 0; i < 8; ++i) { u0[i] = a[i] * d[i]; o[i] = cbf[i] * (w0[i] * u2[i] + w1[i] * u1[i] + w2[i] * u0[i]); }
            *(v4u*)(BRC + (size_t)(row0 + k) * MIXW + c) = pack8(o);
            if (k >= 6 && (smp || t0 == SEQ - 8)) { float* dst = out_ + (smp ? O_CONVS + (((size_t)l * NBS + b) * 2 + (k - 6)) * MIXW : O_CONVP + (((size_t)l * NBP + b) * 2 + (k - 6)) * MIXW) + c;
                *(f32x4*)dst = (f32x4){u0[0], u0[1], u0[2], u0[3]}; *(f32x4*)(dst + 4) = (f32x4){u0[4], u0[5], u0[6], u0[7]}; }
#pragma unroll
            for (int i = 0; i < 8; ++i) { u2[i] = u1[i]; u1[i] = u0[i]; } }
    }
}

__device__ __forceinline__ void gla_stage_wg(const Args& A, Frame& F, int l, int h, LAS float* wgs) {
    const float* const in_I_GB = (const float*)(const GAS float*)karg64<8 * I_GB>();
    const float* const in_I_GUP = (const float*)(const GAS float*)karg64<8 * I_GUP>();
    for (int i = F.tid; i < 16 * 128; i += NTHR) wgs[i] = in_I_GUP[(size_t)l * GRANK * 512 + (i >> 7) * 512 + h * 128 + (i & 127)];
    if (F.tid < 128) wgs[2048 + F.tid] = in_I_GB[l * 512 + h * 128 + F.tid];
}
__device__ __forceinline__ float gla_lg(const float (&gl)[16], LAS const float* wgs, int d) {
    float zg = wgs[2048 + d];
#pragma unroll
    for (int r = 0; r < 16; ++r) zg += gl[r] * wgs[r * 128 + d];
    return (fminf(zg, 0.f) - __logf(1.0f + __expf(-fabsf(zg)))) * (1.0f / 16.0f);
}
__device__ __forceinline__ void load_glr(const bf16* zr, float (&gl)[16]) {
    float a[8], b[8]; unpack8(*(const v4u*)zr, a); unpack8(*(const v4u*)(zr + 8), b);
#pragma unroll
    for (int i = 0; i < 8; ++i) { gl[i] = a[i]; gl[8 + i] = b[i]; }
}
__device__ __forceinline__ void gla_chunk_b(const Args& A, Frame& F, int l, int row0, int h, LAS float* bl, LAS float* wgs) {
    unsigned char* const ws_ = (unsigned char*)(GAS unsigned char*)karg64<KA_WS>();
    gla_stage_wg(A, F, l, h, wgs);
    __syncthreads();
    { const int t = F.tid >> 3, dg = F.tid & 7; float gl[16]; load_glr(((bf16*)(ws_ + WS_Z)) + (size_t)(row0 + t) * NINP + ZC_GLR, gl);
#pragma unroll 4
      for (int dd = 0; dd < 16; ++dd) { const int d = dg * 16 + dd; bl[t * 128 + d] = gla_lg(gl, wgs, d); } }
    __syncthreads();
    if (F.tid < 128) { float a = 0.f; for (int t = 0; t < 64; ++t) { a += bl[t * 128 + F.tid]; bl[t * 128 + F.tid] = a; } }
    __syncthreads();
}

typedef short bf16x8 __attribute__((ext_vector_type(8)));
typedef short v4i16_t __attribute__((ext_vector_type(4)));
#define MFMA16(a, b, c) __builtin_amdgcn_mfma_f32_16x16x32_bf16((a), (b), (c), 0, 0, 0)
__device__ __forceinline__ bf16x8 frag_row(LAS const unsigned char* T, int stride, int r0, int k0, int lane) {
    return *(LAS const bf16x8*)(T + (r0 + (lane & 15)) * stride + (k0 + 8 * (lane >> 4)) * 2);
}
__device__ __forceinline__ bf16x8 frag_tr(LAS const unsigned char* T, int stride, int rlo, int rhi, int n0, int lane) {
    const int q = (lane & 15) >> 2, p = lane & 3;
    const v4i16_t lo = __builtin_amdgcn_ds_read_tr16_b64_v4i16((LAS v4i16_t*)(T + (rlo + q) * stride + n0 * 2 + 8 * p));
    const v4i16_t hi = __builtin_amdgcn_ds_read_tr16_b64_v4i16((LAS v4i16_t*)(T + (rhi + q) * stride + n0 * 2 + 8 * p));
    return (bf16x8){lo[0], lo[1], lo[2], lo[3], hi[0], hi[1], hi[2], hi[3]};
}
__device__ __forceinline__ bf16x8 pack_p(const f32x4 a, const f32x4 b) {
    v4u w; w.x = pk2(a[0], a[1]); w.y = pk2(a[2], a[3]); w.z = pk2(b[0], b[1]); w.w = pk2(b[2], b[3]); return __builtin_bit_cast(bf16x8, w);
}

constexpr int SW_STR = 160, SW_ROWS = 208, SW_K = 0, SW_V = SW_ROWS * SW_STR, SW_BT = 2 * SW_ROWS * SW_STR;
__device__ __forceinline__ void swa_tile(LAS const unsigned char* Ks, LAS const unsigned char* Vs, LAS const float* bt, float sink, const bf16* qrow, bf16* orow, int krow0, int kmin, bool store, int lane) {
    const int n = lane & 15, g = lane >> 4;
    bf16x8 qf[2];
#pragma unroll
    for (int ks = 0; ks < 2; ++ks) qf[ks] = *(const bf16x8*)(qrow + 32 * ks + 8 * g);
    f32x4 s[10];
#pragma unroll
    for (int mt = 0; mt < 10; ++mt) { s[mt] = (f32x4){0.f, 0.f, 0.f, 0.f};
#pragma unroll
        for (int ks = 0; ks < 2; ++ks) s[mt] = MFMA16(frag_row(Ks, SW_STR, krow0 + 16 * mt, 32 * ks, lane), qf[ks], s[mt]); }
    float mx = sink;
#pragma unroll
    for (int mt = 0; mt < 10; ++mt)
#pragma unroll
        for (int i = 0; i < 4; ++i) { const int kcol = 16 * mt + 4 * g + i, dist = n + 128 - kcol; const bool valid = (dist >= 0) && (dist <= 128) && (kcol >= kmin);
            const int di = dist < 0 ? 0 : (dist > 128 ? 128 : dist); const float v = valid ? s[mt][i] + bt[di] : -INFINITY; s[mt][i] = v; mx = fmaxf(mx, v); }
    mx = fmaxf(mx, __shfl_xor(mx, 16)); mx = fmaxf(mx, __shfl_xor(mx, 32));
    float sum = 0.f;
#pragma unroll
    for (int mt = 0; mt < 10; ++mt)
#pragma unroll
        for (int i = 0; i < 4; ++i) { const float p = __expf(s[mt][i] - mx); s[mt][i] = p; sum += p; }
    sum += __shfl_xor(sum, 16); sum += __shfl_xor(sum, 32);
    const float inv = 1.0f / (sum + __expf(sink - mx));
    f32x4 o[4];
#pragma unroll
    for (int mt = 0; mt < 4; ++mt) o[mt] = (f32x4){0.f, 0.f, 0.f, 0.f};
#pragma unroll
    for (int k2 = 0; k2 < 5; ++k2) { const bf16x8 pf = pack_p(s[2 * k2], s[2 * k2 + 1]);
#pragma unroll
        for (int mt = 0; mt < 4; ++mt) o[mt] = MFMA16(frag_tr(Vs, SW_STR, krow0 + 32 * k2 + 4 * g, krow0 + 32 * k2 + 16 + 4 * g, 16 * mt, lane), pf, o[mt]); }
    if (store) {
#pragma unroll
        for (int mt = 0; mt < 4; ++mt) { v2u w; w.x = pk2(o[mt][0] * inv, o[mt][1] * inv); w.y = pk2(o[mt][2] * inv, o[mt][3] * inv); *(v2u*)(orow + 16 * mt + 4 * g) = w; } }
}
__device__ __forceinline__ void swa_phase_mfma(const Args& A, Frame& F0, int l) {
    unsigned char* const ws_ = (unsigned char*)(GAS unsigned char*)karg64<KA_WS>();
    float* const out_ = (float*)(GAS float*)karg64<KA_OUT>();
    const float* const in_I_CSK = (const float*)(const GAS float*)karg64<8 * I_CSK>();
    const float* const in_I_CSV = (const float*)(const GAS float*)karg64<8 * I_CSV>();
    const float* const in_I_RELB = (const float*)(const GAS float*)karg64<8 * I_RELB>();
    const float* const in_I_SINK = (const float*)(const GAS float*)karg64<8 * I_SINK>();
    Frame F = F0; LAUNDER(F);
    LAS unsigned char* Ks = F.lds + SW_K; LAS unsigned char* Vs = F.lds + SW_V; LAS float* BT = (LAS float*)(F.lds + SW_BT);
    const bf16* Z = (const bf16*)(ws_ + WS_Z); bf16* BRB = (bf16*)(ws_ + WS_BR) + (size_t)M * MIXW;
    for (int i = F.tid; i < SH * 129; i += NTHR) { const int h = i / 129, d = i % 129; BT[h * SWA_BTS + d] = in_I_RELB[t5_bucket(d) * SH + h]; }
    const float* sinks = in_I_SINK + l * SH;
#pragma unroll 1
    for (int u = F.vcu; u < 256 + 64; u += F.G) {
        asm volatile("" : "+v"(F.tid), "+v"(F.lane));
        __syncthreads();
        if (u < 256) {
            const int b = u >> 7, kvh = (u >> 6) & 1, qb = u & 63, q0 = qb * 64;
            for (int i = F.tid; i < SW_ROWS * 8; i += NTHR) { const int r = i >> 3, c8 = i & 7, pos = q0 - 128 + r; v4u kv = (v4u){0u, 0u, 0u, 0u}, vv = kv;
                if (pos >= 0 && pos < SEQ) { const bf16* zr = Z + (size_t)(b * SEQ + pos) * NINP + kvh * 64 + c8 * 8; kv = *(const v4u*)(zr + ZC_SK); vv = *(const v4u*)(zr + ZC_SV); }
                *(LAS v4u*)(Ks + r * SW_STR + c8 * 16) = kv; *(LAS v4u*)(Vs + r * SW_STR + c8 * 16) = vv;
                if (qb == 63 && r >= 64 && r < 192) { float fk[8], fv[8]; unpack8(kv, fk); unpack8(vv, fv); const size_t o = ((((size_t)l * NBP + b) * WIN + (r - 64)) * SKV + kvh) * SHD + c8 * 8;
                    *(f32x4*)(out_ + O_SKP + o) = (f32x4){fk[0], fk[1], fk[2], fk[3]}; *(f32x4*)(out_ + O_SKP + o + 4) = (f32x4){fk[4], fk[5], fk[6], fk[7]};
                    *(f32x4*)(out_ + O_SVP + o) = (f32x4){fv[0], fv[1], fv[2], fv[3]}; *(f32x4*)(out_ + O_SVP + o + 4) = (f32x4){fv[4], fv[5], fv[6], fv[7]}; }
            }
            __syncthreads();
            const int head = kvh * 8 + F.wave; const float sink = sinks[head];
#pragma unroll 1
            for (int mq = 0; mq < 4; ++mq) {
                int ln = F.lane; asm volatile("" : "+v"(ln));
                const int t0 = q0 + 16 * mq; const size_t row = (size_t)b * SEQ + t0 + (ln & 15);
                swa_tile(Ks, Vs, BT + head * SWA_BTS, sink, Z + row * NINP + ZC_SQ + head * 64, BRB + row * MIXW + head * 64, 16 * mq, 128 - t0, true, ln);
            }
        } else {
            const int su = u - 256, b = su >> 1, kvh = su & 1;
            for (int i = F.tid; i < 160 * 8; i += NTHR) { const int r = i >> 3, c8 = i & 7; float fk[8], fv[8];
                if (r < 128) { const size_t o = ((((size_t)l * NBS + b) * WIN + r) * SKV + kvh) * SHD + c8 * 8; const f32x4 a0 = *(const f32x4*)(in_I_CSK + o), a1 = *(const f32x4*)(in_I_CSK + o + 4), b0 = *(const f32x4*)(in_I_CSV + o), b1 = *(const f32x4*)(in_I_CSV + o + 4);
#pragma unroll
                    for (int k = 0; k < 4; ++k) { fk[k] = a0[k]; fk[4 + k] = a1[k]; fv[k] = b0[k]; fv[4 + k] = b1[k]; } }
                else if (r < 136) { const bf16* zr = Z + (size_t)(MP + b * TS + (r - 128)) * NINP + kvh * 64 + c8 * 8; unpack8(*(const v4u*)(zr + ZC_SK), fk); unpack8(*(const v4u*)(zr + ZC_SV), fv); }
                else {
#pragma unroll
                    for (int k = 0; k < 8; ++k) { fk[k] = 0.f; fv[k] = 0.f; } }
                *(LAS v4u*)(Ks + r * SW_STR + c8 * 16) = pack8(fk); *(LAS v4u*)(Vs + r * SW_STR + c8 * 16) = pack8(fv);
                if (r >= 8 && r < 136) { const size_t o = ((((size_t)l * NBS + b) * WIN + (r - 8)) * SKV + kvh) * SHD + c8 * 8;
                    *(f32x4*)(out_ + O_SKS + o) = (f32x4){fk[0], fk[1], fk[2], fk[3]}; *(f32x4*)(out_ + O_SKS + o + 4) = (f32x4){fk[4], fk[5], fk[6], fk[7]};
                    *(f32x4*)(out_ + O_SVS + o) = (f32x4){fv[0], fv[1], fv[2], fv[3]}; *(f32x4*)(out_ + O_SVS + o + 4) = (f32x4){fv[4], fv[5], fv[6], fv[7]}; }
            }
            __syncthreads();
            const int head = kvh * 8 + F.wave, n = F.lane & 15; const size_t row = (size_t)MP + b * TS + (n & 7);
            swa_tile(Ks, Vs, BT + head * SWA_BTS, sinks[head], Z + row * NINP + ZC_SQ + head * 64, BRB + row * MIXW + head * 64, 0, 0, n < 8, F.lane);
        }
    }
    __syncthreads();
}

constexpr int XA_STR = 272, XA_K = 0, XA_V = 256 * XA_STR;
__device__ __forceinline__ void xattn_tile(LAS const unsigned char* Ks, LAS const unsigned char* Vs, const bf16* qrow, bf16* orow, bool store, int lane) {
    const int g = lane >> 4;
    bf16x8 qf[4];
#pragma unroll
    for (int ks = 0; ks < 4; ++ks) qf[ks] = *(const bf16x8*)(qrow + 32 * ks + 8 * g);
    f32x4 s[16]; float mx = -INFINITY;
#pragma unroll
    for (int mt = 0; mt < 16; ++mt) { s[mt] = (f32x4){0.f, 0.f, 0.f, 0.f};
#pragma unroll
        for (int ks = 0; ks < 4; ++ks) s[mt] = MFMA16(frag_row(Ks, XA_STR, 16 * mt, 32 * ks, lane), qf[ks], s[mt]);
        mx = fmaxf(mx, fmaxf(fmaxf(s[mt][0], s[mt][1]), fmaxf(s[mt][2], s[mt][3]))); }
    mx = fmaxf(mx, __shfl_xor(mx, 16)); mx = fmaxf(mx, __shfl_xor(mx, 32));
    float sum = 0.f;
#pragma unroll
    for (int mt = 0; mt < 16; ++mt)
#pragma unroll
        for (int i = 0; i < 4; ++i) { const float p = __expf(s[mt][i] - mx); s[mt][i] = p; sum += p; }
    sum += __shfl_xor(sum, 16); sum += __shfl_xor(sum, 32);
    const float inv = 1.0f / sum;
    f32x4 o[8];
#pragma unroll
    for (int mt = 0; mt < 8; ++mt) o[mt] = (f32x4){0.f, 0.f, 0.f, 0.f};
#pragma unroll
    for (int k2 = 0; k2 < 8; ++k2) { const bf16x8 pf = pack_p(s[2 * k2], s[2 * k2 + 1]);
#pragma unroll
        for (int mt = 0; mt < 8; ++mt) o[mt] = MFMA16(frag_tr(Vs, XA_STR, 32 * k2 + 4 * g, 32 * k2 + 16 + 4 * g, 16 * mt, lane), pf, o[mt]); }
    if (store) {
#pragma unroll
        for (int mt = 0; mt < 8; ++mt) { v2u w; w.x = pk2(o[mt][0] * inv, o[mt][1] * inv); w.y = pk2(o[mt][2] * inv, o[mt][3] * inv); *(v2u*)(orow + 16 * mt + 4 * g) = w; } }
}
__device__ __forceinline__ void xattn_phase_mfma(const Args& A, Frame& F0, int l) {
    unsigned char* const ws_ = (unsigned char*)(GAS unsigned char*)karg64<KA_WS>();
    const float* const in_I_CMK = (const float*)(const GAS float*)karg64<8 * I_CMK>();
    const float* const in_I_CMV = (const float*)(const GAS float*)karg64<8 * I_CMV>();
    Frame F = F0; LAUNDER(F);
    LAS unsigned char* Ks = F.lds + XA_K; LAS unsigned char* Vs = F.lds + XA_V;
    const bf16* XQ = (const bf16*)(ws_ + WS_XQ); bf16* XO = (bf16*)(ws_ + WS_XO);
#pragma unroll 1
    for (int u = F.vcu; u < 128 + 128; u += F.G) {
        asm volatile("" : "+v"(F.tid), "+v"(F.lane));
        __syncthreads();
        if (u < 128) {
            const int b = u >> 6, h = (u >> 4) & 3, q0 = (u & 15) * 256;
            for (int i = F.tid; i < 256 * 16; i += NTHR) { const int mrow = i >> 4, c8 = i & 15; const bf16* src = (const bf16*)(ws_ + WS_MEMKV) + ((size_t)l * 512 + b * 256 + mrow) * 1024 + h * 128 + c8 * 8;
                *(LAS v4u*)(Ks + mrow * XA_STR + c8 * 16) = *(const v4u*)src; *(LAS v4u*)(Vs + mrow * XA_STR + c8 * 16) = *(const v4u*)(src + 512); }
            __syncthreads();
#pragma unroll 1
            for (int qt = F.wave; qt < 16; qt += NWAVES) { int ln = F.lane; asm volatile("" : "+v"(ln)); const size_t row = (size_t)b * SEQ + q0 + 16 * qt + (ln & 15);
                xattn_tile(Ks, Vs, XQ + row * XW + h * 128, XO + row * XW + h * 128, true, ln); }
        } else {
            const int su = u - 128, b = su >> 2, h = su & 3;
            for (int i = F.tid; i < 256 * 16; i += NTHR) { const int mrow = i >> 4, c8 = i & 15; const size_t o = (((size_t)l * NBS + b) * NMEM + mrow) * XW + h * 128 + c8 * 8; float fk[8], fv[8];
                const f32x4 a0 = *(const f32x4*)(in_I_CMK + o), a1 = *(const f32x4*)(in_I_CMK + o + 4), b0 = *(const f32x4*)(in_I_CMV + o), b1 = *(const f32x4*)(in_I_CMV + o + 4);
#pragma unroll
                for (int k = 0; k < 4; ++k) { fk[k] = a0[k]; fk[4 + k] = a1[k]; fv[k] = b0[k]; fv[4 + k] = b1[k]; }
                *(LAS v4u*)(Ks + mrow * XA_STR + c8 * 16) = pack8(fk); *(LAS v4u*)(Vs + mrow * XA_STR + c8 * 16) = pack8(fv); }
            __syncthreads();
            if (F.wave == 0) { const int n = F.lane & 15; const size_t row = (size_t)MP + b * TS + (n & 7);
                xattn_tile(Ks, Vs, XQ + row * XW + h * 128, XO + row * XW + h * 128, n < 8, F.lane); }
        }
    }
    __syncthreads();
}

__device__ __forceinline__ void gla_scan16(const bf16* Z, int row0, int lane, int wave, LAS const float* wgs, float (&bb)[16], float (&bend)[16]) {
    float gl[16]; load_glr(Z + (size_t)(row0 + lane) * NINP + ZC_GLR, gl);
#pragma unroll
    for (int dd = 0; dd < 16; ++dd) { float x = gla_lg(gl, wgs, 16 * wave + dd);
#pragma unroll
        for (int off = 1; off < 64; off <<= 1) { const float y = __shfl_up(x, off); if (lane >= off) x += y; }
        bb[dd] = x; bend[dd] = __shfl(x, 63); }
}
__device__ __forceinline__ void load16(const bf16* p, float (&f)[16]) {
    float a[8], b[8]; unpack8(*(const v4u*)p, a); unpack8(*(const v4u*)(p + 8), b);
#pragma unroll
    for (int i = 0; i < 8; ++i) { f[i] = a[i]; f[8 + i] = b[i]; }
}
__device__ __forceinline__ void store16_lds(LAS unsigned char* p, const float (&f)[16]) {
    v4u w0, w1; w0.x = pk2(f[0], f[1]); w0.y = pk2(f[2], f[3]); w0.z = pk2(f[4], f[5]); w0.w = pk2(f[6], f[7]); w1.x = pk2(f[8], f[9]); w1.y = pk2(f[10], f[11]); w1.z = pk2(f[12], f[13]); w1.w = pk2(f[14], f[15]);
    *(LAS v4u*)p = w0; *(LAS v4u*)(p + 16) = w1;
}
constexpr int G1_KSTR = 288, G1_VSTR = 544, G1_WGS = 0, G1_KT = 9216, G1_V = G1_KT + 64 * G1_KSTR;
__device__ __forceinline__ void gla_pass1_prompt_mfma(const Args& A, Frame& F, int l, int u) {
    unsigned char* const ws_ = (unsigned char*)(GAS unsigned char*)karg64<KA_WS>();
    LAS float* wgs = (LAS float*)(F.lds + G1_WGS); LAS unsigned char* Kt = F.lds + G1_KT; LAS unsigned char* Vb = F.lds + G1_V;
    const bf16* Z = (const bf16*)(ws_ + WS_Z);
    const int bh = u >> 6, c = u & 63, b = bh >> 2, h = bh & 3, row0 = b * SEQ + c * 64, lane = F.lane, w = F.wave;
    gla_stage_wg(A, F, l, h, wgs);
#pragma unroll 2
    for (int i = F.tid; i < 64 * 32; i += NTHR) { const int t = i >> 5, c8 = i & 31; *(LAS v4u*)(Vb + t * G1_VSTR + c8 * 16) = *(const v4u*)(Z + (size_t)(row0 + t) * NINP + ZC_GV + h * 256 + c8 * 8); }
    __syncthreads();
    { float bb[16], bend[16], k[16]; gla_scan16(Z, row0, lane, w, wgs, bb, bend); load16(Z + (size_t)(row0 + lane) * NINP + ZC_GK + h * 128 + 16 * w, k);
#pragma unroll
      for (int dd = 0; dd < 16; ++dd) k[dd] *= __expf(bend[dd] - bb[dd]);
      store16_lds(Kt + lane * G1_KSTR + 32 * w, k);
      { float* bo = (float*)(ws_ + WS_GLAB) + ((size_t)u * 64 + lane) * 128 + 16 * w;
#pragma unroll
        for (int q4 = 0; q4 < 4; ++q4) *(f32x4*)(bo + 4 * q4) = (f32x4){bb[4 * q4], bb[4 * q4 + 1], bb[4 * q4 + 2], bb[4 * q4 + 3]}; }
      if (lane == 0) {
#pragma unroll
          for (int dd = 0; dd < 16; ++dd) ((float*)(ws_ + WS_GLAD))[(size_t)u * 128 + 16 * w + dd] = __expf(bend[dd]); } }
    __syncthreads();
    const int g = lane >> 4, n = lane & 15;
    bf16x8 af[2];
#pragma unroll
    for (int ks = 0; ks < 2; ++ks) af[ks] = frag_tr(Kt, G1_KSTR, 32 * ks + 8 * g, 32 * ks + 8 * g + 4, 16 * w, lane);
    float* U = (float*)(ws_ + WS_GLAU) + (size_t)u * GDK * GDV;
#pragma unroll 4
    for (int nt = 0; nt < 16; ++nt) { f32x4 acc = (f32x4){0.f, 0.f, 0.f, 0.f};
#pragma unroll
        for (int ks = 0; ks < 2; ++ks) acc = MFMA16(af[ks], frag_tr(Vb, G1_VSTR, 32 * ks + 8 * g, 32 * ks + 8 * g + 4, 16 * nt, lane), acc);
        *(f32x4*)(U + (size_t)(16 * nt + n) * 128 + 16 * w + 4 * g) = acc; }
}
constexpr int G3_QSTR = 272, G3_VSTR = 528, G3_PSTR = 160, G3_QD = 0, G3_KD = 64 * G3_QSTR, G3_V = 2 * 64 * G3_QSTR, G3_S = G3_V + 64 * G3_VSTR, G3_PM = G3_S + 128 * G3_VSTR, G3_END = G3_PM + 64 * G3_PSTR;
static_assert(G3_END <= 146944 && 64 * 260 * 4 <= 128 * G3_VSTR && 8704 <= 64 * G3_PSTR, "pass-3 LDS map");
__device__ __forceinline__ void gla_pass3_mfma(const Args& A, Frame& F0, int l) {
    unsigned char* const ws_ = (unsigned char*)(GAS unsigned char*)karg64<KA_WS>();
    const float* const in_I_GNORM = (const float*)(const GAS float*)karg64<8 * I_GNORM>();
    Frame F = F0; LAUNDER(F);
    LAS unsigned char* Qd = F.lds + G3_QD; LAS unsigned char* Kd = F.lds + G3_KD; LAS unsigned char* Vb = F.lds + G3_V; LAS unsigned char* Sb = F.lds + G3_S; LAS unsigned char* Pm = F.lds + G3_PM;
    LAS float* wgs = (LAS float*)Pm; LAS float* Of = (LAS float*)Sb;
    const bf16* Z = (const bf16*)(ws_ + WS_Z); bf16* BRA = (bf16*)(ws_ + WS_BR);
#pragma unroll 1
    for (int u = F.vcu; u < 512; u += F.G) {
        asm volatile("" : "+v"(F.tid), "+v"(F.lane));
        const int lane = F.lane, w = F.wave, g = lane >> 4, n = lane & 15;
        __syncthreads();
        const int bh = u >> 6, c = u & 63, b = bh >> 2, h = bh & 3, row0 = b * SEQ + c * 64; const bf16* Sg = (const bf16*)(ws_ + WS_GLAS) + (size_t)u * GDK * GDV;
#pragma unroll 2
        for (int i = F.tid; i < 64 * 32; i += NTHR) { const int t = i >> 5, c8 = i & 31; *(LAS v4u*)(Vb + t * G3_VSTR + c8 * 16) = *(const v4u*)(Z + (size_t)(row0 + t) * NINP + ZC_GV + h * 256 + c8 * 8); }
        { float bb[16], q[16], k[16];
          { const float* bi = (const float*)(ws_ + WS_GLAB) + ((size_t)u * 64 + lane) * 128 + 16 * w;
#pragma unroll
            for (int q4 = 0; q4 < 4; ++q4) { const f32x4 t4 = *(const f32x4*)(bi + 4 * q4); bb[4 * q4] = t4[0]; bb[4 * q4 + 1] = t4[1]; bb[4 * q4 + 2] = t4[2]; bb[4 * q4 + 3] = t4[3]; } }
          load16(Z + (size_t)(row0 + lane) * NINP + ZC_GQ + h * 128 + 16 * w, q); load16(Z + (size_t)(row0 + lane) * NINP + ZC_GK + h * 128 + 16 * w, k);
#pragma unroll
          for (int dd = 0; dd < 16; ++dd) { q[dd] *= __expf(bb[dd]); k[dd] *= __expf(-bb[dd]); }
          store16_lds(Qd + lane * G3_QSTR + 32 * w, q); store16_lds(Kd + lane * G3_QSTR + 32 * w, k); }
        __syncthreads();
        {
            const int mt = w >> 1;
#pragma unroll
            for (int j = 0; j < 2; ++j) { const int nt = 2 * (w & 1) + j; f32x4 acc = (f32x4){0.f, 0.f, 0.f, 0.f};
#pragma unroll
                for (int ks = 0; ks < 4; ++ks) acc = MFMA16(frag_row(Qd, G3_QSTR, 16 * mt, 32 * ks, lane), frag_row(Kd, G3_QSTR, 16 * nt, 32 * ks, lane), acc);
#pragma unroll
                for (int i = 0; i < 4; ++i) { const int t = 16 * mt + 4 * g + i, s = 16 * nt + n; *(LAS bf16*)(Pm + t * G3_PSTR + s * 2) = (bf16)(pk2((s <= t) ? acc[i] : 0.f, 0.f) & 0xffffu); } }
        }
        __syncthreads();
        f32x4 o[4][2];
#pragma unroll
        for (int mt = 0; mt < 4; ++mt) { o[mt][0] = (f32x4){0.f, 0.f, 0.f, 0.f}; o[mt][1] = (f32x4){0.f, 0.f, 0.f, 0.f}; }
#pragma unroll
        for (int j = 0; j < 2; ++j) { const int nt = 2 * w + j;
#pragma unroll
            for (int ks = 0; ks < 4; ++ks) { const bf16x8 bf = *(const bf16x8*)(Sg + (size_t)(16 * nt + n) * 128 + 32 * ks + 8 * g);
#pragma unroll
                for (int mt = 0; mt < 4; ++mt) o[mt][j] = MFMA16(frag_row(Qd, G3_QSTR, 16 * mt, 32 * ks, lane), bf, o[mt][j]); }
#pragma unroll
            for (int ks = 0; ks < 2; ++ks) { const bf16x8 bf = frag_tr(Vb, G3_VSTR, 32 * ks + 8 * g, 32 * ks + 8 * g + 4, 16 * nt, lane);
#pragma unroll
                for (int mt = 0; mt < 4; ++mt) o[mt][j] = MFMA16(frag_row(Pm, G3_PSTR, 16 * mt, 32 * ks, lane), bf, o[mt][j]); } }
        __syncthreads();
#pragma unroll
        for (int mt = 0; mt < 4; ++mt)
#pragma unroll
            for (int j = 0; j < 2; ++j)
#pragma unroll
                for (int i = 0; i < 4; ++i) Of[(16 * mt + 4 * g + i) * 260 + 16 * (2 * w + j) + n] = o[mt][j][i];
        __syncthreads();
        {
            const int tb = F.tid >> 5, vb = F.tid & 31; float gn[8];
#pragma unroll
            for (int j = 0; j < 8; ++j) gn[j] = in_I_GNORM[l * GDV + 8 * vb + j];
#pragma unroll
            for (int i = 0; i < 4; ++i) { const int t = 4 * tb + i; const f32x4 o0 = *(LAS const f32x4*)(Of + t * 260 + 8 * vb), o1 = *(LAS const f32x4*)(Of + t * 260 + 8 * vb + 4);
                float ov[8] = {o0[0], o0[1], o0[2], o0[3], o1[0], o1[1], o1[2], o1[3]}; float ss = 0.f;
#pragma unroll
                for (int j = 0; j < 8; ++j) ss += ov[j] * ov[j];
#pragma unroll
                for (int x = 1; x < 32; x <<= 1) ss += __shfl_xor(ss, x);
                const float rs = rsqrtf(ss * (1.0f / 256.0f) + EPS); const int row = row0 + t; float gv[8], r[8]; unpack8(*(const v4u*)(Z + (size_t)row * NINP + ZC_GR + h * 256 + 8 * vb), gv);
#pragma unroll
                for (int j = 0; j < 8; ++j) r[j] = ov[j] * rs * gn[j] * gv[j] * sigm(gv[j]);
                *(v4u*)(BRA + (size_t)row * MIXW + h * 256 + 8 * vb) = pack8(r); }
        }
    }
    __syncthreads();
}
__device__ __forceinline__ void gla_pass1(const Args& A, Frame& F0, int l) {
    unsigned char* const ws_ = (unsigned char*)(GAS unsigned char*)karg64<KA_WS>();
    float* const out_ = (float*)(GAS float*)karg64<KA_OUT>();
    const float* const in_I_GNORM = (const float*)(const GAS float*)karg64<8 * I_GNORM>();
    const float* const in_I_SGLA = (const float*)(const GAS float*)karg64<8 * I_SGLA>();
    Frame F = F0; LAUNDER(F);
    LAS float* bl = (LAS float*)(F.lds); LAS float* kt = (LAS float*)(F.lds + 32768); LAS float* wgs = (LAS float*)(F.lds + 65536);
#pragma unroll 1
    for (int u = F.vcu; u < 512 + 128; u += F.G) {
        asm volatile("" : "+v"(F.tid), "+v"(F.lane));
        __syncthreads();
        if (u < 512) {
            gla_pass1_prompt_mfma(A, F, l, u);
        } else {
            const int su = u - 512, b = su >> 2, h = su & 3, row0 = MP + b * TS;
            LAS float* qs = (LAS float*)(F.lds); LAS float* ks = qs + 1024; LAS float* es = qs + 2048; LAS float* vs = qs + 3072; LAS float* red = qs + 5120;
            gla_stage_wg(A, F, l, h, wgs);
            __syncthreads();
            { const int t = F.tid >> 6, dp = F.tid & 63; float gl[16]; load_glr(((bf16*)(ws_ + WS_Z)) + (size_t)(row0 + t) * NINP + ZC_GLR, gl);
              es[t * 128 + 2 * dp] = __expf(gla_lg(gl, wgs, 2 * dp)); es[t * 128 + 2 * dp + 1] = __expf(gla_lg(gl, wgs, 2 * dp + 1)); }
            for (int i = F.tid; i < 8 * 128; i += NTHR) { const int t = i >> 7, d = i & 127; const bf16* zr = ((bf16*)(ws_ + WS_Z)) + (size_t)(row0 + t) * NINP + h * 128 + d; qs[i] = bf1(zr[ZC_GQ]); ks[i] = bf1(zr[ZC_GK]); }
            for (int i = F.tid; i < 8 * 256; i += NTHR) { const int t = i >> 8, v = i & 255; vs[i] = bf1(((bf16*)(ws_ + WS_Z))[(size_t)(row0 + t) * NINP + ZC_GV + h * 256 + v]); }
            __syncthreads();
            const int v = F.tid & 255, half = F.tid >> 8; const size_t sidx = (((size_t)l * NBS + b) * GH + h) * GDK * GDV;
            const float* S0 = in_I_SGLA + sidx + (size_t)(64 * half) * 256 + v;
            float S[64];
#pragma unroll
            for (int i = 0; i < 64; ++i) S[i] = S0[i * 256];
            for (int t = 0; t < 8; ++t) { const float vv = vs[t * 256 + v]; float part = 0.f;
#pragma unroll
                for (int i = 0; i < 64; ++i) { const int d = 64 * half + i; S[i] = es[t * 128 + d] * S[i] + ks[t * 128 + d] * vv; part += qs[t * 128 + d] * S[i]; }
                red[(t * 2 + half) * 256 + v] = part; }
            float* So = out_ + O_GLAS + sidx + (size_t)(64 * half) * 256 + v;
#pragma unroll
            for (int i = 0; i < 64; ++i) So[i * 256] = S[i];
            __syncthreads();
            { const int t = F.wave, row = row0 + t; float o[4]; float ss = 0.f;
#pragma unroll
              for (int k = 0; k < 4; ++k) { const int vv = F.lane + 64 * k; o[k] = red[(t * 2) * 256 + vv] + red[(t * 2 + 1) * 256 + vv]; ss += o[k] * o[k]; }
              ss = wave_sum(ss); const float rs = rsqrtf(ss * (1.0f / 256.0f) + EPS);
#pragma unroll
              for (int k = 0; k < 4; ++k) { const int vv = F.lane + 64 * k; const float g = bf1(((bf16*)(ws_ + WS_Z))[(size_t)row * NINP + ZC_GR + h * 256 + vv]);
                  ((bf16*)(ws_ + WS_BR))[(size_t)row * MIXW + h * 256 + vv] = (bf16)(pk2(o[k] * rs * in_I_GNORM[l * GDV + vv] * g * sigm(g), 0.f) & 0xffffu); } }
        }
    }
    __syncthreads();
}
__device__ __forceinline__ void gla_pass2(const Args& A, Frame& F0, int l) {
    unsigned char* const ws_ = (unsigned char*)(GAS unsigned char*)karg64<KA_WS>();
    float* const out_ = (float*)(GAS float*)karg64<KA_OUT>();
    Frame F = F0; LAUNDER(F);
#pragma unroll 1
    for (int e = F.vcu * NTHR + F.tid; e < 8 * GDK * GDV; e += F.G * NTHR) {
        const int bh = e >> 15, vd = e & 32767, v = vd >> 7, d = vd & 127;
        const float* U = ((const float*)(ws_ + WS_GLAU)) + (size_t)bh * 64 * GDK * GDV + vd; const float* D = ((const float*)(ws_ + WS_GLAD)) + (size_t)bh * 64 * 128 + d;
        bf16* Sg = ((bf16*)(ws_ + WS_GLAS)) + (size_t)bh * 64 * GDK * GDV + vd;
        float S = 0.f;
#pragma unroll 1
        for (int c0 = 0; c0 < 64; c0 += 16) { float uu[16], dd[16];
#pragma unroll
            for (int k = 0; k < 16; ++k) { uu[k] = U[(size_t)(c0 + k) * GDK * GDV]; dd[k] = D[(c0 + k) * 128]; }
#pragma unroll
            for (int k = 0; k < 16; ++k) { Sg[(size_t)(c0 + k) * GDK * GDV] = (bf16)(pk2(S, 0.f) & 0xffffu); S = dd[k] * S + uu[k]; } }
        out_[O_GLAP + ((size_t)l * 8 + bh) * GDK * GDV + (size_t)d * GDV + v] = S;
    }
}
__device__ __forceinline__ void gla_pass3(const Args& A, Frame& F0, int l) {
    unsigned char* const ws_ = (unsigned char*)(GAS unsigned char*)karg64<KA_WS>();
    const float* const in_I_GNORM = (const float*)(const GAS float*)karg64<8 * I_GNORM>();
    Frame F = F0; LAUNDER(F);
    LAS float* bl = (LAS float*)(F.lds); LAS float* qdT = (LAS float*)(F.lds + 32768); LAS float* kdT = (LAS float*)(F.lds + 67584); LAS float* Am = (LAS float*)(F.lds + 102400); LAS float* wgs = (LAS float*)(F.lds + 119808);
    for (int u = F.vcu; u < 512; u += F.G) {
        __syncthreads();
        const int bh = u >> 6, c = u & 63, b = bh >> 2, h = bh & 3, row0 = b * SEQ + c * 64;
        gla_chunk_b(A, F, l, row0, h, bl, wgs);
        { const int t = F.tid & 63, dg = F.tid >> 6; const bf16* zr = ((bf16*)(ws_ + WS_Z)) + (size_t)(row0 + t) * NINP + h * 128 + dg * 16; float q[16], k[16];
          { float a[8], bb[8]; unpack8(*(const v4u*)(zr + ZC_GQ), a); unpack8(*(const v4u*)(zr + ZC_GQ + 8), bb);
#pragma unroll
            for (int i = 0; i < 8; ++i) { q[i] = a[i]; q[8 + i] = bb[i]; }
            unpack8(*(const v4u*)(zr + ZC_GK), a); unpack8(*(const v4u*)(zr + ZC_GK + 8), bb);
#pragma unroll
            for (int i = 0; i < 8; ++i) { k[i] = a[i]; k[8 + i] = bb[i]; } }
#pragma unroll
          for (int i = 0; i < 16; ++i) { const int d = dg * 16 + i; const float bb = bl[t * 128 + d]; qdT[d * 68 + t] = q[i] * __expf(bb); kdT[d * 68 + t] = k[i] * __expf(-bb); } }
        __syncthreads();
        const int tb = F.tid >> 5, vb = F.tid & 31;
        {
            float a[4][2];
#pragma unroll
            for (int i = 0; i < 4; ++i) { a[i][0] = 0.f; a[i][1] = 0.f; }
            for (int d = 0; d < 128; ++d) { const f32x4 qq = *(LAS const f32x4*)(qdT + d * 68 + 4 * tb); const f32x2 kk = *(LAS const f32x2*)(kdT + d * 68 + 2 * vb);
#pragma unroll
                for (int i = 0; i < 4; ++i) { a[i][0] += qq[i] * kk[0]; a[i][1] += qq[i] * kk[1]; } }
#pragma unroll
            for (int i = 0; i < 4; ++i)
#pragma unroll
                for (int j = 0; j < 2; ++j) { const int t = 4 * tb + i, s = 2 * vb + j; Am[s * 68 + t] = (s <= t) ? a[i][j] : 0.f; }
        }
        float o[4][8];
#pragma unroll
        for (int i = 0; i < 4; ++i)
#pragma unroll
            for (int j = 0; j < 8; ++j) o[i][j] = 0.f;
        { const float* S = ((float*)(ws_ + WS_GLAU)) + (size_t)u * GDK * GDV + 8 * vb;
          for (int d = 0; d < 128; ++d) { const f32x4 qq = *(LAS const f32x4*)(qdT + d * 68 + 4 * tb); const f32x4 s0 = *(const f32x4*)(S + d * 256), s1 = *(const f32x4*)(S + d * 256 + 4);
#pragma unroll
              for (int i = 0; i < 4; ++i)
#pragma unroll
                  for (int j = 0; j < 4; ++j) { o[i][j] += qq[i] * s0[j]; o[i][4 + j] += qq[i] * s1[j]; } } }
        __syncthreads();
        for (int s = 0; s < 64; ++s) { const f32x4 aa = *(LAS const f32x4*)(Am + s * 68 + 4 * tb); float vv[8]; unpack8(*(const v4u*)(((bf16*)(ws_ + WS_Z)) + (size_t)(row0 + s) * NINP + ZC_GV + h * 256 + 8 * vb), vv);
#pragma unroll
            for (int i = 0; i < 4; ++i)
#pragma unroll
                for (int j = 0; j < 8; ++j) o[i][j] += aa[i] * vv[j]; }
        float gn[8];
#pragma unroll
        for (int j = 0; j < 8; ++j) gn[j] = in_I_GNORM[l * GDV + 8 * vb + j];
#pragma unroll
        for (int i = 0; i < 4; ++i) { float ss = 0.f;
#pragma unroll
            for (int j = 0; j < 8; ++j) ss += o[i][j] * o[i][j];
#pragma unroll
            for (int x = 1; x < 32; x <<= 1) ss += __shfl_xor(ss, x);
            const float rs = rsqrtf(ss * (1.0f / 256.0f) + EPS); const int row = row0 + 4 * tb + i; float g[8], r[8]; unpack8(*(const v4u*)(((bf16*)(ws_ + WS_Z)) + (size_t)row * NINP + ZC_GR + h * 256 + 8 * vb), g);
#pragma unroll
            for (int j = 0; j < 8; ++j) r[j] = o[i][j] * rs * gn[j] * g[j] * sigm(g[j]);
            *(v4u*)(((bf16*)(ws_ + WS_BR)) + (size_t)row * MIXW + h * 256 + 8 * vb) = pack8(r); }
    }
    __syncthreads();
}

__device__ __forceinline__ void xattn_phase(const Args& A, Frame& F0, int l) {
    unsigned char* const ws_ = (unsigned char*)(GAS unsigned char*)karg64<KA_WS>();
    const float* const in_I_CMK = (const float*)(const GAS float*)karg64<8 * I_CMK>();
    const float* const in_I_CMV = (const float*)(const GAS float*)karg64<8 * I_CMV>();
    Frame F = F0; LAUNDER(F);
    LAS unsigned char* Ks = F.lds; LAS unsigned char* Vs = F.lds + 65536;
    for (int u = F.vcu; u < 128 + 128; u += F.G) {
        __syncthreads();
        if (u < 128) {
            const int b = u >> 6, h = (u >> 4) & 3, q0 = (u & 15) * 256;
            for (int i = F.tid; i < 256 * 16; i += NTHR) { const int mrow = i >> 4, c8 = i & 15; const bf16* src = ((bf16*)(ws_ + WS_MEMKV)) + ((size_t)l * 512 + b * 256 + mrow) * 1024 + h * 128 + c8 * 8;
                *(LAS v4u*)(Ks + mrow * 256 + c8 * 16) = *(const v4u*)src; *(LAS v4u*)(Vs + mrow * 256 + c8 * 16) = *(const v4u*)(src + 512); }
            __syncthreads();
            const int qi = F.tid >> 1, half = F.tid & 1, row = b * SEQ + q0 + qi;
            float q[64], o[64]; load_q64(((bf16*)(ws_ + WS_XQ)) + (size_t)row * XW + h * 128 + 64 * half, q);
#pragma unroll
            for (int i = 0; i < 64; ++i) o[i] = 0.f;
            float m = -INFINITY, ls = 0.f;
            attn_core<256, true, false>(q, Ks + half * 128, Vs + half * 128, 256, 0, nullptr, m, ls, o);
            store_o64(((bf16*)(ws_ + WS_XO)) + (size_t)row * XW + h * 128 + 64 * half, o, 1.0f / ls);
        } else {
            const int su = u - 128, b = su >> 2, h = su & 3;
            for (int i = F.tid; i < 256 * 16; i += NTHR) { const int mrow = i >> 4, c8 = i & 15; const size_t o = (((size_t)l * NBS + b) * NMEM + mrow) * XW + h * 128 + c8 * 8; float fk[8], fv[8];
                const f32x4 a0 = *(const f32x4*)(in_I_CMK + o), a1 = *(const f32x4*)(in_I_CMK + o + 4), b0 = *(const f32x4*)(in_I_CMV + o), b1 = *(const f32x4*)(in_I_CMV + o + 4);
#pragma unroll
                for (int k = 0; k < 4; ++k) { fk[k] = a0[k]; fk[4 + k] = a1[k]; fv[k] = b0[k]; fv[4 + k] = b1[k]; }
                *(LAS v4u*)(Ks + mrow * 256 + c8 * 16) = pack8(fk); *(LAS v4u*)(Vs + mrow * 256 + c8 * 16) = pack8(fv); }
            __syncthreads();
            if (F.tid < 16) {
                const int qi = F.tid >> 1, half = F.tid & 1, row = MP + b * TS + qi;
                float q[64], o[64]; load_q64(((bf16*)(ws_ + WS_XQ)) + (size_t)row * XW + h * 128 + 64 * half, q);
#pragma unroll
                for (int i = 0; i < 64; ++i) o[i] = 0.f;
                float m = -INFINITY, ls = 0.f;
                attn_core<256, true, false>(q, Ks + half * 128, Vs + half * 128, 256, 0, nullptr, m, ls, o);
                store_o64(((bf16*)(ws_ + WS_XO)) + (size_t)row * XW + h * 128 + 64 * half, o, 1.0f / ls);
            }
        }
    }
    __syncthreads();
}

__device__ __forceinline__ void ffnact_phase(const Args& A, Frame& F0, int l) {
    unsigned char* const ws_ = (unsigned char*)(GAS unsigned char*)karg64<KA_WS>();
    float* const out_ = (float*)(GAS float*)karg64<KA_OUT>();
    const float* const in_I_FCB = (const float*)(const GAS float*)karg64<8 * I_FCB>();
    const float* const in_I_FCW = (const float*)(const GAS float*)karg64<8 * I_FCW>();
    const float* const in_I_SFFN = (const float*)(const GAS float*)karg64<8 * I_SFFN>();
    Frame F = F0; LAUNDER(F);
    const float* cw = in_I_FCW + (size_t)l * 3 * DFF; const float* cbp = in_I_FCB + (size_t)l * DFF; const bf16* UG = (const bf16*)(ws_ + WS_UG); bf16* ACT = (bf16*)(ws_ + WS_ACT);
    constexpr int NG = DFF / 8;
#pragma unroll 1
    for (int idx = F.vcu * NTHR + F.tid; idx < (M / 8) * NG; idx += F.G * NTHR) {
        const int row0 = (idx / NG) * 8, c = (idx % NG) * 8; const bool smp = row0 >= MP; const int b = smp ? (row0 - MP) >> 3 : row0 >> 12, t0 = smp ? 0 : (row0 & (SEQ - 1));
        v4u gg[10], uu[8];
#pragma unroll
        for (int k = 0; k < 10; ++k) { gg[k] = (v4u){0u, 0u, 0u, 0u}; if (k >= 2 || t0 > 0) gg[k] = *(const v4u*)(UG + (size_t)(row0 + k - 2) * 2 * DFF + DFF + c); }
#pragma unroll
        for (int k = 0; k < 8; ++k) uu[k] = *(const v4u*)(UG + (size_t)(row0 + k) * 2 * DFF + c);
        float w0[8], w1[8], w2[8], cb[8];
#pragma unroll
        for (int i = 0; i < 8; ++i) { w0[i] = cw[c + i]; w1[i] = cw[DFF + c + i]; w2[i] = cw[2 * DFF + c + i]; cb[i] = cbp[c + i]; }
        float g2[8], g1[8], g0[8];
        unpack8(gg[0], g2); unpack8(gg[1], g1);
        if (smp) { const float* sp = in_I_SFFN + (((size_t)l * NBS + b) * 2) * DFF + c; const f32x4 a0 = *(const f32x4*)sp, a1 = *(const f32x4*)(sp + 4), b0 = *(const f32x4*)(sp + DFF), b1 = *(const f32x4*)(sp + DFF + 4);
#pragma unroll
            for (int i = 0; i < 4; ++i) { g2[i] = a0[i]; g2[4 + i] = a1[i]; g1[i] = b0[i]; g1[4 + i] = b1[i]; } }
#pragma unroll
        for (int k = 0; k < 8; ++k) { float uf[8], o[8]; unpack8(gg[k + 2], g0); unpack8(uu[k], uf);
#pragma unroll
            for (int i = 0; i < 8; ++i) { const float gc = w0[i] * g2[i] + w1[i] * g1[i] + w2[i] * g0[i] + cb[i]; o[i] = gc * sigm(gc) * uf[i]; }
            *(v4u*)(ACT + (size_t)(row0 + k) * DFF + c) = pack8(o);
            if (k >= 6 && (smp || t0 == SEQ - 8)) { float* dst = out_ + (smp ? O_FFNS + (((size_t)l * NBS + b) * 2 + (k - 6)) * DFF : O_FFNP + (((size_t)l * NBP + b) * 2 + (k - 6)) * DFF) + c;
                *(f32x4*)dst = (f32x4){g0[0], g0[1], g0[2], g0[3]}; *(f32x4*)(dst + 4) = (f32x4){g0[4], g0[5], g0[6], g0[7]}; }
#pragma unroll
            for (int i = 0; i < 8; ++i) { g2[i] = g1[i]; g1[i] = g0[i]; } }
    }
}

__device__ __forceinline__ void final_phase(const Args& A, Frame& F0) {
    unsigned char* const ws_ = (unsigned char*)(GAS unsigned char*)karg64<KA_WS>();
    float* const out_ = (float*)(GAS float*)karg64<KA_OUT>();
    const float* const in_I_NFIN = (const float*)(const GAS float*)karg64<8 * I_NFIN>();
    Frame F = F0; LAUNDER(F);
    const int gw = F.vcu * NWAVES + F.wave, NGW = F.G * NWAVES, lane = F.lane; const float* g = in_I_NFIN;
    for (int m = gw; m < M; m += NGW) {
        float s = (lane < 32) ? ((float*)(ws_ + WS_SSQ))[(size_t)m * 32 + lane] : 0.f; s = wave_sum(s);
        const float rs = rsqrtf(s * (1.0f / DM) + EPS);
        float* dst = out_ + ((m < MP) ? O_YP + (size_t)m * DM : O_YS + (size_t)(m - MP) * DM);
#pragma unroll
        for (int j = 0; j < 8; ++j) { const v2u o = *((const v2u*)(((const bf16*)(ws_ + WS_XB)) + (size_t)m * DM) + lane + 64 * j); const f32x4 v = (f32x4){bflo(o.x), bfhi(o.x), bflo(o.y), bfhi(o.y)};
            const f32x4 gg = *((const f32x4*)g + lane + 64 * j); *((f32x4*)dst + lane + 64 * j) = v * rs * gg; }
    }
}

__device__ __forceinline__ f32x4 sk_tile(const bf16* A, const bf16* Bt, int K, int rb, int cb, LAS float* red, int tid, int lane, int wave) {
    const int n = lane & 15, g = lane >> 4, npairs = K >> 6;
    f32x4 acc[2][4];
#pragma unroll
    for (int mt = 0; mt < 2; ++mt)
#pragma unroll
        for (int nt = 0; nt < 4; ++nt) acc[mt][nt] = (f32x4){0.f, 0.f, 0.f, 0.f};
    const bf16* ap = A + (size_t)(32 * rb + n) * K + 8 * g; const bf16* bp = Bt + (size_t)(64 * cb + n) * K + 8 * g;
#pragma unroll 2
    for (int p = wave; p < npairs; p += NWAVES) {
        bf16x8 af[2][2], bfr[4][2];
#pragma unroll
        for (int ks = 0; ks < 2; ++ks) {
#pragma unroll
            for (int mt = 0; mt < 2; ++mt) af[mt][ks] = *(const bf16x8*)(ap + (size_t)(16 * mt) * K + 64 * p + 32 * ks);
#pragma unroll
            for (int nt = 0; nt < 4; ++nt) bfr[nt][ks] = *(const bf16x8*)(bp + (size_t)(16 * nt) * K + 64 * p + 32 * ks); }
#pragma unroll
        for (int ks = 0; ks < 2; ++ks)
#pragma unroll
            for (int mt = 0; mt < 2; ++mt)
#pragma unroll
                for (int nt = 0; nt < 4; ++nt) acc[mt][nt] = MFMA16(af[mt][ks], bfr[nt][ks], acc[mt][nt]);
    }
    __syncthreads();
#pragma unroll
    for (int mt = 0; mt < 2; ++mt)
#pragma unroll
        for (int nt = 0; nt < 4; ++nt)
#pragma unroll
            for (int i = 0; i < 4; ++i) red[wave * 2048 + (16 * mt + 4 * g + i) * 64 + 16 * nt + n] = acc[mt][nt][i];
    __syncthreads();
    const int r = tid >> 4, cg = tid & 15; f32x4 s = *(LAS const f32x4*)(red + r * 64 + 4 * cg);
#pragma unroll
    for (int w = 1; w < 8; ++w) s += *(LAS const f32x4*)(red + w * 2048 + r * 64 + 4 * cg);
    return s;
}
__device__ __forceinline__ void sk_residual(const bf16* A, const bf16* Bt, int K, Frame& F0, size_t probe_off) {
    Frame F = F0; LAUNDER(F);
    unsigned char* const ws_ = (unsigned char*)(GAS unsigned char*)karg64<KA_WS>();
    const bf16* XB = (const bf16*)(ws_ + WS_XB); bf16* XBo = (bf16*)(ws_ + WS_XB + probe_off); float* SSQ = (float*)(ws_ + WS_SSQ + probe_off);
    LAS float* red = (LAS float*)F.lds;
#pragma unroll 1
    for (int u = F.vcu; u < 256; u += F.G) {
        asm volatile("" : "+v"(F.tid), "+v"(F.lane));
        const int rb = u >> 5, cb = u & 31;
        const f32x4 s = sk_tile(A, Bt, K, rb, cb, red, F.tid, F.lane, F.wave);
        const int row = MP + 32 * rb + (F.tid >> 4), col = 64 * cb + 4 * (F.tid & 15); const size_t off = (size_t)row * DM + col;
        const v2u o = *(const v2u*)(XB + off); const f32x4 x = (f32x4){bflo(o.x), bfhi(o.x), bflo(o.y), bfhi(o.y)} + s;
        v2u w; w.x = pk2(x[0], x[1]); w.y = pk2(x[2], x[3]); *(v2u*)(XBo + off) = w;
        float ss = (x[0] * x[0] + x[1] * x[1]) + (x[2] * x[2] + x[3] * x[3]);
        ss += __shfl_xor(ss, 1); ss += __shfl_xor(ss, 2); ss += __shfl_xor(ss, 4); ss += __shfl_xor(ss, 8);
        if ((F.tid & 15) == 0) SSQ[(size_t)row * 32 + cb] = ss;
    }
    __syncthreads();
}
__device__ __forceinline__ void sk_branch(Frame& F0, int l) {
    Frame F = F0; LAUNDER(F);
    unsigned char* const ws_ = (unsigned char*)(GAS unsigned char*)karg64<KA_WS>();
    const bf16* BR = (const bf16*)(ws_ + WS_BR); const bf16* Wb = (const bf16*)(ws_ + WS_WBR) + (size_t)l * 3 * DM * MIXW; const bf16* Z = (const bf16*)(ws_ + WS_Z); bf16* MG = (bf16*)(ws_ + WS_MG);
    LAS float* red = (LAS float*)F.lds;
#pragma unroll 1
    for (int u = F.vcu; u < 256; u += F.G) {
        asm volatile("" : "+v"(F.tid), "+v"(F.lane));
        const int rb = u >> 5, cb = u & 31; const int row = MP + 32 * rb + (F.tid >> 4), col = 64 * cb + 4 * (F.tid & 15);
        f32x4 mg = (f32x4){0.f, 0.f, 0.f, 0.f};
#pragma unroll 1
        for (int i = 0; i < 3; ++i) {
            const f32x4 s = sk_tile(BR + (size_t)i * M * MIXW + (size_t)MP * MIXW, Wb + (size_t)i * DM * MIXW, MIXW, rb, cb, red, F.tid, F.lane, F.wave);
            const v2u gw = *(const v2u*)(Z + (size_t)row * NINP + ZC_GATE + i * DM + col);
            mg += s * (f32x4){bflo(gw.x), bfhi(gw.x), bflo(gw.y), bfhi(gw.y)};
        }
        v2u w; w.x = pk2(mg[0], mg[1]); w.y = pk2(mg[2], mg[3]); *(v2u*)(MG + (size_t)row * DM + col) = w;
    }
    __syncthreads();
}

#ifndef PH_MASK
#define PH_MASK 0xffffffffu
#endif
#define PON(i) constexpr ((PH_MASK >> (i)) & 1u) for (int rep_ = 0; rep_ <= (int)((PROBE_MASK >> (i)) & 1u); ++rep_)
#ifndef PROBE_MASK
#define PROBE_MASK 0u
#endif
#ifndef USE_MFMA
#define USE_MFMA 7
#endif
#ifndef MK_PER_PHASE
#define MK_PER_PHASE 0
#endif
constexpr int PH_PER_LAYER = 12, N_PHASES = 1 + DEPTH * PH_PER_LAYER + 1;

__global__ void __launch_bounds__(NTHR, 2) fwd(const Args A) {
    extern __shared__ __attribute__((aligned(16))) unsigned char lds[];
    Frame F;
    F.lds = (LAS unsigned char*)lds;
    F.MISC = (volatile LAS unsigned*)(F.lds + MISC_OFF);
    F.wave = __builtin_amdgcn_readfirstlane((int)threadIdx.x >> 6); F.lane = 0; F.tid = 0;
    F.G = gridDim.x; { const int bx = blockIdx.x; F.vcu = (F.G % 8 == 0) ? (bx % 8) * (F.G / 8) + bx / 8 : bx; }
    F.ctl = (gu32*)(((unsigned char*)(GAS unsigned char*)karg64<KA_WS>()) + WS_CTL);
    for (int u = F.wave * 64 + lane_id(); u < (LDS_BYTES - LDSCTL_OFF) / 4; u += NTHR) ((LAS unsigned*)(F.lds + LDSCTL_OFF))[u] = 0u;
    __syncthreads();
    XcdBarrier bar; bar.bar = (unsigned*)(F.ctl + CW_BAR); bar.x = 0; bar.st = nullptr; bar.wv = (unsigned)F.wave;
    if (!MK_PER_PHASE) bar = xcd_barrier_post((unsigned*)(F.ctl + CW_BAR), F.MISC + 8, (unsigned)F.wave);
    const int lo = karg32<KA_LO>(), hi = karg32<KA_HI>();
#define IN(k) (lo <= (k) && (k) < hi)
#define SEAM(k) do { if (IN(k) && IN((k) + 1)) xcd_barrier(bar); } while (0)
    typedef pg8::StaticOrder SO;
#define BX_ launder_s((int)blockIdx.x)
#define G_ launder_s(F.G)
    LAS unsigned char* ring = F.lds + RING_OFF;

    if (IN(0)) { if PON(0) p0_convert(A, F, 0, 0, 1, F.vcu, G_, true); }
    SEAM(0);
    for (int l = 0; l < DEPTH; ++l) {
        const int pb = 1 + l * PH_PER_LAYER;
        if (IN(pb + 0)) { if PON(2) {
            pg8::Gemm g{((bf16*)(((unsigned char*)(GAS unsigned char*)karg64<KA_WS>()) + WS_XB)), ((bf16*)(((unsigned char*)(GAS unsigned char*)karg64<KA_WS>()) + WS_WIN)) + (size_t)l * NINP * DM, M, NINP, DM}; SO S; S.init(M, NINP, G_, BX_);
            pg8::EpiScaleBf16 E{((bf16*)(((unsigned char*)(GAS unsigned char*)karg64<KA_WS>()) + WS_Z)), NINP, ((float*)(((unsigned char*)(GAS unsigned char*)karg64<KA_WS>()) + WS_SSQ)), ZC_GATE / 256, ZC_GLR / 256};
            pg8::gemm_phase<pg8::EpiScaleBf16, SO, true, true>(ring, g, S, E, F.wave * 64 + lane_id());
            {
                const int bx = BX_, cc = (bx >= 246 && G_ == 256) ? bx - 246 : ((G_ == 256) ? 256 : bx);
                pg8::Gemm g2{((bf16*)(((unsigned char*)(GAS unsigned char*)karg64<KA_WS>()) + WS_MEMB)), ((bf16*)(((unsigned char*)(GAS unsigned char*)karg64<KA_WS>()) + WS_WXKV)) + (size_t)l * 2 * XW * DM, NBP * NMEM, 2 * XW, DM}; SO S2; S2.init(NBP * NMEM, 2 * XW, G_, cc);
                pg8::EpiMemKV E2{((float*)(GAS float*)karg64<KA_OUT>()) + O_MKP + (size_t)l * NBP * NMEM * XW, ((float*)(GAS float*)karg64<KA_OUT>()) + O_MVP + (size_t)l * NBP * NMEM * XW, ((bf16*)(((unsigned char*)(GAS unsigned char*)karg64<KA_WS>()) + WS_MEMKV)) + (size_t)l * NBP * NMEM * 2 * XW};
                pg8::gemm_phase<pg8::EpiMemKV, SO, true, true>(ring, g2, S2, E2, F.wave * 64 + lane_id());
            }
        } }
        SEAM(pb + 0);
        if (IN(pb + 1)) { if PON(3) conv_phase(A, F, l); if PON(4) { if (USE_MFMA & 1) swa_phase_mfma(A, F, l); else swa_phase(A, F, l); } if PON(5) gla_pass1(A, F, l); }
        SEAM(pb + 1);
        if (IN(pb + 2)) { if PON(6) gla_pass2(A, F, l); }
        SEAM(pb + 2);
        if (IN(pb + 3)) { if PON(7) { if (USE_MFMA & 2) gla_pass3_mfma(A, F, l); else gla_pass3(A, F, l); } }
        SEAM(pb + 3);
        if (IN(pb + 4)) { if PON(8) {
            for (int i = 0; i < 3; ++i) {
                pg8::Gemm g{((bf16*)(((unsigned char*)(GAS unsigned char*)karg64<KA_WS>()) + WS_BR)) + (size_t)i * M * MIXW, ((bf16*)(((unsigned char*)(GAS unsigned char*)karg64<KA_WS>()) + WS_WBR)) + ((size_t)l * 3 + i) * DM * MIXW, MP, DM, MIXW}; SO S; S.init(MP, DM, G_, BX_);
                pg8::EpiBranch E{((bf16*)(((unsigned char*)(GAS unsigned char*)karg64<KA_WS>()) + WS_MG)), ((bf16*)(((unsigned char*)(GAS unsigned char*)karg64<KA_WS>()) + WS_Z)) + ZC_GATE + i * DM, NINP, i == 0 ? 1 : 0};
                pg8::gemm_phase<pg8::EpiBranch, SO, true, true>(ring, g, S, E, F.wave * 64 + lane_id());
            }
            sk_branch(F, l);
        } }
        SEAM(pb + 4);
        if (IN(pb + 5)) { if PON(9) {
            constexpr int PID_ = 9;
            pg8::Gemm g{((bf16*)(((unsigned char*)(GAS unsigned char*)karg64<KA_WS>()) + WS_MG)), ((bf16*)(((unsigned char*)(GAS unsigned char*)karg64<KA_WS>()) + WS_WOUT)) + (size_t)l * DM * DM, MP, DM, DM}; SO S; S.init(MP, DM, G_, BX_);
            const size_t po_ = (rep_ < (int)((PROBE_MASK >> PID_) & 1u)) ? PROBE_OFF : 0; unsigned char* wsb_ = (unsigned char*)(GAS unsigned char*)karg64<KA_WS>();
            pg8::EpiResidual E{(const bf16*)(wsb_ + WS_XB), (bf16*)(wsb_ + WS_XB + po_), (float*)(wsb_ + WS_SSQ + po_)};
            pg8::gemm_phase<pg8::EpiResidual, SO, true, true>(ring, g, S, E, F.wave * 64 + lane_id());
            sk_residual(((const bf16*)(((unsigned char*)(GAS unsigned char*)karg64<KA_WS>()) + WS_MG)) + (size_t)MP * DM, ((const bf16*)(((unsigned char*)(GAS unsigned char*)karg64<KA_WS>()) + WS_WOUT)) + (size_t)l * DM * DM, DM, F, po_);
        } }
        SEAM(pb + 5);
        if (IN(pb + 6)) { if PON(10) {
            pg8::Gemm g{((bf16*)(((unsigned char*)(GAS unsigned char*)karg64<KA_WS>()) + WS_XB)), ((bf16*)(((unsigned char*)(GAS unsigned char*)karg64<KA_WS>()) + WS_WXQ)) + (size_t)l * XW * DM, M, XW, DM}; SO S; S.init(M, XW, G_, BX_);
            pg8::EpiScaleBf16 E{((bf16*)(((unsigned char*)(GAS unsigned char*)karg64<KA_WS>()) + WS_XQ)), XW, ((float*)(((unsigned char*)(GAS unsigned char*)karg64<KA_WS>()) + WS_SSQ)), 0, 0};
            pg8::gemm_phase<pg8::EpiScaleBf16, SO, true, true>(ring, g, S, E, F.wave * 64 + lane_id());
            if (l + 1 < DEPTH) { const int bx = BX_; const bool std_ = (G_ == 256); p0_convert(A, F, l + 1, 0, 2, std_ ? ((bx >= 66) ? bx - 66 : -1) : bx, std_ ? 190 : G_, false); }
        } }
        SEAM(pb + 6);
        if (IN(pb + 7)) { if PON(11) { if (USE_MFMA & 4) xattn_phase_mfma(A, F, l); else xattn_phase(A, F, l); } }
        SEAM(pb + 7);
        if (IN(pb + 8)) { if PON(12) {
            constexpr int PID_ = 12;
            pg8::Gemm g{((bf16*)(((unsigned char*)(GAS unsigned char*)karg64<KA_WS>()) + WS_XO)), ((bf16*)(((unsigned char*)(GAS unsigned char*)karg64<KA_WS>()) + WS_WXO)) + (size_t)l * DM * XW, MP, DM, XW}; SO S; S.init(MP, DM, G_, BX_);
            const size_t po_ = (rep_ < (int)((PROBE_MASK >> PID_) & 1u)) ? PROBE_OFF : 0; unsigned char* wsb_ = (unsigned char*)(GAS unsigned char*)karg64<KA_WS>();
            pg8::EpiResidual E{(const bf16*)(wsb_ + WS_XB), (bf16*)(wsb_ + WS_XB + po_), (float*)(wsb_ + WS_SSQ + po_)};
            pg8::gemm_phase<pg8::EpiResidual, SO, true, true>(ring, g, S, E, F.wave * 64 + lane_id());
            sk_residual(((const bf16*)(((unsigned char*)(GAS unsigned char*)karg64<KA_WS>()) + WS_XO)) + (size_t)MP * XW, ((const bf16*)(((unsigned char*)(GAS unsigned char*)karg64<KA_WS>()) + WS_WXO)) + (size_t)l * DM * XW, XW, F, po_);
        } }
        SEAM(pb + 8);
        if (IN(pb + 9)) { if PON(13) {
            pg8::Gemm g{((bf16*)(((unsigned char*)(GAS unsigned char*)karg64<KA_WS>()) + WS_XB)), ((bf16*)(((unsigned char*)(GAS unsigned char*)karg64<KA_WS>()) + WS_WUP)) + (size_t)l * 2 * DFF * DM, M, 2 * DFF, DM}; SO S; S.init(M, 2 * DFF, G_, BX_);
            pg8::EpiScaleBf16 E{((bf16*)(((unsigned char*)(GAS unsigned char*)karg64<KA_WS>()) + WS_UG)), 2 * DFF, ((float*)(((unsigned char*)(GAS unsigned char*)karg64<KA_WS>()) + WS_SSQ)), 0, 0};
            pg8::gemm_phase<pg8::EpiScaleBf16, SO, true, true>(ring, g, S, E, F.wave * 64 + lane_id());
            if (l + 1 < DEPTH) { const int bx = BX_; const bool std_ = (G_ == 256); p0_convert(A, F, l + 1, 1, 2, std_ ? ((bx >= 139) ? bx - 139 : -1) : bx, std_ ? 117 : G_, false); }
        } }
        SEAM(pb + 9);
        if (IN(pb + 10)) { if PON(14) ffnact_phase(A, F, l); }
        SEAM(pb + 10);
        if (IN(pb + 11)) { if PON(15) {
            constexpr int PID_ = 15;
            pg8::Gemm g{((bf16*)(((unsigned char*)(GAS unsigned char*)karg64<KA_WS>()) + WS_ACT)), ((bf16*)(((unsigned char*)(GAS unsigned char*)karg64<KA_WS>()) + WS_WDN)) + (size_t)l * DM * DFF, MP, DM, DFF}; SO S; S.init(MP, DM, G_, BX_);
            const size_t po_ = (rep_ < (int)((PROBE_MASK >> PID_) & 1u)) ? PROBE_OFF : 0; unsigned char* wsb_ = (unsigned char*)(GAS unsigned char*)karg64<KA_WS>();
            pg8::EpiResidual E{(const bf16*)(wsb_ + WS_XB), (bf16*)(wsb_ + WS_XB + po_), (float*)(wsb_ + WS_SSQ + po_)};
            pg8::gemm_phase<pg8::EpiResidual, SO, true, true>(ring, g, S, E, F.wave * 64 + lane_id());
            sk_residual(((const bf16*)(((unsigned char*)(GAS unsigned char*)karg64<KA_WS>()) + WS_ACT)) + (size_t)MP * DFF, ((const bf16*)(((unsigned char*)(GAS unsigned char*)karg64<KA_WS>()) + WS_WDN)) + (size_t)l * DM * DFF, DFF, F, po_);
        } }
        SEAM(pb + 11);
    }
    if (IN(N_PHASES - 1)) { if PON(16) final_phase(A, F); }
#undef IN
#undef SEAM
}

extern "C" void kernel_launch(void* const* d_in, const int* in_sizes, int n_in, void* d_out, int out_size, void* d_ws, size_t ws_size, hipStream_t stream) {
    static int grid = 0;
    if (grid == 0) {
        if (n_in != N_INPUTS || (size_t)out_size != O_END || ws_size < WS_END2) { fprintf(stderr, "kernel_launch: built for %d inputs, %zu outputs, >= %zu bytes of workspace; got n_in %d, out %d, ws %zu; nothing launched\n", N_INPUTS, (size_t)O_END, (size_t)WS_END, n_in, out_size, ws_size); grid = -1; return; }
        int dev = 0, cus = 0, per_cu = 0;
        if (hipGetDevice(&dev) != hipSuccess || hipDeviceGetAttribute(&cus, hipDeviceAttributeMultiprocessorCount, dev) != hipSuccess) { fprintf(stderr, "kernel_launch: device query failed\n"); grid = -1; return; }
        if (hipFuncSetAttribute((const void*)fwd, hipFuncAttributeMaxDynamicSharedMemorySize, LDS_BYTES) != hipSuccess) { fprintf(stderr, "kernel_launch: hipFuncSetAttribute failed\n"); grid = -1; return; }
        if (hipOccupancyMaxActiveBlocksPerMultiprocessor(&per_cu, (const void*)fwd, NTHR, LDS_BYTES) != hipSuccess || per_cu < 1) { fprintf(stderr, "kernel_launch: occupancy query reports %d workgroups per CU\n", per_cu); }
        (void)hipGetLastError();
        grid = cus;
    }
    if (grid < 0) return;
    if (hipMemsetAsync((char*)d_ws + WS_CTL, 0, CTL_ZERO_BYTES, stream) != hipSuccess) { fprintf(stderr, "kernel_launch: memset failed\n"); return; }
    Args a{};
    for (int i = 0; i < N_INPUTS; ++i) a.in[i] = (const float*)d_in[i];
    a.out = (float*)d_out; a.ws = (unsigned char*)d_ws;
#if MK_PER_PHASE
    for (int p = 0; p < N_PHASES; ++p) {
        a.ph_lo = p; a.ph_hi = p + 1;
        hipLaunchKernelGGL(fwd, dim3(grid), dim3(NTHR), LDS_BYTES, stream, a);
    }
#else
    a.ph_lo = 0; a.ph_hi = N_PHASES;
    hipLaunchKernelGGL(fwd, dim3(grid), dim3(NTHR), LDS_BYTES, stream, a);
#endif
    const hipError_t le = hipPeekAtLastError();
    if (le != hipSuccess) fprintf(stderr, "kernel_launch: launch failed: %s\n", hipGetErrorName(le));
}
```
